# Optimizing an MI355X kernel written in HIP

```python
import jax, jax.numpy as jnp
from jax import lax
import numpy as np

D_MODEL = 1024
BATCH = 16
SEQ = 4096
DEPTH = 4

N_MIXERS = 4
EPS = 1e-6
D_FF = 4 * D_MODEL

A_CHUNK = 128
A_GROUPS = 8
A_WIDTH = D_MODEL
A_GDIM = A_WIDTH // A_GROUPS

B_WIDTH = D_MODEL
B_KSIZE = 3

C_WINDOWS = (2, 4, 8, 16)
C_GROUPS = len(C_WINDOWS)
C_GDIM = D_MODEL // C_GROUPS

D_HEADS = 16
D_LAT = 128
D_VDIM = D_MODEL // D_HEADS
D_IDX_HEADS = 8
D_IDX_DIM = 64
D_TOPK_MAX = 256
D_QBLOCK = 128
D_SPLITS = (D_HEADS * D_LAT,
            D_HEADS * D_LAT + D_LAT,
            D_HEADS * D_LAT + D_LAT + D_IDX_HEADS * D_IDX_DIM,
            D_HEADS * D_LAT + D_LAT + D_IDX_HEADS * D_IDX_DIM + D_IDX_DIM)
D_IN_COLS = D_SPLITS[-1] + D_IDX_HEADS

kernel_name = "hybrid_interleaved_sgu_conv_pool_dsa"


def _type_counts():
    return [sum(1 for i in range(DEPTH) if i % N_MIXERS == m) for m in range(N_MIXERS)]


def rmsnorm(x, g):
    xf = x.astype(jnp.float32)
    y = xf * lax.rsqrt(jnp.mean(xf * xf, axis=-1, keepdims=True) + EPS)
    return (y * g.astype(jnp.float32)).astype(x.dtype)


def mixer_chunked_sgu(h, w_in, v_g, w_s, b_s, w_out):
    bsz, L, _ = h.shape
    z = jax.nn.gelu(h @ w_in)
    u, v = jnp.split(z, 2, axis=-1)
    v = rmsnorm(v, v_g)
    n = L // A_CHUNK
    v = v.reshape(bsz, n, A_CHUNK, A_GROUPS, A_GDIM)
    causal = jnp.tril(jnp.ones((A_CHUNK, A_CHUNK), dtype=bool))
    ws = jnp.where(causal[None], w_s, jnp.zeros_like(w_s)).astype(v.dtype)
    s = jnp.einsum('gts,bnsgc->bntgc', ws, v) + b_s.T.astype(v.dtype)[None, None, :, :, None]
    s = s.reshape(bsz, L, A_WIDTH)
    return (u * s) @ w_out


def mixer_short_conv(h, w_in, conv_w, w_out):
    bg, cg, hv = jnp.split(h @ w_in, 3, axis=-1)
    z = cg * hv
    y = lax.conv_general_dilated(z, conv_w.astype(z.dtype), window_strides=(1,),
                                 padding=[(B_KSIZE - 1, 0)],
                                 dimension_numbers=('NWC', 'WIO', 'NWC'),
                                 feature_group_count=B_WIDTH)
    return (bg * y) @ w_out


def mixer_multiscale_pool(h, w_in, w_grp, scale):
    bsz, L, _ = h.shape
    z = h @ w_in
    zf = z.astype(jnp.float32).reshape(bsz, L, C_GROUPS, C_GDIM)
    cs = jnp.cumsum(zf, axis=1)
    cs = jnp.concatenate([jnp.zeros_like(cs[:, :1]), cs], axis=1)
    t = jnp.arange(L)
    pooled = []
    for g, w in enumerate(C_WINDOWS):
        lo = jnp.maximum(t + 1 - w, 0)
        seg = cs[:, 1:, g] - cs[:, lo, g]
        cnt = (t + 1 - lo).astype(jnp.float32)
        pooled.append(seg / cnt[None, :, None])
    pooled = jnp.stack(pooled, axis=2) - zf
    y = jnp.einsum('blgc,gcd->blgd', pooled.astype(z.dtype), w_grp)
    return y.reshape(bsz, L, D_MODEL) * scale


def mixer_dsa(h, w_in, kv_g, w_uv, w_out):
    bsz, L, _ = h.shape
    topk = min(D_TOPK_MAX, L // 4)
    q, c, qi, ki, wi = jnp.split(h @ w_in, list(D_SPLITS), axis=-1)
    q = q.reshape(bsz, L, D_HEADS, D_LAT)
    c = rmsnorm(c, kv_g)
    qi = qi.reshape(bsz, L, D_IDX_HEADS, D_IDX_DIM)
    wi = wi * (D_IDX_HEADS ** -0.5 * D_IDX_DIM ** -0.5)
    n_blk = L // D_QBLOCK
    key_pos = jnp.arange(L)

    def to_blocks(a):
        return a.reshape(bsz, n_blk, D_QBLOCK, *a.shape[2:]).swapaxes(0, 1)

    def block(args):
        qb, qib, wib, blk = args
        qpos = blk * D_QBLOCK + jnp.arange(D_QBLOCK)
        logits = jnp.einsum('bthd,bsd->bths', qib, ki)
        score = jnp.einsum('bths,bth->bts', jax.nn.relu(logits).astype(jnp.float32),
                           wib.astype(jnp.float32))
        causal = key_pos[None, :] <= qpos[:, None]
        score = jnp.where(causal[None], score, -jnp.inf)
        _, idx = lax.top_k(score, topk)
        kv_sel = jax.vmap(lambda cb, ib: cb[ib])(c, idx)
        valid = idx <= qpos[None, :, None]
        att = jnp.einsum('bthd,btkd->bthk', qb, kv_sel).astype(jnp.float32) * (D_LAT ** -0.5)
        att = jnp.where(valid[:, :, None, :], att, -jnp.inf)
        p = jax.nn.softmax(att, axis=-1).astype(c.dtype)
        return jnp.einsum('bthk,btkd->bthd', p, kv_sel)

    o = lax.map(block, (to_blocks(q), to_blocks(qi), to_blocks(wi), jnp.arange(n_blk)))
    o = o.swapaxes(0, 1).reshape(bsz, L, D_HEADS, D_LAT)
    o = jnp.einsum('blhc,hcv->blhv', o, w_uv).reshape(bsz, L, D_HEADS * D_VDIM)
    return o @ w_out


def channel_mlp(h, w1, w2):
    a = jax.nn.relu(h @ w1)
    return (a * a) @ w2


def setup_inputs(seed: int = 0) -> dict:
    key = jax.random.key(seed)
    ks = iter(jax.random.split(key, 32))
    nA, nB, nC, nD = _type_counts()
    f32 = jnp.float32

    def nrm(shape, scale):
        return jax.random.normal(next(ks), shape, f32) * scale

    def gain(shape):
        return 1.0 + 0.02 * jax.random.normal(next(ks), shape, f32)

    return {
        "x": jax.random.normal(next(ks), (BATCH, SEQ, D_MODEL), f32),
        "norm_mix_g": gain((DEPTH, D_MODEL)),
        "norm_mlp_g": gain((DEPTH, D_MODEL)),
        "final_g": gain((D_MODEL,)),
        "a_w_in": nrm((nA, D_MODEL, 2 * A_WIDTH), D_MODEL ** -0.5),
        "a_v_g": gain((nA, A_WIDTH)),
        "a_w_s": nrm((nA, A_GROUPS, A_CHUNK, A_CHUNK), A_CHUNK ** -0.5),
        "a_b_s": gain((nA, A_GROUPS, A_CHUNK)),
        "a_w_out": nrm((nA, A_WIDTH, D_MODEL), A_WIDTH ** -0.5),
        "b_w_in": nrm((nB, D_MODEL, 3 * B_WIDTH), D_MODEL ** -0.5),
        "b_conv_w": nrm((nB, B_KSIZE, 1, B_WIDTH), B_KSIZE ** -0.5),
        "b_w_out": nrm((nB, B_WIDTH, D_MODEL), B_WIDTH ** -0.5),
        "c_w_in": nrm((nC, D_MODEL, D_MODEL), D_MODEL ** -0.5),
        "c_w_grp": nrm((nC, C_GROUPS, C_GDIM, C_GDIM), C_GDIM ** -0.5),
        "c_scale": gain((nC, D_MODEL)),
        "d_w_in": nrm((nD, D_MODEL, D_IN_COLS), D_MODEL ** -0.5),
        "d_kv_g": gain((nD, D_LAT)),
        "d_w_uv": nrm((nD, D_HEADS, D_LAT, D_VDIM), D_LAT ** -0.5),
        "d_w_out": nrm((nD, D_HEADS * D_VDIM, D_MODEL), (D_HEADS * D_VDIM) ** -0.5),
        "mlp_w1": nrm((DEPTH, D_MODEL, D_FF), D_MODEL ** -0.5),
        "mlp_w2": nrm((DEPTH, D_FF, D_MODEL), D_FF ** -0.5),
    }


def reference(x, norm_mix_g, norm_mlp_g, final_g, a_w_in, a_v_g, a_w_s, a_b_s, a_w_out,
              b_w_in, b_conv_w, b_w_out, c_w_in, c_w_grp, c_scale,
              d_w_in, d_kv_g, d_w_uv, d_w_out, mlp_w1, mlp_w2):
    for i in range(DEPTH):
        m, j = i % N_MIXERS, i // N_MIXERS
        h = rmsnorm(x, norm_mix_g[i])
        if m == 0:
            y = mixer_chunked_sgu(h, a_w_in[j], a_v_g[j], a_w_s[j], a_b_s[j], a_w_out[j])
        elif m == 1:
            y = mixer_short_conv(h, b_w_in[j], b_conv_w[j], b_w_out[j])
        elif m == 2:
            y = mixer_multiscale_pool(h, c_w_in[j], c_w_grp[j], c_scale[j])
        else:
            y = mixer_dsa(h, d_w_in[j], d_kv_g[j], d_w_uv[j], d_w_out[j])
        x = x + y
        x = x + channel_mlp(rmsnorm(x, norm_mlp_g[i]), mlp_w1[i], mlp_w2[i])
    return rmsnorm(x, final_g)
```

```cpp
#include <hip/hip_runtime.h>
#include <hip/hip_cooperative_groups.h>
#include <cstdio>
namespace cg = cooperative_groups;

#define LAS __attribute__((address_space(3)))
typedef unsigned short bf16_t;
typedef short bf16x8 __attribute__((ext_vector_type(8)));
typedef float f32x4 __attribute__((ext_vector_type(4)));
typedef float f32x2 __attribute__((ext_vector_type(2)));
typedef unsigned u32x4 __attribute__((ext_vector_type(4)));
typedef unsigned u32x2 __attribute__((ext_vector_type(2)));
typedef unsigned short u16x4 __attribute__((ext_vector_type(4)));

constexpr int MTOK = 65536, DM = 1024, SEQ = 4096;
constexpr size_t MiB = 1ull << 20;
constexpr size_t WS_XB = 0;
constexpr size_t WS_BIG = 128 * MiB;
constexpr size_t WS_CN = 640 * MiB;
constexpr size_t WS_IDX = 656 * MiB;
constexpr size_t WS_SS = 800 * MiB;
constexpr size_t WS_W = 692 * MiB;
constexpr size_t W_A_IN = WS_W + 0 * MiB, W_A_OUT = WS_W + 4 * MiB, W_A_S = WS_W + 6 * MiB, W_B_IN = WS_W + 7 * MiB, W_B_OUT = WS_W + 13 * MiB,
                 W_C_IN = WS_W + 15 * MiB, W_C_GRP = WS_W + 17 * MiB, W_D_IN = WS_W + 18 * MiB, W_D_COMB = WS_W + 24 * MiB, W_1 = WS_W + 28 * MiB, W_2 = WS_W + 60 * MiB;
constexpr int DSA_LD = 2816;
constexpr int LDS_BYTES = 131072 + 1024;
constexpr int NPHASE = 23;

struct Params {
    const float *x, *norm_mix_g, *norm_mlp_g, *final_g, *a_w_in, *a_v_g, *a_w_s, *a_b_s, *a_w_out, *b_w_in, *b_conv_w, *b_w_out, *c_w_in, *c_w_grp, *c_scale,
        *d_w_in, *d_kv_g, *d_w_uv, *d_w_out, *mlp_w1, *mlp_w2;
    float* out; unsigned char* ws; int ph_lo, ph_hi;
};

__device__ __forceinline__ unsigned cvt_pk_bf16(float lo, float hi) { unsigned r; asm volatile("v_cvt_pk_bf16_f32 %0, %1, %2" : "=v"(r) : "v"(lo), "v"(hi)); return r; }
__device__ __forceinline__ int opaque_tid() { int t = threadIdx.x; asm volatile("" : "+v"(t)); return t; }
__device__ __forceinline__ float bflo(unsigned w) { return __uint_as_float(w << 16); }
__device__ __forceinline__ float bfhi(unsigned w) { return __uint_as_float(w & 0xffff0000u); }
__device__ __forceinline__ float wave_sum(float v) {
#pragma unroll
    for (int o = 32; o; o >>= 1) v += __shfl_xor(v, o);
    return v;
}
__device__ __forceinline__ float sum16(const float* p) { const f32x4 a = *(const f32x4*)p, b = *(const f32x4*)(p + 4), c = *(const f32x4*)(p + 8), d = *(const f32x4*)(p + 12);
    return (((a[0] + a[1]) + (a[2] + a[3])) + ((b[0] + b[1]) + (b[2] + b[3]))) + (((c[0] + c[1]) + (c[2] + c[3])) + ((d[0] + d[1]) + (d[2] + d[3]))); }
__device__ __forceinline__ unsigned off_b(unsigned row, unsigned ch) { return 256u * row + 16u * (ch ^ (((row & 3) << 2) | ((row >> 2) & 3))); }
__device__ __forceinline__ bf16x8 tr_read2(unsigned a0, unsigned a1) {
    u16x4 lo, hi;
    asm volatile("ds_read_b64_tr_b16 %0, %2\n\tds_read_b64_tr_b16 %1, %3\n\ts_waitcnt lgkmcnt(0)" : "=&v"(lo), "=&v"(hi) : "v"(a0), "v"(a1) : "memory");
    bf16x8 r; r[0] = (short)lo[0]; r[1] = (short)lo[1]; r[2] = (short)lo[2]; r[3] = (short)lo[3]; r[4] = (short)hi[0]; r[5] = (short)hi[1]; r[6] = (short)hi[2]; r[7] = (short)hi[3];
    return r;
}

namespace pg8 {
constexpr int BM = 256, BK = 64, HALF = 128, HTB = HALF * BK * 2, STAGE_BYTES = 8 * HTB, NXCD = 8, WGM = 8;
__device__ __forceinline__ int lds_byte(int r, int c) { const int st = (r >> 4) * 2 + (c >> 5), rr = r & 15, cc = c & 31, ob = rr * 64 + cc * 2; return st * 1024 + (ob ^ (((ob >> 9) & 1) << 5)); }
__device__ __forceinline__ void stage_rc(int b, int& R, int& C) { const int st = b / 1024, sb = b % 1024, swz = sb ^ (((sb >> 9) & 1) << 5); R = (st >> 1) * 16 + swz / 64; C = (st & 1) * 32 + (swz % 64) / 2; }
__device__ __forceinline__ int perm32(int rho) { const int n = rho >> 4, i = rho & 15; return 8 * (i >> 2) + 4 * n + (i & 3); }
struct Unit { int pm, pn; };
struct Gemm { const bf16_t* A; const bf16_t* Bt; int M, N, K, lda, apn; };
struct StaticOrder {
    int nM, nN, nwg, G, c;
    __device__ void init(int M, int N, int G_, int c_) { nM = M / BM; nN = N / BM; nwg = nM * nN; G = G_; c = c_; }
    __device__ bool next(int i, Unit& u) const {
        const long L = (long)i * G + c; if (L >= nwg) return false;
        int wgid = (int)L; { const int q = nwg / NXCD, r = nwg % NXCD, xcd = wgid % NXCD, off = wgid / NXCD; wgid = (xcd < r ? xcd * (q + 1) : r * (q + 1) + (xcd - r) * q) + off; }
        const int nig = WGM * nN, gid = wgid / nig, fm = gid * WGM, gsz = (nM - fm) < WGM ? (nM - fm) : WGM;
        u.pm = fm + ((wgid % nig) % gsz); u.pn = (wgid % nig) / gsz; return true;
    }
};

__device__ __forceinline__ float gelu_tanh(float x) {
    const float y = 0.7978845608f * (x + 0.044715f * x * x * x);
    const float e = __builtin_amdgcn_exp2f(-2.885390082f * y);
    return x * __builtin_amdgcn_rcpf(1.0f + e);
}
struct EpiAct {
    static constexpr bool PERM = true;
    bf16_t* O; int ldc; const float* ss_in; float* ssv; int ACT;
    __device__ __forceinline__ void operator()(const f32x4 (&acc)[2][2][4][2], const Unit& u, int wr, int wc, int fr, int fq) const {
        const int row0 = u.pm * BM + wr * 64 + fr, col0 = u.pn * BM + wc * 32 + 8 * fq;
#pragma unroll
        for (int ai = 0; ai < 2; ++ai)
#pragma unroll
            for (int m = 0; m < 4; ++m) {
                const int row = row0 + ai * HALF + m * 16;
                const float rs = rsqrtf(sum16(ss_in + (size_t)row * 16) * (1.0f / 1024.0f) + 1e-6f);
                bf16_t* rowp = O + (size_t)row * ldc + col0; float sq = 0.f;
#pragma unroll
                for (int bj = 0; bj < 2; ++bj) {
                    f32x4 v0 = acc[ai][bj][m][0] * rs, v1 = acc[ai][bj][m][1] * rs;
                    if (ACT == 1) {
#pragma unroll
                        for (int j = 0; j < 4; ++j) { v0[j] = gelu_tanh(v0[j]); v1[j] = gelu_tanh(v1[j]); sq += v0[j] * v0[j] + v1[j] * v1[j]; }
                    }
                    if (ACT == 2) {
#pragma unroll
                        for (int j = 0; j < 4; ++j) { const float a = fmaxf(v0[j], 0.f), b = fmaxf(v1[j], 0.f); v0[j] = a * a; v1[j] = b * b; }
                    }
                    u32x4 w; w.x = cvt_pk_bf16(v0[0], v0[1]); w.y = cvt_pk_bf16(v0[2], v0[3]); w.z = cvt_pk_bf16(v1[0], v1[1]); w.w = cvt_pk_bf16(v1[2], v1[3]);
                    *(u32x4*)(rowp + bj * HALF) = w;
                }
                if (ACT == 1) {
                    sq += __shfl_xor(sq, 16); sq += __shfl_xor(sq, 32);
                    if (u.pn >= 4 && fq == 0) ssv[(size_t)row * 16 + (u.pn - 4) * 4 + wc] = sq;
                }
            }
    }
};
struct EpiResid {
    static constexpr bool PERM = false;
    const float* xin; float* xout; bf16_t* xb; float* ss_out;
    __device__ __forceinline__ void operator()(const f32x4 (&acc)[2][2][4][2], const Unit& u, int wr, int wc, int fr, int fq) const {
        const int row0 = u.pm * BM + wr * 64 + fr, col0 = u.pn * BM + wc * 32 + 4 * fq;
#pragma unroll
        for (int ai = 0; ai < 2; ++ai)
#pragma unroll
            for (int m = 0; m < 4; ++m) {
                const int row = row0 + ai * HALF + m * 16; const size_t off = (size_t)row * DM + col0; float sq = 0.f;
#pragma unroll
                for (int bj = 0; bj < 2; ++bj)
#pragma unroll
                    for (int n = 0; n < 2; ++n) {
                        const f32x4 xo = *(const f32x4*)(xin + off + bj * HALF + n * 16); const f32x4 v = xo + acc[ai][bj][m][n];
                        *(f32x4*)(xout + off + bj * HALF + n * 16) = v;
                        u32x2 w; w.x = cvt_pk_bf16(v[0], v[1]); w.y = cvt_pk_bf16(v[2], v[3]); *(u32x2*)(xb + off + bj * HALF + n * 16) = w;
                        sq += (v[0] * v[0] + v[1] * v[1]) + (v[2] * v[2] + v[3] * v[3]);
                    }
                sq += __shfl_xor(sq, 16); sq += __shfl_xor(sq, 32);
                if (fq == 0) ss_out[(size_t)row * 16 + u.pn * 4 + wc] = sq;
                asm volatile("" ::: "memory");
            }
    }
};

template <class Epi>
__device__ __forceinline__ void gemm_phase(LAS unsigned char* lds, const Gemm g, const StaticOrder& S, const Epi& E) {
    const int tid = opaque_tid(), wid = __builtin_amdgcn_readfirstlane(tid >> 6), lane = tid & 63, wr = wid >> 2, wc = wid & 3, fr = lane & 15, fq = lane >> 4;
    const int K = g.K, nt = K / BK, lda = g.lda;
    unsigned voffA[2], voffB[2];
#pragma unroll
    for (int i = 0; i < 2; ++i) { int R, C; stage_rc(tid * 16 + i * 8192, R, C); const int Rb = Epi::PERM ? ((R & ~31) + perm32(R & 31)) : R;
        voffA[i] = (unsigned)(R * lda + C) * 2u; voffB[i] = (unsigned)(Rb * K + C) * 2u; }
    const size_t kstep = (size_t)(BK * 2);
    const size_t hstepA = (size_t)HALF * lda * 2, hstepB = (size_t)HALF * K * 2;
    const size_t tstepA = 2 * hstepA, tstepB = 2 * hstepB;
    const unsigned ldsw = (unsigned)wid * 1024u;
    const int aoff = lds_byte(wr * 64 + fr, fq * 8), boff = lds_byte(wc * 32 + fr, fq * 8);
#define PG8_SA(b, h) (((b) * 2 + (h)) * HTB)
#define PG8_SB(b, h) ((4 + (b) * 2 + (h)) * HTB)
#define PG8_STAGE(bufoff, gbase, voff) do { _Pragma("unroll") for (int _i = 0; _i < 2; ++_i) \
        __builtin_amdgcn_global_load_lds((const unsigned*)((const char*)(gbase) + (voff)[_i]), (LAS unsigned*)(lds + (bufoff) + ldsw + _i * 8192), 16, 0, 0); } while (0)
#define PG8_LDA(dst, b, h) do { _Pragma("unroll") for (int m = 0; m < 4; ++m) _Pragma("unroll") for (int k = 0; k < 2; ++k) dst[m][k] = *(const LAS bf16x8*)(lds + PG8_SA(b, h) + aoff + m * 2048 + k * 1024); } while (0)
#define PG8_LDB(dst, b, h) do { _Pragma("unroll") for (int n = 0; n < 2; ++n) _Pragma("unroll") for (int k = 0; k < 2; ++k) dst[n][k] = *(const LAS bf16x8*)(lds + PG8_SB(b, h) + boff + n * 2048 + k * 1024); } while (0)
#define PG8_MMA(ai, bj, At, Bt) do { __builtin_amdgcn_s_setprio(1); _Pragma("unroll") for (int m = 0; m < 4; ++m) _Pragma("unroll") for (int n = 0; n < 2; ++n) _Pragma("unroll") for (int k = 0; k < 2; ++k) \
        acc[ai][bj][m][n] = __builtin_amdgcn_mfma_f32_16x16x32_bf16(Bt[n][k], At[m][k], acc[ai][bj][m][n], 0, 0, 0); __builtin_amdgcn_s_setprio(0); } while (0)
#define PG8_WAIT_V(n) asm volatile("s_waitcnt vmcnt(" #n ")" ::: "memory")
#define PG8_WAIT_L(n) asm volatile("s_waitcnt lgkmcnt(" #n ")" ::: "memory")
#define PG8_BAR __builtin_amdgcn_s_barrier()
#define PG8_SCHED __builtin_amdgcn_sched_barrier(0)
    Unit cur, nxt; int ui = 0;
    if (!S.next(0, cur)) return;
    f32x4 acc[2][2][4][2];
#pragma unroll
    for (int a = 0; a < 2; ++a)
#pragma unroll
        for (int b = 0; b < 2; ++b)
#pragma unroll
            for (int m = 0; m < 4; ++m)
#pragma unroll
                for (int n = 0; n < 2; ++n) acc[a][b][m][n] = (f32x4){0.f, 0.f, 0.f, 0.f};
    bf16x8 At[4][2], B0[2][2], B1[2][2];
    const char* cA = (const char*)g.A + (size_t)cur.pm * tstepA + (size_t)cur.pn * g.apn; const char* cB = (const char*)g.Bt + (size_t)cur.pn * tstepB;
    PG8_STAGE(PG8_SB(0, 0), cB, voffB); PG8_STAGE(PG8_SA(0, 0), cA, voffA); PG8_STAGE(PG8_SB(0, 1), cB + hstepB, voffB); PG8_STAGE(PG8_SA(0, 1), cA + hstepA, voffA);
    if (wr == 1) PG8_BAR;
    PG8_WAIT_V(4); PG8_BAR;
    PG8_STAGE(PG8_SB(1, 0), cB + kstep, voffB); PG8_STAGE(PG8_SA(1, 0), cA + kstep, voffA); PG8_STAGE(PG8_SB(1, 1), cB + hstepB + kstep, voffB);
    PG8_WAIT_V(6); PG8_BAR;
    for (;;) {
        const bool has_next = S.next(ui + 1, nxt);
        const char* nA = has_next ? (const char*)g.A + (size_t)nxt.pm * tstepA + (size_t)nxt.pn * g.apn : cA; const char* nB = has_next ? (const char*)g.Bt + (size_t)nxt.pn * tstepB : cB;
        for (int t = 0; t < nt; t += 2) {
            const bool last = (t == nt - 2);
            const char* a1 = cA + (size_t)(t + 1) * kstep;
            const char* a2 = last ? nA : cA + (size_t)(t + 2) * kstep; const char* b2 = last ? nB : cB + (size_t)(t + 2) * kstep;
            const char* a3 = a2 + kstep; const char* b3 = b2 + kstep;
            PG8_LDB(B0, 0, 0); PG8_SCHED; PG8_LDA(At, 0, 0); PG8_STAGE(PG8_SA(1, 1), a1 + hstepA, voffA);
            PG8_WAIT_L(8); PG8_BAR; PG8_WAIT_L(0); PG8_MMA(0, 0, At, B0); PG8_BAR; PG8_SCHED;
            PG8_LDB(B1, 0, 1); PG8_STAGE(PG8_SB(0, 0), b2, voffB);
            PG8_BAR; PG8_WAIT_L(0); PG8_MMA(0, 1, At, B1); PG8_BAR;
            PG8_LDA(At, 0, 1); PG8_STAGE(PG8_SA(0, 0), a2, voffA);
            PG8_BAR; PG8_WAIT_L(0); PG8_MMA(1, 0, At, B0); PG8_BAR; PG8_SCHED;
            PG8_STAGE(PG8_SB(0, 1), b2 + hstepB, voffB);
            PG8_WAIT_V(6); PG8_BAR; PG8_MMA(1, 1, At, B1); PG8_BAR;
            PG8_LDB(B0, 1, 0); PG8_SCHED; PG8_LDA(At, 1, 0); PG8_STAGE(PG8_SA(0, 1), a2 + hstepA, voffA);
            PG8_WAIT_L(8); PG8_BAR; PG8_WAIT_L(0); PG8_MMA(0, 0, At, B0); PG8_BAR; PG8_SCHED;
            PG8_LDB(B1, 1, 1); PG8_STAGE(PG8_SB(1, 0), b3, voffB);
            PG8_BAR; PG8_WAIT_L(0); PG8_MMA(0, 1, At, B1); PG8_BAR;
            PG8_LDA(At, 1, 1); PG8_STAGE(PG8_SA(1, 0), a3, voffA);
            PG8_BAR; PG8_WAIT_L(0); PG8_MMA(1, 0, At, B0); PG8_BAR; PG8_SCHED;
            PG8_STAGE(PG8_SB(1, 1), b3 + hstepB, voffB);
            PG8_WAIT_V(6); PG8_BAR; PG8_MMA(1, 1, At, B1); PG8_BAR;
        }
        E(acc, cur, wr, wc, fr, fq);
        if (!has_next) break;
#pragma unroll
        for (int a = 0; a < 2; ++a)
#pragma unroll
            for (int b = 0; b < 2; ++b)
#pragma unroll
                for (int m = 0; m < 4; ++m)
#pragma unroll
                    for (int n = 0; n < 2; ++n) acc[a][b][m][n] = (f32x4){0.f, 0.f, 0.f, 0.f};
        cur = nxt; cA = nA; cB = nB; ++ui;
    }
    PG8_WAIT_V(0);
    if (wr == 0) PG8_BAR;
    PG8_BAR;
#undef PG8_SA
#undef PG8_SB
#undef PG8_STAGE
#undef PG8_LDA
#undef PG8_LDB
#undef PG8_MMA
#undef PG8_WAIT_V
#undef PG8_WAIT_L
#undef PG8_BAR
#undef PG8_SCHED
}
}

__device__ void transpose_convert(LAS float* tile, const float* W, int K, int N, int Npad, bf16_t* Wt, int ldt, const float* rowgain, const float* colgain) {
    const int tid = opaque_tid(), tk = K / 64, tn = Npad / 64;
    for (int t = blockIdx.x; t < tk * tn; t += gridDim.x) {
        const int k0 = (t % tk) * 64, n0 = (t / tk) * 64;
#pragma unroll
        for (int i = 0; i < 8; ++i) {
            const int e = tid + 512 * i, kk = e >> 6, nn = e & 63, n = n0 + nn; float v = 0.f;
            if (n < N) { v = W[(size_t)(k0 + kk) * N + n]; if (rowgain) v *= rowgain[k0 + kk]; if (colgain) v *= colgain[n]; }
            tile[nn * 65 + kk] = v;
        }
        __syncthreads();
#pragma unroll
        for (int i = 0; i < 8; ++i) {
            const int e = tid + 512 * i, nn = e >> 6, kk = e & 63;
            Wt[(size_t)(n0 + nn) * ldt + k0 + kk] = (bf16_t)(cvt_pk_bf16(tile[nn * 65 + kk], 0.f) & 0xffffu);
        }
        __syncthreads();
    }
}

__device__ void phase_prologue(const Params& p, LAS unsigned char* lds) {
    unsigned char* ws = p.ws; LAS float* tile = (LAS float*)lds;
    const int tid = opaque_tid(), lane = tid & 63, wave = tid >> 6;
    const size_t gtid = (size_t)blockIdx.x * 512 + tid, gsz = (size_t)gridDim.x * 512;
    float* ss = (float*)(ws + WS_SS);
    bf16_t* xb = (bf16_t*)(ws + WS_XB);
    for (int row = blockIdx.x * 8 + wave; row < MTOK; row += gridDim.x * 8) {
        const f32x4* xr = (const f32x4*)(p.x + (size_t)row * DM); float sq = 0.f;
#pragma unroll
        for (int i = 0; i < 4; ++i) { const f32x4 v = xr[lane + 64 * i]; sq += (v[0] * v[0] + v[1] * v[1]) + (v[2] * v[2] + v[3] * v[3]);
            u32x2 w; w.x = cvt_pk_bf16(v[0], v[1]); w.y = cvt_pk_bf16(v[2], v[3]); *(u32x2*)(xb + (size_t)row * DM + (lane + 64 * i) * 4) = w; }
        sq = wave_sum(sq);
        if (lane < 16) ss[(size_t)row * 16 + lane] = lane == 0 ? sq : 0.f;
    }
    transpose_convert(tile, p.a_w_in, 1024, 2048, 2048, (bf16_t*)(ws + W_A_IN), 1024, p.norm_mix_g + 0 * DM, nullptr);
    transpose_convert(tile, p.a_w_out, 1024, 1024, 1024, (bf16_t*)(ws + W_A_OUT), 1024, nullptr, nullptr);
    transpose_convert(tile, p.b_w_in, 1024, 3072, 3072, (bf16_t*)(ws + W_B_IN), 1024, p.norm_mix_g + 1 * DM, nullptr);
    transpose_convert(tile, p.b_w_out, 1024, 1024, 1024, (bf16_t*)(ws + W_B_OUT), 1024, nullptr, nullptr);
    transpose_convert(tile, p.c_w_in, 1024, 1024, 1024, (bf16_t*)(ws + W_C_IN), 1024, p.norm_mix_g + 2 * DM, nullptr);
    for (int g = 0; g < 4; ++g)
        transpose_convert(tile, p.c_w_grp + (size_t)g * 65536, 256, 256, 256, (bf16_t*)(ws + W_C_GRP) + (size_t)g * 65536, 256, nullptr, p.c_scale + g * 256);
    transpose_convert(tile, p.d_w_in, 1024, 2760, DSA_LD, (bf16_t*)(ws + W_D_IN), 1024, p.norm_mix_g + 3 * DM, nullptr);
    for (int l = 0; l < 4; ++l) {
        transpose_convert(tile, p.mlp_w1 + (size_t)l * 4194304, 1024, 4096, 4096, (bf16_t*)(ws + W_1) + (size_t)l * 4194304, 1024, p.norm_mlp_g + l * DM, nullptr);
        transpose_convert(tile, p.mlp_w2 + (size_t)l * 4194304, 4096, 1024, 1024, (bf16_t*)(ws + W_2) + (size_t)l * 4194304, 4096, nullptr, nullptr);
    }
    { bf16_t* wsm = (bf16_t*)(ws + W_A_S);
      for (size_t i = gtid; i < (size_t)8 * 128 * 128; i += gsz) { const int s = (int)(i & 127), t = (int)((i >> 7) & 127); const float v = (s <= t) ? p.a_w_s[i] : 0.f; wsm[i] = (bf16_t)(cvt_pk_bf16(v, 0.f) & 0xffffu); } }
    { bf16_t* wc = (bf16_t*)(ws + W_D_COMB);
      for (size_t i = gtid; i < (size_t)2048 * 1024; i += gsz) { const int n = (int)(i & 1023), k = (int)(i >> 10), h = k >> 7;
          const float* uv = p.d_w_uv + (size_t)k * 64; const float* wo = p.d_w_out + (size_t)h * 64 * 1024 + n; float s = 0.f;
#pragma unroll 8
          for (int v = 0; v < 64; ++v) s += uv[v] * wo[(size_t)v * 1024];
          wc[(size_t)n * 2048 + k] = (bf16_t)(cvt_pk_bf16(s, 0.f) & 0xffffu); } }
}

__device__ void phase_sgu(const Params& p, LAS unsigned char* lds) {
    unsigned char* ws = p.ws;
    const int tid = opaque_tid(), lane = tid & 63, wave = __builtin_amdgcn_readfirstlane(tid >> 6), g4 = lane >> 4, l15 = lane & 15, q = l15 >> 2, pp = lane & 3;
    const bf16_t* z = (const bf16_t*)(ws + WS_BIG); bf16_t* us = (bf16_t*)(ws + WS_BIG + 256 * MiB);
    const float* ssv = (const float*)(ws + WS_SS) + (size_t)9 * MTOK * 16; const bf16_t* wsm = (const bf16_t*)(ws + W_A_S);
    const unsigned ldsbase = (unsigned)(size_t)(unsigned char*)lds;
    for (int unit = blockIdx.x; unit < 4096; unit += gridDim.x) {
        const int g = unit & 7, chunk = unit >> 3; const size_t row0 = (size_t)chunk * 128;
#pragma unroll
        for (int i = 0; i < 4; ++i) {
            const int e = tid + 512 * i, r = e >> 4, ch = e & 15;
            const u32x4 raw = *(const u32x4*)(z + (row0 + r) * 2048 + 1024 + g * 128 + ch * 8);
            const float rs = rsqrtf(sum16(ssv + (row0 + r) * 16) * (1.0f / 1024.0f) + 1e-6f);
            const f32x4 g0 = *(const f32x4*)(p.a_v_g + g * 128 + ch * 8), g1 = *(const f32x4*)(p.a_v_g + g * 128 + ch * 8 + 4);
            u32x4 o;
            o.x = cvt_pk_bf16(bflo(raw.x) * rs * g0[0], bfhi(raw.x) * rs * g0[1]); o.y = cvt_pk_bf16(bflo(raw.y) * rs * g0[2], bfhi(raw.y) * rs * g0[3]);
            o.z = cvt_pk_bf16(bflo(raw.z) * rs * g1[0], bfhi(raw.z) * rs * g1[1]); o.w = cvt_pk_bf16(bflo(raw.w) * rs * g1[2], bfhi(raw.w) * rs * g1[3]);
            *(LAS u32x4*)(lds + (r >> 5) * 8192 + off_b(r & 31, ch)) = o;
        }
        __syncthreads();
        const int t = 16 * wave + l15, nks = (wave >> 1) + 1;
        f32x4 acc[8];
#pragma unroll
        for (int ct = 0; ct < 8; ++ct) acc[ct] = (f32x4){0.f, 0.f, 0.f, 0.f};
        for (int ks = 0; ks < nks; ++ks) {
            const bf16x8 Bw = *(const bf16x8*)(wsm + ((size_t)g * 128 + t) * 128 + 32 * ks + 8 * g4);
#pragma unroll
            for (int ct = 0; ct < 8; ++ct) {
                const unsigned a0 = ldsbase + ks * 8192 + off_b(8 * g4 + q, 2 * ct + (pp >> 1)) + 8 * (pp & 1);
                const unsigned a1 = ldsbase + ks * 8192 + off_b(8 * g4 + 4 + q, 2 * ct + (pp >> 1)) + 8 * (pp & 1);
                const bf16x8 Av = tr_read2(a0, a1);
                acc[ct] = __builtin_amdgcn_mfma_f32_16x16x32_bf16(Av, Bw, acc[ct], 0, 0, 0);
            }
        }
        const float bias = p.a_b_s[g * 128 + t]; const size_t rowg = row0 + t;
#pragma unroll
        for (int ct = 0; ct < 8; ++ct) {
            const u32x2 uu = *(const u32x2*)(z + rowg * 2048 + g * 128 + 16 * ct + 4 * g4);
            u32x2 o; o.x = cvt_pk_bf16(bflo(uu.x) * (acc[ct][0] + bias), bfhi(uu.x) * (acc[ct][1] + bias)); o.y = cvt_pk_bf16(bflo(uu.y) * (acc[ct][2] + bias), bfhi(uu.y) * (acc[ct][3] + bias));
            *(u32x2*)(us + rowg * 1024 + g * 128 + 16 * ct + 4 * g4) = o;
        }
        __syncthreads();
    }
}

__device__ void phase_conv(const Params& p) {
    unsigned char* ws = p.ws; const bf16_t* bch = (const bf16_t*)(ws + WS_BIG); bf16_t* gated = (bf16_t*)(ws + WS_BIG + 384 * MiB);
    const size_t gtid = (size_t)blockIdx.x * 512 + opaque_tid(), gsz = (size_t)gridDim.x * 512;
    for (size_t it = gtid; it < (size_t)4096 * 128; it += gsz) {
        const int ch = (int)(it & 127) * 8, rb = (int)(it >> 7); const int r0 = rb * 16;
        float w0[8], w1[8], w2[8], zm2[8], zm1[8];
#pragma unroll
        for (int j = 0; j < 8; ++j) { w0[j] = p.b_conv_w[ch + j]; w1[j] = p.b_conv_w[1024 + ch + j]; w2[j] = p.b_conv_w[2048 + ch + j]; zm2[j] = 0.f; zm1[j] = 0.f; }
        const int tpos0 = r0 & (SEQ - 1);
        for (int d = 2; d >= 1; --d) {
            if (tpos0 - d >= 0) {
                const bf16_t* rp = bch + (size_t)(r0 - d) * 3072; const u32x4 c = *(const u32x4*)(rp + 1024 + ch), h = *(const u32x4*)(rp + 2048 + ch);
                float zz[8] = {bflo(c.x) * bflo(h.x), bfhi(c.x) * bfhi(h.x), bflo(c.y) * bflo(h.y), bfhi(c.y) * bfhi(h.y), bflo(c.z) * bflo(h.z), bfhi(c.z) * bfhi(h.z), bflo(c.w) * bflo(h.w), bfhi(c.w) * bfhi(h.w)};
#pragma unroll
                for (int j = 0; j < 8; ++j) { if (d == 2) zm2[j] = zz[j]; else zm1[j] = zz[j]; }
            }
        }
        for (int r = r0; r < r0 + 16; ++r) {
            const bf16_t* rp = bch + (size_t)r * 3072; const u32x4 b = *(const u32x4*)(rp + ch), c = *(const u32x4*)(rp + 1024 + ch), h = *(const u32x4*)(rp + 2048 + ch);
            float zz[8] = {bflo(c.x) * bflo(h.x), bfhi(c.x) * bfhi(h.x), bflo(c.y) * bflo(h.y), bfhi(c.y) * bfhi(h.y), bflo(c.z) * bflo(h.z), bfhi(c.z) * bfhi(h.z), bflo(c.w) * bflo(h.w), bfhi(c.w) * bfhi(h.w)};
            float bb[8] = {bflo(b.x), bfhi(b.x), bflo(b.y), bfhi(b.y), bflo(b.z), bfhi(b.z), bflo(b.w), bfhi(b.w)};
            float o[8];
#pragma unroll
            for (int j = 0; j < 8; ++j) { o[j] = bb[j] * (w0[j] * zm2[j] + w1[j] * zm1[j] + w2[j] * zz[j]); zm2[j] = zm1[j]; zm1[j] = zz[j]; }
            u32x4 w; w.x = cvt_pk_bf16(o[0], o[1]); w.y = cvt_pk_bf16(o[2], o[3]); w.z = cvt_pk_bf16(o[4], o[5]); w.w = cvt_pk_bf16(o[6], o[7]);
            *(u32x4*)(gated + (size_t)r * 1024 + ch) = w;
        }
    }
}

__device__ __forceinline__ void ld8(const bf16_t* ptr, float (&f)[8]) {
    const u32x4 v = *(const u32x4*)ptr; f[0] = bflo(v.x); f[1] = bfhi(v.x); f[2] = bflo(v.y); f[3] = bfhi(v.y); f[4] = bflo(v.z); f[5] = bfhi(v.z); f[6] = bflo(v.w); f[7] = bfhi(v.w);
}
__device__ void phase_pool(const Params& p) {
    unsigned char* ws = p.ws; const bf16_t* z = (const bf16_t*)(ws + WS_BIG); bf16_t* pooled = (bf16_t*)(ws + WS_BIG + 128 * MiB);
    const size_t gtid = (size_t)blockIdx.x * 512 + opaque_tid(), gsz = (size_t)gridDim.x * 512;
    for (size_t it = gtid; it < (size_t)2048 * 128; it += gsz) {
        const int lane = (int)(it & 63), wv = (int)(it >> 6), chunk = (wv & 3) * 32 + (lane & 31), rb = (wv >> 2) * 2 + (lane >> 5);
        const int ch = chunk * 8, w = 2 << (ch >> 8), r0 = rb * 32;
        float S[8];
#pragma unroll
        for (int j = 0; j < 8; ++j) S[j] = 0.f;
        const int tpos0 = r0 & (SEQ - 1);
        for (int d = 1; d <= w; ++d) {
            if (tpos0 - d >= 0) { float f[8]; ld8(z + (size_t)(r0 - d) * 1024 + ch, f);
#pragma unroll
                for (int j = 0; j < 8; ++j) S[j] += f[j]; }
        }
        for (int r = r0; r < r0 + 32; ++r) {
            const int tpos = r & (SEQ - 1); float f[8]; ld8(z + (size_t)r * 1024 + ch, f);
#pragma unroll
            for (int j = 0; j < 8; ++j) S[j] += f[j];
            if (tpos - w >= 0) { float o[8]; ld8(z + (size_t)(r - w) * 1024 + ch, o);
#pragma unroll
                for (int j = 0; j < 8; ++j) S[j] -= o[j]; }
            const int cnt = (tpos + 1 < w) ? tpos + 1 : w; const float inv = 1.0f / (float)cnt;
            u32x4 o; o.x = cvt_pk_bf16(S[0] * inv - f[0], S[1] * inv - f[1]); o.y = cvt_pk_bf16(S[2] * inv - f[2], S[3] * inv - f[3]);
            o.z = cvt_pk_bf16(S[4] * inv - f[4], S[5] * inv - f[5]); o.w = cvt_pk_bf16(S[6] * inv - f[6], S[7] * inv - f[7]);
            *(u32x4*)(pooled + (size_t)r * 1024 + ch) = o;
        }
    }
}

__device__ void phase_topk(const Params& p, LAS unsigned char* lds) {
    unsigned char* ws = p.ws;
    const int tid = opaque_tid(), lane = tid & 63, wave = __builtin_amdgcn_readfirstlane(tid >> 6), g4 = lane >> 4, l15 = lane & 15;
    const bf16_t* din = (const bf16_t*)(ws + WS_BIG); bf16_t* cn = (bf16_t*)(ws + WS_CN); unsigned short* idx = (unsigned short*)(ws + WS_IDX);
    LAS float* S = (LAS float*)lds;
    for (int row = blockIdx.x * 8 + wave; row < MTOK; row += gridDim.x * 8) {
        const unsigned raw = *(const unsigned*)(din + (size_t)row * DSA_LD + 2048 + 2 * lane); const float a = bflo(raw), b = bfhi(raw);
        const float sq = wave_sum(a * a + b * b); const float rs = rsqrtf(sq * (1.0f / 128.0f) + 1e-6f);
        *(unsigned*)(cn + (size_t)row * 128 + 2 * lane) = cvt_pk_bf16(a * rs * p.d_kv_g[2 * lane], b * rs * p.d_kv_g[2 * lane + 1]);
    }
    for (int unit = blockIdx.x; unit < 8192; unit += gridDim.x) {
        const int b = unit >> 9, qpos0 = (unit & 511) * 8; const size_t rowq0 = (size_t)b * SEQ + qpos0;
        bf16x8 Aq[4][2]; float wv[4][4];
#pragma unroll
        for (int pr = 0; pr < 4; ++pr) {
            const bf16_t* base = din + (rowq0 + 2 * pr + (l15 >> 3)) * DSA_LD + 2176 + (l15 & 7) * 64;
            Aq[pr][0] = *(const bf16x8*)(base + 8 * g4); Aq[pr][1] = *(const bf16x8*)(base + 32 + 8 * g4);
            const u32x2 wr = *(const u32x2*)(din + (rowq0 + 2 * pr + (g4 >> 1)) * DSA_LD + 2752 + 4 * (g4 & 1));
            wv[pr][0] = bflo(wr.x) * 0.04419417382f; wv[pr][1] = bfhi(wr.x) * 0.04419417382f; wv[pr][2] = bflo(wr.y) * 0.04419417382f; wv[pr][3] = bfhi(wr.y) * 0.04419417382f;
        }
        const int nkt = (qpos0 + 7) / 16 + 1;
        for (int kt = wave; kt < nkt; kt += 8) {
            const bf16_t* kb = din + ((size_t)b * SEQ + 16 * kt + l15) * DSA_LD + 2688;
            const bf16x8 B0 = *(const bf16x8*)(kb + 8 * g4), B1 = *(const bf16x8*)(kb + 32 + 8 * g4);
#pragma unroll
            for (int pr = 0; pr < 4; ++pr) {
                f32x4 c = (f32x4){0.f, 0.f, 0.f, 0.f};
                c = __builtin_amdgcn_mfma_f32_16x16x32_bf16(Aq[pr][0], B0, c, 0, 0, 0);
                c = __builtin_amdgcn_mfma_f32_16x16x32_bf16(Aq[pr][1], B1, c, 0, 0, 0);
                float part = fmaxf(c[0], 0.f) * wv[pr][0] + fmaxf(c[1], 0.f) * wv[pr][1] + fmaxf(c[2], 0.f) * wv[pr][2] + fmaxf(c[3], 0.f) * wv[pr][3];
                part += __shfl_xor(part, 16);
                if ((g4 & 1) == 0) S[(2 * pr + (g4 >> 1)) * 4096 + 16 * kt + l15] = part + 0.0f;
            }
        }
        __syncthreads();
        {
            const int qpos = qpos0 + wave, n = qpos + 1; unsigned short* out = idx + (rowq0 + wave) * 256;
            if (n <= 256) {
#pragma unroll
                for (int i = 0; i < 4; ++i) { const int j = lane + 64 * i; out[j] = (unsigned short)(j < n ? j : 0xFFFF); }
            } else {
                unsigned u[64];
#pragma unroll
                for (int i = 0; i < 64; ++i) { const int key = lane + 64 * i; unsigned bits = __float_as_uint(S[wave * 4096 + key]); bits ^= (bits >> 31) ? 0xFFFFFFFFu : 0x80000000u; u[i] = key < n ? bits : 0u; }
                unsigned T = 0u;
                for (int bit = 31; bit >= 0; --bit) {
                    const unsigned cand = T | (1u << bit); int cnt = 0;
#pragma unroll
                    for (int i = 0; i < 64; ++i) cnt += __popcll(__ballot(u[i] >= cand));
                    if (cnt >= 256) T = cand;
                }
                int G = 0;
#pragma unroll
                for (int i = 0; i < 64; ++i) G += __popcll(__ballot(u[i] > T));
                const int need = 256 - G; int base = 0, tie_seen = 0;
                const unsigned long long ltmask = (1ull << lane) - 1ull;
#pragma unroll
                for (int i = 0; i < 64; ++i) {
                    const bool gt = u[i] > T, eq = u[i] == T;
                    const unsigned long long meq = __ballot(eq);
                    const bool sel = gt || (eq && (tie_seen + __popcll(meq & ltmask)) < need);
                    const unsigned long long msel = __ballot(sel);
                    if (sel) out[base + __popcll(msel & ltmask)] = (unsigned short)(lane + 64 * i);
                    base += __popcll(msel); tie_seen += __popcll(meq);
                }
            }
        }
        __syncthreads();
    }
}

__device__ void phase_attn(const Params& p, LAS unsigned char* lds) {
    unsigned char* ws = p.ws;
    const int tid = opaque_tid(), lane = tid & 63, wave = __builtin_amdgcn_readfirstlane(tid >> 6), g4 = lane >> 4, l15 = lane & 15, q = l15 >> 2, pp = lane & 3;
    bf16_t* din = (bf16_t*)(ws + WS_BIG); const bf16_t* cn = (const bf16_t*)(ws + WS_CN); const unsigned short* idx = (const unsigned short*)(ws + WS_IDX);
    LAS unsigned char* wl = lds + wave * 8192; const unsigned wbase = (unsigned)(size_t)(unsigned char*)lds + wave * 8192;
    const float scale = 0.08838834764f;
    for (int Q = blockIdx.x * 8 + wave; Q < MTOK; Q += gridDim.x * 8) {
        const int b = Q >> 12, qpos = Q & (SEQ - 1); const int nvalid = qpos + 1 < 256 ? qpos + 1 : 256;
        bf16_t* qrow = din + (size_t)Q * DSA_LD;
        bf16x8 Bq[4];
#pragma unroll
        for (int s = 0; s < 4; ++s) Bq[s] = *(const bf16x8*)(qrow + l15 * 128 + 32 * s + 8 * g4);
        f32x4 O[8];
#pragma unroll
        for (int mt = 0; mt < 8; ++mt) O[mt] = (f32x4){0.f, 0.f, 0.f, 0.f};
        float mrun = -1e30f, lrun = 0.f;
        for (int ck = 0; ck < 8; ++ck) {
            if (ck * 32 >= nvalid) break;
            bf16x8 A[2][4];
#pragma unroll
            for (int tl = 0; tl < 2; ++tl) {
                const int slot = ck * 32 + tl * 16 + l15; unsigned kid = idx[(size_t)Q * 256 + slot]; if (slot >= nvalid) kid = 0u;
                const bf16_t* crow = cn + ((size_t)b * SEQ + kid) * 128;
#pragma unroll
                for (int s = 0; s < 4; ++s) A[tl][s] = *(const bf16x8*)(crow + 32 * s + 8 * g4);
            }
            f32x4 S0 = (f32x4){0.f, 0.f, 0.f, 0.f}, S1 = (f32x4){0.f, 0.f, 0.f, 0.f};
#pragma unroll
            for (int s = 0; s < 4; ++s) { S0 = __builtin_amdgcn_mfma_f32_16x16x32_bf16(A[0][s], Bq[s], S0, 0, 0, 0); S1 = __builtin_amdgcn_mfma_f32_16x16x32_bf16(A[1][s], Bq[s], S1, 0, 0, 0); }
#pragma unroll
            for (int tl = 0; tl < 2; ++tl)
#pragma unroll
                for (int s = 0; s < 4; ++s) *(LAS bf16x8*)(wl + off_b(16 * tl + l15, 4 * s + g4)) = A[tl][s];
            float sv[8];
#pragma unroll
            for (int j = 0; j < 4; ++j) { const int s0 = ck * 32 + 4 * g4 + j; sv[j] = s0 < nvalid ? S0[j] * scale : -1e30f; sv[4 + j] = (s0 + 16) < nvalid ? S1[j] * scale : -1e30f; }
            float cm = fmaxf(fmaxf(fmaxf(sv[0], sv[1]), fmaxf(sv[2], sv[3])), fmaxf(fmaxf(sv[4], sv[5]), fmaxf(sv[6], sv[7])));
            cm = fmaxf(cm, __shfl_xor(cm, 16)); cm = fmaxf(cm, __shfl_xor(cm, 32));
            const float mn = fmaxf(mrun, cm), alpha = __expf(mrun - mn);
            float pv[8], ps = 0.f;
#pragma unroll
            for (int j = 0; j < 8; ++j) { pv[j] = __expf(sv[j] - mn); ps += pv[j]; }
            lrun = lrun * alpha + ps; mrun = mn;
#pragma unroll
            for (int mt = 0; mt < 8; ++mt) O[mt] *= alpha;
            union { u32x4 u; bf16x8 h; } Pb;
            Pb.u.x = cvt_pk_bf16(pv[0], pv[1]); Pb.u.y = cvt_pk_bf16(pv[2], pv[3]); Pb.u.z = cvt_pk_bf16(pv[4], pv[5]); Pb.u.w = cvt_pk_bf16(pv[6], pv[7]);
            asm volatile("s_waitcnt lgkmcnt(0)" ::: "memory");
#pragma unroll
            for (int mt = 0; mt < 8; ++mt) {
                const unsigned a0 = wbase + off_b(4 * g4 + q, 2 * mt + (pp >> 1)) + 8 * (pp & 1);
                const unsigned a1 = wbase + off_b(16 + 4 * g4 + q, 2 * mt + (pp >> 1)) + 8 * (pp & 1);
                const bf16x8 Av = tr_read2(a0, a1);
                O[mt] = __builtin_amdgcn_mfma_f32_16x16x32_bf16(Av, Pb.h, O[mt], 0, 0, 0);
            }
        }
        lrun += __shfl_xor(lrun, 16); lrun += __shfl_xor(lrun, 32);
        const float inv = 1.0f / lrun;
#pragma unroll
        for (int mt = 0; mt < 8; ++mt) {
            u32x2 o; o.x = cvt_pk_bf16(O[mt][0] * inv, O[mt][1] * inv); o.y = cvt_pk_bf16(O[mt][2] * inv, O[mt][3] * inv);
            *(u32x2*)(qrow + l15 * 128 + 16 * mt + 4 * g4) = o;
        }
    }
}

__device__ void phase_final(const Params& p) {
    const int tid = opaque_tid(); const int lane = tid & 63, wave = tid >> 6;
    const float* ss = (const float*)(p.ws + WS_SS) + (size_t)8 * MTOK * 16;
    for (int row = blockIdx.x * 8 + wave; row < MTOK; row += gridDim.x * 8) {
        const float rs = rsqrtf(sum16(ss + (size_t)row * 16) * (1.0f / 1024.0f) + 1e-6f);
        f32x4* xr = (f32x4*)(p.out + (size_t)row * DM);
#pragma unroll
        for (int i = 0; i < 4; ++i) { const f32x4 g = *(const f32x4*)(p.final_g + (lane + 64 * i) * 4); f32x4 v = xr[lane + 64 * i]; v = v * rs * g; xr[lane + 64 * i] = v; }
    }
}

enum { K_PRO = 0, K_GACT, K_GRES, K_SGU, K_CONV, K_POOL, K_TOPK, K_ATTN, K_FINAL };
struct PhaseDesc { int kind, act, lda, apn, N, K, ldc, ss_idx, xin_is_x, pad; size_t a_off, w_off; };
__device__ __forceinline__ PhaseDesc mk_act(int act, size_t w_off, int N, int ss_idx) { PhaseDesc d{}; d.kind = K_GACT; d.act = act; d.lda = 1024; d.apn = 0; d.N = N; d.K = 1024; d.ldc = N; d.ss_idx = ss_idx; d.a_off = WS_XB; d.w_off = w_off; return d; }
__device__ __forceinline__ PhaseDesc mk_res(size_t a_off, int lda, int apn, size_t w_off, int K, int xin_is_x, int ss_idx) { PhaseDesc d{}; d.kind = K_GRES; d.lda = lda; d.apn = apn; d.N = 1024; d.K = K; d.ss_idx = ss_idx; d.xin_is_x = xin_is_x; d.a_off = a_off; d.w_off = w_off; return d; }
__device__ __forceinline__ PhaseDesc mk_kind(int kind) { PhaseDesc d{}; d.kind = kind; return d; }
__device__ __forceinline__ PhaseDesc phase_desc(int ph) {
    switch (ph) {
    case 0: return mk_kind(K_PRO);
    case 1: return mk_act(1, W_A_IN, 2048, 0);
    case 2: return mk_kind(K_SGU);
    case 3: return mk_res(WS_BIG + 256 * MiB, 1024, 0, W_A_OUT, 1024, 1, 1);
    case 4: return mk_act(2, W_1 + 0 * 8 * MiB, 4096, 1);
    case 5: return mk_res(WS_BIG, 4096, 0, W_2 + 0 * 8 * MiB, 4096, 0, 2);
    case 6: return mk_act(0, W_B_IN, 3072, 2);
    case 7: return mk_kind(K_CONV);
    case 8: return mk_res(WS_BIG + 384 * MiB, 1024, 0, W_B_OUT, 1024, 0, 3);
    case 9: return mk_act(2, W_1 + 1 * 8 * MiB, 4096, 3);
    case 10: return mk_res(WS_BIG, 4096, 0, W_2 + 1 * 8 * MiB, 4096, 0, 4);
    case 11: return mk_act(0, W_C_IN, 1024, 4);
    case 12: return mk_kind(K_POOL);
    case 13: return mk_res(WS_BIG + 128 * MiB, 1024, 512, W_C_GRP, 256, 0, 5);
    case 14: return mk_act(2, W_1 + 2 * 8 * MiB, 4096, 5);
    case 15: return mk_res(WS_BIG, 4096, 0, W_2 + 2 * 8 * MiB, 4096, 0, 6);
    case 16: return mk_act(0, W_D_IN, DSA_LD, 6);
    case 17: return mk_kind(K_TOPK);
    case 18: return mk_kind(K_ATTN);
    case 19: return mk_res(WS_BIG, DSA_LD, 0, W_D_COMB, 2048, 0, 7);
    case 20: return mk_act(2, W_1 + 3 * 8 * MiB, 4096, 7);
    case 21: return mk_res(WS_BIG, 4096, 0, W_2 + 3 * 8 * MiB, 4096, 0, 8);
    default: return mk_kind(K_FINAL);
    }
}

__device__ __forceinline__ void run_phase(int ph, const Params& p, LAS unsigned char* lds) {
    const PhaseDesc d = phase_desc(ph);
    unsigned char* ws = p.ws; float* ss = (float*)(ws + WS_SS);
    if (d.kind == K_GACT || d.kind == K_GRES) {
        pg8::Gemm g; g.A = (const bf16_t*)(ws + d.a_off); g.Bt = (const bf16_t*)(ws + d.w_off); g.M = MTOK; g.N = d.N; g.K = d.K; g.lda = d.lda; g.apn = d.apn;
        pg8::StaticOrder S; S.init(MTOK, d.N, gridDim.x, blockIdx.x);
        if (d.kind == K_GACT) { pg8::EpiAct E; E.O = (bf16_t*)(ws + WS_BIG); E.ldc = d.ldc; E.ss_in = ss + (size_t)d.ss_idx * MTOK * 16; E.ssv = ss + (size_t)9 * MTOK * 16; E.ACT = d.act; pg8::gemm_phase(lds, g, S, E); }
        else { pg8::EpiResid E; E.xin = d.xin_is_x ? p.x : p.out; E.xout = p.out; E.xb = (bf16_t*)(ws + WS_XB); E.ss_out = ss + (size_t)d.ss_idx * MTOK * 16; pg8::gemm_phase(lds, g, S, E); }
    }
    else if (d.kind == K_PRO) phase_prologue(p, lds);
    else if (d.kind == K_SGU) phase_sgu(p, lds);
    else if (d.kind == K_CONV) phase_conv(p);
    else if (d.kind == K_POOL) phase_pool(p);
    else if (d.kind == K_TOPK) phase_topk(p, lds);
    else if (d.kind == K_ATTN) phase_attn(p, lds);
    else phase_final(p);
}

__global__ void __launch_bounds__(512, 2) fwd_megakernel(Params p) {
    extern __shared__ __attribute__((aligned(16))) unsigned char lds_raw[];
    LAS unsigned char* lds = (LAS unsigned char*)lds_raw;
    for (int ph = p.ph_lo; ph < p.ph_hi; ++ph) {
        run_phase(ph, p, lds);
        if (ph + 1 < p.ph_hi) { cg::this_grid().sync(); }
    }
}

#ifndef MK_MULTI
#define MK_MULTI 1
#endif

extern "C" void kernel_launch(void* const* d_in, const int* in_sizes, int n_in, void* d_out, int out_size, void* d_ws, size_t ws_size, hipStream_t stream) {
    static int grid = 0;
    if (grid == 0) {
        int dev = 0, cus = 0, per_cu = 0;
        hipGetDevice(&dev);
        hipDeviceGetAttribute(&cus, hipDeviceAttributeMultiprocessorCount, dev);
        if (hipFuncSetAttribute((const void*)fwd_megakernel, hipFuncAttributeMaxDynamicSharedMemorySize, LDS_BYTES) != hipSuccess) { fprintf(stderr, "hipFuncSetAttribute failed\n"); grid = -1; return; }
        if (hipOccupancyMaxActiveBlocksPerMultiprocessor(&per_cu, (const void*)fwd_megakernel, 512, LDS_BYTES) != hipSuccess || per_cu < 1) { fprintf(stderr, "occupancy query: %d\n", per_cu); per_cu = 1; }
        (void)hipGetLastError();
        grid = cus * (per_cu > 1 ? 1 : per_cu);
        if (ws_size < 840 * MiB) { fprintf(stderr, "workspace too small\n"); grid = -1; return; }
    }
    if (grid < 0) return;
    Params p{};
    const float** pp = (const float**)&p;
    for (int i = 0; i < 21; ++i) pp[i] = (const float*)d_in[i];
    p.out = (float*)d_out; p.ws = (unsigned char*)d_ws;
#if MK_MULTI
    for (int ph = 0; ph < NPHASE; ++ph) {
        p.ph_lo = ph; p.ph_hi = ph + 1;
        hipLaunchKernelGGL(fwd_megakernel, dim3(grid), dim3(512), LDS_BYTES, stream, p);
    }
#else
    p.ph_lo = 0; p.ph_hi = NPHASE;
    void* args[] = {&p};
    hipError_t e = hipLaunchCooperativeKernel((const void*)fwd_megakernel, dim3(grid), dim3(512), args, LDS_BYTES, stream);
    if (e != hipSuccess) fprintf(stderr, "cooperative launch failed: %s (grid %d)\n", hipGetErrorString(e), grid);
#endif
}
```

```cpp
#include <hip/hip_runtime.h>
#include <hip/hip_cooperative_groups.h>
#include <cstdio>
namespace cg = cooperative_groups;

#define LAS __attribute__((address_space(3)))
typedef unsigned short bf16_t;
typedef short bf16x8 __attribute__((ext_vector_type(8)));
typedef float f32x4 __attribute__((ext_vector_type(4)));
typedef float f32x2 __attribute__((ext_vector_type(2)));
typedef unsigned u32x4 __attribute__((ext_vector_type(4)));
typedef unsigned u32x2 __attribute__((ext_vector_type(2)));
typedef unsigned short u16x4 __attribute__((ext_vector_type(4)));

constexpr int MTOK = 65536, DM = 1024, SEQ = 4096;
constexpr size_t MiB = 1ull << 20;
constexpr size_t WS_XB = 0;
constexpr size_t WS_BIG = 128 * MiB;
constexpr size_t WS_CN = 640 * MiB;
constexpr size_t WS_IDX = 656 * MiB;
constexpr size_t WS_SS = 800 * MiB;
constexpr size_t WS_W = 692 * MiB;
constexpr size_t W_A_IN = WS_W + 0 * MiB, W_A_OUT = WS_W + 4 * MiB, W_A_S = WS_W + 6 * MiB, W_B_IN = WS_W + 7 * MiB, W_B_OUT = WS_W + 13 * MiB,
                 W_C_IN = WS_W + 15 * MiB, W_C_GRP = WS_W + 17 * MiB, W_D_IN = WS_W + 18 * MiB, W_D_COMB = WS_W + 24 * MiB, W_1 = WS_W + 28 * MiB, W_2 = WS_W + 60 * MiB;
constexpr int DSA_LD = 2816;
constexpr int LDS_BYTES = 131072 + 1024;
constexpr int NPHASE = 23;

struct Params {
    const float *x, *norm_mix_g, *norm_mlp_g, *final_g, *a_w_in, *a_v_g, *a_w_s, *a_b_s, *a_w_out, *b_w_in, *b_conv_w, *b_w_out, *c_w_in, *c_w_grp, *c_scale,
        *d_w_in, *d_kv_g, *d_w_uv, *d_w_out, *mlp_w1, *mlp_w2;
    float* out; unsigned char* ws; int ph_lo, ph_hi;
};

__device__ __forceinline__ unsigned cvt_pk_bf16(float lo, float hi) { unsigned r; asm volatile("v_cvt_pk_bf16_f32 %0, %1, %2" : "=v"(r) : "v"(lo), "v"(hi)); return r; }
__device__ __forceinline__ int opaque_tid() { int t = threadIdx.x; asm volatile("" : "+v"(t)); return t; }
__device__ __forceinline__ float bflo(unsigned w) { return __uint_as_float(w << 16); }
__device__ __forceinline__ float bfhi(unsigned w) { return __uint_as_float(w & 0xffff0000u); }
__device__ __forceinline__ float wave_sum(float v) {
#pragma unroll
    for (int o = 32; o; o >>= 1) v += __shfl_xor(v, o);
    return v;
}
__device__ __forceinline__ float sum16(const float* p) { const f32x4 a = *(const f32x4*)p, b = *(const f32x4*)(p + 4), c = *(const f32x4*)(p + 8), d = *(const f32x4*)(p + 12);
    return (((a[0] + a[1]) + (a[2] + a[3])) + ((b[0] + b[1]) + (b[2] + b[3]))) + (((c[0] + c[1]) + (c[2] + c[3])) + ((d[0] + d[1]) + (d[2] + d[3]))); }
__device__ __forceinline__ unsigned off_b(unsigned row, unsigned ch) { return 256u * row + 16u * (ch ^ (((row & 3) << 2) | ((row >> 2) & 3))); }
__device__ __forceinline__ bf16x8 tr_read2(unsigned a0, unsigned a1) {
    u16x4 lo, hi;
    asm volatile("ds_read_b64_tr_b16 %0, %2\n\tds_read_b64_tr_b16 %1, %3\n\ts_waitcnt lgkmcnt(0)" : "=&v"(lo), "=&v"(hi) : "v"(a0), "v"(a1) : "memory");
    bf16x8 r; r[0] = (short)lo[0]; r[1] = (short)lo[1]; r[2] = (short)lo[2]; r[3] = (short)lo[3]; r[4] = (short)hi[0]; r[5] = (short)hi[1]; r[6] = (short)hi[2]; r[7] = (short)hi[3];
    return r;
}

namespace pg8 {
constexpr int BM = 256, BK = 64, HALF = 128, HTB = HALF * BK * 2, STAGE_BYTES = 8 * HTB, NXCD = 8, WGM = 8;
__device__ __forceinline__ int lds_byte(int r, int c) { const int st = (r >> 4) * 2 + (c >> 5), rr = r & 15, cc = c & 31, ob = rr * 64 + cc * 2; return st * 1024 + (ob ^ (((ob >> 9) & 1) << 5)); }
__device__ __forceinline__ void stage_rc(int b, int& R, int& C) { const int st = b / 1024, sb = b % 1024, swz = sb ^ (((sb >> 9) & 1) << 5); R = (st >> 1) * 16 + swz / 64; C = (st & 1) * 32 + (swz % 64) / 2; }
__device__ __forceinline__ int perm32(int rho) { const int n = rho >> 4, i = rho & 15; return 8 * (i >> 2) + 4 * n + (i & 3); }
struct Unit { int pm, pn; };
struct Gemm { const bf16_t* A; const bf16_t* Bt; int M, N, K, lda, apn; };
struct StaticOrder {
    int nM, nN, nwg, G, c;
    __device__ void init(int M, int N, int G_, int c_) { nM = M / BM; nN = N / BM; nwg = nM * nN; G = G_; c = c_; }
    __device__ bool next(int i, Unit& u) const {
        const long L = (long)i * G + c; if (L >= nwg) return false;
        int wgid = (int)L; { const int q = nwg / NXCD, r = nwg % NXCD, xcd = wgid % NXCD, off = wgid / NXCD; wgid = (xcd < r ? xcd * (q + 1) : r * (q + 1) + (xcd - r) * q) + off; }
        const int nig = WGM * nN, gid = wgid / nig, fm = gid * WGM, gsz = (nM - fm) < WGM ? (nM - fm) : WGM;
        u.pm = fm + ((wgid % nig) % gsz); u.pn = (wgid % nig) / gsz; return true;
    }
};

__device__ __forceinline__ float gelu_tanh(float x) {
    const float y = 0.7978845608f * (x + 0.044715f * x * x * x);
    const float e = __builtin_amdgcn_exp2f(-2.885390082f * y);
    return x * __builtin_amdgcn_rcpf(1.0f + e);
}
struct EpiAct {
    static constexpr bool PERM = true;
    bf16_t* O; int ldc; const float* ss_in; float* ssv; int ACT;
    __device__ __forceinline__ void operator()(const f32x4 (&acc)[2][2][4][2], const Unit& u, int wr, int wc, int fr, int fq) const {
        const int row0 = u.pm * BM + wr * 64 + fr, col0 = u.pn * BM + wc * 32 + 8 * fq;
#pragma unroll
        for (int ai = 0; ai < 2; ++ai)
#pragma unroll
            for (int m = 0; m < 4; ++m) {
                const int row = row0 + ai * HALF + m * 16;
                const float rs = rsqrtf(sum16(ss_in + (size_t)row * 16) * (1.0f / 1024.0f) + 1e-6f);
                bf16_t* rowp = O + (size_t)row * ldc + col0; float sq = 0.f;
#pragma unroll
                for (int bj = 0; bj < 2; ++bj) {
                    f32x4 v0 = acc[ai][bj][m][0] * rs, v1 = acc[ai][bj][m][1] * rs;
                    if (ACT == 1) {
#pragma unroll
                        for (int j = 0; j < 4; ++j) { v0[j] = gelu_tanh(v0[j]); v1[j] = gelu_tanh(v1[j]); sq += v0[j] * v0[j] + v1[j] * v1[j]; }
                    }
                    if (ACT == 2) {
#pragma unroll
                        for (int j = 0; j < 4; ++j) { const float a = fmaxf(v0[j], 0.f), b = fmaxf(v1[j], 0.f); v0[j] = a * a; v1[j] = b * b; }
                    }
                    u32x4 w; w.x = cvt_pk_bf16(v0[0], v0[1]); w.y = cvt_pk_bf16(v0[2], v0[3]); w.z = cvt_pk_bf16(v1[0], v1[1]); w.w = cvt_pk_bf16(v1[2], v1[3]);
                    *(u32x4*)(rowp + bj * HALF) = w;
                }
                if (ACT == 1) {
                    sq += __shfl_xor(sq, 16); sq += __shfl_xor(sq, 32);
                    if (u.pn >= 4 && fq == 0) ssv[(size_t)row * 16 + (u.pn - 4) * 4 + wc] = sq;
                }
            }
    }
};
struct EpiResid {
    static constexpr bool PERM = false;
    const float* xin; float* xout; bf16_t* xb; float* ss_out;
    __device__ __forceinline__ void operator()(const f32x4 (&acc)[2][2][4][2], const Unit& u, int wr, int wc, int fr, int fq) const {
        const int row0 = u.pm * BM + wr * 64 + fr, col0 = u.pn * BM + wc * 32 + 4 * fq;
#pragma unroll
        for (int ai = 0; ai < 2; ++ai)
#pragma unroll
            for (int m = 0; m < 4; ++m) {
                const int row = row0 + ai * HALF + m * 16; const size_t off = (size_t)row * DM + col0; float sq = 0.f;
#pragma unroll
                for (int bj = 0; bj < 2; ++bj)
#pragma unroll
                    for (int n = 0; n < 2; ++n) {
                        const f32x4 xo = *(const f32x4*)(xin + off + bj * HALF + n * 16); const f32x4 v = xo + acc[ai][bj][m][n];
                        *(f32x4*)(xout + off + bj * HALF + n * 16) = v;
                        u32x2 w; w.x = cvt_pk_bf16(v[0], v[1]); w.y = cvt_pk_bf16(v[2], v[3]); *(u32x2*)(xb + off + bj * HALF + n * 16) = w;
                        sq += (v[0] * v[0] + v[1] * v[1]) + (v[2] * v[2] + v[3] * v[3]);
                    }
                sq += __shfl_xor(sq, 16); sq += __shfl_xor(sq, 32);
                if (fq == 0) ss_out[(size_t)row * 16 + u.pn * 4 + wc] = sq;
                asm volatile("" ::: "memory");
            }
    }
};

template <class Epi>
__device__ __forceinline__ void gemm_phase(LAS unsigned char* lds, const Gemm g, const StaticOrder& S, const Epi& E) {
    const int tid = opaque_tid(), wid = __builtin_amdgcn_readfirstlane(tid >> 6), lane = tid & 63, wr = wid >> 2, wc = wid & 3, fr = lane & 15, fq = lane >> 4;
    const int K = g.K, nt = K / BK, lda = g.lda;
    unsigned voffA[2], voffB[2];
#pragma unroll
    for (int i = 0; i < 2; ++i) { int R, C; stage_rc(tid * 16 + i * 8192, R, C); const int Rb = Epi::PERM ? ((R & ~31) + perm32(R & 31)) : R;
        voffA[i] = (unsigned)(R * lda + C) * 2u; voffB[i] = (unsigned)(Rb * K + C) * 2u; }
    const size_t kstep = (size_t)(BK * 2);
    const size_t hstepA = (size_t)HALF * lda * 2, hstepB = (size_t)HALF * K * 2;
    const size_t tstepA = 2 * hstepA, tstepB = 2 * hstepB;
    const unsigned ldsw = (unsigned)wid * 1024u;
    const int aoff = lds_byte(wr * 64 + fr, fq * 8), boff = lds_byte(wc * 32 + fr, fq * 8);
#define PG8_SA(b, h) (((b) * 2 + (h)) * HTB)
#define PG8_SB(b, h) ((4 + (b) * 2 + (h)) * HTB)
#define PG8_STAGE(bufoff, gbase, voff) do { _Pragma("unroll") for (int _i = 0; _i < 2; ++_i) \
        __builtin_amdgcn_global_load_lds((const unsigned*)((const char*)(gbase) + (voff)[_i]), (LAS unsigned*)(lds + (bufoff) + ldsw + _i * 8192), 16, 0, 0); } while (0)
#define PG8_LDA(dst, b, h) do { _Pragma("unroll") for (int m = 0; m < 4; ++m) _Pragma("unroll") for (int k = 0; k < 2; ++k) dst[m][k] = *(const LAS bf16x8*)(lds + PG8_SA(b, h) + aoff + m * 2048 + k * 1024); } while (0)
#define PG8_LDB(dst, b, h) do { _Pragma("unroll") for (int n = 0; n < 2; ++n) _Pragma("unroll") for (int k = 0; k < 2; ++k) dst[n][k] = *(const LAS bf16x8*)(lds + PG8_SB(b, h) + boff + n * 2048 + k * 1024); } while (0)
#define PG8_MMA(ai, bj, At, Bt) do { __builtin_amdgcn_s_setprio(1); _Pragma("unroll") for (int m = 0; m < 4; ++m) _Pragma("unroll") for (int n = 0; n < 2; ++n) _Pragma("unroll") for (int k = 0; k < 2; ++k) \
        acc[ai][bj][m][n] = __builtin_amdgcn_mfma_f32_16x16x32_bf16(Bt[n][k], At[m][k], acc[ai][bj][m][n], 0, 0, 0); __builtin_amdgcn_s_setprio(0); } while (0)
#define PG8_WAIT_V(n) asm volatile("s_waitcnt vmcnt(" #n ")" ::: "memory")
#define PG8_WAIT_L(n) asm volatile("s_waitcnt lgkmcnt(" #n ")" ::: "memory")
#define PG8_BAR __builtin_amdgcn_s_barrier()
#define PG8_SCHED __builtin_amdgcn_sched_barrier(0)
    Unit cur, nxt; int ui = 0;
    if (!S.next(0, cur)) return;
    f32x4 acc[2][2][4][2];
#pragma unroll
    for (int a = 0; a < 2; ++a)
#pragma unroll
        for (int b = 0; b < 2; ++b)
#pragma unroll
            for (int m = 0; m < 4; ++m)
#pragma unroll
                for (int n = 0; n < 2; ++n) acc[a][b][m][n] = (f32x4){0.f, 0.f, 0.f, 0.f};
    bf16x8 At[4][2], B0[2][2], B1[2][2];
    const char* cA = (const char*)g.A + (size_t)cur.pm * tstepA + (size_t)cur.pn * g.apn; const char* cB = (const char*)g.Bt + (size_t)cur.pn * tstepB;
    PG8_STAGE(PG8_SB(0, 0), cB, voffB); PG8_STAGE(PG8_SA(0, 0), cA, voffA); PG8_STAGE(PG8_SB(0, 1), cB + hstepB, voffB); PG8_STAGE(PG8_SA(0, 1), cA + hstepA, voffA);
    if (wr == 1) PG8_BAR;
    PG8_WAIT_V(4); PG8_BAR;
    PG8_STAGE(PG8_SB(1, 0), cB + kstep, voffB); PG8_STAGE(PG8_SA(1, 0), cA + kstep, voffA); PG8_STAGE(PG8_SB(1, 1), cB + hstepB + kstep, voffB);
    PG8_WAIT_V(6); PG8_BAR;
    for (;;) {
        const bool has_next = S.next(ui + 1, nxt);
        const char* nA = has_next ? (const char*)g.A + (size_t)nxt.pm * tstepA + (size_t)nxt.pn * g.apn : cA; const char* nB = has_next ? (const char*)g.Bt + (size_t)nxt.pn * tstepB : cB;
        for (int t = 0; t < nt; t += 2) {
            const bool last = (t == nt - 2);
            const char* a1 = cA + (size_t)(t + 1) * kstep;
            const char* a2 = last ? nA : cA + (size_t)(t + 2) * kstep; const char* b2 = last ? nB : cB + (size_t)(t + 2) * kstep;
            const char* a3 = a2 + kstep; const char* b3 = b2 + kstep;
            PG8_LDB(B0, 0, 0); PG8_SCHED; PG8_LDA(At, 0, 0); PG8_STAGE(PG8_SA(1, 1), a1 + hstepA, voffA);
            PG8_WAIT_L(8); PG8_BAR; PG8_WAIT_L(0); PG8_MMA(0, 0, At, B0); PG8_BAR; PG8_SCHED;
            PG8_LDB(B1, 0, 1); PG8_STAGE(PG8_SB(0, 0), b2, voffB);
            PG8_BAR; PG8_WAIT_L(0); PG8_MMA(0, 1, At, B1); PG8_BAR;
            PG8_LDA(At, 0, 1); PG8_STAGE(PG8_SA(0, 0), a2, voffA);
            PG8_BAR; PG8_WAIT_L(0); PG8_MMA(1, 0, At, B0); PG8_BAR; PG8_SCHED;
            PG8_STAGE(PG8_SB(0, 1), b2 + hstepB, voffB);
            PG8_WAIT_V(6); PG8_BAR; PG8_MMA(1, 1, At, B1); PG8_BAR;
            PG8_LDB(B0, 1, 0); PG8_SCHED; PG8_LDA(At, 1, 0); PG8_STAGE(PG8_SA(0, 1), a2 + hstepA, voffA);
            PG8_WAIT_L(8); PG8_BAR; PG8_WAIT_L(0); PG8_MMA(0, 0, At, B0); PG8_BAR; PG8_SCHED;
            PG8_LDB(B1, 1, 1); PG8_STAGE(PG8_SB(1, 0), b3, voffB);
            PG8_BAR; PG8_WAIT_L(0); PG8_MMA(0, 1, At, B1); PG8_BAR;
            PG8_LDA(At, 1, 1); PG8_STAGE(PG8_SA(1, 0), a3, voffA);
            PG8_BAR; PG8_WAIT_L(0); PG8_MMA(1, 0, At, B0); PG8_BAR; PG8_SCHED;
            PG8_STAGE(PG8_SB(1, 1), b3 + hstepB, voffB);
            PG8_WAIT_V(6); PG8_BAR; PG8_MMA(1, 1, At, B1); PG8_BAR;
        }
        E(acc, cur, wr, wc, fr, fq);
        if (!has_next) break;
#pragma unroll
        for (int a = 0; a < 2; ++a)
#pragma unroll
            for (int b = 0; b < 2; ++b)
#pragma unroll
                for (int m = 0; m < 4; ++m)
#pragma unroll
                    for (int n = 0; n < 2; ++n) acc[a][b][m][n] = (f32x4){0.f, 0.f, 0.f, 0.f};
        cur = nxt; cA = nA; cB = nB; ++ui;
    }
    PG8_WAIT_V(0);
    if (wr == 0) PG8_BAR;
    PG8_BAR;
#undef PG8_SA
#undef PG8_SB
#undef PG8_STAGE
#undef PG8_LDA
#undef PG8_LDB
#undef PG8_MMA
#undef PG8_WAIT_V
#undef PG8_WAIT_L
#undef PG8_BAR
#undef PG8_SCHED
}
}

__device__ void transpose_convert(LAS float* tile, const float* W, int K, int N, int Npad, bf16_t* Wt, int ldt, const float* rowgain, const float* colgain) {
    const int tid = opaque_tid(), tk = K / 64, tn = Npad / 64;
    for (int t = blockIdx.x; t < tk * tn; t += gridDim.x) {
        const int k0 = (t % tk) * 64, n0 = (t / tk) * 64;
#pragma unroll
        for (int i = 0; i < 8; ++i) {
            const int e = tid + 512 * i, kk = e >> 6, nn = e & 63, n = n0 + nn; float v = 0.f;
            if (n < N) { v = W[(size_t)(k0 + kk) * N + n]; if (rowgain) v *= rowgain[k0 + kk]; if (colgain) v *= colgain[n]; }
            tile[nn * 65 + kk] = v;
        }
        __syncthreads();
#pragma unroll
        for (int i = 0; i < 8; ++i) {
            const int e = tid + 512 * i, nn = e >> 6, kk = e & 63;
            Wt[(size_t)(n0 + nn) * ldt + k0 + kk] = (bf16_t)(cvt_pk_bf16(tile[nn * 65 + kk], 0.f) & 0xffffu);
        }
        __syncthreads();
    }
}

__device__ void phase_prologue(const Params& p, LAS unsigned char* lds) {
    unsigned char* ws = p.ws; LAS float* tile = (LAS float*)lds;
    const int tid = opaque_tid(), lane = tid & 63, wave = tid >> 6;
    const size_t gtid = (size_t)blockIdx.x * 512 + tid, gsz = (size_t)gridDim.x * 512;
    float* ss = (float*)(ws + WS_SS);
    bf16_t* xb = (bf16_t*)(ws + WS_XB);
    for (int row = blockIdx.x * 8 + wave; row < MTOK; row += gridDim.x * 8) {
        const f32x4* xr = (const f32x4*)(p.x + (size_t)row * DM); float sq = 0.f;
#pragma unroll
        for (int i = 0; i < 4; ++i) { const f32x4 v = xr[lane + 64 * i]; sq += (v[0] * v[0] + v[1] * v[1]) + (v[2] * v[2] + v[3] * v[3]);
            u32x2 w; w.x = cvt_pk_bf16(v[0], v[1]); w.y = cvt_pk_bf16(v[2], v[3]); *(u32x2*)(xb + (size_t)row * DM + (lane + 64 * i) * 4) = w; }
        sq = wave_sum(sq);
        if (lane < 16) ss[(size_t)row * 16 + lane] = lane == 0 ? sq : 0.f;
    }
    transpose_convert(tile, p.a_w_in, 1024, 2048, 2048, (bf16_t*)(ws + W_A_IN), 1024, p.norm_mix_g + 0 * DM, nullptr);
    transpose_convert(tile, p.a_w_out, 1024, 1024, 1024, (bf16_t*)(ws + W_A_OUT), 1024, nullptr, nullptr);
    transpose_convert(tile, p.b_w_in, 1024, 3072, 3072, (bf16_t*)(ws + W_B_IN), 1024, p.norm_mix_g + 1 * DM, nullptr);
    transpose_convert(tile, p.b_w_out, 1024, 1024, 1024, (bf16_t*)(ws + W_B_OUT), 1024, nullptr, nullptr);
    transpose_convert(tile, p.c_w_in, 1024, 1024, 1024, (bf16_t*)(ws + W_C_IN), 1024, p.norm_mix_g + 2 * DM, nullptr);
    for (int g = 0; g < 4; ++g)
        transpose_convert(tile, p.c_w_grp + (size_t)g * 65536, 256, 256, 256, (bf16_t*)(ws + W_C_GRP) + (size_t)g * 65536, 256, nullptr, p.c_scale + g * 256);
    transpose_convert(tile, p.d_w_in, 1024, 2760, DSA_LD, (bf16_t*)(ws + W_D_IN), 1024, p.norm_mix_g + 3 * DM, nullptr);
    for (int l = 0; l < 4; ++l) {
        transpose_convert(tile, p.mlp_w1 + (size_t)l * 4194304, 1024, 4096, 4096, (bf16_t*)(ws + W_1) + (size_t)l * 4194304, 1024, p.norm_mlp_g + l * DM, nullptr);
        transpose_convert(tile, p.mlp_w2 + (size_t)l * 4194304, 4096, 1024, 1024, (bf16_t*)(ws + W_2) + (size_t)l * 4194304, 4096, nullptr, nullptr);
    }
    { bf16_t* wsm = (bf16_t*)(ws + W_A_S);
      for (size_t i = gtid; i < (size_t)8 * 128 * 128; i += gsz) { const int s = (int)(i & 127), t = (int)((i >> 7) & 127); const float v = (s <= t) ? p.a_w_s[i] : 0.f; wsm[i] = (bf16_t)(cvt_pk_bf16(v, 0.f) & 0xffffu); } }
    { bf16_t* wc = (bf16_t*)(ws + W_D_COMB);
      for (size_t i = gtid; i < (size_t)2048 * 1024; i += gsz) { const int n = (int)(i & 1023), k = (int)(i >> 10), h = k >> 7;
          const float* uv = p.d_w_uv + (size_t)k * 64; const float* wo = p.d_w_out + (size_t)h * 64 * 1024 + n; float s = 0.f;
#pragma unroll 8
          for (int v = 0; v < 64; ++v) s += uv[v] * wo[(size_t)v * 1024];
          wc[(size_t)n * 2048 + k] = (bf16_t)(cvt_pk_bf16(s, 0.f) & 0xffffu); } }
}

__device__ void phase_sgu(const Params& p, LAS unsigned char* lds) {
    unsigned char* ws = p.ws;
    const int tid = opaque_tid(), lane = tid & 63, wave = __builtin_amdgcn_readfirstlane(tid >> 6), g4 = lane >> 4, l15 = lane & 15, q = l15 >> 2, pp = lane & 3;
    const bf16_t* z = (const bf16_t*)(ws + WS_BIG); bf16_t* us = (bf16_t*)(ws + WS_BIG + 256 * MiB);
    const float* ssv = (const float*)(ws + WS_SS) + (size_t)9 * MTOK * 16; const bf16_t* wsm = (const bf16_t*)(ws + W_A_S);
    const unsigned ldsbase = (unsigned)(size_t)(unsigned char*)lds;
    for (int unit = blockIdx.x; unit < 4096; unit += gridDim.x) {
        const int g = unit & 7, chunk = unit >> 3; const size_t row0 = (size_t)chunk * 128;
#pragma unroll
        for (int i = 0; i < 4; ++i) {
            const int e = tid + 512 * i, r = e >> 4, ch = e & 15;
            const u32x4 raw = *(const u32x4*)(z + (row0 + r) * 2048 + 1024 + g * 128 + ch * 8);
            const float rs = rsqrtf(sum16(ssv + (row0 + r) * 16) * (1.0f / 1024.0f) + 1e-6f);
            const f32x4 g0 = *(const f32x4*)(p.a_v_g + g * 128 + ch * 8), g1 = *(const f32x4*)(p.a_v_g + g * 128 + ch * 8 + 4);
            u32x4 o;
            o.x = cvt_pk_bf16(bflo(raw.x) * rs * g0[0], bfhi(raw.x) * rs * g0[1]); o.y = cvt_pk_bf16(bflo(raw.y) * rs * g0[2], bfhi(raw.y) * rs * g0[3]);
            o.z = cvt_pk_bf16(bflo(raw.z) * rs * g1[0], bfhi(raw.z) * rs * g1[1]); o.w = cvt_pk_bf16(bflo(raw.w) * rs * g1[2], bfhi(raw.w) * rs * g1[3]);
            *(LAS u32x4*)(lds + (r >> 5) * 8192 + off_b(r & 31, ch)) = o;
        }
        __syncthreads();
        const int t = 16 * wave + l15, nks = (wave >> 1) + 1;
        f32x4 acc[8];
#pragma unroll
        for (int ct = 0; ct < 8; ++ct) acc[ct] = (f32x4){0.f, 0.f, 0.f, 0.f};
        for (int ks = 0; ks < nks; ++ks) {
            const bf16x8 Bw = *(const bf16x8*)(wsm + ((size_t)g * 128 + t) * 128 + 32 * ks + 8 * g4);
#pragma unroll
            for (int ct = 0; ct < 8; ++ct) {
                const unsigned a0 = ldsbase + ks * 8192 + off_b(8 * g4 + q, 2 * ct + (pp >> 1)) + 8 * (pp & 1);
                const unsigned a1 = ldsbase + ks * 8192 + off_b(8 * g4 + 4 + q, 2 * ct + (pp >> 1)) + 8 * (pp & 1);
                const bf16x8 Av = tr_read2(a0, a1);
                acc[ct] = __builtin_amdgcn_mfma_f32_16x16x32_bf16(Av, Bw, acc[ct], 0, 0, 0);
            }
        }
        const float bias = p.a_b_s[g * 128 + t]; const size_t rowg = row0 + t;
#pragma unroll
        for (int ct = 0; ct < 8; ++ct) {
            const u32x2 uu = *(const u32x2*)(z + rowg * 2048 + g * 128 + 16 * ct + 4 * g4);
            u32x2 o; o.x = cvt_pk_bf16(bflo(uu.x) * (acc[ct][0] + bias), bfhi(uu.x) * (acc[ct][1] + bias)); o.y = cvt_pk_bf16(bflo(uu.y) * (acc[ct][2] + bias), bfhi(uu.y) * (acc[ct][3] + bias));
            *(u32x2*)(us + rowg * 1024 + g * 128 + 16 * ct + 4 * g4) = o;
        }
        __syncthreads();
    }
}

__device__ void phase_conv(const Params& p) {
    unsigned char* ws = p.ws; const bf16_t* bch = (const bf16_t*)(ws + WS_BIG); bf16_t* gated = (bf16_t*)(ws + WS_BIG + 384 * MiB);
    const size_t gtid = (size_t)blockIdx.x * 512 + opaque_tid(), gsz = (size_t)gridDim.x * 512;
    for (size_t it = gtid; it < (size_t)4096 * 128; it += gsz) {
        const int ch = (int)(it & 127) * 8, rb = (int)(it >> 7); const int r0 = rb * 16;
        float w0[8], w1[8], w2[8], zm2[8], zm1[8];
#pragma unroll
        for (int j = 0; j < 8; ++j) { w0[j] = p.b_conv_w[ch + j]; w1[j] = p.b_conv_w[1024 + ch + j]; w2[j] = p.b_conv_w[2048 + ch + j]; zm2[j] = 0.f; zm1[j] = 0.f; }
        const int tpos0 = r0 & (SEQ - 1);
        for (int d = 2; d >= 1; --d) {
            if (tpos0 - d >= 0) {
                const bf16_t* rp = bch + (size_t)(r0 - d) * 3072; const u32x4 c = *(const u32x4*)(rp + 1024 + ch), h = *(const u32x4*)(rp + 2048 + ch);
                float zz[8] = {bflo(c.x) * bflo(h.x), bfhi(c.x) * bfhi(h.x), bflo(c.y) * bflo(h.y), bfhi(c.y) * bfhi(h.y), bflo(c.z) * bflo(h.z), bfhi(c.z) * bfhi(h.z), bflo(c.w) * bflo(h.w), bfhi(c.w) * bfhi(h.w)};
#pragma unroll
                for (int j = 0; j < 8; ++j) { if (d == 2) zm2[j] = zz[j]; else zm1[j] = zz[j]; }
            }
        }
        for (int r = r0; r < r0 + 16; ++r) {
            const bf16_t* rp = bch + (size_t)r * 3072; const u32x4 b = *(const u32x4*)(rp + ch), c = *(const u32x4*)(rp + 1024 + ch), h = *(const u32x4*)(rp + 2048 + ch);
            float zz[8] = {bflo(c.x) * bflo(h.x), bfhi(c.x) * bfhi(h.x), bflo(c.y) * bflo(h.y), bfhi(c.y) * bfhi(h.y), bflo(c.z) * bflo(h.z), bfhi(c.z) * bfhi(h.z), bflo(c.w) * bflo(h.w), bfhi(c.w) * bfhi(h.w)};
            float bb[8] = {bflo(b.x), bfhi(b.x), bflo(b.y), bfhi(b.y), bflo(b.z), bfhi(b.z), bflo(b.w), bfhi(b.w)};
            float o[8];
#pragma unroll
            for (int j = 0; j < 8; ++j) { o[j] = bb[j] * (w0[j] * zm2[j] + w1[j] * zm1[j] + w2[j] * zz[j]); zm2[j] = zm1[j]; zm1[j] = zz[j]; }
            u32x4 w; w.x = cvt_pk_bf16(o[0], o[1]); w.y = cvt_pk_bf16(o[2], o[3]); w.z = cvt_pk_bf16(o[4], o[5]); w.w = cvt_pk_bf16(o[6], o[7]);
            *(u32x4*)(gated + (size_t)r * 1024 + ch) = w;
        }
    }
}

__device__ __forceinline__ void ld8(const bf16_t* ptr, float (&f)[8]) {
    const u32x4 v = *(const u32x4*)ptr; f[0] = bflo(v.x); f[1] = bfhi(v.x); f[2] = bflo(v.y); f[3] = bfhi(v.y); f[4] = bflo(v.z); f[5] = bfhi(v.z); f[6] = bflo(v.w); f[7] = bfhi(v.w);
}
__device__ void phase_pool(const Params& p) {
    unsigned char* ws = p.ws; const bf16_t* z = (const bf16_t*)(ws + WS_BIG); bf16_t* pooled = (bf16_t*)(ws + WS_BIG + 128 * MiB);
    const size_t gtid = (size_t)blockIdx.x * 512 + opaque_tid(), gsz = (size_t)gridDim.x * 512;
    for (size_t it = gtid; it < (size_t)2048 * 128; it += gsz) {
        const int lane = (int)(it & 63), wv = (int)(it >> 6), chunk = (wv & 3) * 32 + (lane & 31), rb = (wv >> 2) * 2 + (lane >> 5);
        const int ch = chunk * 8, w = 2 << (ch >> 8), r0 = rb * 32;
        float S[8];
#pragma unroll
        for (int j = 0; j < 8; ++j) S[j] = 0.f;
        const int tpos0 = r0 & (SEQ - 1);
        for (int d = 1; d <= w; ++d) {
            if (tpos0 - d >= 0) { float f[8]; ld8(z + (size_t)(r0 - d) * 1024 + ch, f);
#pragma unroll
                for (int j = 0; j < 8; ++j) S[j] += f[j]; }
        }
        for (int r = r0; r < r0 + 32; ++r) {
            const int tpos = r & (SEQ - 1); float f[8]; ld8(z + (size_t)r * 1024 + ch, f);
#pragma unroll
            for (int j = 0; j < 8; ++j) S[j] += f[j];
            if (tpos - w >= 0) { float o[8]; ld8(z + (size_t)(r - w) * 1024 + ch, o);
#pragma unroll
                for (int j = 0; j < 8; ++j) S[j] -= o[j]; }
            const int cnt = (tpos + 1 < w) ? tpos + 1 : w; const float inv = 1.0f / (float)cnt;
            u32x4 o; o.x = cvt_pk_bf16(S[0] * inv - f[0], S[1] * inv - f[1]); o.y = cvt_pk_bf16(S[2] * inv - f[2], S[3] * inv - f[3]);
            o.z = cvt_pk_bf16(S[4] * inv - f[4], S[5] * inv - f[5]); o.w = cvt_pk_bf16(S[6] * inv - f[6], S[7] * inv - f[7]);
            *(u32x4*)(pooled + (size_t)r * 1024 + ch) = o;
        }
    }
}

__device__ void phase_topk(const Params& p, LAS unsigned char* lds) {
    unsigned char* ws = p.ws;
    const int tid = opaque_tid(), lane = tid & 63, wave = __builtin_amdgcn_readfirstlane(tid >> 6), g4 = lane >> 4, l15 = lane & 15;
    const bf16_t* din = (const bf16_t*)(ws + WS_BIG); bf16_t* cn = (bf16_t*)(ws + WS_CN); unsigned short* idx = (unsigned short*)(ws + WS_IDX);
    LAS float* S = (LAS float*)lds;
    for (int row = blockIdx.x * 8 + wave; row < MTOK; row += gridDim.x * 8) {
        const unsigned raw = *(const unsigned*)(din + (size_t)row * DSA_LD + 2048 + 2 * lane); const float a = bflo(raw), b = bfhi(raw);
        const float sq = wave_sum(a * a + b * b); const float rs = rsqrtf(sq * (1.0f / 128.0f) + 1e-6f);
        *(unsigned*)(cn + (size_t)row * 128 + 2 * lane) = cvt_pk_bf16(a * rs * p.d_kv_g[2 * lane], b * rs * p.d_kv_g[2 * lane + 1]);
    }
    for (int unit = blockIdx.x; unit < 8192; unit += gridDim.x) {
        const int b = unit >> 9, qpos0 = (unit & 511) * 8; const size_t rowq0 = (size_t)b * SEQ + qpos0;
        bf16x8 Aq[4][2]; float wv[4][4];
#pragma unroll
        for (int pr = 0; pr < 4; ++pr) {
            const bf16_t* base = din + (rowq0 + 2 * pr + (l15 >> 3)) * DSA_LD + 2176 + (l15 & 7) * 64;
            Aq[pr][0] = *(const bf16x8*)(base + 8 * g4); Aq[pr][1] = *(const bf16x8*)(base + 32 + 8 * g4);
            const u32x2 wr = *(const u32x2*)(din + (rowq0 + 2 * pr + (g4 >> 1)) * DSA_LD + 2752 + 4 * (g4 & 1));
            wv[pr][0] = bflo(wr.x) * 0.04419417382f; wv[pr][1] = bfhi(wr.x) * 0.04419417382f; wv[pr][2] = bflo(wr.y) * 0.04419417382f; wv[pr][3] = bfhi(wr.y) * 0.04419417382f;
        }
        const int nkt = (qpos0 + 7) / 16 + 1;
        for (int kt = wave; kt < nkt; kt += 8) {
            const bf16_t* kb = din + ((size_t)b * SEQ + 16 * kt + l15) * DSA_LD + 2688;
            const bf16x8 B0 = *(const bf16x8*)(kb + 8 * g4), B1 = *(const bf16x8*)(kb + 32 + 8 * g4);
#pragma unroll
            for (int pr = 0; pr < 4; ++pr) {
                f32x4 c = (f32x4){0.f, 0.f, 0.f, 0.f};
                c = __builtin_amdgcn_mfma_f32_16x16x32_bf16(Aq[pr][0], B0, c, 0, 0, 0);
                c = __builtin_amdgcn_mfma_f32_16x16x32_bf16(Aq[pr][1], B1, c, 0, 0, 0);
                float part = fmaxf(c[0], 0.f) * wv[pr][0] + fmaxf(c[1], 0.f) * wv[pr][1] + fmaxf(c[2], 0.f) * wv[pr][2] + fmaxf(c[3], 0.f) * wv[pr][3];
                part += __shfl_xor(part, 16);
                if ((g4 & 1) == 0) S[(2 * pr + (g4 >> 1)) * 4096 + 16 * kt + l15] = part + 0.0f;
            }
        }
        __syncthreads();
        {
            const int qpos = qpos0 + wave, n = qpos + 1; unsigned short* out = idx + (rowq0 + wave) * 256;
            if (n <= 256) {
#pragma unroll
                for (int i = 0; i < 4; ++i) { const int j = lane + 64 * i; out[j] = (unsigned short)(j < n ? j : 0xFFFF); }
            } else {
                unsigned u[64];
#pragma unroll
                for (int i = 0; i < 64; ++i) { const int key = lane + 64 * i; unsigned bits = __float_as_uint(S[wave * 4096 + key]); bits ^= (bits >> 31) ? 0xFFFFFFFFu : 0x80000000u; u[i] = key < n ? bits : 0u; }
                unsigned T = 0u;
                for (int bit = 31; bit >= 0; --bit) {
                    const unsigned cand = T | (1u << bit); int cnt = 0;
#pragma unroll
                    for (int i = 0; i < 64; ++i) cnt += __popcll(__ballot(u[i] >= cand));
                    if (cnt >= 256) T = cand;
                }
                int G = 0;
#pragma unroll
                for (int i = 0; i < 64; ++i) G += __popcll(__ballot(u[i] > T));
                const int need = 256 - G; int base = 0, tie_seen = 0;
                const unsigned long long ltmask = (1ull << lane) - 1ull;
#pragma unroll
                for (int i = 0; i < 64; ++i) {
                    const bool gt = u[i] > T, eq = u[i] == T;
                    const unsigned long long meq = __ballot(eq);
                    const bool sel = gt || (eq && (tie_seen + __popcll(meq & ltmask)) < need);
                    const unsigned long long msel = __ballot(sel);
                    if (sel) out[base + __popcll(msel & ltmask)] = (unsigned short)(lane + 64 * i);
                    base += __popcll(msel); tie_seen += __popcll(meq);
                }
            }
        }
        __syncthreads();
    }
}

__device__ void phase_attn(const Params& p, LAS unsigned char* lds) {
    unsigned char* ws = p.ws;
    const int tid = opaque_tid(), lane = tid & 63, wave = __builtin_amdgcn_readfirstlane(tid >> 6), g4 = lane >> 4, l15 = lane & 15, q = l15 >> 2, pp = lane & 3;
    bf16_t* din = (bf16_t*)(ws + WS_BIG); const bf16_t* cn = (const bf16_t*)(ws + WS_CN); const unsigned short* idx = (const unsigned short*)(ws + WS_IDX);
    LAS unsigned char* wl = lds + wave * 8192; const unsigned wbase = (unsigned)(size_t)(unsigned char*)lds + wave * 8192;
    const float scale = 0.08838834764f;
    for (int Q = blockIdx.x * 8 + wave; Q < MTOK; Q += gridDim.x * 8) {
        const int b = Q >> 12, qpos = Q & (SEQ - 1); const int nvalid = qpos + 1 < 256 ? qpos + 1 : 256;
        bf16_t* qrow = din + (size_t)Q * DSA_LD;
        bf16x8 Bq[4];
#pragma unroll
        for (int s = 0; s < 4; ++s) Bq[s] = *(const bf16x8*)(qrow + l15 * 128 + 32 * s + 8 * g4);
        f32x4 O[8];
#pragma unroll
        for (int mt = 0; mt < 8; ++mt) O[mt] = (f32x4){0.f, 0.f, 0.f, 0.f};
        float mrun = -1e30f, lrun = 0.f;
        for (int ck = 0; ck < 8; ++ck) {
            if (ck * 32 >= nvalid) break;
            bf16x8 A[2][4];
#pragma unroll
            for (int tl = 0; tl < 2; ++tl) {
                const int slot = ck * 32 + tl * 16 + l15; unsigned kid = idx[(size_t)Q * 256 + slot]; if (slot >= nvalid) kid = 0u;
                const bf16_t* crow = cn + ((size_t)b * SEQ + kid) * 128;
#pragma unroll
                for (int s = 0; s < 4; ++s) A[tl][s] = *(const bf16x8*)(crow + 32 * s + 8 * g4);
            }
            f32x4 S0 = (f32x4){0.f, 0.f, 0.f, 0.f}, S1 = (f32x4){0.f, 0.f, 0.f, 0.f};
#pragma unroll
            for (int s = 0; s < 4; ++s) { S0 = __builtin_amdgcn_mfma_f32_16x16x32_bf16(A[0][s], Bq[s], S0, 0, 0, 0); S1 = __builtin_amdgcn_mfma_f32_16x16x32_bf16(A[1][s], Bq[s], S1, 0, 0, 0); }
#pragma unroll
            for (int tl = 0; tl < 2; ++tl)
#pragma unroll
                for (int s = 0; s < 4; ++s) *(LAS bf16x8*)(wl + off_b(16 * tl + l15, 4 * s + g4)) = A[tl][s];
            float sv[8];
#pragma unroll
            for (int j = 0; j < 4; ++j) { const int s0 = ck * 32 + 4 * g4 + j; sv[j] = s0 < nvalid ? S0[j] * scale : -1e30f; sv[4 + j] = (s0 + 16) < nvalid ? S1[j] * scale : -1e30f; }
            float cm = fmaxf(fmaxf(fmaxf(sv[0], sv[1]), fmaxf(sv[2], sv[3])), fmaxf(fmaxf(sv[4], sv[5]), fmaxf(sv[6], sv[7])));
            cm = fmaxf(cm, __shfl_xor(cm, 16)); cm = fmaxf(cm, __shfl_xor(cm, 32));
            const float mn = fmaxf(mrun, cm), alpha = __expf(mrun - mn);
            float pv[8], ps = 0.f;
#pragma unroll
            for (int j = 0; j < 8; ++j) { pv[j] = __expf(sv[j] - mn); ps += pv[j]; }
            lrun = lrun * alpha + ps; mrun = mn;
#pragma unroll
            for (int mt = 0; mt < 8; ++mt) O[mt] *= alpha;
            union { u32x4 u; bf16x8 h; } Pb;
            Pb.u.x = cvt_pk_bf16(pv[0], pv[1]); Pb.u.y = cvt_pk_bf16(pv[2], pv[3]); Pb.u.z = cvt_pk_bf16(pv[4], pv[5]); Pb.u.w = cvt_pk_bf16(pv[6], pv[7]);
            asm volatile("s_waitcnt lgkmcnt(0)" ::: "memory");
#pragma unroll
            for (int mt = 0; mt < 8; ++mt) {
                const unsigned a0 = wbase + off_b(4 * g4 + q, 2 * mt + (pp >> 1)) + 8 * (pp & 1);
                const unsigned a1 = wbase + off_b(16 + 4 * g4 + q, 2 * mt + (pp >> 1)) + 8 * (pp & 1);
                const bf16x8 Av = tr_read2(a0, a1);
                O[mt] = __builtin_amdgcn_mfma_f32_16x16x32_bf16(Av, Pb.h, O[mt], 0, 0, 0);
            }
        }
        lrun += __shfl_xor(lrun, 16); lrun += __shfl_xor(lrun, 32);
        const float inv = 1.0f / lrun;
#pragma unroll
        for (int mt = 0; mt < 8; ++mt) {
            u32x2 o; o.x = cvt_pk_bf16(O[mt][0] * inv, O[mt][1] * inv); o.y = cvt_pk_bf16(O[mt][2] * inv, O[mt][3] * inv);
            *(u32x2*)(qrow + l15 * 128 + 16 * mt + 4 * g4) = o;
        }
    }
}

__device__ void phase_final(const Params& p) {
    const int tid = opaque_tid(); const int lane = tid & 63, wave = tid >> 6;
    const float* ss = (const float*)(p.ws + WS_SS) + (size_t)8 * MTOK * 16;
    for (int row = blockIdx.x * 8 + wave; row < MTOK; row += gridDim.x * 8) {
        const float rs = rsqrtf(sum16(ss + (size_t)row * 16) * (1.0f / 1024.0f) + 1e-6f);
        f32x4* xr = (f32x4*)(p.out + (size_t)row * DM);
#pragma unroll
        for (int i = 0; i < 4; ++i) { const f32x4 g = *(const f32x4*)(p.final_g + (lane + 64 * i) * 4); f32x4 v = xr[lane + 64 * i]; v = v * rs * g; xr[lane + 64 * i] = v; }
    }
}

enum { K_PRO = 0, K_GACT, K_GRES, K_SGU, K_CONV, K_POOL, K_TOPK, K_ATTN, K_FINAL };
struct PhaseDesc { int kind, act, lda, apn, N, K, ldc, ss_idx, xin_is_x, pad; size_t a_off, w_off; };
__device__ __forceinline__ PhaseDesc mk_act(int act, size_t w_off, int N, int ss_idx) { PhaseDesc d{}; d.kind = K_GACT; d.act = act; d.lda = 1024; d.apn = 0; d.N = N; d.K = 1024; d.ldc = N; d.ss_idx = ss_idx; d.a_off = WS_XB; d.w_off = w_off; return d; }
__device__ __forceinline__ PhaseDesc mk_res(size_t a_off, int lda, int apn, size_t w_off, int K, int xin_is_x, int ss_idx) { PhaseDesc d{}; d.kind = K_GRES; d.lda = lda; d.apn = apn; d.N = 1024; d.K = K; d.ss_idx = ss_idx; d.xin_is_x = xin_is_x; d.a_off = a_off; d.w_off = w_off; return d; }
__device__ __forceinline__ PhaseDesc mk_kind(int kind) { PhaseDesc d{}; d.kind = kind; return d; }
__device__ __forceinline__ PhaseDesc phase_desc(int ph) {
    switch (ph) {
    case 0: return mk_kind(K_PRO);
    case 1: return mk_act(1, W_A_IN, 2048, 0);
    case 2: return mk_kind(K_SGU);
    case 3: return mk_res(WS_BIG + 256 * MiB, 1024, 0, W_A_OUT, 1024, 1, 1);
    case 4: return mk_act(2, W_1 + 0 * 8 * MiB, 4096, 1);
    case 5: return mk_res(WS_BIG, 4096, 0, W_2 + 0 * 8 * MiB, 4096, 0, 2);
    case 6: return mk_act(0, W_B_IN, 3072, 2);
    case 7: return mk_kind(K_CONV);
    case 8: return mk_res(WS_BIG + 384 * MiB, 1024, 0, W_B_OUT, 1024, 0, 3);
    case 9: return mk_act(2, W_1 + 1 * 8 * MiB, 4096, 3);
    case 10: return mk_res(WS_BIG, 4096, 0, W_2 + 1 * 8 * MiB, 4096, 0, 4);
    case 11: return mk_act(0, W_C_IN, 1024, 4);
    case 12: return mk_kind(K_POOL);
    case 13: return mk_res(WS_BIG + 128 * MiB, 1024, 512, W_C_GRP, 256, 0, 5);
    case 14: return mk_act(2, W_1 + 2 * 8 * MiB, 4096, 5);
    case 15: return mk_res(WS_BIG, 4096, 0, W_2 + 2 * 8 * MiB, 4096, 0, 6);
    case 16: return mk_act(0, W_D_IN, DSA_LD, 6);
    case 17: return mk_kind(K_TOPK);
    case 18: return mk_kind(K_ATTN);
    case 19: return mk_res(WS_BIG, DSA_LD, 0, W_D_COMB, 2048, 0, 7);
    case 20: return mk_act(2, W_1 + 3 * 8 * MiB, 4096, 7);
    case 21: return mk_res(WS_BIG, 4096, 0, W_2 + 3 * 8 * MiB, 4096, 0, 8);
    default: return mk_kind(K_FINAL);
    }
}

__device__ __forceinline__ void run_phase(int ph, const Params& p, LAS unsigned char* lds) {
    const PhaseDesc d = phase_desc(ph);
    unsigned char* ws = p.ws; float* ss = (float*)(ws + WS_SS);
    if (d.kind == K_GACT || d.kind == K_GRES) {
        pg8::Gemm g; g.A = (const bf16_t*)(ws + d.a_off); g.Bt = (const bf16_t*)(ws + d.w_off); g.M = MTOK; g.N = d.N; g.K = d.K; g.lda = d.lda; g.apn = d.apn;
        pg8::StaticOrder S; S.init(MTOK, d.N, gridDim.x, blockIdx.x);
        if (d.kind == K_GACT) { pg8::EpiAct E; E.O = (bf16_t*)(ws + WS_BIG); E.ldc = d.ldc; E.ss_in = ss + (size_t)d.ss_idx * MTOK * 16; E.ssv = ss + (size_t)9 * MTOK * 16; E.ACT = d.act; pg8::gemm_phase(lds, g, S, E); }
        else { pg8::EpiResid E; E.xin = d.xin_is_x ? p.x : p.out; E.xout = p.out; E.xb = (bf16_t*)(ws + WS_XB); E.ss_out = ss + (size_t)d.ss_idx * MTOK * 16; pg8::gemm_phase(lds, g, S, E); }
    }
    else if (d.kind == K_PRO) phase_prologue(p, lds);
    else if (d.kind == K_SGU) phase_sgu(p, lds);
    else if (d.kind == K_CONV) phase_conv(p);
    else if (d.kind == K_POOL) phase_pool(p);
    else if (d.kind == K_TOPK) phase_topk(p, lds);
    else if (d.kind == K_ATTN) phase_attn(p, lds);
    else phase_final(p);
}

__global__ void __launch_bounds__(512, 2) fwd_megakernel(Params p) {
    extern __shared__ __attribute__((aligned(16))) unsigned char lds_raw[];
    LAS unsigned char* lds = (LAS unsigned char*)lds_raw;
    for (int ph = p.ph_lo; ph < p.ph_hi; ++ph) {
        run_phase(ph, p, lds);
        if (ph + 1 < p.ph_hi) { cg::this_grid().sync(); }
    }
}

#ifndef MK_MULTI
#define MK_MULTI 0
#endif

extern "C" void kernel_launch(void* const* d_in, const int* in_sizes, int n_in, void* d_out, int out_size, void* d_ws, size_t ws_size, hipStream_t stream) {
    static int grid = 0;
    if (grid == 0) {
        int dev = 0, cus = 0, per_cu = 0;
        hipGetDevice(&dev);
        hipDeviceGetAttribute(&cus, hipDeviceAttributeMultiprocessorCount, dev);
        if (hipFuncSetAttribute((const void*)fwd_megakernel, hipFuncAttributeMaxDynamicSharedMemorySize, LDS_BYTES) != hipSuccess) { fprintf(stderr, "hipFuncSetAttribute failed\n"); grid = -1; return; }
        if (hipOccupancyMaxActiveBlocksPerMultiprocessor(&per_cu, (const void*)fwd_megakernel, 512, LDS_BYTES) != hipSuccess || per_cu < 1) { fprintf(stderr, "occupancy query: %d\n", per_cu); per_cu = 1; }
        (void)hipGetLastError();
        grid = cus * (per_cu > 1 ? 1 : per_cu);
        if (ws_size < 840 * MiB) { fprintf(stderr, "workspace too small\n"); grid = -1; return; }
    }
    if (grid < 0) return;
    Params p{};
    const float** pp = (const float**)&p;
    for (int i = 0; i < 21; ++i) pp[i] = (const float*)d_in[i];
    p.out = (float*)d_out; p.ws = (unsigned char*)d_ws;
#if MK_MULTI
    for (int ph = 0; ph < NPHASE; ++ph) {
        p.ph_lo = ph; p.ph_hi = ph + 1;
        hipLaunchKernelGGL(fwd_megakernel, dim3(grid), dim3(512), LDS_BYTES, stream, p);
    }
#else
    p.ph_lo = 0; p.ph_hi = NPHASE;
    void* args[] = {&p};
    hipError_t e = hipLaunchCooperativeKernel((const void*)fwd_megakernel, dim3(grid), dim3(512), args, LDS_BYTES, stream);
    if (e != hipSuccess) fprintf(stderr, "cooperative launch failed: %s (grid %d)\n", hipGetErrorString(e), grid);
#endif
}
```

```cpp
#include <hip/hip_runtime.h>
#include <hip/hip_cooperative_groups.h>
#include <cstdio>
namespace cg = cooperative_groups;

#ifndef PROBE_DUP
#define PROBE_DUP 0
#endif
#ifndef PROBE_TOPK
#define PROBE_TOPK 0
#endif
#define LAS __attribute__((address_space(3)))
typedef unsigned short bf16_t;
typedef short bf16x8 __attribute__((ext_vector_type(8)));
typedef float f32x4 __attribute__((ext_vector_type(4)));
typedef float f32x2 __attribute__((ext_vector_type(2)));
typedef unsigned u32x4 __attribute__((ext_vector_type(4)));
typedef unsigned u32x2 __attribute__((ext_vector_type(2)));
typedef unsigned short u16x4 __attribute__((ext_vector_type(4)));

constexpr int MTOK = 65536, DM = 1024, SEQ = 4096;
constexpr size_t MiB = 1ull << 20;
constexpr size_t WS_XB = 0;
constexpr size_t WS_BIG = 128 * MiB;
constexpr size_t WS_CN = 640 * MiB;
constexpr size_t WS_IDX = 656 * MiB;
constexpr size_t WS_SS = 800 * MiB;
constexpr size_t WS_W = 692 * MiB;
constexpr size_t W_A_IN = WS_W + 0 * MiB, W_A_OUT = WS_W + 4 * MiB, W_A_S = WS_W + 6 * MiB, W_B_IN = WS_W + 7 * MiB, W_B_OUT = WS_W + 13 * MiB,
                 W_C_IN = WS_W + 15 * MiB, W_C_GRP = WS_W + 17 * MiB, W_D_IN = WS_W + 18 * MiB, W_D_COMB = WS_W + 24 * MiB, W_1 = WS_W + 28 * MiB, W_2 = WS_W + 60 * MiB;
constexpr int DSA_LD = 2816;
constexpr int LDS_BYTES = 131072 + 1024;
constexpr int NPHASE = 23;

struct Params {
    const float *x, *norm_mix_g, *norm_mlp_g, *final_g, *a_w_in, *a_v_g, *a_w_s, *a_b_s, *a_w_out, *b_w_in, *b_conv_w, *b_w_out, *c_w_in, *c_w_grp, *c_scale,
        *d_w_in, *d_kv_g, *d_w_uv, *d_w_out, *mlp_w1, *mlp_w2;
    float* out; unsigned char* ws; int ph_lo, ph_hi;
};

__device__ __forceinline__ unsigned cvt_pk_bf16(float lo, float hi) { unsigned r; asm volatile("v_cvt_pk_bf16_f32 %0, %1, %2" : "=v"(r) : "v"(lo), "v"(hi)); return r; }
__device__ __forceinline__ int opaque_tid() { int t = threadIdx.x; asm volatile("" : "+v"(t)); return t; }
__device__ __forceinline__ float bflo(unsigned w) { return __uint_as_float(w << 16); }
__device__ __forceinline__ float bfhi(unsigned w) { return __uint_as_float(w & 0xffff0000u); }
__device__ __forceinline__ float wave_sum(float v) {
#pragma unroll
    for (int o = 32; o; o >>= 1) v += __shfl_xor(v, o);
    return v;
}
__device__ __forceinline__ float sum16(const float* p) { const f32x4 a = *(const f32x4*)p, b = *(const f32x4*)(p + 4), c = *(const f32x4*)(p + 8), d = *(const f32x4*)(p + 12);
    return (((a[0] + a[1]) + (a[2] + a[3])) + ((b[0] + b[1]) + (b[2] + b[3]))) + (((c[0] + c[1]) + (c[2] + c[3])) + ((d[0] + d[1]) + (d[2] + d[3]))); }
__device__ __forceinline__ unsigned off_b(unsigned row, unsigned ch) { return 256u * row + 16u * (ch ^ (((row & 3) << 2) | ((row >> 2) & 3))); }
__device__ __forceinline__ bf16x8 tr_read2(unsigned a0, unsigned a1) {
    u16x4 lo, hi;
    asm volatile("ds_read_b64_tr_b16 %0, %2\n\tds_read_b64_tr_b16 %1, %3\n\ts_waitcnt lgkmcnt(0)" : "=&v"(lo), "=&v"(hi) : "v"(a0), "v"(a1) : "memory");
    bf16x8 r; r[0] = (short)lo[0]; r[1] = (short)lo[1]; r[2] = (short)lo[2]; r[3] = (short)lo[3]; r[4] = (short)hi[0]; r[5] = (short)hi[1]; r[6] = (short)hi[2]; r[7] = (short)hi[3];
    return r;
}

namespace pg8 {
constexpr int BM = 256, BK = 64, HALF = 128, HTB = HALF * BK * 2, STAGE_BYTES = 8 * HTB, NXCD = 8, WGM = 8;
__device__ __forceinline__ int lds_byte(int r, int c) { const int st = (r >> 4) * 2 + (c >> 5), rr = r & 15, cc = c & 31, ob = rr * 64 + cc * 2; return st * 1024 + (ob ^ (((ob >> 9) & 1) << 5)); }
__device__ __forceinline__ void stage_rc(int b, int& R, int& C) { const int st = b / 1024, sb = b % 1024, swz = sb ^ (((sb >> 9) & 1) << 5); R = (st >> 1) * 16 + swz / 64; C = (st & 1) * 32 + (swz % 64) / 2; }
__device__ __forceinline__ int perm32(int rho) { const int n = rho >> 4, i = rho & 15; return 8 * (i >> 2) + 4 * n + (i & 3); }
struct Unit { int pm, pn; };
struct Gemm { const bf16_t* A; const bf16_t* Bt; int M, N, K, lda, apn; };
struct StaticOrder {
    int nM, nN, nwg, G, c;
    __device__ void init(int M, int N, int G_, int c_) { nM = M / BM; nN = N / BM; nwg = nM * nN; G = G_; c = c_; }
    __device__ bool next(int i, Unit& u) const {
        const long L = (long)i * G + c; if (L >= nwg) return false;
        int wgid = (int)L; { const int q = nwg / NXCD, r = nwg % NXCD, xcd = wgid % NXCD, off = wgid / NXCD; wgid = (xcd < r ? xcd * (q + 1) : r * (q + 1) + (xcd - r) * q) + off; }
        const int nig = WGM * nN, gid = wgid / nig, fm = gid * WGM, gsz = (nM - fm) < WGM ? (nM - fm) : WGM;
        u.pm = fm + ((wgid % nig) % gsz); u.pn = (wgid % nig) / gsz; return true;
    }
};

__device__ __forceinline__ float gelu_tanh(float x) {
    const float y = 0.7978845608f * (x + 0.044715f * x * x * x);
    const float e = __builtin_amdgcn_exp2f(-2.885390082f * y);
    return x * __builtin_amdgcn_rcpf(1.0f + e);
}
struct EpiAct {
    static constexpr bool PERM = true;
    bf16_t* O; int ldc; const float* ss_in; float* ssv; int ACT;
    __device__ __forceinline__ void operator()(const f32x4 (&acc)[2][2][4][2], const Unit& u, int wr, int wc, int fr, int fq) const {
        const int row0 = u.pm * BM + wr * 64 + fr, col0 = u.pn * BM + wc * 32 + 8 * fq;
        float rsv[2][4];
#pragma unroll
        for (int ai = 0; ai < 2; ++ai)
#pragma unroll
            for (int m = 0; m < 4; ++m) {
                const f32x4 pz = *(const f32x4*)(ss_in + (size_t)(row0 + ai * HALF + m * 16) * 16 + 4 * fq);
                float s = (pz[0] + pz[1]) + (pz[2] + pz[3]); s += __shfl_xor(s, 16); s += __shfl_xor(s, 32);
                rsv[ai][m] = rsqrtf(s * (1.0f / 1024.0f) + 1e-6f);
            }
#pragma unroll
        for (int ai = 0; ai < 2; ++ai)
#pragma unroll
            for (int m = 0; m < 4; ++m) {
                const int row = row0 + ai * HALF + m * 16;
                const float rs = rsv[ai][m];
                bf16_t* rowp = O + (size_t)row * ldc + col0; float sq = 0.f;
#pragma unroll
                for (int bj = 0; bj < 2; ++bj) {
                    f32x4 v0 = acc[ai][bj][m][0] * rs, v1 = acc[ai][bj][m][1] * rs;
                    if (ACT == 1) {
#pragma unroll
                        for (int j = 0; j < 4; ++j) { v0[j] = gelu_tanh(v0[j]); v1[j] = gelu_tanh(v1[j]); sq += v0[j] * v0[j] + v1[j] * v1[j]; }
                    }
                    if (ACT == 2) {
#pragma unroll
                        for (int j = 0; j < 4; ++j) { const float a = fmaxf(v0[j], 0.f), b = fmaxf(v1[j], 0.f); v0[j] = a * a; v1[j] = b * b; }
                    }
                    u32x4 w; w.x = cvt_pk_bf16(v0[0], v0[1]); w.y = cvt_pk_bf16(v0[2], v0[3]); w.z = cvt_pk_bf16(v1[0], v1[1]); w.w = cvt_pk_bf16(v1[2], v1[3]);
                    *(u32x4*)(rowp + bj * HALF) = w;
                }
                if (ACT == 1) {
                    sq += __shfl_xor(sq, 16); sq += __shfl_xor(sq, 32);
                    if (u.pn >= 4 && fq == 0) ssv[(size_t)row * 16 + (u.pn - 4) * 4 + wc] = sq;
                }
            }
    }
};
struct EpiResid {
    static constexpr bool PERM = false;
    const float* xin; float* xout; bf16_t* xb; float* ss_out;
    __device__ __forceinline__ void operator()(const f32x4 (&acc)[2][2][4][2], const Unit& u, int wr, int wc, int fr, int fq) const {
        const int row0 = u.pm * BM + wr * 64 + fr, col0 = u.pn * BM + wc * 32 + 4 * fq;
#pragma unroll
        for (int ai = 0; ai < 2; ++ai) {
            f32x4 xo4[4][2][2];
#pragma unroll
            for (int m = 0; m < 4; ++m)
#pragma unroll
                for (int bj = 0; bj < 2; ++bj)
#pragma unroll
                    for (int n = 0; n < 2; ++n) xo4[m][bj][n] = *(const f32x4*)(xin + (size_t)(row0 + ai * HALF + m * 16) * DM + col0 + bj * HALF + n * 16);
#pragma unroll
            for (int m = 0; m < 4; ++m) {
                const int row = row0 + ai * HALF + m * 16; const size_t off = (size_t)row * DM + col0; float sq = 0.f;
#pragma unroll
                for (int bj = 0; bj < 2; ++bj)
#pragma unroll
                    for (int n = 0; n < 2; ++n) {
                        const f32x4 v = xo4[m][bj][n] + acc[ai][bj][m][n];
                        *(f32x4*)(xout + off + bj * HALF + n * 16) = v;
                        u32x2 w; w.x = cvt_pk_bf16(v[0], v[1]); w.y = cvt_pk_bf16(v[2], v[3]); *(u32x2*)(xb + off + bj * HALF + n * 16) = w;
                        sq += (v[0] * v[0] + v[1] * v[1]) + (v[2] * v[2] + v[3] * v[3]);
                    }
                sq += __shfl_xor(sq, 16); sq += __shfl_xor(sq, 32);
                if (fq == 0) ss_out[(size_t)row * 16 + u.pn * 4 + wc] = sq;
            }
            asm volatile("" ::: "memory");
        }
    }
};

template <class Epi>
__device__ __forceinline__ void gemm_phase(LAS unsigned char* lds, const Gemm g, const StaticOrder& S, const Epi& E) {
    const int tid = opaque_tid(), wid = __builtin_amdgcn_readfirstlane(tid >> 6), lane = tid & 63, wr = wid >> 2, wc = wid & 3, fr = lane & 15, fq = lane >> 4;
    const int K = g.K, nt = K / BK, lda = g.lda;
    unsigned voffA[2], voffB[2];
#pragma unroll
    for (int i = 0; i < 2; ++i) { int R, C; stage_rc(tid * 16 + i * 8192, R, C); const int Rb = Epi::PERM ? ((R & ~31) + perm32(R & 31)) : R;
        voffA[i] = (unsigned)(R * lda + C) * 2u; voffB[i] = (unsigned)(Rb * K + C) * 2u; }
    const size_t kstep = (size_t)(BK * 2);
    const size_t hstepA = (size_t)HALF * lda * 2, hstepB = (size_t)HALF * K * 2;
    const size_t tstepA = 2 * hstepA, tstepB = 2 * hstepB;
    const unsigned ldsw = (unsigned)wid * 1024u;
    const int aoff = lds_byte(wr * 64 + fr, fq * 8), boff = lds_byte(wc * 32 + fr, fq * 8);
#define PG8_SA(b, h) (((b) * 2 + (h)) * HTB)
#define PG8_SB(b, h) ((4 + (b) * 2 + (h)) * HTB)
#define PG8_STAGE(bufoff, gbase, voff) do { _Pragma("unroll") for (int _i = 0; _i < 2; ++_i) \
        __builtin_amdgcn_global_load_lds((const unsigned*)((const char*)(gbase) + (voff)[_i]), (LAS unsigned*)(lds + (bufoff) + ldsw + _i * 8192), 16, 0, 0); } while (0)
#define PG8_LDA(dst, b, h) do { _Pragma("unroll") for (int m = 0; m < 4; ++m) _Pragma("unroll") for (int k = 0; k < 2; ++k) dst[m][k] = *(const LAS bf16x8*)(lds + PG8_SA(b, h) + aoff + m * 2048 + k * 1024); } while (0)
#define PG8_LDB(dst, b, h) do { _Pragma("unroll") for (int n = 0; n < 2; ++n) _Pragma("unroll") for (int k = 0; k < 2; ++k) dst[n][k] = *(const LAS bf16x8*)(lds + PG8_SB(b, h) + boff + n * 2048 + k * 1024); } while (0)
#define PG8_MMA(ai, bj, At, Bt) do { __builtin_amdgcn_s_setprio(1); _Pragma("unroll") for (int m = 0; m < 4; ++m) _Pragma("unroll") for (int n = 0; n < 2; ++n) _Pragma("unroll") for (int k = 0; k < 2; ++k) \
        acc[ai][bj][m][n] = __builtin_amdgcn_mfma_f32_16x16x32_bf16(Bt[n][k], At[m][k], acc[ai][bj][m][n], 0, 0, 0); __builtin_amdgcn_s_setprio(0); } while (0)
#define PG8_WAIT_V(n) asm volatile("s_waitcnt vmcnt(" #n ")" ::: "memory")
#define PG8_WAIT_L(n) asm volatile("s_waitcnt lgkmcnt(" #n ")" ::: "memory")
#define PG8_BAR __builtin_amdgcn_s_barrier()
#define PG8_SCHED __builtin_amdgcn_sched_barrier(0)
    Unit cur, nxt; int ui = 0;
    if (!S.next(0, cur)) return;
    f32x4 acc[2][2][4][2];
#pragma unroll
    for (int a = 0; a < 2; ++a)
#pragma unroll
        for (int b = 0; b < 2; ++b)
#pragma unroll
            for (int m = 0; m < 4; ++m)
#pragma unroll
                for (int n = 0; n < 2; ++n) acc[a][b][m][n] = (f32x4){0.f, 0.f, 0.f, 0.f};
    bf16x8 At[4][2], B0[2][2], B1[2][2];
    const char* cA = (const char*)g.A + (size_t)cur.pm * tstepA + (size_t)cur.pn * g.apn; const char* cB = (const char*)g.Bt + (size_t)cur.pn * tstepB;
    PG8_STAGE(PG8_SB(0, 0), cB, voffB); PG8_STAGE(PG8_SA(0, 0), cA, voffA); PG8_STAGE(PG8_SB(0, 1), cB + hstepB, voffB); PG8_STAGE(PG8_SA(0, 1), cA + hstepA, voffA);
    if (wr == 1) PG8_BAR;
    PG8_WAIT_V(4); PG8_BAR;
    PG8_STAGE(PG8_SB(1, 0), cB + kstep, voffB); PG8_STAGE(PG8_SA(1, 0), cA + kstep, voffA); PG8_STAGE(PG8_SB(1, 1), cB + hstepB + kstep, voffB);
    PG8_WAIT_V(6); PG8_BAR;
    for (;;) {
        const bool has_next = S.next(ui + 1, nxt);
        const char* nA = has_next ? (const char*)g.A + (size_t)nxt.pm * tstepA + (size_t)nxt.pn * g.apn : cA; const char* nB = has_next ? (const char*)g.Bt + (size_t)nxt.pn * tstepB : cB;
        for (int t = 0; t < nt; t += 2) {
            const bool last = (t == nt - 2);
            const char* a1 = cA + (size_t)(t + 1) * kstep;
            const char* a2 = last ? nA : cA + (size_t)(t + 2) * kstep; const char* b2 = last ? nB : cB + (size_t)(t + 2) * kstep;
            const char* a3 = a2 + kstep; const char* b3 = b2 + kstep;
            PG8_LDB(B0, 0, 0); PG8_SCHED; PG8_LDA(At, 0, 0); PG8_STAGE(PG8_SA(1, 1), a1 + hstepA, voffA);
            PG8_WAIT_L(8); PG8_BAR; PG8_WAIT_L(0); PG8_MMA(0, 0, At, B0); PG8_BAR; PG8_SCHED;
            PG8_LDB(B1, 0, 1); PG8_STAGE(PG8_SB(0, 0), b2, voffB);
            PG8_BAR; PG8_WAIT_L(0); PG8_MMA(0, 1, At, B1); PG8_BAR;
            PG8_LDA(At, 0, 1); PG8_STAGE(PG8_SA(0, 0), a2, voffA);
            PG8_BAR; PG8_WAIT_L(0); PG8_MMA(1, 0, At, B0); PG8_BAR; PG8_SCHED;
            PG8_STAGE(PG8_SB(0, 1), b2 + hstepB, voffB);
            PG8_WAIT_V(6); PG8_BAR; PG8_MMA(1, 1, At, B1); PG8_BAR;
            PG8_LDB(B0, 1, 0); PG8_SCHED; PG8_LDA(At, 1, 0); PG8_STAGE(PG8_SA(0, 1), a2 + hstepA, voffA);
            PG8_WAIT_L(8); PG8_BAR; PG8_WAIT_L(0); PG8_MMA(0, 0, At, B0); PG8_BAR; PG8_SCHED;
            PG8_LDB(B1, 1, 1); PG8_STAGE(PG8_SB(1, 0), b3, voffB);
            PG8_BAR; PG8_WAIT_L(0); PG8_MMA(0, 1, At, B1); PG8_BAR;
            PG8_LDA(At, 1, 1); PG8_STAGE(PG8_SA(1, 0), a3, voffA);
            PG8_BAR; PG8_WAIT_L(0); PG8_MMA(1, 0, At, B0); PG8_BAR; PG8_SCHED;
            PG8_STAGE(PG8_SB(1, 1), b3 + hstepB, voffB);
            PG8_WAIT_V(6); PG8_BAR; PG8_MMA(1, 1, At, B1); PG8_BAR;
        }
        E(acc, cur, wr, wc, fr, fq);
        if (!has_next) break;
#pragma unroll
        for (int a = 0; a < 2; ++a)
#pragma unroll
            for (int b = 0; b < 2; ++b)
#pragma unroll
                for (int m = 0; m < 4; ++m)
#pragma unroll
                    for (int n = 0; n < 2; ++n) acc[a][b][m][n] = (f32x4){0.f, 0.f, 0.f, 0.f};
        cur = nxt; cA = nA; cB = nB; ++ui;
    }
    PG8_WAIT_V(0);
    if (wr == 0) PG8_BAR;
    PG8_BAR;
#undef PG8_SA
#undef PG8_SB
#undef PG8_STAGE
#undef PG8_LDA
#undef PG8_LDB
#undef PG8_MMA
#undef PG8_WAIT_V
#undef PG8_WAIT_L
#undef PG8_BAR
#undef PG8_SCHED
}
}

__device__ void transpose_convert(int gw, int nw, int lane, const float* W, int K, int N, int Npad, bf16_t* Wt, int ldt, const float* rowgain, const float* colgain) {
    const int kb_n = K / 8, units = kb_n * (Npad / 256);
    for (int u = gw; u < units; u += nw) {
        const int k0 = (u % kb_n) * 8, n = (u / kb_n) * 256 + 4 * lane;
        f32x4 v[8];
        if (n < N) {
#pragma unroll
            for (int i = 0; i < 8; ++i) v[i] = *(const f32x4*)(W + (size_t)(k0 + i) * N + n);
            if (rowgain) {
#pragma unroll
                for (int i = 0; i < 8; ++i) v[i] *= rowgain[k0 + i];
            }
            if (colgain) { const f32x4 cgv = *(const f32x4*)(colgain + n);
#pragma unroll
                for (int i = 0; i < 8; ++i) v[i] *= cgv; }
        } else {
#pragma unroll
            for (int i = 0; i < 8; ++i) v[i] = (f32x4){0.f, 0.f, 0.f, 0.f};
        }
#pragma unroll
        for (int j = 0; j < 4; ++j) {
            u32x4 w; w.x = cvt_pk_bf16(v[0][j], v[1][j]); w.y = cvt_pk_bf16(v[2][j], v[3][j]); w.z = cvt_pk_bf16(v[4][j], v[5][j]); w.w = cvt_pk_bf16(v[6][j], v[7][j]);
            *(u32x4*)(Wt + (size_t)(n + j) * ldt + k0) = w;
        }
    }
}

__device__ void phase_prologue(const Params& p, LAS unsigned char* lds) {
    unsigned char* ws = p.ws;
    const int tid = opaque_tid(), lane = tid & 63, wave = tid >> 6;
    const int gw = blockIdx.x * 8 + wave, nw = gridDim.x * 8;
    const size_t gtid = (size_t)blockIdx.x * 512 + tid, gsz = (size_t)gridDim.x * 512;
    float* ss = (float*)(ws + WS_SS);
    bf16_t* xb = (bf16_t*)(ws + WS_XB);
    for (int row = blockIdx.x * 8 + wave; row < MTOK; row += gridDim.x * 8) {
        const f32x4* xr = (const f32x4*)(p.x + (size_t)row * DM); float sq = 0.f;
#pragma unroll
        for (int i = 0; i < 4; ++i) { const f32x4 v = xr[lane + 64 * i]; sq += (v[0] * v[0] + v[1] * v[1]) + (v[2] * v[2] + v[3] * v[3]);
            u32x2 w; w.x = cvt_pk_bf16(v[0], v[1]); w.y = cvt_pk_bf16(v[2], v[3]); *(u32x2*)(xb + (size_t)row * DM + (lane + 64 * i) * 4) = w; }
        sq = wave_sum(sq);
        if (lane < 16) ss[(size_t)row * 16 + lane] = lane == 0 ? sq : 0.f;
    }
    transpose_convert(gw, nw, lane, p.a_w_in, 1024, 2048, 2048, (bf16_t*)(ws + W_A_IN), 1024, p.norm_mix_g + 0 * DM, nullptr);
    transpose_convert(gw, nw, lane, p.a_w_out, 1024, 1024, 1024, (bf16_t*)(ws + W_A_OUT), 1024, nullptr, nullptr);
    transpose_convert(gw, nw, lane, p.b_w_in, 1024, 3072, 3072, (bf16_t*)(ws + W_B_IN), 1024, p.norm_mix_g + 1 * DM, nullptr);
    transpose_convert(gw, nw, lane, p.b_w_out, 1024, 1024, 1024, (bf16_t*)(ws + W_B_OUT), 1024, nullptr, nullptr);
    transpose_convert(gw, nw, lane, p.c_w_in, 1024, 1024, 1024, (bf16_t*)(ws + W_C_IN), 1024, p.norm_mix_g + 2 * DM, nullptr);
    for (int g = 0; g < 4; ++g)
        transpose_convert(gw, nw, lane, p.c_w_grp + (size_t)g * 65536, 256, 256, 256, (bf16_t*)(ws + W_C_GRP) + (size_t)g * 65536, 256, nullptr, p.c_scale + g * 256);
    transpose_convert(gw, nw, lane, p.d_w_in, 1024, 2760, DSA_LD, (bf16_t*)(ws + W_D_IN), 1024, p.norm_mix_g + 3 * DM, nullptr);
    for (int l = 0; l < 4; ++l) {
        transpose_convert(gw, nw, lane, p.mlp_w1 + (size_t)l * 4194304, 1024, 4096, 4096, (bf16_t*)(ws + W_1) + (size_t)l * 4194304, 1024, p.norm_mlp_g + l * DM, nullptr);
        transpose_convert(gw, nw, lane, p.mlp_w2 + (size_t)l * 4194304, 4096, 1024, 1024, (bf16_t*)(ws + W_2) + (size_t)l * 4194304, 4096, nullptr, nullptr);
    }
    { bf16_t* wsm = (bf16_t*)(ws + W_A_S);
      for (size_t i = gtid; i < (size_t)8 * 128 * 128; i += gsz) { const int s = (int)(i & 127), t = (int)((i >> 7) & 127); const float v = (s <= t) ? p.a_w_s[i] : 0.f; wsm[i] = (bf16_t)(cvt_pk_bf16(v, 0.f) & 0xffffu); } }
    { bf16_t* wc = (bf16_t*)(ws + W_D_COMB);
      for (int u = gw; u < 256 * 4; u += nw) {
          const int k0 = (u >> 2) * 8, n = (u & 3) * 256 + 4 * lane, h = k0 >> 7;
          const float* uv = p.d_w_uv + (size_t)k0 * 64; const float* wo = p.d_w_out + (size_t)h * 64 * 1024 + n;
          f32x4 a[8];
#pragma unroll
          for (int i = 0; i < 8; ++i) a[i] = (f32x4){0.f, 0.f, 0.f, 0.f};
#pragma unroll 4
          for (int v = 0; v < 64; ++v) { const f32x4 w4 = *(const f32x4*)(wo + (size_t)v * 1024);
#pragma unroll
              for (int i = 0; i < 8; ++i) a[i] += w4 * uv[i * 64 + v]; }
#pragma unroll
          for (int j = 0; j < 4; ++j) {
              u32x4 w; w.x = cvt_pk_bf16(a[0][j], a[1][j]); w.y = cvt_pk_bf16(a[2][j], a[3][j]); w.z = cvt_pk_bf16(a[4][j], a[5][j]); w.w = cvt_pk_bf16(a[6][j], a[7][j]);
              *(u32x4*)(wc + (size_t)(n + j) * 2048 + k0) = w; } } }
}

__device__ void phase_sgu(const Params& p, LAS unsigned char* lds) {
    unsigned char* ws = p.ws;
    const int tid = opaque_tid(), lane = tid & 63, wave = __builtin_amdgcn_readfirstlane(tid >> 6), g4 = lane >> 4, l15 = lane & 15, q = l15 >> 2, pp = lane & 3;
    const bf16_t* z = (const bf16_t*)(ws + WS_BIG); bf16_t* us = (bf16_t*)(ws + WS_BIG + 256 * MiB);
    const float* ssv = (const float*)(ws + WS_SS) + (size_t)9 * MTOK * 16; const bf16_t* wsm = (const bf16_t*)(ws + W_A_S);
    const unsigned ldsbase = (unsigned)(size_t)(unsigned char*)lds;
    for (int unit = blockIdx.x; unit < 4096; unit += gridDim.x) {
        const int g = unit & 7, chunk = unit >> 3; const size_t row0 = (size_t)chunk * 128;
#pragma unroll
        for (int i = 0; i < 4; ++i) {
            const int e = tid + 512 * i, r = e >> 4, ch = e & 15;
            const u32x4 raw = *(const u32x4*)(z + (row0 + r) * 2048 + 1024 + g * 128 + ch * 8);
            const float rs = rsqrtf(sum16(ssv + (row0 + r) * 16) * (1.0f / 1024.0f) + 1e-6f);
            const f32x4 g0 = *(const f32x4*)(p.a_v_g + g * 128 + ch * 8), g1 = *(const f32x4*)(p.a_v_g + g * 128 + ch * 8 + 4);
            u32x4 o;
            o.x = cvt_pk_bf16(bflo(raw.x) * rs * g0[0], bfhi(raw.x) * rs * g0[1]); o.y = cvt_pk_bf16(bflo(raw.y) * rs * g0[2], bfhi(raw.y) * rs * g0[3]);
            o.z = cvt_pk_bf16(bflo(raw.z) * rs * g1[0], bfhi(raw.z) * rs * g1[1]); o.w = cvt_pk_bf16(bflo(raw.w) * rs * g1[2], bfhi(raw.w) * rs * g1[3]);
            *(LAS u32x4*)(lds + (r >> 5) * 8192 + off_b(r & 31, ch)) = o;
        }
        __syncthreads();
        const int t = 16 * wave + l15, nks = (wave >> 1) + 1;
        f32x4 acc[8];
#pragma unroll
        for (int ct = 0; ct < 8; ++ct) acc[ct] = (f32x4){0.f, 0.f, 0.f, 0.f};
        for (int ks = 0; ks < nks; ++ks) {
            const bf16x8 Bw = *(const bf16x8*)(wsm + ((size_t)g * 128 + t) * 128 + 32 * ks + 8 * g4);
#pragma unroll
            for (int ct = 0; ct < 8; ++ct) {
                const unsigned a0 = ldsbase + ks * 8192 + off_b(8 * g4 + q, 2 * ct + (pp >> 1)) + 8 * (pp & 1);
                const unsigned a1 = ldsbase + ks * 8192 + off_b(8 * g4 + 4 + q, 2 * ct + (pp >> 1)) + 8 * (pp & 1);
                const bf16x8 Av = tr_read2(a0, a1);
                acc[ct] = __builtin_amdgcn_mfma_f32_16x16x32_bf16(Av, Bw, acc[ct], 0, 0, 0);
            }
        }
        const float bias = p.a_b_s[g * 128 + t]; const size_t rowg = row0 + t;
#pragma unroll
        for (int ct = 0; ct < 8; ++ct) {
            const u32x2 uu = *(const u32x2*)(z + rowg * 2048 + g * 128 + 16 * ct + 4 * g4);
            u32x2 o; o.x = cvt_pk_bf16(bflo(uu.x) * (acc[ct][0] + bias), bfhi(uu.x) * (acc[ct][1] + bias)); o.y = cvt_pk_bf16(bflo(uu.y) * (acc[ct][2] + bias), bfhi(uu.y) * (acc[ct][3] + bias));
            *(u32x2*)(us + rowg * 1024 + g * 128 + 16 * ct + 4 * g4) = o;
        }
        __syncthreads();
    }
}

__device__ void phase_conv(const Params& p) {
    unsigned char* ws = p.ws; const bf16_t* bch = (const bf16_t*)(ws + WS_BIG); bf16_t* gated = (bf16_t*)(ws + WS_BIG + 384 * MiB);
    const size_t gtid = (size_t)blockIdx.x * 512 + opaque_tid(), gsz = (size_t)gridDim.x * 512;
    for (size_t it = gtid; it < (size_t)4096 * 128; it += gsz) {
        const int ch = (int)(it & 127) * 8, rb = (int)(it >> 7); const int r0 = rb * 16;
        float w0[8], w1[8], w2[8], zm2[8], zm1[8];
#pragma unroll
        for (int j = 0; j < 8; ++j) { w0[j] = p.b_conv_w[ch + j]; w1[j] = p.b_conv_w[1024 + ch + j]; w2[j] = p.b_conv_w[2048 + ch + j]; zm2[j] = 0.f; zm1[j] = 0.f; }
        const int tpos0 = r0 & (SEQ - 1);
        for (int d = 2; d >= 1; --d) {
            if (tpos0 - d >= 0) {
                const bf16_t* rp = bch + (size_t)(r0 - d) * 3072; const u32x4 c = *(const u32x4*)(rp + 1024 + ch), h = *(const u32x4*)(rp + 2048 + ch);
                float zz[8] = {bflo(c.x) * bflo(h.x), bfhi(c.x) * bfhi(h.x), bflo(c.y) * bflo(h.y), bfhi(c.y) * bfhi(h.y), bflo(c.z) * bflo(h.z), bfhi(c.z) * bfhi(h.z), bflo(c.w) * bflo(h.w), bfhi(c.w) * bfhi(h.w)};
#pragma unroll
                for (int j = 0; j < 8; ++j) { if (d == 2) zm2[j] = zz[j]; else zm1[j] = zz[j]; }
            }
        }
        for (int r = r0; r < r0 + 16; ++r) {
            const bf16_t* rp = bch + (size_t)r * 3072; const u32x4 b = *(const u32x4*)(rp + ch), c = *(const u32x4*)(rp + 1024 + ch), h = *(const u32x4*)(rp + 2048 + ch);
            float zz[8] = {bflo(c.x) * bflo(h.x), bfhi(c.x) * bfhi(h.x), bflo(c.y) * bflo(h.y), bfhi(c.y) * bfhi(h.y), bflo(c.z) * bflo(h.z), bfhi(c.z) * bfhi(h.z), bflo(c.w) * bflo(h.w), bfhi(c.w) * bfhi(h.w)};
            float bb[8] = {bflo(b.x), bfhi(b.x), bflo(b.y), bfhi(b.y), bflo(b.z), bfhi(b.z), bflo(b.w), bfhi(b.w)};
            float o[8];
#pragma unroll
            for (int j = 0; j < 8; ++j) { o[j] = bb[j] * (w0[j] * zm2[j] + w1[j] * zm1[j] + w2[j] * zz[j]); zm2[j] = zm1[j]; zm1[j] = zz[j]; }
            u32x4 w; w.x = cvt_pk_bf16(o[0], o[1]); w.y = cvt_pk_bf16(o[2], o[3]); w.z = cvt_pk_bf16(o[4], o[5]); w.w = cvt_pk_bf16(o[6], o[7]);
            *(u32x4*)(gated + (size_t)r * 1024 + ch) = w;
        }
    }
}

__device__ __forceinline__ void ld8(const bf16_t* ptr, float (&f)[8]) {
    const u32x4 v = *(const u32x4*)ptr; f[0] = bflo(v.x); f[1] = bfhi(v.x); f[2] = bflo(v.y); f[3] = bfhi(v.y); f[4] = bflo(v.z); f[5] = bfhi(v.z); f[6] = bflo(v.w); f[7] = bfhi(v.w);
}
__device__ void phase_pool(const Params& p) {
    unsigned char* ws = p.ws; const bf16_t* z = (const bf16_t*)(ws + WS_BIG); bf16_t* pooled = (bf16_t*)(ws + WS_BIG + 128 * MiB);
    const size_t gtid = (size_t)blockIdx.x * 512 + opaque_tid(), gsz = (size_t)gridDim.x * 512;
    for (size_t it = gtid; it < (size_t)2048 * 128; it += gsz) {
        const int lane = (int)(it & 63), wv = (int)(it >> 6), chunk = (wv & 3) * 32 + (lane & 31), rb = (wv >> 2) * 2 + (lane >> 5);
        const int ch = chunk * 8, w = 2 << (ch >> 8), r0 = rb * 32;
        float S[8];
#pragma unroll
        for (int j = 0; j < 8; ++j) S[j] = 0.f;
        const int tpos0 = r0 & (SEQ - 1);
        for (int d = 1; d <= w; ++d) {
            if (tpos0 - d >= 0) { float f[8]; ld8(z + (size_t)(r0 - d) * 1024 + ch, f);
#pragma unroll
                for (int j = 0; j < 8; ++j) S[j] += f[j]; }
        }
        for (int r = r0; r < r0 + 32; ++r) {
            const int tpos = r & (SEQ - 1); float f[8]; ld8(z + (size_t)r * 1024 + ch, f);
#pragma unroll
            for (int j = 0; j < 8; ++j) S[j] += f[j];
            if (tpos - w >= 0) { float o[8]; ld8(z + (size_t)(r - w) * 1024 + ch, o);
#pragma unroll
                for (int j = 0; j < 8; ++j) S[j] -= o[j]; }
            const int cnt = (tpos + 1 < w) ? tpos + 1 : w; const float inv = 1.0f / (float)cnt;
            u32x4 o; o.x = cvt_pk_bf16(S[0] * inv - f[0], S[1] * inv - f[1]); o.y = cvt_pk_bf16(S[2] * inv - f[2], S[3] * inv - f[3]);
            o.z = cvt_pk_bf16(S[4] * inv - f[4], S[5] * inv - f[5]); o.w = cvt_pk_bf16(S[6] * inv - f[6], S[7] * inv - f[7]);
            *(u32x4*)(pooled + (size_t)r * 1024 + ch) = o;
        }
    }
}

__device__ __forceinline__ int cnt_ge8(const unsigned* v, unsigned cand) {
    unsigned long long m0, m1, m2, m3, m4, m5, m6, m7;
    asm("v_cmp_le_u32_e64 %0, %8, %9\n\tv_cmp_le_u32_e64 %1, %8, %10\n\tv_cmp_le_u32_e64 %2, %8, %11\n\tv_cmp_le_u32_e64 %3, %8, %12\n\t"
        "v_cmp_le_u32_e64 %4, %8, %13\n\tv_cmp_le_u32_e64 %5, %8, %14\n\tv_cmp_le_u32_e64 %6, %8, %15\n\tv_cmp_le_u32_e64 %7, %8, %16"
        : "=&s"(m0), "=&s"(m1), "=&s"(m2), "=&s"(m3), "=&s"(m4), "=&s"(m5), "=&s"(m6), "=&s"(m7)
        : "s"(cand), "v"(v[0]), "v"(v[1]), "v"(v[2]), "v"(v[3]), "v"(v[4]), "v"(v[5]), "v"(v[6]), "v"(v[7]));
    return (__builtin_popcountll(m0) + __builtin_popcountll(m1)) + (__builtin_popcountll(m2) + __builtin_popcountll(m3)) +
           (__builtin_popcountll(m4) + __builtin_popcountll(m5)) + (__builtin_popcountll(m6) + __builtin_popcountll(m7));
}
__device__ void phase_topk(const Params& p, LAS unsigned char* lds) {
    unsigned char* ws = p.ws;
    const int tid = opaque_tid(), lane = tid & 63, wave = __builtin_amdgcn_readfirstlane(tid >> 6), g4 = lane >> 4, l15 = lane & 15;
    const bf16_t* din = (const bf16_t*)(ws + WS_BIG); bf16_t* cn = (bf16_t*)(ws + WS_CN); unsigned short* idx = (unsigned short*)(ws + WS_IDX);
    LAS float* S = (LAS float*)lds;
    constexpr int SROW = 4112;
    { const float kg0 = p.d_kv_g[2 * lane], kg1 = p.d_kv_g[2 * lane + 1];
      for (int row4 = (blockIdx.x * 8 + wave) * 4; row4 < MTOK; row4 += gridDim.x * 32) {
        unsigned raw[4];
#pragma unroll
        for (int j = 0; j < 4; ++j) raw[j] = *(const unsigned*)(din + (size_t)(row4 + j) * DSA_LD + 2048 + 2 * lane);
#pragma unroll
        for (int j = 0; j < 4; ++j) { const float a = bflo(raw[j]), b = bfhi(raw[j]);
            const float sq = wave_sum(a * a + b * b); const float rs = rsqrtf(sq * (1.0f / 128.0f) + 1e-6f);
            *(unsigned*)(cn + (size_t)(row4 + j) * 128 + 2 * lane) = cvt_pk_bf16(a * rs * kg0, b * rs * kg1); }
      } }
    for (int unit = blockIdx.x; unit < 8192; unit += gridDim.x) {
        const int pi = (unit / (2 * (int)gridDim.x)) * (int)gridDim.x + (unit % (int)gridDim.x), hi = (unit / (int)gridDim.x) & 1;
        const int b = pi >> 8, cc = pi & 255, qt = hi ? 511 - cc : cc, qpos0 = qt * 8; const size_t rowq0 = (size_t)b * SEQ + qpos0;
        bf16x8 Aq[4][2]; float wv[4][4];
#pragma unroll
        for (int pr = 0; pr < 4; ++pr) {
            const int qg = pr >> 1, hh = pr & 1;
            const bf16_t* base = din + (rowq0 + 4 * qg + (l15 >> 2)) * DSA_LD + 2176 + (4 * hh + (l15 & 3)) * 64;
            Aq[pr][0] = *(const bf16x8*)(base + 8 * g4); Aq[pr][1] = *(const bf16x8*)(base + 32 + 8 * g4);
            const u32x2 wr = *(const u32x2*)(din + (rowq0 + 4 * qg + g4) * DSA_LD + 2752 + 4 * hh);
            wv[pr][0] = bflo(wr.x) * 0.04419417382f; wv[pr][1] = bfhi(wr.x) * 0.04419417382f; wv[pr][2] = bflo(wr.y) * 0.04419417382f; wv[pr][3] = bfhi(wr.y) * 0.04419417382f;
        }
        const int nkt = (qpos0 + 7) / 16 + 1;
#if PROBE_TOPK == 1
        for (int rep_ = 0; rep_ < 2; ++rep_) {
#endif
        bf16x8 B0[4], B1[4], N0[4], N1[4];
#pragma unroll
        for (int j = 0; j < 4; ++j) { const int kt = (wave + 8 * j < nkt) ? wave + 8 * j : 0;
            const bf16_t* kb = din + ((size_t)b * SEQ + 16 * kt + l15) * DSA_LD + 2688;
            B0[j] = *(const bf16x8*)(kb + 8 * g4); B1[j] = *(const bf16x8*)(kb + 32 + 8 * g4); }
        for (int kt0 = wave; kt0 < nkt; kt0 += 32) {
#pragma unroll
            for (int j = 0; j < 4; ++j) { const int kt = (kt0 + 32 + 8 * j < nkt) ? kt0 + 32 + 8 * j : 0;
                const bf16_t* kb = din + ((size_t)b * SEQ + 16 * kt + l15) * DSA_LD + 2688;
                N0[j] = *(const bf16x8*)(kb + 8 * g4); N1[j] = *(const bf16x8*)(kb + 32 + 8 * g4); }
#pragma unroll
            for (int j = 0; j < 4; ++j) {
                const int kt = kt0 + 8 * j;
                if (kt < nkt) {
#pragma unroll
                    for (int qg = 0; qg < 2; ++qg) {
                        float part = 0.f;
#pragma unroll
                        for (int hh = 0; hh < 2; ++hh) {
                            const int pr = 2 * qg + hh;
                            f32x4 c = (f32x4){0.f, 0.f, 0.f, 0.f};
                            c = __builtin_amdgcn_mfma_f32_16x16x32_bf16(Aq[pr][0], B0[j], c, 0, 0, 0);
                            c = __builtin_amdgcn_mfma_f32_16x16x32_bf16(Aq[pr][1], B1[j], c, 0, 0, 0);
                            part += (fmaxf(c[0], 0.f) * wv[pr][0] + fmaxf(c[1], 0.f) * wv[pr][1]) + (fmaxf(c[2], 0.f) * wv[pr][2] + fmaxf(c[3], 0.f) * wv[pr][3]);
                        }
                        S[(4 * qg + g4) * SROW + 16 * kt + l15] = part + 0.0f;
                    }
                }
            }
#pragma unroll
            for (int j = 0; j < 4; ++j) { B0[j] = N0[j]; B1[j] = N1[j]; }
        }
#if PROBE_TOPK == 1
        }
#endif
        __syncthreads();
#if PROBE_TOPK == 2
        for (int rep_ = 0; rep_ < 2; ++rep_)
#endif
        {
            const int qpos = qpos0 + wave, n = qpos + 1; unsigned short* out = idx + (rowq0 + wave) * 256;
            if (n <= 256) {
#pragma unroll
                for (int i = 0; i < 4; ++i) { const int j = lane + 64 * i; out[j] = (unsigned short)(j < n ? j : 0xFFFF); }
            } else {
                unsigned u[64];
                const int ni = (n + 63) >> 6;
#pragma unroll
                for (int blk = 0; blk < 8; ++blk) {
                    if (blk * 8 < ni) {
#pragma unroll
                        for (int i = blk * 8; i < blk * 8 + 8; ++i) { const int key = lane + 64 * i; unsigned bits = __float_as_uint(S[wave * SROW + key]); bits ^= (bits >> 31) ? 0xFFFFFFFFu : 0x80000000u; u[i] = key < n ? bits : 0u; }
                    } else {
#pragma unroll
                        for (int i = blk * 8; i < blk * 8 + 8; ++i) u[i] = 0u;
                    }
                }
                unsigned T = 0u;
                for (int bit = 31; bit >= 0; --bit) {
                    const unsigned cand = __builtin_amdgcn_readfirstlane(T | (1u << bit)); int cnt = 0;
#pragma unroll
                    for (int blk = 0; blk < 8; ++blk) {
                        if (blk * 8 < ni) cnt += cnt_ge8(&u[blk * 8], cand);
                    }
                    if (cnt >= 256) T = cand;
                }
                int G = 0;
#pragma unroll
                for (int i = 0; i < 64; ++i) G += __popcll(__ballot(u[i] > T));
                const int need = 256 - G; int base = 0, tie_seen = 0;
                const unsigned long long ltmask = (1ull << lane) - 1ull;
#pragma unroll
                for (int blk = 0; blk < 8; ++blk) {
                    if (blk * 8 < ni) {
#pragma unroll
                        for (int i = blk * 8; i < blk * 8 + 8; ++i) {
                            const bool gt = u[i] > T, eq = u[i] == T;
                            const unsigned long long meq = __ballot(eq);
                            const bool sel = gt || (eq && (tie_seen + __popcll(meq & ltmask)) < need);
                            const unsigned long long msel = __ballot(sel);
                            if (sel) out[base + __popcll(msel & ltmask)] = (unsigned short)(lane + 64 * i);
                            base += __popcll(msel); tie_seen += __popcll(meq);
                        }
                    }
                }
            }
        }
        __syncthreads();
    }
}

__device__ void phase_attn(const Params& p, LAS unsigned char* lds, bool dry) {
    unsigned char* ws = p.ws;
    const int tid = opaque_tid(), lane = tid & 63, wave = __builtin_amdgcn_readfirstlane(tid >> 6), g4 = lane >> 4, l15 = lane & 15, q = l15 >> 2, pp = lane & 3;
    bf16_t* din = (bf16_t*)(ws + WS_BIG); const bf16_t* cn = (const bf16_t*)(ws + WS_CN); const unsigned short* idx = (const unsigned short*)(ws + WS_IDX);
    LAS unsigned char* wl = lds + wave * 8192; const unsigned wbase = (unsigned)(size_t)(unsigned char*)lds + wave * 8192;
    const float scale = 0.08838834764f;
    for (int Q = blockIdx.x * 8 + wave; Q < MTOK; Q += gridDim.x * 8) {
        const int b = Q >> 12, qpos = Q & (SEQ - 1); const int nvalid = qpos + 1 < 256 ? qpos + 1 : 256;
        bf16_t* qrow = din + (size_t)Q * DSA_LD;
        bf16x8 Bq[4];
#pragma unroll
        for (int s = 0; s < 4; ++s) Bq[s] = *(const bf16x8*)(qrow + l15 * 128 + 32 * s + 8 * g4);
        f32x4 O[8];
#pragma unroll
        for (int mt = 0; mt < 8; ++mt) O[mt] = (f32x4){0.f, 0.f, 0.f, 0.f};
        float mrun = -1e30f, lrun = 0.f;
        unsigned kid[16];
#pragma unroll
        for (int i = 0; i < 16; ++i) { const int slot = i * 16 + l15; const unsigned v = idx[(size_t)Q * 256 + slot]; kid[i] = slot < nvalid ? v : 0u; }
        bf16x8 A[2][4], An[2][4];
#pragma unroll
        for (int tl = 0; tl < 2; ++tl) { const bf16_t* crow = cn + ((size_t)b * SEQ + kid[tl]) * 128;
#pragma unroll
            for (int s = 0; s < 4; ++s) A[tl][s] = *(const bf16x8*)(crow + 32 * s + 8 * g4); }
#pragma unroll
        for (int ck = 0; ck < 8; ++ck) {
            if (ck * 32 < nvalid) {
                if (ck < 7) {
#pragma unroll
                    for (int tl = 0; tl < 2; ++tl) { const bf16_t* crow = cn + ((size_t)b * SEQ + kid[(ck < 7 ? ck + 1 : ck) * 2 + tl]) * 128;
#pragma unroll
                        for (int s = 0; s < 4; ++s) An[tl][s] = *(const bf16x8*)(crow + 32 * s + 8 * g4); }
                }
                f32x4 S0 = (f32x4){0.f, 0.f, 0.f, 0.f}, S1 = (f32x4){0.f, 0.f, 0.f, 0.f};
#pragma unroll
                for (int s = 0; s < 4; ++s) { S0 = __builtin_amdgcn_mfma_f32_16x16x32_bf16(A[0][s], Bq[s], S0, 0, 0, 0); S1 = __builtin_amdgcn_mfma_f32_16x16x32_bf16(A[1][s], Bq[s], S1, 0, 0, 0); }
#pragma unroll
                for (int tl = 0; tl < 2; ++tl)
#pragma unroll
                    for (int s = 0; s < 4; ++s) *(LAS bf16x8*)(wl + off_b(16 * tl + l15, 4 * s + g4)) = A[tl][s];
                float sv[8];
#pragma unroll
                for (int j = 0; j < 4; ++j) { const int s0 = ck * 32 + 4 * g4 + j; sv[j] = s0 < nvalid ? S0[j] * scale : -1e30f; sv[4 + j] = (s0 + 16) < nvalid ? S1[j] * scale : -1e30f; }
                float cm = fmaxf(fmaxf(fmaxf(sv[0], sv[1]), fmaxf(sv[2], sv[3])), fmaxf(fmaxf(sv[4], sv[5]), fmaxf(sv[6], sv[7])));
                cm = fmaxf(cm, __shfl_xor(cm, 16)); cm = fmaxf(cm, __shfl_xor(cm, 32));
                const float mn = fmaxf(mrun, cm), alpha = __expf(mrun - mn);
                float pv[8], ps = 0.f;
#pragma unroll
                for (int j = 0; j < 8; ++j) { pv[j] = __expf(sv[j] - mn); ps += pv[j]; }
                lrun = lrun * alpha + ps; mrun = mn;
#pragma unroll
                for (int mt = 0; mt < 8; ++mt) O[mt] *= alpha;
                union { u32x4 u; bf16x8 h; } Pb;
                Pb.u.x = cvt_pk_bf16(pv[0], pv[1]); Pb.u.y = cvt_pk_bf16(pv[2], pv[3]); Pb.u.z = cvt_pk_bf16(pv[4], pv[5]); Pb.u.w = cvt_pk_bf16(pv[6], pv[7]);
                asm volatile("s_waitcnt lgkmcnt(0)" ::: "memory");
#pragma unroll
                for (int mt = 0; mt < 8; ++mt) {
                    const unsigned a0 = wbase + off_b(4 * g4 + q, 2 * mt + (pp >> 1)) + 8 * (pp & 1);
                    const unsigned a1 = wbase + off_b(16 + 4 * g4 + q, 2 * mt + (pp >> 1)) + 8 * (pp & 1);
                    const bf16x8 Av = tr_read2(a0, a1);
                    O[mt] = __builtin_amdgcn_mfma_f32_16x16x32_bf16(Av, Pb.h, O[mt], 0, 0, 0);
                }
                if (ck < 7) {
#pragma unroll
                    for (int tl = 0; tl < 2; ++tl)
#pragma unroll
                        for (int s = 0; s < 4; ++s) A[tl][s] = An[tl][s];
                }
            }
        }
        lrun += __shfl_xor(lrun, 16); lrun += __shfl_xor(lrun, 32);
        const float inv = 1.0f / lrun;
#pragma unroll
        for (int mt = 0; mt < 8; ++mt) {
            u32x2 o; o.x = cvt_pk_bf16(O[mt][0] * inv, O[mt][1] * inv); o.y = cvt_pk_bf16(O[mt][2] * inv, O[mt][3] * inv);
            if (!dry) *(u32x2*)(qrow + l15 * 128 + 16 * mt + 4 * g4) = o;
        }
    }
}

__device__ void phase_final(const Params& p) {
    const int tid = opaque_tid(); const int lane = tid & 63, wave = tid >> 6;
    const float* ss = (const float*)(p.ws + WS_SS) + (size_t)8 * MTOK * 16;
    for (int row = blockIdx.x * 8 + wave; row < MTOK; row += gridDim.x * 8) {
        const float rs = rsqrtf(sum16(ss + (size_t)row * 16) * (1.0f / 1024.0f) + 1e-6f);
        f32x4* xr = (f32x4*)(p.out + (size_t)row * DM);
#pragma unroll
        for (int i = 0; i < 4; ++i) { const f32x4 g = *(const f32x4*)(p.final_g + (lane + 64 * i) * 4); f32x4 v = xr[lane + 64 * i]; v = v * rs * g; xr[lane + 64 * i] = v; }
    }
}

enum { K_PRO = 0, K_GACT, K_GRES, K_SGU, K_CONV, K_POOL, K_TOPK, K_ATTN, K_FINAL };
struct PhaseDesc { int kind, act, lda, apn, N, K, ldc, ss_idx, xin_is_x, pad; size_t a_off, w_off; };
__device__ __forceinline__ PhaseDesc mk_act(int act, size_t w_off, int N, int ss_idx) { PhaseDesc d{}; d.kind = K_GACT; d.act = act; d.lda = 1024; d.apn = 0; d.N = N; d.K = 1024; d.ldc = N; d.ss_idx = ss_idx; d.a_off = WS_XB; d.w_off = w_off; return d; }
__device__ __forceinline__ PhaseDesc mk_res(size_t a_off, int lda, int apn, size_t w_off, int K, int xin_is_x, int ss_idx) { PhaseDesc d{}; d.kind = K_GRES; d.lda = lda; d.apn = apn; d.N = 1024; d.K = K; d.ss_idx = ss_idx; d.xin_is_x = xin_is_x; d.a_off = a_off; d.w_off = w_off; return d; }
__device__ __forceinline__ PhaseDesc mk_kind(int kind) { PhaseDesc d{}; d.kind = kind; return d; }
__device__ __forceinline__ PhaseDesc phase_desc(int ph) {
    switch (ph) {
    case 0: return mk_kind(K_PRO);
    case 1: return mk_act(1, W_A_IN, 2048, 0);
    case 2: return mk_kind(K_SGU);
    case 3: return mk_res(WS_BIG + 256 * MiB, 1024, 0, W_A_OUT, 1024, 1, 1);
    case 4: return mk_act(2, W_1 + 0 * 8 * MiB, 4096, 1);
    case 5: return mk_res(WS_BIG, 4096, 0, W_2 + 0 * 8 * MiB, 4096, 0, 2);
    case 6: return mk_act(0, W_B_IN, 3072, 2);
    case 7: return mk_kind(K_CONV);
    case 8: return mk_res(WS_BIG + 384 * MiB, 1024, 0, W_B_OUT, 1024, 0, 3);
    case 9: return mk_act(2, W_1 + 1 * 8 * MiB, 4096, 3);
    case 10: return mk_res(WS_BIG, 4096, 0, W_2 + 1 * 8 * MiB, 4096, 0, 4);
    case 11: return mk_act(0, W_C_IN, 1024, 4);
    case 12: return mk_kind(K_POOL);
    case 13: return mk_res(WS_BIG + 128 * MiB, 1024, 512, W_C_GRP, 256, 0, 5);
    case 14: return mk_act(2, W_1 + 2 * 8 * MiB, 4096, 5);
    case 15: return mk_res(WS_BIG, 4096, 0, W_2 + 2 * 8 * MiB, 4096, 0, 6);
    case 16: return mk_act(0, W_D_IN, DSA_LD, 6);
    case 17: return mk_kind(K_TOPK);
    case 18: return mk_kind(K_ATTN);
    case 19: return mk_res(WS_BIG, DSA_LD, 0, W_D_COMB, 2048, 0, 7);
    case 20: return mk_act(2, W_1 + 3 * 8 * MiB, 4096, 7);
    case 21: return mk_res(WS_BIG, 4096, 0, W_2 + 3 * 8 * MiB, 4096, 0, 8);
    default: return mk_kind(K_FINAL);
    }
}

__device__ __forceinline__ void run_phase(int ph, const Params& p, LAS unsigned char* lds, bool dry) {
    const PhaseDesc d = phase_desc(ph);
    unsigned char* ws = p.ws; float* ss = (float*)(ws + WS_SS);
    if (d.kind == K_GACT || d.kind == K_GRES) {
        pg8::Gemm g; g.A = (const bf16_t*)(ws + d.a_off); g.Bt = (const bf16_t*)(ws + d.w_off); g.M = MTOK; g.N = d.N; g.K = d.K; g.lda = d.lda; g.apn = d.apn;
        pg8::StaticOrder S; S.init(MTOK, d.N, gridDim.x, blockIdx.x);
        if (d.kind == K_GACT) { pg8::EpiAct E; E.O = (bf16_t*)(ws + WS_BIG); E.ldc = d.ldc; E.ss_in = ss + (size_t)d.ss_idx * MTOK * 16; E.ssv = ss + (size_t)9 * MTOK * 16; E.ACT = d.act; pg8::gemm_phase(lds, g, S, E); }
        else { pg8::EpiResid E; E.xin = d.xin_is_x ? p.x : p.out; E.xout = p.out; E.xb = (bf16_t*)(ws + WS_XB); E.ss_out = ss + (size_t)d.ss_idx * MTOK * 16; pg8::gemm_phase(lds, g, S, E); }
    }
    else if (d.kind == K_PRO) phase_prologue(p, lds);
    else if (d.kind == K_SGU) phase_sgu(p, lds);
    else if (d.kind == K_CONV) phase_conv(p);
    else if (d.kind == K_POOL) phase_pool(p);
    else if (d.kind == K_TOPK) phase_topk(p, lds);
    else if (d.kind == K_ATTN) phase_attn(p, lds, dry);
    else phase_final(p);
}

__global__ void __launch_bounds__(512, 2) fwd_megakernel(Params p) {
    extern __shared__ __attribute__((aligned(16))) unsigned char lds_raw[];
    LAS unsigned char* lds = (LAS unsigned char*)lds_raw;
    for (int ph = p.ph_lo; ph < p.ph_hi; ++ph) {
#if PROBE_DUP
        const int reps = ((PROBE_DUP >> ph) & 1) ? 2 : 1;
        for (int r = 0; r < reps; ++r) { run_phase(ph, p, lds, r + 1 < reps); if (r + 1 < reps) cg::this_grid().sync(); }
#else
        run_phase(ph, p, lds, false);
#endif
        if (ph + 1 < p.ph_hi) { cg::this_grid().sync(); }
    }
}

#ifndef MK_MULTI
#define MK_MULTI 0
#endif

extern "C" void kernel_launch(void* const* d_in, const int* in_sizes, int n_in, void* d_out, int out_size, void* d_ws, size_t ws_size, hipStream_t stream) {
    static int grid = 0;
    if (grid == 0) {
        int dev = 0, cus = 0, per_cu = 0;
        hipGetDevice(&dev);
        hipDeviceGetAttribute(&cus, hipDeviceAttributeMultiprocessorCount, dev);
        if (hipFuncSetAttribute((const void*)fwd_megakernel, hipFuncAttributeMaxDynamicSharedMemorySize, LDS_BYTES) != hipSuccess) { fprintf(stderr, "hipFuncSetAttribute failed\n"); grid = -1; return; }
        if (hipOccupancyMaxActiveBlocksPerMultiprocessor(&per_cu, (const void*)fwd_megakernel, 512, LDS_BYTES) != hipSuccess || per_cu < 1) { fprintf(stderr, "occupancy query: %d\n", per_cu); per_cu = 1; }
        (void)hipGetLastError();
        grid = cus * (per_cu > 1 ? 1 : per_cu);
        if (ws_size < 840 * MiB) { fprintf(stderr, "workspace too small\n"); grid = -1; return; }
    }
    if (grid < 0) return;
    Params p{};
    const float** pp = (const float**)&p;
    for (int i = 0; i < 21; ++i) pp[i] = (const float*)d_in[i];
    p.out = (float*)d_out; p.ws = (unsigned char*)d_ws;
#if MK_MULTI
    for (int ph = 0; ph < NPHASE; ++ph) {
        p.ph_lo = ph; p.ph_hi = ph + 1;
        hipLaunchKernelGGL(fwd_megakernel, dim3(grid), dim3(512), LDS_BYTES, stream, p);
    }
#else
    p.ph_lo = 0; p.ph_hi = NPHASE;
    void* args[] = {&p};
    hipError_t e = hipLaunchCooperativeKernel((const void*)fwd_megakernel, dim3(grid), dim3(512), args, LDS_BYTES, stream);
    if (e != hipSuccess) fprintf(stderr, "cooperative launch failed: %s (grid %d)\n", hipGetErrorString(e), grid);
#endif
}
```

```cpp
#include <hip/hip_runtime.h>
#include <hip/hip_cooperative_groups.h>
#include <cstdio>
namespace cg = cooperative_groups;

#ifndef PROBE_DUP
#define PROBE_DUP 0
#endif
#ifndef PROBE_TOPK
#define PROBE_TOPK 0
#endif
#define LAS __attribute__((address_space(3)))
typedef unsigned short bf16_t;
typedef short bf16x8 __attribute__((ext_vector_type(8)));
typedef float f32x4 __attribute__((ext_vector_type(4)));
typedef float f32x2 __attribute__((ext_vector_type(2)));
typedef unsigned u32x4 __attribute__((ext_vector_type(4)));
typedef unsigned u32x2 __attribute__((ext_vector_type(2)));
typedef unsigned short u16x4 __attribute__((ext_vector_type(4)));

constexpr int MTOK = 65536, DM = 1024, SEQ = 4096;
constexpr size_t MiB = 1ull << 20;
constexpr size_t WS_XB = 0;
constexpr size_t WS_BIG = 128 * MiB;
constexpr size_t WS_CN = 640 * MiB;
constexpr size_t WS_IDX = 656 * MiB;
constexpr size_t WS_SS = 800 * MiB;
constexpr size_t WS_BAR = 688 * MiB;
constexpr size_t WS_W = 692 * MiB;
constexpr size_t W_A_IN = WS_W + 0 * MiB, W_A_OUT = WS_W + 4 * MiB, W_A_S = WS_W + 6 * MiB, W_B_IN = WS_W + 7 * MiB, W_B_OUT = WS_W + 13 * MiB,
                 W_C_IN = WS_W + 15 * MiB, W_C_GRP = WS_W + 17 * MiB, W_D_IN = WS_W + 18 * MiB, W_D_COMB = WS_W + 24 * MiB, W_1 = WS_W + 28 * MiB, W_2 = WS_W + 60 * MiB;
constexpr int DSA_LD = 2816;
constexpr int LDS_BYTES = 131072 + 1024;
constexpr int NPHASE = 23;

struct Params {
    const float *x, *norm_mix_g, *norm_mlp_g, *final_g, *a_w_in, *a_v_g, *a_w_s, *a_b_s, *a_w_out, *b_w_in, *b_conv_w, *b_w_out, *c_w_in, *c_w_grp, *c_scale,
        *d_w_in, *d_kv_g, *d_w_uv, *d_w_out, *mlp_w1, *mlp_w2;
    float* out; unsigned char* ws; int ph_lo, ph_hi;
};

__device__ __forceinline__ unsigned cvt_pk_bf16(float lo, float hi) { unsigned r; asm volatile("v_cvt_pk_bf16_f32 %0, %1, %2" : "=v"(r) : "v"(lo), "v"(hi)); return r; }
__device__ __forceinline__ int opaque_tid() { int t = threadIdx.x; asm volatile("" : "+v"(t)); return t; }
__device__ __forceinline__ float bflo(unsigned w) { return __uint_as_float(w << 16); }
__device__ __forceinline__ float bfhi(unsigned w) { return __uint_as_float(w & 0xffff0000u); }
__device__ __forceinline__ float wave_sum(float v) {
#pragma unroll
    for (int o = 32; o; o >>= 1) v += __shfl_xor(v, o);
    return v;
}
__device__ __forceinline__ float sum16(const float* p) { const f32x4 a = *(const f32x4*)p, b = *(const f32x4*)(p + 4), c = *(const f32x4*)(p + 8), d = *(const f32x4*)(p + 12);
    return (((a[0] + a[1]) + (a[2] + a[3])) + ((b[0] + b[1]) + (b[2] + b[3]))) + (((c[0] + c[1]) + (c[2] + c[3])) + ((d[0] + d[1]) + (d[2] + d[3]))); }
__device__ __forceinline__ float xrow16_max(float x) {
    auto s = __builtin_amdgcn_permlane16_swap(__float_as_uint(x), __float_as_uint(x), false, false);
    x = fmaxf(__uint_as_float(s[0]), __uint_as_float(s[1]));
    auto t = __builtin_amdgcn_permlane32_swap(__float_as_uint(x), __float_as_uint(x), false, false);
    return fmaxf(__uint_as_float(t[0]), __uint_as_float(t[1]));
}
__device__ __forceinline__ float xrow16_sum(float x) {
    auto s = __builtin_amdgcn_permlane16_swap(__float_as_uint(x), __float_as_uint(x), false, false);
    x = __uint_as_float(s[0]) + __uint_as_float(s[1]);
    auto t = __builtin_amdgcn_permlane32_swap(__float_as_uint(x), __float_as_uint(x), false, false);
    return __uint_as_float(t[0]) + __uint_as_float(t[1]);
}
__device__ __forceinline__ unsigned off_b(unsigned row, unsigned ch) { return 256u * row + 16u * (ch ^ (((row & 3) << 2) | ((row >> 2) & 3))); }
__device__ __forceinline__ bf16x8 tr_read2(unsigned a0, unsigned a1) {
    u16x4 lo, hi;
    asm volatile("ds_read_b64_tr_b16 %0, %2\n\tds_read_b64_tr_b16 %1, %3\n\ts_waitcnt lgkmcnt(0)" : "=&v"(lo), "=&v"(hi) : "v"(a0), "v"(a1) : "memory");
    bf16x8 r; r[0] = (short)lo[0]; r[1] = (short)lo[1]; r[2] = (short)lo[2]; r[3] = (short)lo[3]; r[4] = (short)hi[0]; r[5] = (short)hi[1]; r[6] = (short)hi[2]; r[7] = (short)hi[3];
    return r;
}
__device__ __forceinline__ void tr_read8(const unsigned (&a)[8], bf16x8 (&r)[4]) {
    u16x4 v0, v1, v2, v3, v4, v5, v6, v7;
    asm volatile("ds_read_b64_tr_b16 %0, %8\n\tds_read_b64_tr_b16 %1, %9\n\tds_read_b64_tr_b16 %2, %10\n\tds_read_b64_tr_b16 %3, %11\n\t"
                 "ds_read_b64_tr_b16 %4, %12\n\tds_read_b64_tr_b16 %5, %13\n\tds_read_b64_tr_b16 %6, %14\n\tds_read_b64_tr_b16 %7, %15\n\ts_waitcnt lgkmcnt(0)"
                 : "=&v"(v0), "=&v"(v1), "=&v"(v2), "=&v"(v3), "=&v"(v4), "=&v"(v5), "=&v"(v6), "=&v"(v7)
                 : "v"(a[0]), "v"(a[1]), "v"(a[2]), "v"(a[3]), "v"(a[4]), "v"(a[5]), "v"(a[6]), "v"(a[7]) : "memory");
    const u16x4 lo[4] = {v0, v2, v4, v6}, hi[4] = {v1, v3, v5, v7};
#pragma unroll
    for (int i = 0; i < 4; ++i) { r[i][0] = (short)lo[i][0]; r[i][1] = (short)lo[i][1]; r[i][2] = (short)lo[i][2]; r[i][3] = (short)lo[i][3]; r[i][4] = (short)hi[i][0]; r[i][5] = (short)hi[i][1]; r[i][6] = (short)hi[i][2]; r[i][7] = (short)hi[i][3]; }
}

namespace pg8 {
constexpr int BM = 256, BK = 64, HALF = 128, HTB = HALF * BK * 2, STAGE_BYTES = 8 * HTB, NXCD = 8, WGM = 8;
__device__ __forceinline__ int lds_byte(int r, int c) { const int st = (r >> 4) * 2 + (c >> 5), rr = r & 15, cc = c & 31, ob = rr * 64 + cc * 2; return st * 1024 + (ob ^ (((ob >> 9) & 1) << 5)); }
__device__ __forceinline__ void stage_rc(int b, int& R, int& C) { const int st = b / 1024, sb = b % 1024, swz = sb ^ (((sb >> 9) & 1) << 5); R = (st >> 1) * 16 + swz / 64; C = (st & 1) * 32 + (swz % 64) / 2; }
__device__ __forceinline__ int perm32(int rho) { const int n = rho >> 4, i = rho & 15; return 8 * (i >> 2) + 4 * n + (i & 3); }
struct Unit { int pm, pn; };
struct Gemm { const bf16_t* A; const bf16_t* Bt; int M, N, K, lda, apn; };
struct StaticOrder {
    int nM, nN, nwg, G, c;
    __device__ void init(int M, int N, int G_, int c_) { nM = M / BM; nN = N / BM; nwg = nM * nN; G = G_; c = c_; }
    __device__ bool next(int i, Unit& u) const {
        const long L = (long)i * G + c; if (L >= nwg) return false;
        int wgid = (int)L; { const int q = nwg / NXCD, r = nwg % NXCD, xcd = wgid % NXCD, off = wgid / NXCD; wgid = (xcd < r ? xcd * (q + 1) : r * (q + 1) + (xcd - r) * q) + off; }
        const int nig = WGM * nN, gid = wgid / nig, fm = gid * WGM, gsz = (nM - fm) < WGM ? (nM - fm) : WGM;
        u.pm = fm + ((wgid % nig) % gsz); u.pn = (wgid % nig) / gsz; return true;
    }
};

__device__ __forceinline__ float gelu_tanh(float x) {
    const float y = 0.7978845608f * (x + 0.044715f * x * x * x);
    const float e = __builtin_amdgcn_exp2f(-2.885390082f * y);
    return x * __builtin_amdgcn_rcpf(1.0f + e);
}
struct EpiAct {
    static constexpr bool PERM = true;
    bf16_t* O; int ldc; const float* ss_in; float* ssv; int ACT;
    __device__ __forceinline__ void operator()(const f32x4 (&acc)[2][2][4][2], const Unit& u, int wr, int wc, int fr, int fq) const {
        const int row0 = u.pm * BM + wr * 64 + fr, col0 = u.pn * BM + wc * 32 + 8 * fq;
        float rsv[2][4];
#pragma unroll
        for (int ai = 0; ai < 2; ++ai)
#pragma unroll
            for (int m = 0; m < 4; ++m) {
                const f32x4 pz = *(const f32x4*)(ss_in + (size_t)(row0 + ai * HALF + m * 16) * 16 + 4 * fq);
                float s = (pz[0] + pz[1]) + (pz[2] + pz[3]); s = xrow16_sum(s);
                rsv[ai][m] = rsqrtf(s * (1.0f / 1024.0f) + 1e-6f);
            }
#pragma unroll
        for (int ai = 0; ai < 2; ++ai)
#pragma unroll
            for (int m = 0; m < 4; ++m) {
                const int row = row0 + ai * HALF + m * 16;
                const float rs = rsv[ai][m];
                bf16_t* rowp = O + (size_t)row * ldc + col0; float sq = 0.f;
#pragma unroll
                for (int bj = 0; bj < 2; ++bj) {
                    f32x4 v0 = acc[ai][bj][m][0] * rs, v1 = acc[ai][bj][m][1] * rs;
                    if (ACT == 1) {
#pragma unroll
                        for (int j = 0; j < 4; ++j) { v0[j] = gelu_tanh(v0[j]); v1[j] = gelu_tanh(v1[j]); sq += v0[j] * v0[j] + v1[j] * v1[j]; }
                    }
                    if (ACT == 2) {
#pragma unroll
                        for (int j = 0; j < 4; ++j) { const float a = fmaxf(v0[j], 0.f), b = fmaxf(v1[j], 0.f); v0[j] = a * a; v1[j] = b * b; }
                    }
                    u32x4 w; w.x = cvt_pk_bf16(v0[0], v0[1]); w.y = cvt_pk_bf16(v0[2], v0[3]); w.z = cvt_pk_bf16(v1[0], v1[1]); w.w = cvt_pk_bf16(v1[2], v1[3]);
                    *(u32x4*)(rowp + bj * HALF) = w;
                }
                if (ACT == 1) {
                    sq = xrow16_sum(sq);
                    if (u.pn >= 4 && fq == 0) ssv[(size_t)row * 16 + (u.pn - 4) * 4 + wc] = sq;
                }
            }
    }
};
struct EpiResid {
    static constexpr bool PERM = false;
    bf16_t* xb; float* ss_out;
    __device__ __forceinline__ void operator()(const f32x4 (&acc)[2][2][4][2], const Unit& u, int wr, int wc, int fr, int fq) const {
        const int row0 = u.pm * BM + wr * 64 + fr, col0 = u.pn * BM + wc * 32 + 4 * fq;
#pragma unroll
        for (int ai = 0; ai < 2; ++ai) {
            u32x2 xo[4][2][2];
#pragma unroll
            for (int m = 0; m < 4; ++m)
#pragma unroll
                for (int bj = 0; bj < 2; ++bj)
#pragma unroll
                    for (int n = 0; n < 2; ++n) xo[m][bj][n] = *(const u32x2*)(xb + (size_t)(row0 + ai * HALF + m * 16) * DM + col0 + bj * HALF + n * 16);
#pragma unroll
            for (int m = 0; m < 4; ++m) {
                const int row = row0 + ai * HALF + m * 16; const size_t off = (size_t)row * DM + col0; float sq = 0.f;
#pragma unroll
                for (int bj = 0; bj < 2; ++bj)
#pragma unroll
                    for (int n = 0; n < 2; ++n) {
                        const u32x2 xw = xo[m][bj][n]; const f32x4 a = acc[ai][bj][m][n];
                        const float v0 = bflo(xw.x) + a[0], v1 = bfhi(xw.x) + a[1], v2 = bflo(xw.y) + a[2], v3 = bfhi(xw.y) + a[3];
                        u32x2 w; w.x = cvt_pk_bf16(v0, v1); w.y = cvt_pk_bf16(v2, v3); *(u32x2*)(xb + off + bj * HALF + n * 16) = w;
                        sq += (v0 * v0 + v1 * v1) + (v2 * v2 + v3 * v3);
                    }
                sq = xrow16_sum(sq);
                if (fq == 0) ss_out[(size_t)row * 16 + u.pn * 4 + wc] = sq;
            }
            asm volatile("" ::: "memory");
        }
    }
};

template <class Epi>
__device__ __forceinline__ void gemm_phase(LAS unsigned char* lds, const Gemm g, const StaticOrder& S, const Epi& E) {
    const int tid = opaque_tid(), wid = __builtin_amdgcn_readfirstlane(tid >> 6), lane = tid & 63, wr = wid >> 2, wc = wid & 3, fr = lane & 15, fq = lane >> 4;
    const int K = g.K, nt = K / BK, lda = g.lda;
    unsigned voffA[2], voffB[2];
#pragma unroll
    for (int i = 0; i < 2; ++i) { int R, C; stage_rc(tid * 16 + i * 8192, R, C); const int Rb = Epi::PERM ? ((R & ~31) + perm32(R & 31)) : R;
        voffA[i] = (unsigned)(R * lda + C) * 2u; voffB[i] = (unsigned)(Rb * K + C) * 2u; }
    const size_t kstep = (size_t)(BK * 2);
    const size_t hstepA = (size_t)HALF * lda * 2, hstepB = (size_t)HALF * K * 2;
    const size_t tstepA = 2 * hstepA, tstepB = 2 * hstepB;
    const unsigned ldsw = (unsigned)wid * 1024u;
    const int aoff = lds_byte(wr * 64 + fr, fq * 8), boff = lds_byte(wc * 32 + fr, fq * 8);
#define PG8_SA(b, h) (((b) * 2 + (h)) * HTB)
#define PG8_SB(b, h) ((4 + (b) * 2 + (h)) * HTB)
#define PG8_STAGE(bufoff, gbase, voff) do { _Pragma("unroll") for (int _i = 0; _i < 2; ++_i) \
        __builtin_amdgcn_global_load_lds((const unsigned*)((const char*)(gbase) + (voff)[_i]), (LAS unsigned*)(lds + (bufoff) + ldsw + _i * 8192), 16, 0, 0); } while (0)
#define PG8_LDA(dst, b, h) do { _Pragma("unroll") for (int m = 0; m < 4; ++m) _Pragma("unroll") for (int k = 0; k < 2; ++k) dst[m][k] = *(const LAS bf16x8*)(lds + PG8_SA(b, h) + aoff + m * 2048 + k * 1024); } while (0)
#define PG8_LDB(dst, b, h) do { _Pragma("unroll") for (int n = 0; n < 2; ++n) _Pragma("unroll") for (int k = 0; k < 2; ++k) dst[n][k] = *(const LAS bf16x8*)(lds + PG8_SB(b, h) + boff + n * 2048 + k * 1024); } while (0)
#define PG8_MMA(ai, bj, At, Bt) do { __builtin_amdgcn_s_setprio(1); _Pragma("unroll") for (int m = 0; m < 4; ++m) _Pragma("unroll") for (int n = 0; n < 2; ++n) _Pragma("unroll") for (int k = 0; k < 2; ++k) \
        acc[ai][bj][m][n] = __builtin_amdgcn_mfma_f32_16x16x32_bf16(Bt[n][k], At[m][k], acc[ai][bj][m][n], 0, 0, 0); __builtin_amdgcn_s_setprio(0); } while (0)
#define PG8_WAIT_V(n) asm volatile("s_waitcnt vmcnt(" #n ")" ::: "memory")
#define PG8_WAIT_L(n) asm volatile("s_waitcnt lgkmcnt(" #n ")" ::: "memory")
#define PG8_BAR __builtin_amdgcn_s_barrier()
#define PG8_SCHED __builtin_amdgcn_sched_barrier(0)
    Unit cur, nxt; int ui = 0;
    if (!S.next(0, cur)) return;
    f32x4 acc[2][2][4][2];
#pragma unroll
    for (int a = 0; a < 2; ++a)
#pragma unroll
        for (int b = 0; b < 2; ++b)
#pragma unroll
            for (int m = 0; m < 4; ++m)
#pragma unroll
                for (int n = 0; n < 2; ++n) acc[a][b][m][n] = (f32x4){0.f, 0.f, 0.f, 0.f};
    bf16x8 At[4][2], B0[2][2], B1[2][2];
    const char* cA = (const char*)g.A + (size_t)cur.pm * tstepA + (size_t)cur.pn * g.apn; const char* cB = (const char*)g.Bt + (size_t)cur.pn * tstepB;
    PG8_STAGE(PG8_SB(0, 0), cB, voffB); PG8_STAGE(PG8_SA(0, 0), cA, voffA); PG8_STAGE(PG8_SB(0, 1), cB + hstepB, voffB); PG8_STAGE(PG8_SA(0, 1), cA + hstepA, voffA);
    if (wr == 1) PG8_BAR;
    PG8_WAIT_V(4); PG8_BAR;
    PG8_STAGE(PG8_SB(1, 0), cB + kstep, voffB); PG8_STAGE(PG8_SA(1, 0), cA + kstep, voffA); PG8_STAGE(PG8_SB(1, 1), cB + hstepB + kstep, voffB);
    PG8_WAIT_V(6); PG8_BAR;
    for (;;) {
        const bool has_next = S.next(ui + 1, nxt);
        const char* nA = has_next ? (const char*)g.A + (size_t)nxt.pm * tstepA + (size_t)nxt.pn * g.apn : cA; const char* nB = has_next ? (const char*)g.Bt + (size_t)nxt.pn * tstepB : cB;
        for (int t = 0; t < nt; t += 2) {
            const bool last = (t == nt - 2);
            const char* a1 = cA + (size_t)(t + 1) * kstep;
            const char* a2 = last ? nA : cA + (size_t)(t + 2) * kstep; const char* b2 = last ? nB : cB + (size_t)(t + 2) * kstep;
            const char* a3 = a2 + kstep; const char* b3 = b2 + kstep;
            PG8_LDB(B0, 0, 0); PG8_SCHED; PG8_LDA(At, 0, 0); PG8_STAGE(PG8_SA(1, 1), a1 + hstepA, voffA);
            PG8_WAIT_L(8); PG8_BAR; PG8_WAIT_L(0); PG8_MMA(0, 0, At, B0); PG8_BAR; PG8_SCHED;
            PG8_LDB(B1, 0, 1); PG8_STAGE(PG8_SB(0, 0), b2, voffB);
            PG8_BAR; PG8_WAIT_L(0); PG8_MMA(0, 1, At, B1); PG8_BAR;
            PG8_LDA(At, 0, 1); PG8_STAGE(PG8_SA(0, 0), a2, voffA);
            PG8_BAR; PG8_WAIT_L(0); PG8_MMA(1, 0, At, B0); PG8_BAR; PG8_SCHED;
            PG8_STAGE(PG8_SB(0, 1), b2 + hstepB, voffB);
            PG8_WAIT_V(6); PG8_BAR; PG8_MMA(1, 1, At, B1); PG8_BAR;
            PG8_LDB(B0, 1, 0); PG8_SCHED; PG8_LDA(At, 1, 0); PG8_STAGE(PG8_SA(0, 1), a2 + hstepA, voffA);
            PG8_WAIT_L(8); PG8_BAR; PG8_WAIT_L(0); PG8_MMA(0, 0, At, B0); PG8_BAR; PG8_SCHED;
            PG8_LDB(B1, 1, 1); PG8_STAGE(PG8_SB(1, 0), b3, voffB);
            PG8_BAR; PG8_WAIT_L(0); PG8_MMA(0, 1, At, B1); PG8_BAR;
            PG8_LDA(At, 1, 1); PG8_STAGE(PG8_SA(1, 0), a3, voffA);
            PG8_BAR; PG8_WAIT_L(0); PG8_MMA(1, 0, At, B0); PG8_BAR; PG8_SCHED;
            PG8_STAGE(PG8_SB(1, 1), b3 + hstepB, voffB);
            PG8_WAIT_V(6); PG8_BAR; PG8_MMA(1, 1, At, B1); PG8_BAR;
        }
        E(acc, cur, wr, wc, fr, fq);
        if (!has_next) break;
#pragma unroll
        for (int a = 0; a < 2; ++a)
#pragma unroll
            for (int b = 0; b < 2; ++b)
#pragma unroll
                for (int m = 0; m < 4; ++m)
#pragma unroll
                    for (int n = 0; n < 2; ++n) acc[a][b][m][n] = (f32x4){0.f, 0.f, 0.f, 0.f};
        cur = nxt; cA = nA; cB = nB; ++ui;
    }
    PG8_WAIT_V(0);
    if (wr == 0) PG8_BAR;
    PG8_BAR;
#undef PG8_SA
#undef PG8_SB
#undef PG8_STAGE
#undef PG8_LDA
#undef PG8_LDB
#undef PG8_MMA
#undef PG8_WAIT_V
#undef PG8_WAIT_L
#undef PG8_BAR
#undef PG8_SCHED
}
}

__device__ void transpose_convert(int gw, int nw, int lane, const float* W, int K, int N, int Npad, bf16_t* Wt, int ldt, const float* rowgain, const float* colgain) {
    const int kb_n = K / 8, units = kb_n * (Npad / 256);
    for (int u = gw; u < units; u += nw) {
        const int k0 = (u % kb_n) * 8, n = (u / kb_n) * 256 + 4 * lane;
        f32x4 v[8];
        if (n < N) {
#pragma unroll
            for (int i = 0; i < 8; ++i) v[i] = *(const f32x4*)(W + (size_t)(k0 + i) * N + n);
            if (rowgain) {
#pragma unroll
                for (int i = 0; i < 8; ++i) v[i] *= rowgain[k0 + i];
            }
            if (colgain) { const f32x4 cgv = *(const f32x4*)(colgain + n);
#pragma unroll
                for (int i = 0; i < 8; ++i) v[i] *= cgv; }
        } else {
#pragma unroll
            for (int i = 0; i < 8; ++i) v[i] = (f32x4){0.f, 0.f, 0.f, 0.f};
        }
#pragma unroll
        for (int j = 0; j < 4; ++j) {
            u32x4 w; w.x = cvt_pk_bf16(v[0][j], v[1][j]); w.y = cvt_pk_bf16(v[2][j], v[3][j]); w.z = cvt_pk_bf16(v[4][j], v[5][j]); w.w = cvt_pk_bf16(v[6][j], v[7][j]);
            *(u32x4*)(Wt + (size_t)(n + j) * ldt + k0) = w;
        }
    }
}

__device__ void phase_prologue(const Params& p, LAS unsigned char* lds) {
    unsigned char* ws = p.ws;
    const int tid = opaque_tid(), lane = tid & 63, wave = tid >> 6;
    const int gw = blockIdx.x * 8 + wave, nw = gridDim.x * 8;
    const size_t gtid = (size_t)blockIdx.x * 512 + tid, gsz = (size_t)gridDim.x * 512;
    float* ss = (float*)(ws + WS_SS);
    bf16_t* xb = (bf16_t*)(ws + WS_XB);
    for (int row = blockIdx.x * 8 + wave; row < MTOK; row += gridDim.x * 8) {
        const f32x4* xr = (const f32x4*)(p.x + (size_t)row * DM); float sq = 0.f;
#pragma unroll
        for (int i = 0; i < 4; ++i) { const f32x4 v = xr[lane + 64 * i]; sq += (v[0] * v[0] + v[1] * v[1]) + (v[2] * v[2] + v[3] * v[3]);
            u32x2 w; w.x = cvt_pk_bf16(v[0], v[1]); w.y = cvt_pk_bf16(v[2], v[3]); *(u32x2*)(xb + (size_t)row * DM + (lane + 64 * i) * 4) = w; }
        sq = wave_sum(sq);
        if (lane < 16) ss[(size_t)row * 16 + lane] = lane == 0 ? sq : 0.f;
    }
    transpose_convert(gw, nw, lane, p.a_w_in, 1024, 2048, 2048, (bf16_t*)(ws + W_A_IN), 1024, p.norm_mix_g + 0 * DM, nullptr);
    transpose_convert(gw, nw, lane, p.a_w_out, 1024, 1024, 1024, (bf16_t*)(ws + W_A_OUT), 1024, nullptr, nullptr);
    transpose_convert(gw, nw, lane, p.b_w_in, 1024, 3072, 3072, (bf16_t*)(ws + W_B_IN), 1024, p.norm_mix_g + 1 * DM, nullptr);
    transpose_convert(gw, nw, lane, p.b_w_out, 1024, 1024, 1024, (bf16_t*)(ws + W_B_OUT), 1024, nullptr, nullptr);
    transpose_convert(gw, nw, lane, p.c_w_in, 1024, 1024, 1024, (bf16_t*)(ws + W_C_IN), 1024, p.norm_mix_g + 2 * DM, nullptr);
    for (int g = 0; g < 4; ++g)
        transpose_convert(gw, nw, lane, p.c_w_grp + (size_t)g * 65536, 256, 256, 256, (bf16_t*)(ws + W_C_GRP) + (size_t)g * 65536, 256, nullptr, p.c_scale + g * 256);
    transpose_convert(gw, nw, lane, p.d_w_in, 1024, 2760, DSA_LD, (bf16_t*)(ws + W_D_IN), 1024, p.norm_mix_g + 3 * DM, nullptr);
    for (int l = 0; l < 4; ++l) {
        transpose_convert(gw, nw, lane, p.mlp_w1 + (size_t)l * 4194304, 1024, 4096, 4096, (bf16_t*)(ws + W_1) + (size_t)l * 4194304, 1024, p.norm_mlp_g + l * DM, nullptr);
        transpose_convert(gw, nw, lane, p.mlp_w2 + (size_t)l * 4194304, 4096, 1024, 1024, (bf16_t*)(ws + W_2) + (size_t)l * 4194304, 4096, nullptr, nullptr);
    }
    { bf16_t* wsm = (bf16_t*)(ws + W_A_S);
      for (size_t i = gtid; i < (size_t)8 * 128 * 128; i += gsz) { const int s = (int)(i & 127), t = (int)((i >> 7) & 127); const float v = (s <= t) ? p.a_w_s[i] : 0.f; wsm[i] = (bf16_t)(cvt_pk_bf16(v, 0.f) & 0xffffu); } }
    { bf16_t* wc = (bf16_t*)(ws + W_D_COMB);
      for (int u = gw; u < 256 * 4; u += nw) {
          const int k0 = (u >> 2) * 8, n = (u & 3) * 256 + 4 * lane, h = k0 >> 7;
          const float* uv = p.d_w_uv + (size_t)k0 * 64; const float* wo = p.d_w_out + (size_t)h * 64 * 1024 + n;
          f32x4 a[8];
#pragma unroll
          for (int i = 0; i < 8; ++i) a[i] = (f32x4){0.f, 0.f, 0.f, 0.f};
#pragma unroll 4
          for (int v = 0; v < 64; ++v) { const f32x4 w4 = *(const f32x4*)(wo + (size_t)v * 1024);
#pragma unroll
              for (int i = 0; i < 8; ++i) a[i] += w4 * uv[i * 64 + v]; }
#pragma unroll
          for (int j = 0; j < 4; ++j) {
              u32x4 w; w.x = cvt_pk_bf16(a[0][j], a[1][j]); w.y = cvt_pk_bf16(a[2][j], a[3][j]); w.z = cvt_pk_bf16(a[4][j], a[5][j]); w.w = cvt_pk_bf16(a[6][j], a[7][j]);
              *(u32x4*)(wc + (size_t)(n + j) * 2048 + k0) = w; } } }
}

__device__ void phase_sgu(const Params& p, LAS unsigned char* lds) {
    unsigned char* ws = p.ws;
    const int tid = opaque_tid(), lane = tid & 63, wave = __builtin_amdgcn_readfirstlane(tid >> 6), g4 = lane >> 4, l15 = lane & 15, q = l15 >> 2, pp = lane & 3;
    const bf16_t* z = (const bf16_t*)(ws + WS_BIG); bf16_t* us = (bf16_t*)(ws + WS_BIG + 256 * MiB);
    const float* ssv = (const float*)(ws + WS_SS) + (size_t)9 * MTOK * 16; const bf16_t* wsm = (const bf16_t*)(ws + W_A_S);
    const unsigned ldsbase = (unsigned)(size_t)(unsigned char*)lds;
    for (int unit = blockIdx.x; unit < 4096; unit += gridDim.x) {
        const int g = unit & 7, chunk = unit >> 3; const size_t row0 = (size_t)chunk * 128;
#pragma unroll
        for (int i = 0; i < 4; ++i) {
            const int e = tid + 512 * i, r = e >> 4, ch = e & 15;
            const u32x4 raw = *(const u32x4*)(z + (row0 + r) * 2048 + 1024 + g * 128 + ch * 8);
            const float rs = rsqrtf(sum16(ssv + (row0 + r) * 16) * (1.0f / 1024.0f) + 1e-6f);
            const f32x4 g0 = *(const f32x4*)(p.a_v_g + g * 128 + ch * 8), g1 = *(const f32x4*)(p.a_v_g + g * 128 + ch * 8 + 4);
            u32x4 o;
            o.x = cvt_pk_bf16(bflo(raw.x) * rs * g0[0], bfhi(raw.x) * rs * g0[1]); o.y = cvt_pk_bf16(bflo(raw.y) * rs * g0[2], bfhi(raw.y) * rs * g0[3]);
            o.z = cvt_pk_bf16(bflo(raw.z) * rs * g1[0], bfhi(raw.z) * rs * g1[1]); o.w = cvt_pk_bf16(bflo(raw.w) * rs * g1[2], bfhi(raw.w) * rs * g1[3]);
            *(LAS u32x4*)(lds + (r >> 5) * 8192 + off_b(r & 31, ch)) = o;
        }
        __syncthreads();
        const int t = 16 * wave + l15, nks = (wave >> 1) + 1;
        const float bias = p.a_b_s[g * 128 + t]; const size_t rowg = row0 + t;
        u32x2 uu8[8];
#pragma unroll
        for (int ct = 0; ct < 8; ++ct) uu8[ct] = *(const u32x2*)(z + rowg * 2048 + g * 128 + 16 * ct + 4 * g4);
        f32x4 acc[8];
#pragma unroll
        for (int ct = 0; ct < 8; ++ct) acc[ct] = (f32x4){0.f, 0.f, 0.f, 0.f};
        for (int ks = 0; ks < nks; ++ks) {
            const bf16x8 Bw = *(const bf16x8*)(wsm + ((size_t)g * 128 + t) * 128 + 32 * ks + 8 * g4);
#pragma unroll
            for (int cb = 0; cb < 2; ++cb) {
                unsigned ad[8]; bf16x8 Av[4];
#pragma unroll
                for (int i = 0; i < 4; ++i) { const int ct = 4 * cb + i;
                    ad[2 * i] = ldsbase + ks * 8192 + off_b(8 * g4 + q, 2 * ct + (pp >> 1)) + 8 * (pp & 1); ad[2 * i + 1] = ldsbase + ks * 8192 + off_b(8 * g4 + 4 + q, 2 * ct + (pp >> 1)) + 8 * (pp & 1); }
                tr_read8(ad, Av);
#pragma unroll
                for (int i = 0; i < 4; ++i) acc[4 * cb + i] = __builtin_amdgcn_mfma_f32_16x16x32_bf16(Av[i], Bw, acc[4 * cb + i], 0, 0, 0);
            }
        }
#pragma unroll
        for (int ct = 0; ct < 8; ++ct) {
            const u32x2 uu = uu8[ct];
            u32x2 o; o.x = cvt_pk_bf16(bflo(uu.x) * (acc[ct][0] + bias), bfhi(uu.x) * (acc[ct][1] + bias)); o.y = cvt_pk_bf16(bflo(uu.y) * (acc[ct][2] + bias), bfhi(uu.y) * (acc[ct][3] + bias));
            *(u32x2*)(us + rowg * 1024 + g * 128 + 16 * ct + 4 * g4) = o;
        }
        __syncthreads();
    }
}

__device__ void phase_conv(const Params& p) {
    unsigned char* ws = p.ws; const bf16_t* bch = (const bf16_t*)(ws + WS_BIG); bf16_t* gated = (bf16_t*)(ws + WS_BIG + 384 * MiB);
    const size_t gtid = (size_t)blockIdx.x * 512 + opaque_tid(), gsz = (size_t)gridDim.x * 512;
    for (size_t it = gtid; it < (size_t)4096 * 128; it += gsz) {
        const int ch = (int)(it & 127) * 8, rb = (int)(it >> 7); const int r0 = rb * 16;
        float w0[8], w1[8], w2[8], zm2[8], zm1[8];
#pragma unroll
        for (int j = 0; j < 8; ++j) { w0[j] = p.b_conv_w[ch + j]; w1[j] = p.b_conv_w[1024 + ch + j]; w2[j] = p.b_conv_w[2048 + ch + j]; zm2[j] = 0.f; zm1[j] = 0.f; }
        const int tpos0 = r0 & (SEQ - 1);
        for (int d = 2; d >= 1; --d) {
            if (tpos0 - d >= 0) {
                const bf16_t* rp = bch + (size_t)(r0 - d) * 3072; const u32x4 c = *(const u32x4*)(rp + 1024 + ch), h = *(const u32x4*)(rp + 2048 + ch);
                float zz[8] = {bflo(c.x) * bflo(h.x), bfhi(c.x) * bfhi(h.x), bflo(c.y) * bflo(h.y), bfhi(c.y) * bfhi(h.y), bflo(c.z) * bflo(h.z), bfhi(c.z) * bfhi(h.z), bflo(c.w) * bflo(h.w), bfhi(c.w) * bfhi(h.w)};
#pragma unroll
                for (int j = 0; j < 8; ++j) { if (d == 2) zm2[j] = zz[j]; else zm1[j] = zz[j]; }
            }
        }
        for (int r = r0; r < r0 + 16; ++r) {
            const bf16_t* rp = bch + (size_t)r * 3072; const u32x4 b = *(const u32x4*)(rp + ch), c = *(const u32x4*)(rp + 1024 + ch), h = *(const u32x4*)(rp + 2048 + ch);
            float zz[8] = {bflo(c.x) * bflo(h.x), bfhi(c.x) * bfhi(h.x), bflo(c.y) * bflo(h.y), bfhi(c.y) * bfhi(h.y), bflo(c.z) * bflo(h.z), bfhi(c.z) * bfhi(h.z), bflo(c.w) * bflo(h.w), bfhi(c.w) * bfhi(h.w)};
            float bb[8] = {bflo(b.x), bfhi(b.x), bflo(b.y), bfhi(b.y), bflo(b.z), bfhi(b.z), bflo(b.w), bfhi(b.w)};
            float o[8];
#pragma unroll
            for (int j = 0; j < 8; ++j) { o[j] = bb[j] * (w0[j] * zm2[j] + w1[j] * zm1[j] + w2[j] * zz[j]); zm2[j] = zm1[j]; zm1[j] = zz[j]; }
            u32x4 w; w.x = cvt_pk_bf16(o[0], o[1]); w.y = cvt_pk_bf16(o[2], o[3]); w.z = cvt_pk_bf16(o[4], o[5]); w.w = cvt_pk_bf16(o[6], o[7]);
            *(u32x4*)(gated + (size_t)r * 1024 + ch) = w;
        }
    }
}

__device__ __forceinline__ void ld8(const bf16_t* ptr, float (&f)[8]) {
    const u32x4 v = *(const u32x4*)ptr; f[0] = bflo(v.x); f[1] = bfhi(v.x); f[2] = bflo(v.y); f[3] = bfhi(v.y); f[4] = bflo(v.z); f[5] = bfhi(v.z); f[6] = bflo(v.w); f[7] = bfhi(v.w);
}
__device__ void phase_pool(const Params& p) {
    unsigned char* ws = p.ws; const bf16_t* z = (const bf16_t*)(ws + WS_BIG); bf16_t* pooled = (bf16_t*)(ws + WS_BIG + 128 * MiB);
    const size_t gtid = (size_t)blockIdx.x * 512 + opaque_tid(), gsz = (size_t)gridDim.x * 512;
    for (size_t it = gtid; it < (size_t)2048 * 128; it += gsz) {
        const int lane = (int)(it & 63), wv = (int)(it >> 6), chunk = (wv & 3) * 32 + (lane & 31), rb = (wv >> 2) * 2 + (lane >> 5);
        const int ch = chunk * 8, w = 2 << (ch >> 8), r0 = rb * 32;
        float S[8];
#pragma unroll
        for (int j = 0; j < 8; ++j) S[j] = 0.f;
        const int tpos0 = r0 & (SEQ - 1);
        for (int d = 1; d <= w; ++d) {
            if (tpos0 - d >= 0) { float f[8]; ld8(z + (size_t)(r0 - d) * 1024 + ch, f);
#pragma unroll
                for (int j = 0; j < 8; ++j) S[j] += f[j]; }
        }
        for (int r = r0; r < r0 + 32; ++r) {
            const int tpos = r & (SEQ - 1); float f[8]; ld8(z + (size_t)r * 1024 + ch, f);
#pragma unroll
            for (int j = 0; j < 8; ++j) S[j] += f[j];
            if (tpos - w >= 0) { float o[8]; ld8(z + (size_t)(r - w) * 1024 + ch, o);
#pragma unroll
                for (int j = 0; j < 8; ++j) S[j] -= o[j]; }
            const int cnt = (tpos + 1 < w) ? tpos + 1 : w; const float inv = 1.0f / (float)cnt;
            u32x4 o; o.x = cvt_pk_bf16(S[0] * inv - f[0], S[1] * inv - f[1]); o.y = cvt_pk_bf16(S[2] * inv - f[2], S[3] * inv - f[3]);
            o.z = cvt_pk_bf16(S[4] * inv - f[4], S[5] * inv - f[5]); o.w = cvt_pk_bf16(S[6] * inv - f[6], S[7] * inv - f[7]);
            *(u32x4*)(pooled + (size_t)r * 1024 + ch) = o;
        }
    }
}

__device__ __forceinline__ int cnt_ge8(const unsigned* v, unsigned cand) {
    unsigned long long m0, m1, m2, m3, m4, m5, m6, m7;
    asm("v_cmp_le_u32_e64 %0, %8, %9\n\tv_cmp_le_u32_e64 %1, %8, %10\n\tv_cmp_le_u32_e64 %2, %8, %11\n\tv_cmp_le_u32_e64 %3, %8, %12\n\t"
        "v_cmp_le_u32_e64 %4, %8, %13\n\tv_cmp_le_u32_e64 %5, %8, %14\n\tv_cmp_le_u32_e64 %6, %8, %15\n\tv_cmp_le_u32_e64 %7, %8, %16"
        : "=&s"(m0), "=&s"(m1), "=&s"(m2), "=&s"(m3), "=&s"(m4), "=&s"(m5), "=&s"(m6), "=&s"(m7)
        : "s"(cand), "v"(v[0]), "v"(v[1]), "v"(v[2]), "v"(v[3]), "v"(v[4]), "v"(v[5]), "v"(v[6]), "v"(v[7]));
    return (__builtin_popcountll(m0) + __builtin_popcountll(m1)) + (__builtin_popcountll(m2) + __builtin_popcountll(m3)) +
           (__builtin_popcountll(m4) + __builtin_popcountll(m5)) + (__builtin_popcountll(m6) + __builtin_popcountll(m7));
}
__device__ void phase_topk(const Params& p, LAS unsigned char* lds) {
    unsigned char* ws = p.ws;
    const int tid = opaque_tid(), lane = tid & 63, wave = __builtin_amdgcn_readfirstlane(tid >> 6), g4 = lane >> 4, l15 = lane & 15;
    const bf16_t* din = (const bf16_t*)(ws + WS_BIG); bf16_t* cn = (bf16_t*)(ws + WS_CN); unsigned short* idx = (unsigned short*)(ws + WS_IDX);
    LAS float* S = (LAS float*)lds;
    constexpr int SROW = 4112;
    { const float kg0 = p.d_kv_g[2 * lane], kg1 = p.d_kv_g[2 * lane + 1];
      for (int row4 = (blockIdx.x * 8 + wave) * 4; row4 < MTOK; row4 += gridDim.x * 32) {
        unsigned raw[4];
#pragma unroll
        for (int j = 0; j < 4; ++j) raw[j] = *(const unsigned*)(din + (size_t)(row4 + j) * DSA_LD + 2048 + 2 * lane);
#pragma unroll
        for (int j = 0; j < 4; ++j) { const float a = bflo(raw[j]), b = bfhi(raw[j]);
            const float sq = wave_sum(a * a + b * b); const float rs = rsqrtf(sq * (1.0f / 128.0f) + 1e-6f);
            *(unsigned*)(cn + (size_t)(row4 + j) * 128 + 2 * lane) = cvt_pk_bf16(a * rs * kg0, b * rs * kg1); }
      } }
    for (int unit = blockIdx.x; unit < 8192; unit += gridDim.x) {
        const int pi = (unit / (2 * (int)gridDim.x)) * (int)gridDim.x + (unit % (int)gridDim.x), hi = (unit / (int)gridDim.x) & 1;
        const int b = pi >> 8, cc = pi & 255, qt = hi ? 511 - cc : cc, qpos0 = qt * 8; const size_t rowq0 = (size_t)b * SEQ + qpos0;
        bf16x8 Aq[4][2]; float wv[4][4];
#pragma unroll
        for (int pr = 0; pr < 4; ++pr) {
            const int qg = pr >> 1, hh = pr & 1;
            const bf16_t* base = din + (rowq0 + 4 * qg + (l15 >> 2)) * DSA_LD + 2176 + (4 * hh + (l15 & 3)) * 64;
            Aq[pr][0] = *(const bf16x8*)(base + 8 * g4); Aq[pr][1] = *(const bf16x8*)(base + 32 + 8 * g4);
            const u32x2 wr = *(const u32x2*)(din + (rowq0 + 4 * qg + g4) * DSA_LD + 2752 + 4 * hh);
            wv[pr][0] = bflo(wr.x) * 0.04419417382f; wv[pr][1] = bfhi(wr.x) * 0.04419417382f; wv[pr][2] = bflo(wr.y) * 0.04419417382f; wv[pr][3] = bfhi(wr.y) * 0.04419417382f;
        }
        const int nkt = (qpos0 + 7) / 16 + 1;
#if PROBE_TOPK == 1
        for (int rep_ = 0; rep_ < 2; ++rep_) {
#endif
        bf16x8 B0[4], B1[4], N0[4], N1[4];
#pragma unroll
        for (int j = 0; j < 4; ++j) { const int kt = (wave + 8 * j < nkt) ? wave + 8 * j : 0;
            const bf16_t* kb = din + ((size_t)b * SEQ + 16 * kt + l15) * DSA_LD + 2688;
            B0[j] = *(const bf16x8*)(kb + 8 * g4); B1[j] = *(const bf16x8*)(kb + 32 + 8 * g4); }
        for (int kt0 = wave; kt0 < nkt; kt0 += 32) {
#pragma unroll
            for (int j = 0; j < 4; ++j) { const int kt = (kt0 + 32 + 8 * j < nkt) ? kt0 + 32 + 8 * j : 0;
                const bf16_t* kb = din + ((size_t)b * SEQ + 16 * kt + l15) * DSA_LD + 2688;
                N0[j] = *(const bf16x8*)(kb + 8 * g4); N1[j] = *(const bf16x8*)(kb + 32 + 8 * g4); }
#pragma unroll
            for (int j = 0; j < 4; ++j) {
                const int kt = kt0 + 8 * j;
                if (kt < nkt) {
#pragma unroll
                    for (int qg = 0; qg < 2; ++qg) {
                        float part = 0.f;
#pragma unroll
                        for (int hh = 0; hh < 2; ++hh) {
                            const int pr = 2 * qg + hh;
                            f32x4 c = (f32x4){0.f, 0.f, 0.f, 0.f};
                            c = __builtin_amdgcn_mfma_f32_16x16x32_bf16(Aq[pr][0], B0[j], c, 0, 0, 0);
                            c = __builtin_amdgcn_mfma_f32_16x16x32_bf16(Aq[pr][1], B1[j], c, 0, 0, 0);
                            part += (fmaxf(c[0], 0.f) * wv[pr][0] + fmaxf(c[1], 0.f) * wv[pr][1]) + (fmaxf(c[2], 0.f) * wv[pr][2] + fmaxf(c[3], 0.f) * wv[pr][3]);
                        }
                        S[(4 * qg + g4) * SROW + 16 * kt + l15] = part + 0.0f;
                    }
                }
            }
#pragma unroll
            for (int j = 0; j < 4; ++j) { B0[j] = N0[j]; B1[j] = N1[j]; }
        }
#if PROBE_TOPK == 1
        }
#endif
        __syncthreads();
#if PROBE_TOPK == 2
        for (int rep_ = 0; rep_ < 2; ++rep_)
#endif
        {
            const int qpos = qpos0 + wave, n = qpos + 1; unsigned short* out = idx + (rowq0 + wave) * 256;
            if (n <= 256) {
#pragma unroll
                for (int i = 0; i < 4; ++i) { const int j = lane + 64 * i; out[j] = (unsigned short)(j < n ? j : 0xFFFF); }
            } else {
                unsigned u[64];
                const int ni = (n + 63) >> 6;
#pragma unroll
                for (int blk = 0; blk < 8; ++blk) {
                    if (blk * 8 < ni) {
#pragma unroll
                        for (int i = blk * 8; i < blk * 8 + 8; ++i) { const int key = lane + 64 * i; unsigned bits = __float_as_uint(S[wave * SROW + key]); bits ^= (bits >> 31) ? 0xFFFFFFFFu : 0x80000000u; u[i] = key < n ? bits : 0u; }
                    } else {
#pragma unroll
                        for (int i = blk * 8; i < blk * 8 + 8; ++i) u[i] = 0u;
                    }
                }
                unsigned T = 0u;
                for (int bit = 31; bit >= 0; --bit) {
                    const unsigned cand = __builtin_amdgcn_readfirstlane(T | (1u << bit)); int cnt = 0;
#pragma unroll
                    for (int blk = 0; blk < 8; ++blk) {
                        if (blk * 8 < ni) cnt += cnt_ge8(&u[blk * 8], cand);
                    }
                    if (cnt >= 256) T = cand;
                }
                int G = 0;
#pragma unroll
                for (int i = 0; i < 64; ++i) G += __popcll(__ballot(u[i] > T));
                const int need = 256 - G; int base = 0, tie_seen = 0;
                const unsigned long long ltmask = (1ull << lane) - 1ull;
#pragma unroll
                for (int blk = 0; blk < 8; ++blk) {
                    if (blk * 8 < ni) {
#pragma unroll
                        for (int i = blk * 8; i < blk * 8 + 8; ++i) {
                            const bool gt = u[i] > T, eq = u[i] == T;
                            const unsigned long long meq = __ballot(eq);
                            const bool sel = gt || (eq && (tie_seen + __popcll(meq & ltmask)) < need);
                            const unsigned long long msel = __ballot(sel);
                            if (sel) out[base + __popcll(msel & ltmask)] = (unsigned short)(lane + 64 * i);
                            base += __popcll(msel); tie_seen += __popcll(meq);
                        }
                    }
                }
            }
        }
        __syncthreads();
    }
}

__device__ void phase_attn(const Params& p, LAS unsigned char* lds, bool dry) {
    unsigned char* ws = p.ws;
    const int tid = opaque_tid(), lane = tid & 63, wave = __builtin_amdgcn_readfirstlane(tid >> 6), g4 = lane >> 4, l15 = lane & 15, q = l15 >> 2, pp = lane & 3;
    bf16_t* din = (bf16_t*)(ws + WS_BIG); const bf16_t* cn = (const bf16_t*)(ws + WS_CN); const unsigned short* idx = (const unsigned short*)(ws + WS_IDX);
    LAS unsigned char* wl = lds + wave * 8192; const unsigned wbase = (unsigned)(size_t)(unsigned char*)lds + wave * 8192;
    const float scale = 0.08838834764f;
    for (int Q = blockIdx.x * 8 + wave; Q < MTOK; Q += gridDim.x * 8) {
        const int b = Q >> 12, qpos = Q & (SEQ - 1); const int nvalid = qpos + 1 < 256 ? qpos + 1 : 256;
        bf16_t* qrow = din + (size_t)Q * DSA_LD;
        bf16x8 Bq[4];
#pragma unroll
        for (int s = 0; s < 4; ++s) Bq[s] = *(const bf16x8*)(qrow + l15 * 128 + 32 * s + 8 * g4);
        f32x4 O[8];
#pragma unroll
        for (int mt = 0; mt < 8; ++mt) O[mt] = (f32x4){0.f, 0.f, 0.f, 0.f};
        float mrun = -1e30f, lrun = 0.f;
        unsigned kid[16];
#pragma unroll
        for (int i = 0; i < 16; ++i) { const int slot = i * 16 + l15; const unsigned v = idx[(size_t)Q * 256 + slot]; kid[i] = slot < nvalid ? v : 0u; }
        bf16x8 A[2][4], An[2][4];
#pragma unroll
        for (int tl = 0; tl < 2; ++tl) { const bf16_t* crow = cn + ((size_t)b * SEQ + kid[tl]) * 128;
#pragma unroll
            for (int s = 0; s < 4; ++s) A[tl][s] = *(const bf16x8*)(crow + 32 * s + 8 * g4); }
#pragma unroll
        for (int ck = 0; ck < 8; ++ck) {
            if (ck * 32 < nvalid) {
                if (ck < 7) {
#pragma unroll
                    for (int tl = 0; tl < 2; ++tl) { const bf16_t* crow = cn + ((size_t)b * SEQ + kid[(ck < 7 ? ck + 1 : ck) * 2 + tl]) * 128;
#pragma unroll
                        for (int s = 0; s < 4; ++s) An[tl][s] = *(const bf16x8*)(crow + 32 * s + 8 * g4); }
                }
                f32x4 S0 = (f32x4){0.f, 0.f, 0.f, 0.f}, S1 = (f32x4){0.f, 0.f, 0.f, 0.f};
#pragma unroll
                for (int s = 0; s < 4; ++s) { S0 = __builtin_amdgcn_mfma_f32_16x16x32_bf16(A[0][s], Bq[s], S0, 0, 0, 0); S1 = __builtin_amdgcn_mfma_f32_16x16x32_bf16(A[1][s], Bq[s], S1, 0, 0, 0); }
#pragma unroll
                for (int tl = 0; tl < 2; ++tl)
#pragma unroll
                    for (int s = 0; s < 4; ++s) *(LAS bf16x8*)(wl + off_b(16 * tl + l15, 4 * s + g4)) = A[tl][s];
                float sv[8];
#pragma unroll
                for (int j = 0; j < 4; ++j) { const int s0 = ck * 32 + 4 * g4 + j; sv[j] = s0 < nvalid ? S0[j] * scale : -1e30f; sv[4 + j] = (s0 + 16) < nvalid ? S1[j] * scale : -1e30f; }
                float cm = fmaxf(fmaxf(fmaxf(sv[0], sv[1]), fmaxf(sv[2], sv[3])), fmaxf(fmaxf(sv[4], sv[5]), fmaxf(sv[6], sv[7])));
                cm = xrow16_max(cm);
                const float mn = fmaxf(mrun, cm), alpha = __expf(mrun - mn);
                float pv[8], ps = 0.f;
#pragma unroll
                for (int j = 0; j < 8; ++j) { pv[j] = __expf(sv[j] - mn); ps += pv[j]; }
                lrun = lrun * alpha + ps; mrun = mn;
#pragma unroll
                for (int mt = 0; mt < 8; ++mt) O[mt] *= alpha;
                union { u32x4 u; bf16x8 h; } Pb;
                Pb.u.x = cvt_pk_bf16(pv[0], pv[1]); Pb.u.y = cvt_pk_bf16(pv[2], pv[3]); Pb.u.z = cvt_pk_bf16(pv[4], pv[5]); Pb.u.w = cvt_pk_bf16(pv[6], pv[7]);
                asm volatile("s_waitcnt lgkmcnt(0)" ::: "memory");
#pragma unroll
                for (int mb = 0; mb < 2; ++mb) {
                    unsigned ad[8]; bf16x8 Av[4];
#pragma unroll
                    for (int i = 0; i < 4; ++i) { const int mt = 4 * mb + i;
                        ad[2 * i] = wbase + off_b(4 * g4 + q, 2 * mt + (pp >> 1)) + 8 * (pp & 1); ad[2 * i + 1] = wbase + off_b(16 + 4 * g4 + q, 2 * mt + (pp >> 1)) + 8 * (pp & 1); }
                    tr_read8(ad, Av);
#pragma unroll
                    for (int i = 0; i < 4; ++i) O[4 * mb + i] = __builtin_amdgcn_mfma_f32_16x16x32_bf16(Av[i], Pb.h, O[4 * mb + i], 0, 0, 0);
                }
                if (ck < 7) {
#pragma unroll
                    for (int tl = 0; tl < 2; ++tl)
#pragma unroll
                        for (int s = 0; s < 4; ++s) A[tl][s] = An[tl][s];
                }
            }
        }
        lrun = xrow16_sum(lrun);
        const float inv = 1.0f / lrun;
#pragma unroll
        for (int mt = 0; mt < 8; ++mt) {
            u32x2 o; o.x = cvt_pk_bf16(O[mt][0] * inv, O[mt][1] * inv); o.y = cvt_pk_bf16(O[mt][2] * inv, O[mt][3] * inv);
            if (!dry) *(u32x2*)(qrow + l15 * 128 + 16 * mt + 4 * g4) = o;
        }
    }
}

__device__ void phase_final(const Params& p) {
    const int tid = opaque_tid(); const int lane = tid & 63, wave = tid >> 6;
    const float* ss = (const float*)(p.ws + WS_SS) + (size_t)8 * MTOK * 16; const bf16_t* xb = (const bf16_t*)(p.ws + WS_XB);
    for (int row = blockIdx.x * 8 + wave; row < MTOK; row += gridDim.x * 8) {
        const float rs = rsqrtf(sum16(ss + (size_t)row * 16) * (1.0f / 1024.0f) + 1e-6f);
        f32x4* orow = (f32x4*)(p.out + (size_t)row * DM);
#pragma unroll
        for (int i = 0; i < 4; ++i) { const f32x4 g = *(const f32x4*)(p.final_g + (lane + 64 * i) * 4); const u32x2 xw = *(const u32x2*)(xb + (size_t)row * DM + (lane + 64 * i) * 4);
            f32x4 v = (f32x4){bflo(xw.x), bfhi(xw.x), bflo(xw.y), bfhi(xw.y)}; v = v * rs * g; orow[lane + 64 * i] = v; }
    }
}

#define XB_TMO      128
#define XB_XCNT(j)  (256  + 64 * (j))
#define XB_XSUB(j)  (1280 + 64 * (j))
#define XB_XGEN(j)  (2304 + 64 * (j))
#define XB_TOP      3328
#define XB_TOPGEN   3392
#define XCD_BAR_WORDS 3456
#define XB_SPIN_CAP (1u << 20)
__device__ __forceinline__ unsigned xb_ld(unsigned* p)              { return __hip_atomic_load(p, __ATOMIC_RELAXED, __HIP_MEMORY_SCOPE_AGENT); }
__device__ __forceinline__ unsigned xb_add(unsigned* p, unsigned v) { return __hip_atomic_fetch_add(p, v, __ATOMIC_RELAXED, __HIP_MEMORY_SCOPE_AGENT); }
__device__ __forceinline__ unsigned xb_xcc_id() { return (unsigned)__builtin_amdgcn_s_getreg((3 << 11) | 20) & 0xFu; }
#define XB_SPIN(cond, bar) do { unsigned _sp = 0; while (cond) { __builtin_amdgcn_s_sleep(1); \
    if ((++_sp & 255u) == 0u) { if (xb_ld(&(bar)[XB_TMO])) break; if (_sp > XB_SPIN_CAP) { atomicAdd(&(bar)[XB_TMO], 1u); break; } } } } while (0)
struct XcdBarrier { unsigned* bar; unsigned x; volatile LAS unsigned* st; };
__device__ __forceinline__ XcdBarrier xcd_barrier_post(unsigned* bar, volatile LAS unsigned* st) {
    XcdBarrier b; b.bar = bar; b.x = xb_xcc_id(); b.st = st;
    if (threadIdx.x == 0) (void)xb_add(&bar[XB_XCNT(b.x)], 1u);
    return b;
}
__device__ __forceinline__ void xcd_barrier_complete(unsigned* bar, unsigned x, unsigned& nloc, unsigned& nx) {
    const unsigned G = gridDim.x * gridDim.y * gridDim.z;
    unsigned sum, cnt, mine, sp = 0u;
    for (;;) {
        sum = 0u; cnt = 0u; mine = 0u;
#pragma unroll
        for (unsigned j = 0; j < 16; ++j) { const unsigned c = xb_ld(&bar[XB_XCNT(j)]); sum += c; cnt += (c > 0u) ? 1u : 0u; mine = (j == x) ? c : mine; }
        if (sum == G) break;
        __builtin_amdgcn_s_sleep(1);
        if ((++sp & 255u) == 0u) { if (xb_ld(&bar[XB_TMO])) break; if (sp > XB_SPIN_CAP) { atomicAdd(&bar[XB_TMO], 1u); break; } }
    }
    nloc = mine > 0u ? mine : 1u; nx = cnt > 0u ? cnt : 1u;
}
__device__ __forceinline__ void xcd_barrier(const XcdBarrier& b) {
    asm volatile("s_waitcnt vmcnt(0)" ::: "memory");
    __syncthreads();
    if (threadIdx.x == 0) {
        unsigned* bar = b.bar;
        __builtin_amdgcn_s_waitcnt(0);
        unsigned nloc = b.st[0], nx = b.st[1];
        if (nloc == 0u) { xcd_barrier_complete(bar, b.x, nloc, nx); b.st[0] = nloc; b.st[1] = nx; }
        const unsigned old = xb_add(&bar[XB_XSUB(b.x)], 1u);
        const unsigned gen = old / nloc;
        if (old + 1u == (gen + 1u) * nloc) {
            __builtin_amdgcn_fence(__ATOMIC_RELEASE, "agent");
            asm volatile("s_waitcnt vmcnt(0)" ::: "memory");
            const unsigned og = xb_add(&bar[XB_TOP], 1u);
            const unsigned tg = og / nx;
            if (og + 1u == (tg + 1u) * nx) xb_add(&bar[XB_TOPGEN], 1u);
            else XB_SPIN(xb_ld(&bar[XB_TOPGEN]) == tg, bar);
            __builtin_amdgcn_fence(__ATOMIC_ACQUIRE, "agent");
            xb_add(&bar[XB_XGEN(b.x)], 1u);
            asm volatile("s_waitcnt vmcnt(0)" ::: "memory");
        } else {
            XB_SPIN(xb_ld(&bar[XB_XGEN(b.x)]) == gen, bar);
            __builtin_amdgcn_fence(__ATOMIC_ACQUIRE, "agent");
            asm volatile("s_waitcnt vmcnt(0)" ::: "memory");
        }
    }
    __syncthreads();
}

enum { K_PRO = 0, K_GACT, K_GRES, K_SGU, K_CONV, K_POOL, K_TOPK, K_ATTN, K_FINAL };
struct PhaseDesc { int kind, act, lda, apn, N, K, ldc, ss_idx, xin_is_x, pad; size_t a_off, w_off; };
__device__ __forceinline__ PhaseDesc mk_act(int act, size_t w_off, int N, int ss_idx) { PhaseDesc d{}; d.kind = K_GACT; d.act = act; d.lda = 1024; d.apn = 0; d.N = N; d.K = 1024; d.ldc = N; d.ss_idx = ss_idx; d.a_off = WS_XB; d.w_off = w_off; return d; }
__device__ __forceinline__ PhaseDesc mk_res(size_t a_off, int lda, int apn, size_t w_off, int K, int xin_is_x, int ss_idx) { PhaseDesc d{}; d.kind = K_GRES; d.lda = lda; d.apn = apn; d.N = 1024; d.K = K; d.ss_idx = ss_idx; d.xin_is_x = xin_is_x; d.a_off = a_off; d.w_off = w_off; return d; }
__device__ __forceinline__ PhaseDesc mk_kind(int kind) { PhaseDesc d{}; d.kind = kind; return d; }
__device__ __forceinline__ PhaseDesc phase_desc(int ph) {
    switch (ph) {
    case 0: return mk_kind(K_PRO);
    case 1: return mk_act(1, W_A_IN, 2048, 0);
    case 2: return mk_kind(K_SGU);
    case 3: return mk_res(WS_BIG + 256 * MiB, 1024, 0, W_A_OUT, 1024, 1, 1);
    case 4: return mk_act(2, W_1 + 0 * 8 * MiB, 4096, 1);
    case 5: return mk_res(WS_BIG, 4096, 0, W_2 + 0 * 8 * MiB, 4096, 0, 2);
    case 6: return mk_act(0, W_B_IN, 3072, 2);
    case 7: return mk_kind(K_CONV);
    case 8: return mk_res(WS_BIG + 384 * MiB, 1024, 0, W_B_OUT, 1024, 0, 3);
    case 9: return mk_act(2, W_1 + 1 * 8 * MiB, 4096, 3);
    case 10: return mk_res(WS_BIG, 4096, 0, W_2 + 1 * 8 * MiB, 4096, 0, 4);
    case 11: return mk_act(0, W_C_IN, 1024, 4);
    case 12: return mk_kind(K_POOL);
    case 13: return mk_res(WS_BIG + 128 * MiB, 1024, 512, W_C_GRP, 256, 0, 5);
    case 14: return mk_act(2, W_1 + 2 * 8 * MiB, 4096, 5);
    case 15: return mk_res(WS_BIG, 4096, 0, W_2 + 2 * 8 * MiB, 4096, 0, 6);
    case 16: return mk_act(0, W_D_IN, DSA_LD, 6);
    case 17: return mk_kind(K_TOPK);
    case 18: return mk_kind(K_ATTN);
    case 19: return mk_res(WS_BIG, DSA_LD, 0, W_D_COMB, 2048, 0, 7);
    case 20: return mk_act(2, W_1 + 3 * 8 * MiB, 4096, 7);
    case 21: return mk_res(WS_BIG, 4096, 0, W_2 + 3 * 8 * MiB, 4096, 0, 8);
    default: return mk_kind(K_FINAL);
    }
}

__device__ __forceinline__ void run_phase(int ph, const Params& p, LAS unsigned char* lds, bool dry) {
    const PhaseDesc d = phase_desc(ph);
    unsigned char* ws = p.ws; float* ss = (float*)(ws + WS_SS);
    if (d.kind == K_GACT || d.kind == K_GRES) {
        pg8::Gemm g; g.A = (const bf16_t*)(ws + d.a_off); g.Bt = (const bf16_t*)(ws + d.w_off); g.M = MTOK; g.N = d.N; g.K = d.K; g.lda = d.lda; g.apn = d.apn;
        pg8::StaticOrder S; S.init(MTOK, d.N, gridDim.x, blockIdx.x);
        if (d.kind == K_GACT) { pg8::EpiAct E; E.O = (bf16_t*)(ws + WS_BIG); E.ldc = d.ldc; E.ss_in = ss + (size_t)d.ss_idx * MTOK * 16; E.ssv = ss + (size_t)9 * MTOK * 16; E.ACT = d.act; pg8::gemm_phase(lds, g, S, E); }
        else { pg8::EpiResid E; E.xb = (bf16_t*)(ws + WS_XB); E.ss_out = ss + (size_t)d.ss_idx * MTOK * 16; pg8::gemm_phase(lds, g, S, E); }
    }
    else if (d.kind == K_PRO) phase_prologue(p, lds);
    else if (d.kind == K_SGU) phase_sgu(p, lds);
    else if (d.kind == K_CONV) phase_conv(p);
    else if (d.kind == K_POOL) phase_pool(p);
    else if (d.kind == K_TOPK) phase_topk(p, lds);
    else if (d.kind == K_ATTN) phase_attn(p, lds, dry);
    else phase_final(p);
}

__global__ void __launch_bounds__(512, 2) fwd_megakernel(Params p) {
    extern __shared__ __attribute__((aligned(16))) unsigned char lds_raw[];
    LAS unsigned char* lds = (LAS unsigned char*)lds_raw;
    volatile LAS unsigned* bst = (volatile LAS unsigned*)(lds + 131584);
    XcdBarrier xbar; xbar.bar = (unsigned*)(p.ws + WS_BAR); xbar.x = 0; xbar.st = bst;
    if (p.ph_hi - p.ph_lo > 1) {
        if (threadIdx.x == 0) { bst[0] = 0u; bst[1] = 0u; }
        __syncthreads();
        xbar = xcd_barrier_post((unsigned*)(p.ws + WS_BAR), bst);
    }
    for (int ph = p.ph_lo; ph < p.ph_hi; ++ph) {
#if PROBE_DUP
        const int reps = ((PROBE_DUP >> ph) & 1) ? 2 : 1;
        for (int r = 0; r < reps; ++r) { run_phase(ph, p, lds, r + 1 < reps); if (r + 1 < reps) cg::this_grid().sync(); }
#else
        run_phase(ph, p, lds, false);
#endif
        if (ph + 1 < p.ph_hi) { if (ph == p.ph_lo) cg::this_grid().sync(); else xcd_barrier(xbar); }
    }
}

#ifndef MK_MULTI
#define MK_MULTI 0
#endif

extern "C" void kernel_launch(void* const* d_in, const int* in_sizes, int n_in, void* d_out, int out_size, void* d_ws, size_t ws_size, hipStream_t stream) {
    static int grid = 0;
    if (grid == 0) {
        int dev = 0, cus = 0, per_cu = 0;
        hipGetDevice(&dev);
        hipDeviceGetAttribute(&cus, hipDeviceAttributeMultiprocessorCount, dev);
        if (hipFuncSetAttribute((const void*)fwd_megakernel, hipFuncAttributeMaxDynamicSharedMemorySize, LDS_BYTES) != hipSuccess) { fprintf(stderr, "hipFuncSetAttribute failed\n"); grid = -1; return; }
        if (hipOccupancyMaxActiveBlocksPerMultiprocessor(&per_cu, (const void*)fwd_megakernel, 512, LDS_BYTES) != hipSuccess || per_cu < 1) { fprintf(stderr, "occupancy query: %d\n", per_cu); per_cu = 1; }
        (void)hipGetLastError();
        grid = cus * (per_cu > 1 ? 1 : per_cu);
        if (ws_size < 840 * MiB) { fprintf(stderr, "workspace too small\n"); grid = -1; return; }
    }
    if (grid < 0) return;
    Params p{};
    const float** pp = (const float**)&p;
    for (int i = 0; i < 21; ++i) pp[i] = (const float*)d_in[i];
    p.out = (float*)d_out; p.ws = (unsigned char*)d_ws;
#if MK_MULTI
    for (int ph = 0; ph < NPHASE; ++ph) {
        p.ph_lo = ph; p.ph_hi = ph + 1;
        hipLaunchKernelGGL(fwd_megakernel, dim3(grid), dim3(512), LDS_BYTES, stream, p);
    }
#else
    p.ph_lo = 0; p.ph_hi = NPHASE;
    if (hipMemsetAsync((unsigned char*)d_ws + WS_BAR, 0, XCD_BAR_WORDS * 4, stream) != hipSuccess) { fprintf(stderr, "barrier memset failed\n"); return; }
    void* args[] = {&p};
    hipError_t e = hipLaunchCooperativeKernel((const void*)fwd_megakernel, dim3(grid), dim3(512), args, LDS_BYTES, stream);
    if (e != hipSuccess) fprintf(stderr, "cooperative launch failed: %s (grid %d)\n", hipGetErrorString(e), grid);
#endif
}
```

```cpp
#include <hip/hip_runtime.h>
#include <hip/hip_cooperative_groups.h>
#include <cstdio>
namespace cg = cooperative_groups;

#ifndef PROBE_DUP
#define PROBE_DUP 0
#endif
#ifndef PROBE_TOPK
#define PROBE_TOPK 0
#endif
#define LAS __attribute__((address_space(3)))
typedef unsigned short bf16_t;
typedef short bf16x8 __attribute__((ext_vector_type(8)));
typedef float f32x4 __attribute__((ext_vector_type(4)));
typedef float f32x2 __attribute__((ext_vector_type(2)));
typedef unsigned u32x4 __attribute__((ext_vector_type(4)));
typedef unsigned u32x2 __attribute__((ext_vector_type(2)));
typedef unsigned short u16x4 __attribute__((ext_vector_type(4)));

constexpr int MTOK = 65536, DM = 1024, SEQ = 4096;
constexpr size_t MiB = 1ull << 20;
constexpr size_t WS_XB = 0;
constexpr size_t WS_BIG = 128 * MiB;
constexpr size_t WS_CN = 640 * MiB;
constexpr size_t WS_IDX = 656 * MiB;
constexpr size_t WS_SS = 800 * MiB;
constexpr size_t WS_BAR = 688 * MiB;
constexpr size_t WS_W = 692 * MiB;
constexpr size_t W_A_IN = WS_W + 0 * MiB, W_A_OUT = WS_W + 4 * MiB, W_A_S = WS_W + 6 * MiB, W_B_IN = WS_W + 7 * MiB, W_B_OUT = WS_W + 13 * MiB,
                 W_C_IN = WS_W + 15 * MiB, W_C_GRP = WS_W + 17 * MiB, W_D_IN = WS_W + 18 * MiB, W_D_COMB = WS_W + 24 * MiB, W_1 = WS_W + 28 * MiB, W_2 = WS_W + 60 * MiB;
constexpr int DSA_LD = 2816;
constexpr int LDS_BYTES = 131072 + 1024;
constexpr int NPHASE = 23;

struct Params {
    const float *x, *norm_mix_g, *norm_mlp_g, *final_g, *a_w_in, *a_v_g, *a_w_s, *a_b_s, *a_w_out, *b_w_in, *b_conv_w, *b_w_out, *c_w_in, *c_w_grp, *c_scale,
        *d_w_in, *d_kv_g, *d_w_uv, *d_w_out, *mlp_w1, *mlp_w2;
    float* out; unsigned char* ws; int ph_lo, ph_hi;
};

__device__ __forceinline__ unsigned cvt_pk_bf16(float lo, float hi) { unsigned r; asm volatile("v_cvt_pk_bf16_f32 %0, %1, %2" : "=v"(r) : "v"(lo), "v"(hi)); return r; }
__device__ __forceinline__ int opaque_tid(int wv) { int l; asm volatile("v_mbcnt_lo_u32_b32 %0, -1, 0\n\tv_mbcnt_hi_u32_b32 %0, -1, %0" : "=v"(l)); return wv * 64 + l; }
__device__ __forceinline__ float bflo(unsigned w) { return __uint_as_float(w << 16); }
__device__ __forceinline__ float bfhi(unsigned w) { return __uint_as_float(w & 0xffff0000u); }
__device__ __forceinline__ float wave_sum(float v) {
#pragma unroll
    for (int o = 32; o; o >>= 1) v += __shfl_xor(v, o);
    return v;
}
__device__ __forceinline__ float sum16(const float* p) { const f32x4 a = *(const f32x4*)p, b = *(const f32x4*)(p + 4), c = *(const f32x4*)(p + 8), d = *(const f32x4*)(p + 12);
    return (((a[0] + a[1]) + (a[2] + a[3])) + ((b[0] + b[1]) + (b[2] + b[3]))) + (((c[0] + c[1]) + (c[2] + c[3])) + ((d[0] + d[1]) + (d[2] + d[3]))); }
__device__ __forceinline__ float xrow16_max(float x) {
    auto s = __builtin_amdgcn_permlane16_swap(__float_as_uint(x), __float_as_uint(x), false, false);
    x = fmaxf(__uint_as_float(s[0]), __uint_as_float(s[1]));
    auto t = __builtin_amdgcn_permlane32_swap(__float_as_uint(x), __float_as_uint(x), false, false);
    return fmaxf(__uint_as_float(t[0]), __uint_as_float(t[1]));
}
__device__ __forceinline__ float xrow16_sum(float x) {
    auto s = __builtin_amdgcn_permlane16_swap(__float_as_uint(x), __float_as_uint(x), false, false);
    x = __uint_as_float(s[0]) + __uint_as_float(s[1]);
    auto t = __builtin_amdgcn_permlane32_swap(__float_as_uint(x), __float_as_uint(x), false, false);
    return __uint_as_float(t[0]) + __uint_as_float(t[1]);
}
__device__ __forceinline__ unsigned off_b(unsigned row, unsigned ch) { return 256u * row + 16u * (ch ^ (((row & 3) << 2) | ((row >> 2) & 3))); }
__device__ __forceinline__ bf16x8 tr_read2(unsigned a0, unsigned a1) {
    u16x4 lo, hi;
    asm volatile("ds_read_b64_tr_b16 %0, %2\n\tds_read_b64_tr_b16 %1, %3\n\ts_waitcnt lgkmcnt(0)" : "=&v"(lo), "=&v"(hi) : "v"(a0), "v"(a1) : "memory");
    bf16x8 r; r[0] = (short)lo[0]; r[1] = (short)lo[1]; r[2] = (short)lo[2]; r[3] = (short)lo[3]; r[4] = (short)hi[0]; r[5] = (short)hi[1]; r[6] = (short)hi[2]; r[7] = (short)hi[3];
    return r;
}
__device__ __forceinline__ void tr_read8(const unsigned (&a)[8], bf16x8 (&r)[4]) {
    u16x4 v0, v1, v2, v3, v4, v5, v6, v7;
    asm volatile("ds_read_b64_tr_b16 %0, %8\n\tds_read_b64_tr_b16 %1, %9\n\tds_read_b64_tr_b16 %2, %10\n\tds_read_b64_tr_b16 %3, %11\n\t"
                 "ds_read_b64_tr_b16 %4, %12\n\tds_read_b64_tr_b16 %5, %13\n\tds_read_b64_tr_b16 %6, %14\n\tds_read_b64_tr_b16 %7, %15\n\ts_waitcnt lgkmcnt(0)"
                 : "=&v"(v0), "=&v"(v1), "=&v"(v2), "=&v"(v3), "=&v"(v4), "=&v"(v5), "=&v"(v6), "=&v"(v7)
                 : "v"(a[0]), "v"(a[1]), "v"(a[2]), "v"(a[3]), "v"(a[4]), "v"(a[5]), "v"(a[6]), "v"(a[7]) : "memory");
    const u16x4 lo[4] = {v0, v2, v4, v6}, hi[4] = {v1, v3, v5, v7};
#pragma unroll
    for (int i = 0; i < 4; ++i) { r[i][0] = (short)lo[i][0]; r[i][1] = (short)lo[i][1]; r[i][2] = (short)lo[i][2]; r[i][3] = (short)lo[i][3]; r[i][4] = (short)hi[i][0]; r[i][5] = (short)hi[i][1]; r[i][6] = (short)hi[i][2]; r[i][7] = (short)hi[i][3]; }
}

namespace pg8 {
constexpr int BM = 256, BK = 64, HALF = 128, HTB = HALF * BK * 2, STAGE_BYTES = 8 * HTB, NXCD = 8, WGM = 8;
__device__ __forceinline__ int lds_byte(int r, int c) { const int st = (r >> 4) * 2 + (c >> 5), rr = r & 15, cc = c & 31, ob = rr * 64 + cc * 2; return st * 1024 + (ob ^ (((ob >> 9) & 1) << 5)); }
__device__ __forceinline__ void stage_rc(int b, int& R, int& C) { const int st = b / 1024, sb = b % 1024, swz = sb ^ (((sb >> 9) & 1) << 5); R = (st >> 1) * 16 + swz / 64; C = (st & 1) * 32 + (swz % 64) / 2; }
__device__ __forceinline__ int perm32(int rho) { const int n = rho >> 4, i = rho & 15; return 8 * (i >> 2) + 4 * n + (i & 3); }
struct Unit { int pm, pn; };
struct Gemm { const bf16_t* A; const bf16_t* Bt; int M, N, K, lda, apn; };
struct StaticOrder {
    int nM, nN, nwg, G, c;
    __device__ void init(int M, int N, int G_, int c_) { nM = M / BM; nN = N / BM; nwg = nM * nN; G = G_; c = c_; }
    __device__ bool next(int i, Unit& u) const {
        const long L = (long)i * G + c; if (L >= nwg) return false;
        int wgid = (int)L; { const int q = nwg / NXCD, r = nwg % NXCD, xcd = wgid % NXCD, off = wgid / NXCD; wgid = (xcd < r ? xcd * (q + 1) : r * (q + 1) + (xcd - r) * q) + off; }
        const int nig = WGM * nN, gid = wgid / nig, fm = gid * WGM, gsz = (nM - fm) < WGM ? (nM - fm) : WGM;
        u.pm = fm + ((wgid % nig) % gsz); u.pn = (wgid % nig) / gsz; return true;
    }
};

__device__ __forceinline__ float gelu_tanh(float x) {
    const float y = 0.7978845608f * (x + 0.044715f * x * x * x);
    const float e = __builtin_amdgcn_exp2f(-2.885390082f * y);
    return x * __builtin_amdgcn_rcpf(1.0f + e);
}
struct EpiAct {
    static constexpr bool PERM = true;
    bf16_t* O; int ldc; const float* ss_in; float* ssv; int ACT;
    __device__ __forceinline__ void operator()(const f32x4 (&acc)[2][2][4][2], const Unit& u, int wr, int wc, int fr, int fq) const {
        const int row0 = u.pm * BM + wr * 64 + fr, col0 = u.pn * BM + wc * 32 + 8 * fq;
        float rsv[2][4];
#pragma unroll
        for (int ai = 0; ai < 2; ++ai)
#pragma unroll
            for (int m = 0; m < 4; ++m) {
                const f32x4 pz = *(const f32x4*)(ss_in + (size_t)(row0 + ai * HALF + m * 16) * 16 + 4 * fq);
                float s = (pz[0] + pz[1]) + (pz[2] + pz[3]); s = xrow16_sum(s);
                rsv[ai][m] = rsqrtf(s * (1.0f / 1024.0f) + 1e-6f);
            }
#pragma unroll
        for (int ai = 0; ai < 2; ++ai)
#pragma unroll
            for (int m = 0; m < 4; ++m) {
                const int row = row0 + ai * HALF + m * 16;
                const float rs = rsv[ai][m];
                bf16_t* rowp = O + (size_t)row * ldc + col0; float sq = 0.f;
#pragma unroll
                for (int bj = 0; bj < 2; ++bj) {
                    f32x4 v0 = acc[ai][bj][m][0] * rs, v1 = acc[ai][bj][m][1] * rs;
                    if (ACT == 1) {
#pragma unroll
                        for (int j = 0; j < 4; ++j) { v0[j] = gelu_tanh(v0[j]); v1[j] = gelu_tanh(v1[j]); sq += v0[j] * v0[j] + v1[j] * v1[j]; }
                    }
                    if (ACT == 2) {
#pragma unroll
                        for (int j = 0; j < 4; ++j) { const float a = fmaxf(v0[j], 0.f), b = fmaxf(v1[j], 0.f); v0[j] = a * a; v1[j] = b * b; }
                    }
                    u32x4 w; w.x = cvt_pk_bf16(v0[0], v0[1]); w.y = cvt_pk_bf16(v0[2], v0[3]); w.z = cvt_pk_bf16(v1[0], v1[1]); w.w = cvt_pk_bf16(v1[2], v1[3]);
                    *(u32x4*)(rowp + bj * HALF) = w;
                }
                if (ACT == 1) {
                    sq = xrow16_sum(sq);
                    if (u.pn >= 4 && fq == 0) ssv[(size_t)row * 16 + (u.pn - 4) * 4 + wc] = sq;
                }
            }
    }
};
struct EpiResid {
    static constexpr bool PERM = false;
    bf16_t* xb; float* ss_out;
    __device__ __forceinline__ void operator()(const f32x4 (&acc)[2][2][4][2], const Unit& u, int wr, int wc, int fr, int fq) const {
        const int row0 = u.pm * BM + wr * 64 + fr, col0 = u.pn * BM + wc * 32 + 4 * fq;
#pragma unroll
        for (int ai = 0; ai < 2; ++ai) {
            u32x2 xo[4][2][2];
#pragma unroll
            for (int m = 0; m < 4; ++m)
#pragma unroll
                for (int bj = 0; bj < 2; ++bj)
#pragma unroll
                    for (int n = 0; n < 2; ++n) xo[m][bj][n] = *(const u32x2*)(xb + (size_t)(row0 + ai * HALF + m * 16) * DM + col0 + bj * HALF + n * 16);
#pragma unroll
            for (int m = 0; m < 4; ++m) {
                const int row = row0 + ai * HALF + m * 16; const size_t off = (size_t)row * DM + col0; float sq = 0.f;
#pragma unroll
                for (int bj = 0; bj < 2; ++bj)
#pragma unroll
                    for (int n = 0; n < 2; ++n) {
                        const u32x2 xw = xo[m][bj][n]; const f32x4 a = acc[ai][bj][m][n];
                        const float v0 = bflo(xw.x) + a[0], v1 = bfhi(xw.x) + a[1], v2 = bflo(xw.y) + a[2], v3 = bfhi(xw.y) + a[3];
                        u32x2 w; w.x = cvt_pk_bf16(v0, v1); w.y = cvt_pk_bf16(v2, v3); *(u32x2*)(xb + off + bj * HALF + n * 16) = w;
                        sq += (v0 * v0 + v1 * v1) + (v2 * v2 + v3 * v3);
                    }
                sq = xrow16_sum(sq);
                if (fq == 0) ss_out[(size_t)row * 16 + u.pn * 4 + wc] = sq;
            }
            asm volatile("" ::: "memory");
        }
    }
};

template <class Epi>
__device__ __forceinline__ void gemm_phase(LAS unsigned char* lds, const Gemm g, const StaticOrder& S, const Epi& E, int wv) {
    const int tid = opaque_tid(wv), wid = __builtin_amdgcn_readfirstlane(tid >> 6), lane = tid & 63, wr = wid >> 2, wc = wid & 3, fr = lane & 15, fq = lane >> 4;
    const int K = g.K, nt = K / BK, lda = g.lda;
    unsigned voffA[2], voffB[2];
#pragma unroll
    for (int i = 0; i < 2; ++i) { int R, C; stage_rc(tid * 16 + i * 8192, R, C); const int Rb = Epi::PERM ? ((R & ~31) + perm32(R & 31)) : R;
        voffA[i] = (unsigned)(R * lda + C) * 2u; voffB[i] = (unsigned)(Rb * K + C) * 2u; }
    const size_t kstep = (size_t)(BK * 2);
    const size_t hstepA = (size_t)HALF * lda * 2, hstepB = (size_t)HALF * K * 2;
    const size_t tstepA = 2 * hstepA, tstepB = 2 * hstepB;
    const unsigned ldsw = (unsigned)wid * 1024u;
    const int aoff = lds_byte(wr * 64 + fr, fq * 8), boff = lds_byte(wc * 32 + fr, fq * 8);
#define PG8_SA(b, h) (((b) * 2 + (h)) * HTB)
#define PG8_SB(b, h) ((4 + (b) * 2 + (h)) * HTB)
#define PG8_STAGE(bufoff, gbase, voff) do { _Pragma("unroll") for (int _i = 0; _i < 2; ++_i) \
        __builtin_amdgcn_global_load_lds((const unsigned*)((const char*)(gbase) + (voff)[_i]), (LAS unsigned*)(lds + (bufoff) + ldsw + _i * 8192), 16, 0, 0); } while (0)
#define PG8_LDA(dst, b, h) do { _Pragma("unroll") for (int m = 0; m < 4; ++m) _Pragma("unroll") for (int k = 0; k < 2; ++k) dst[m][k] = *(const LAS bf16x8*)(lds + PG8_SA(b, h) + aoff + m * 2048 + k * 1024); } while (0)
#define PG8_LDB(dst, b, h) do { _Pragma("unroll") for (int n = 0; n < 2; ++n) _Pragma("unroll") for (int k = 0; k < 2; ++k) dst[n][k] = *(const LAS bf16x8*)(lds + PG8_SB(b, h) + boff + n * 2048 + k * 1024); } while (0)
#define PG8_MMA(ai, bj, At, Bt) do { __builtin_amdgcn_s_setprio(1); _Pragma("unroll") for (int m = 0; m < 4; ++m) _Pragma("unroll") for (int n = 0; n < 2; ++n) _Pragma("unroll") for (int k = 0; k < 2; ++k) \
        acc[ai][bj][m][n] = __builtin_amdgcn_mfma_f32_16x16x32_bf16(Bt[n][k], At[m][k], acc[ai][bj][m][n], 0, 0, 0); __builtin_amdgcn_s_setprio(0); } while (0)
#define PG8_WAIT_V(n) asm volatile("s_waitcnt vmcnt(" #n ")" ::: "memory")
#define PG8_WAIT_L(n) asm volatile("s_waitcnt lgkmcnt(" #n ")" ::: "memory")
#define PG8_BAR __builtin_amdgcn_s_barrier()
#define PG8_SCHED __builtin_amdgcn_sched_barrier(0)
    Unit cur, nxt; int ui = 0;
    if (!S.next(0, cur)) return;
    f32x4 acc[2][2][4][2];
#pragma unroll
    for (int a = 0; a < 2; ++a)
#pragma unroll
        for (int b = 0; b < 2; ++b)
#pragma unroll
            for (int m = 0; m < 4; ++m)
#pragma unroll
                for (int n = 0; n < 2; ++n) acc[a][b][m][n] = (f32x4){0.f, 0.f, 0.f, 0.f};
    bf16x8 At[4][2], B0[2][2], B1[2][2];
    const char* cA = (const char*)g.A + (size_t)cur.pm * tstepA + (size_t)cur.pn * g.apn; const char* cB = (const char*)g.Bt + (size_t)cur.pn * tstepB;
    PG8_STAGE(PG8_SB(0, 0), cB, voffB); PG8_STAGE(PG8_SA(0, 0), cA, voffA); PG8_STAGE(PG8_SB(0, 1), cB + hstepB, voffB); PG8_STAGE(PG8_SA(0, 1), cA + hstepA, voffA);
    if (wr == 1) PG8_BAR;
    PG8_WAIT_V(4); PG8_BAR;
    PG8_STAGE(PG8_SB(1, 0), cB + kstep, voffB); PG8_STAGE(PG8_SA(1, 0), cA + kstep, voffA); PG8_STAGE(PG8_SB(1, 1), cB + hstepB + kstep, voffB);
    PG8_WAIT_V(6); PG8_BAR;
    for (;;) {
        const bool has_next = S.next(ui + 1, nxt);
        const char* nA = has_next ? (const char*)g.A + (size_t)nxt.pm * tstepA + (size_t)nxt.pn * g.apn : cA; const char* nB = has_next ? (const char*)g.Bt + (size_t)nxt.pn * tstepB : cB;
        for (int t = 0; t < nt; t += 2) {
            const bool last = (t == nt - 2);
            const char* a1 = cA + (size_t)(t + 1) * kstep;
            const char* a2 = last ? nA : cA + (size_t)(t + 2) * kstep; const char* b2 = last ? nB : cB + (size_t)(t + 2) * kstep;
            const char* a3 = a2 + kstep; const char* b3 = b2 + kstep;
            PG8_LDB(B0, 0, 0); PG8_SCHED; PG8_LDA(At, 0, 0); PG8_STAGE(PG8_SA(1, 1), a1 + hstepA, voffA);
            PG8_WAIT_L(8); PG8_BAR; PG8_WAIT_L(0); PG8_MMA(0, 0, At, B0); PG8_BAR; PG8_SCHED;
            PG8_LDB(B1, 0, 1); PG8_STAGE(PG8_SB(0, 0), b2, voffB);
            PG8_BAR; PG8_WAIT_L(0); PG8_MMA(0, 1, At, B1); PG8_BAR;
            PG8_LDA(At, 0, 1); PG8_STAGE(PG8_SA(0, 0), a2, voffA);
            PG8_BAR; PG8_WAIT_L(0); PG8_MMA(1, 0, At, B0); PG8_BAR; PG8_SCHED;
            PG8_STAGE(PG8_SB(0, 1), b2 + hstepB, voffB);
            PG8_WAIT_V(6); PG8_BAR; PG8_MMA(1, 1, At, B1); PG8_BAR;
            PG8_LDB(B0, 1, 0); PG8_SCHED; PG8_LDA(At, 1, 0); PG8_STAGE(PG8_SA(0, 1), a2 + hstepA, voffA);
            PG8_WAIT_L(8); PG8_BAR; PG8_WAIT_L(0); PG8_MMA(0, 0, At, B0); PG8_BAR; PG8_SCHED;
            PG8_LDB(B1, 1, 1); PG8_STAGE(PG8_SB(1, 0), b3, voffB);
            PG8_BAR; PG8_WAIT_L(0); PG8_MMA(0, 1, At, B1); PG8_BAR;
            PG8_LDA(At, 1, 1); PG8_STAGE(PG8_SA(1, 0), a3, voffA);
            PG8_BAR; PG8_WAIT_L(0); PG8_MMA(1, 0, At, B0); PG8_BAR; PG8_SCHED;
            PG8_STAGE(PG8_SB(1, 1), b3 + hstepB, voffB);
            PG8_WAIT_V(6); PG8_BAR; PG8_MMA(1, 1, At, B1); PG8_BAR;
        }
        E(acc, cur, wr, wc, fr, fq);
        if (!has_next) break;
#pragma unroll
        for (int a = 0; a < 2; ++a)
#pragma unroll
            for (int b = 0; b < 2; ++b)
#pragma unroll
                for (int m = 0; m < 4; ++m)
#pragma unroll
                    for (int n = 0; n < 2; ++n) acc[a][b][m][n] = (f32x4){0.f, 0.f, 0.f, 0.f};
        cur = nxt; cA = nA; cB = nB; ++ui;
    }
    PG8_WAIT_V(0);
    if (wr == 0) PG8_BAR;
    PG8_BAR;
#undef PG8_SA
#undef PG8_SB
#undef PG8_STAGE
#undef PG8_LDA
#undef PG8_LDB
#undef PG8_MMA
#undef PG8_WAIT_V
#undef PG8_WAIT_L
#undef PG8_BAR
#undef PG8_SCHED
}
}

__device__ void transpose_convert(int gw, int nw, int lane, const float* W, int K, int N, int Npad, bf16_t* Wt, int ldt, const float* rowgain, const float* colgain) {
    const int kb_n = K / 8, units = kb_n * (Npad / 256);
    for (int u = gw; u < units; u += nw) {
        const int k0 = (u % kb_n) * 8, n = (u / kb_n) * 256 + 4 * lane;
        f32x4 v[8];
        if (n < N) {
#pragma unroll
            for (int i = 0; i < 8; ++i) v[i] = *(const f32x4*)(W + (size_t)(k0 + i) * N + n);
            if (rowgain) {
#pragma unroll
                for (int i = 0; i < 8; ++i) v[i] *= rowgain[k0 + i];
            }
            if (colgain) { const f32x4 cgv = *(const f32x4*)(colgain + n);
#pragma unroll
                for (int i = 0; i < 8; ++i) v[i] *= cgv; }
        } else {
#pragma unroll
            for (int i = 0; i < 8; ++i) v[i] = (f32x4){0.f, 0.f, 0.f, 0.f};
        }
#pragma unroll
        for (int j = 0; j < 4; ++j) {
            u32x4 w; w.x = cvt_pk_bf16(v[0][j], v[1][j]); w.y = cvt_pk_bf16(v[2][j], v[3][j]); w.z = cvt_pk_bf16(v[4][j], v[5][j]); w.w = cvt_pk_bf16(v[6][j], v[7][j]);
            *(u32x4*)(Wt + (size_t)(n + j) * ldt + k0) = w;
        }
    }
}

__device__ void phase_prologue(const Params& p, LAS unsigned char* lds, int wv) {
    unsigned char* ws = p.ws;
    const int tid = opaque_tid(wv), lane = tid & 63, wave = tid >> 6;
    const int gw = blockIdx.x * 8 + wave, nw = gridDim.x * 8;
    const size_t gtid = (size_t)blockIdx.x * 512 + tid, gsz = (size_t)gridDim.x * 512;
    float* ss = (float*)(ws + WS_SS);
    bf16_t* xb = (bf16_t*)(ws + WS_XB);
    for (int row = blockIdx.x * 8 + wave; row < MTOK; row += gridDim.x * 8) {
        const f32x4* xr = (const f32x4*)(p.x + (size_t)row * DM); float sq = 0.f;
#pragma unroll
        for (int i = 0; i < 4; ++i) { const f32x4 v = xr[lane + 64 * i]; sq += (v[0] * v[0] + v[1] * v[1]) + (v[2] * v[2] + v[3] * v[3]);
            u32x2 w; w.x = cvt_pk_bf16(v[0], v[1]); w.y = cvt_pk_bf16(v[2], v[3]); *(u32x2*)(xb + (size_t)row * DM + (lane + 64 * i) * 4) = w; }
        sq = wave_sum(sq);
        if (lane < 16) ss[(size_t)row * 16 + lane] = lane == 0 ? sq : 0.f;
    }
    transpose_convert(gw, nw, lane, p.a_w_in, 1024, 2048, 2048, (bf16_t*)(ws + W_A_IN), 1024, p.norm_mix_g + 0 * DM, nullptr);
    transpose_convert(gw, nw, lane, p.a_w_out, 1024, 1024, 1024, (bf16_t*)(ws + W_A_OUT), 1024, nullptr, nullptr);
    transpose_convert(gw, nw, lane, p.b_w_in, 1024, 3072, 3072, (bf16_t*)(ws + W_B_IN), 1024, p.norm_mix_g + 1 * DM, nullptr);
    transpose_convert(gw, nw, lane, p.b_w_out, 1024, 1024, 1024, (bf16_t*)(ws + W_B_OUT), 1024, nullptr, nullptr);
    transpose_convert(gw, nw, lane, p.c_w_in, 1024, 1024, 1024, (bf16_t*)(ws + W_C_IN), 1024, p.norm_mix_g + 2 * DM, nullptr);
    for (int g = 0; g < 4; ++g)
        transpose_convert(gw, nw, lane, p.c_w_grp + (size_t)g * 65536, 256, 256, 256, (bf16_t*)(ws + W_C_GRP) + (size_t)g * 65536, 256, nullptr, p.c_scale + g * 256);
    transpose_convert(gw, nw, lane, p.d_w_in, 1024, 2760, DSA_LD, (bf16_t*)(ws + W_D_IN), 1024, p.norm_mix_g + 3 * DM, nullptr);
    for (int l = 0; l < 4; ++l) {
        transpose_convert(gw, nw, lane, p.mlp_w1 + (size_t)l * 4194304, 1024, 4096, 4096, (bf16_t*)(ws + W_1) + (size_t)l * 4194304, 1024, p.norm_mlp_g + l * DM, nullptr);
        transpose_convert(gw, nw, lane, p.mlp_w2 + (size_t)l * 4194304, 4096, 1024, 1024, (bf16_t*)(ws + W_2) + (size_t)l * 4194304, 4096, nullptr, nullptr);
    }
    { bf16_t* wsm = (bf16_t*)(ws + W_A_S);
      for (size_t i = gtid; i < (size_t)8 * 128 * 128; i += gsz) { const int s = (int)(i & 127), t = (int)((i >> 7) & 127); const float v = (s <= t) ? p.a_w_s[i] : 0.f; wsm[i] = (bf16_t)(cvt_pk_bf16(v, 0.f) & 0xffffu); } }
    { bf16_t* wc = (bf16_t*)(ws + W_D_COMB);
      for (int u = gw; u < 256 * 4; u += nw) {
          const int k0 = (u >> 2) * 8, n = (u & 3) * 256 + 4 * lane, h = k0 >> 7;
          const float* uv = p.d_w_uv + (size_t)k0 * 64; const float* wo = p.d_w_out + (size_t)h * 64 * 1024 + n;
          f32x4 a[8];
#pragma unroll
          for (int i = 0; i < 8; ++i) a[i] = (f32x4){0.f, 0.f, 0.f, 0.f};
#pragma unroll 4
          for (int v = 0; v < 64; ++v) { const f32x4 w4 = *(const f32x4*)(wo + (size_t)v * 1024);
#pragma unroll
              for (int i = 0; i < 8; ++i) a[i] += w4 * uv[i * 64 + v]; }
#pragma unroll
          for (int j = 0; j < 4; ++j) {
              u32x4 w; w.x = cvt_pk_bf16(a[0][j], a[1][j]); w.y = cvt_pk_bf16(a[2][j], a[3][j]); w.z = cvt_pk_bf16(a[4][j], a[5][j]); w.w = cvt_pk_bf16(a[6][j], a[7][j]);
              *(u32x4*)(wc + (size_t)(n + j) * 2048 + k0) = w; } } }
}

__device__ void phase_sgu(const Params& p, LAS unsigned char* lds, int wv) {
    unsigned char* ws = p.ws;
    const int tid = opaque_tid(wv), lane = tid & 63, wave = __builtin_amdgcn_readfirstlane(tid >> 6), g4 = lane >> 4, l15 = lane & 15, q = l15 >> 2, pp = lane & 3;
    const bf16_t* z = (const bf16_t*)(ws + WS_BIG); bf16_t* us = (bf16_t*)(ws + WS_BIG + 256 * MiB);
    const float* ssv = (const float*)(ws + WS_SS) + (size_t)9 * MTOK * 16; const bf16_t* wsm = (const bf16_t*)(ws + W_A_S);
    const unsigned ldsbase = (unsigned)(size_t)(unsigned char*)lds;
    for (int unit = blockIdx.x; unit < 4096; unit += gridDim.x) {
        const int g = unit & 7, chunk = unit >> 3; const size_t row0 = (size_t)chunk * 128;
#pragma unroll
        for (int i = 0; i < 4; ++i) {
            const int e = tid + 512 * i, r = e >> 4, ch = e & 15;
            const u32x4 raw = *(const u32x4*)(z + (row0 + r) * 2048 + 1024 + g * 128 + ch * 8);
            const float rs = rsqrtf(sum16(ssv + (row0 + r) * 16) * (1.0f / 1024.0f) + 1e-6f);
            const f32x4 g0 = *(const f32x4*)(p.a_v_g + g * 128 + ch * 8), g1 = *(const f32x4*)(p.a_v_g + g * 128 + ch * 8 + 4);
            u32x4 o;
            o.x = cvt_pk_bf16(bflo(raw.x) * rs * g0[0], bfhi(raw.x) * rs * g0[1]); o.y = cvt_pk_bf16(bflo(raw.y) * rs * g0[2], bfhi(raw.y) * rs * g0[3]);
            o.z = cvt_pk_bf16(bflo(raw.z) * rs * g1[0], bfhi(raw.z) * rs * g1[1]); o.w = cvt_pk_bf16(bflo(raw.w) * rs * g1[2], bfhi(raw.w) * rs * g1[3]);
            *(LAS u32x4*)(lds + (r >> 5) * 8192 + off_b(r & 31, ch)) = o;
        }
        __syncthreads();
        const int t = 16 * wave + l15, nks = (wave >> 1) + 1;
        const float bias = p.a_b_s[g * 128 + t]; const size_t rowg = row0 + t;
        u32x2 uu8[8];
#pragma unroll
        for (int ct = 0; ct < 8; ++ct) uu8[ct] = *(const u32x2*)(z + rowg * 2048 + g * 128 + 16 * ct + 4 * g4);
        f32x4 acc[8];
#pragma unroll
        for (int ct = 0; ct < 8; ++ct) acc[ct] = (f32x4){0.f, 0.f, 0.f, 0.f};
        for (int ks = 0; ks < nks; ++ks) {
            const bf16x8 Bw = *(const bf16x8*)(wsm + ((size_t)g * 128 + t) * 128 + 32 * ks + 8 * g4);
#pragma unroll
            for (int cb = 0; cb < 2; ++cb) {
                unsigned ad[8]; bf16x8 Av[4];
#pragma unroll
                for (int i = 0; i < 4; ++i) { const int ct = 4 * cb + i;
                    ad[2 * i] = ldsbase + ks * 8192 + off_b(8 * g4 + q, 2 * ct + (pp >> 1)) + 8 * (pp & 1); ad[2 * i + 1] = ldsbase + ks * 8192 + off_b(8 * g4 + 4 + q, 2 * ct + (pp >> 1)) + 8 * (pp & 1); }
                tr_read8(ad, Av);
#pragma unroll
                for (int i = 0; i < 4; ++i) acc[4 * cb + i] = __builtin_amdgcn_mfma_f32_16x16x32_bf16(Av[i], Bw, acc[4 * cb + i], 0, 0, 0);
            }
        }
#pragma unroll
        for (int ct = 0; ct < 8; ++ct) {
            const u32x2 uu = uu8[ct];
            u32x2 o; o.x = cvt_pk_bf16(bflo(uu.x) * (acc[ct][0] + bias), bfhi(uu.x) * (acc[ct][1] + bias)); o.y = cvt_pk_bf16(bflo(uu.y) * (acc[ct][2] + bias), bfhi(uu.y) * (acc[ct][3] + bias));
            *(u32x2*)(us + rowg * 1024 + g * 128 + 16 * ct + 4 * g4) = o;
        }
        __syncthreads();
    }
}

__device__ void phase_conv(const Params& p, int wv) {
    unsigned char* ws = p.ws; const bf16_t* bch = (const bf16_t*)(ws + WS_BIG); bf16_t* gated = (bf16_t*)(ws + WS_BIG + 384 * MiB);
    const size_t gtid = (size_t)blockIdx.x * 512 + opaque_tid(wv), gsz = (size_t)gridDim.x * 512;
    for (size_t it = gtid; it < (size_t)4096 * 128; it += gsz) {
        const int ch = (int)(it & 127) * 8, rb = (int)(it >> 7); const int r0 = rb * 16;
        float w0[8], w1[8], w2[8], zm2[8], zm1[8];
#pragma unroll
        for (int j = 0; j < 8; ++j) { w0[j] = p.b_conv_w[ch + j]; w1[j] = p.b_conv_w[1024 + ch + j]; w2[j] = p.b_conv_w[2048 + ch + j]; zm2[j] = 0.f; zm1[j] = 0.f; }
        const int tpos0 = r0 & (SEQ - 1);
        for (int d = 2; d >= 1; --d) {
            if (tpos0 - d >= 0) {
                const bf16_t* rp = bch + (size_t)(r0 - d) * 3072; const u32x4 c = *(const u32x4*)(rp + 1024 + ch), h = *(const u32x4*)(rp + 2048 + ch);
                float zz[8] = {bflo(c.x) * bflo(h.x), bfhi(c.x) * bfhi(h.x), bflo(c.y) * bflo(h.y), bfhi(c.y) * bfhi(h.y), bflo(c.z) * bflo(h.z), bfhi(c.z) * bfhi(h.z), bflo(c.w) * bflo(h.w), bfhi(c.w) * bfhi(h.w)};
#pragma unroll
                for (int j = 0; j < 8; ++j) { if (d == 2) zm2[j] = zz[j]; else zm1[j] = zz[j]; }
            }
        }
        for (int r = r0; r < r0 + 16; ++r) {
            const bf16_t* rp = bch + (size_t)r * 3072; const u32x4 b = *(const u32x4*)(rp + ch), c = *(const u32x4*)(rp + 1024 + ch), h = *(const u32x4*)(rp + 2048 + ch);
            float zz[8] = {bflo(c.x) * bflo(h.x), bfhi(c.x) * bfhi(h.x), bflo(c.y) * bflo(h.y), bfhi(c.y) * bfhi(h.y), bflo(c.z) * bflo(h.z), bfhi(c.z) * bfhi(h.z), bflo(c.w) * bflo(h.w), bfhi(c.w) * bfhi(h.w)};
            float bb[8] = {bflo(b.x), bfhi(b.x), bflo(b.y), bfhi(b.y), bflo(b.z), bfhi(b.z), bflo(b.w), bfhi(b.w)};
            float o[8];
#pragma unroll
            for (int j = 0; j < 8; ++j) { o[j] = bb[j] * (w0[j] * zm2[j] + w1[j] * zm1[j] + w2[j] * zz[j]); zm2[j] = zm1[j]; zm1[j] = zz[j]; }
            u32x4 w; w.x = cvt_pk_bf16(o[0], o[1]); w.y = cvt_pk_bf16(o[2], o[3]); w.z = cvt_pk_bf16(o[4], o[5]); w.w = cvt_pk_bf16(o[6], o[7]);
            *(u32x4*)(gated + (size_t)r * 1024 + ch) = w;
        }
    }
}

__device__ __forceinline__ void ld8(const bf16_t* ptr, float (&f)[8]) {
    const u32x4 v = *(const u32x4*)ptr; f[0] = bflo(v.x); f[1] = bfhi(v.x); f[2] = bflo(v.y); f[3] = bfhi(v.y); f[4] = bflo(v.z); f[5] = bfhi(v.z); f[6] = bflo(v.w); f[7] = bfhi(v.w);
}
__device__ void phase_pool(const Params& p, int wv) {
    unsigned char* ws = p.ws; const bf16_t* z = (const bf16_t*)(ws + WS_BIG); bf16_t* pooled = (bf16_t*)(ws + WS_BIG + 128 * MiB);
    const size_t gtid = (size_t)blockIdx.x * 512 + opaque_tid(wv), gsz = (size_t)gridDim.x * 512;
    for (size_t it = gtid; it < (size_t)2048 * 128; it += gsz) {
        const int lane = (int)(it & 63), wv = (int)(it >> 6), chunk = (wv & 3) * 32 + (lane & 31), rb = (wv >> 2) * 2 + (lane >> 5);
        const int ch = chunk * 8, w = 2 << (ch >> 8), r0 = rb * 32;
        float S[8];
#pragma unroll
        for (int j = 0; j < 8; ++j) S[j] = 0.f;
        const int tpos0 = r0 & (SEQ - 1);
        for (int d = 1; d <= w; ++d) {
            if (tpos0 - d >= 0) { float f[8]; ld8(z + (size_t)(r0 - d) * 1024 + ch, f);
#pragma unroll
                for (int j = 0; j < 8; ++j) S[j] += f[j]; }
        }
        for (int r = r0; r < r0 + 32; ++r) {
            const int tpos = r & (SEQ - 1); float f[8]; ld8(z + (size_t)r * 1024 + ch, f);
#pragma unroll
            for (int j = 0; j < 8; ++j) S[j] += f[j];
            if (tpos - w >= 0) { float o[8]; ld8(z + (size_t)(r - w) * 1024 + ch, o);
#pragma unroll
                for (int j = 0; j < 8; ++j) S[j] -= o[j]; }
            const int cnt = (tpos + 1 < w) ? tpos + 1 : w; const float inv = 1.0f / (float)cnt;
            u32x4 o; o.x = cvt_pk_bf16(S[0] * inv - f[0], S[1] * inv - f[1]); o.y = cvt_pk_bf16(S[2] * inv - f[2], S[3] * inv - f[3]);
            o.z = cvt_pk_bf16(S[4] * inv - f[4], S[5] * inv - f[5]); o.w = cvt_pk_bf16(S[6] * inv - f[6], S[7] * inv - f[7]);
            *(u32x4*)(pooled + (size_t)r * 1024 + ch) = o;
        }
    }
}

__device__ __forceinline__ int cnt_ge8(const unsigned* v, unsigned cand) {
    unsigned long long m0, m1, m2, m3, m4, m5, m6, m7;
    asm("v_cmp_le_u32_e64 %0, %8, %9\n\tv_cmp_le_u32_e64 %1, %8, %10\n\tv_cmp_le_u32_e64 %2, %8, %11\n\tv_cmp_le_u32_e64 %3, %8, %12\n\t"
        "v_cmp_le_u32_e64 %4, %8, %13\n\tv_cmp_le_u32_e64 %5, %8, %14\n\tv_cmp_le_u32_e64 %6, %8, %15\n\tv_cmp_le_u32_e64 %7, %8, %16"
        : "=&s"(m0), "=&s"(m1), "=&s"(m2), "=&s"(m3), "=&s"(m4), "=&s"(m5), "=&s"(m6), "=&s"(m7)
        : "s"(cand), "v"(v[0]), "v"(v[1]), "v"(v[2]), "v"(v[3]), "v"(v[4]), "v"(v[5]), "v"(v[6]), "v"(v[7]));
    return (__builtin_popcountll(m0) + __builtin_popcountll(m1)) + (__builtin_popcountll(m2) + __builtin_popcountll(m3)) +
           (__builtin_popcountll(m4) + __builtin_popcountll(m5)) + (__builtin_popcountll(m6) + __builtin_popcountll(m7));
}
__device__ void phase_topk(const Params& p, LAS unsigned char* lds, int wv) {
    unsigned char* ws = p.ws;
    const int tid = opaque_tid(wv), lane = tid & 63, wave = __builtin_amdgcn_readfirstlane(tid >> 6), g4 = lane >> 4, l15 = lane & 15;
    const bf16_t* din = (const bf16_t*)(ws + WS_BIG); bf16_t* cn = (bf16_t*)(ws + WS_CN); unsigned short* idx = (unsigned short*)(ws + WS_IDX);
    LAS unsigned short* S16 = (LAS unsigned short*)lds;
    constexpr int SROW = 4112;
    { const float kg0 = p.d_kv_g[2 * lane], kg1 = p.d_kv_g[2 * lane + 1];
      for (int row4 = (blockIdx.x * 8 + wave) * 4; row4 < MTOK; row4 += gridDim.x * 32) {
        unsigned raw[4];
#pragma unroll
        for (int j = 0; j < 4; ++j) raw[j] = *(const unsigned*)(din + (size_t)(row4 + j) * DSA_LD + 2048 + 2 * lane);
#pragma unroll
        for (int j = 0; j < 4; ++j) { const float a = bflo(raw[j]), b = bfhi(raw[j]);
            const float sq = wave_sum(a * a + b * b); const float rs = rsqrtf(sq * (1.0f / 128.0f) + 1e-6f);
            *(unsigned*)(cn + (size_t)(row4 + j) * 128 + 2 * lane) = cvt_pk_bf16(a * rs * kg0, b * rs * kg1); }
      } }
    for (int unit = blockIdx.x; unit < 4096; unit += gridDim.x) {
        const int pi = (unit / (2 * (int)gridDim.x)) * (int)gridDim.x + (unit % (int)gridDim.x), hi = (unit / (int)gridDim.x) & 1;
        const int b = pi >> 7, cc = pi & 127, qt = hi ? 255 - cc : cc, qpos0 = qt * 16; const size_t rowq0 = (size_t)b * SEQ + qpos0;
        bf16x8 Aq[8][2]; float wv[8][4];
#pragma unroll
        for (int pr = 0; pr < 8; ++pr) {
            const int qg = pr >> 1, hh = pr & 1;
            const bf16_t* base = din + (rowq0 + 4 * qg + (l15 >> 2)) * DSA_LD + 2176 + (4 * hh + (l15 & 3)) * 64;
            Aq[pr][0] = *(const bf16x8*)(base + 8 * g4); Aq[pr][1] = *(const bf16x8*)(base + 32 + 8 * g4);
            const u32x2 wr = *(const u32x2*)(din + (rowq0 + 4 * qg + g4) * DSA_LD + 2752 + 4 * hh);
            wv[pr][0] = bflo(wr.x) * 0.04419417382f; wv[pr][1] = bfhi(wr.x) * 0.04419417382f; wv[pr][2] = bflo(wr.y) * 0.04419417382f; wv[pr][3] = bfhi(wr.y) * 0.04419417382f;
        }
        const int nkt = (qpos0 + 15) / 16 + 1;
        {
        bf16x8 B0[4], B1[4], N0[4], N1[4];
#pragma unroll
        for (int j = 0; j < 4; ++j) { const int kt = (wave + 8 * j < nkt) ? wave + 8 * j : 0;
            const bf16_t* kb = din + ((size_t)b * SEQ + 16 * kt + l15) * DSA_LD + 2688;
            B0[j] = *(const bf16x8*)(kb + 8 * g4); B1[j] = *(const bf16x8*)(kb + 32 + 8 * g4); }
        for (int kt0 = wave; kt0 < nkt; kt0 += 32) {
#pragma unroll
            for (int j = 0; j < 4; ++j) { const int kt = (kt0 + 32 + 8 * j < nkt) ? kt0 + 32 + 8 * j : 0;
                const bf16_t* kb = din + ((size_t)b * SEQ + 16 * kt + l15) * DSA_LD + 2688;
                N0[j] = *(const bf16x8*)(kb + 8 * g4); N1[j] = *(const bf16x8*)(kb + 32 + 8 * g4); }
#pragma unroll
            for (int j = 0; j < 4; ++j) {
                const int kt = kt0 + 8 * j;
                if (kt < nkt) {
#pragma unroll
                    for (int qg = 0; qg < 4; ++qg) {
                        float part = 0.f;
#pragma unroll
                        for (int hh = 0; hh < 2; ++hh) {
                            const int pr = 2 * qg + hh;
                            f32x4 c = (f32x4){0.f, 0.f, 0.f, 0.f};
                            c = __builtin_amdgcn_mfma_f32_16x16x32_bf16(Aq[pr][0], B0[j], c, 0, 0, 0);
                            c = __builtin_amdgcn_mfma_f32_16x16x32_bf16(Aq[pr][1], B1[j], c, 0, 0, 0);
                            part += (fmaxf(c[0], 0.f) * wv[pr][0] + fmaxf(c[1], 0.f) * wv[pr][1]) + (fmaxf(c[2], 0.f) * wv[pr][2] + fmaxf(c[3], 0.f) * wv[pr][3]);
                        }
                        const _Float16 hsc = (_Float16)(part + 0.0f);
                        S16[(4 * qg + g4) * SROW + 16 * kt + l15] = __builtin_bit_cast(unsigned short, hsc);
                    }
                }
            }
#pragma unroll
            for (int j = 0; j < 4; ++j) { B0[j] = N0[j]; B1[j] = N1[j]; }
        }
        }
        __syncthreads();
        for (int qi2 = 0; qi2 < 2; ++qi2) {
            const int ql = wave + 8 * qi2;
            const int qpos = qpos0 + ql, n = qpos + 1; unsigned short* out = idx + (rowq0 + ql) * 256;
            if (n <= 256) {
#pragma unroll
                for (int i = 0; i < 4; ++i) { const int j = lane + 64 * i; out[j] = (unsigned short)(j < n ? j : 0xFFFF); }
            } else {
                unsigned u[64];
                const int ni = (n + 63) >> 6;
#pragma unroll
                for (int blk = 0; blk < 8; ++blk) {
                    if (blk * 8 < ni) {
#pragma unroll
                        for (int i = blk * 8; i < blk * 8 + 8; ++i) { const int key = lane + 64 * i; unsigned bits = S16[ql * SROW + key]; bits ^= (bits & 0x8000u) ? 0xFFFFu : 0x8000u; u[i] = key < n ? bits : 0u; }
                    } else {
#pragma unroll
                        for (int i = blk * 8; i < blk * 8 + 8; ++i) u[i] = 0u;
                    }
                }
                unsigned T = 0u;
                for (int bit = 15; bit >= 0; --bit) {
                    const unsigned cand = __builtin_amdgcn_readfirstlane(T | (1u << bit)); int cnt = 0;
#pragma unroll
                    for (int blk = 0; blk < 8; ++blk) {
                        if (blk * 8 < ni) cnt += cnt_ge8(&u[blk * 8], cand);
                    }
                    if (cnt >= 256) T = cand;
                }
                int G = 0;
#pragma unroll
                for (int i = 0; i < 64; ++i) G += __popcll(__ballot(u[i] > T));
                const int need = 256 - G; int base = 0, tie_seen = 0;
                const unsigned long long ltmask = (1ull << lane) - 1ull;
#pragma unroll
                for (int blk = 0; blk < 8; ++blk) {
                    if (blk * 8 < ni) {
#pragma unroll
                        for (int i = blk * 8; i < blk * 8 + 8; ++i) {
                            const bool gt = u[i] > T, eq = u[i] == T;
                            const unsigned long long meq = __ballot(eq);
                            const bool sel = gt || (eq && (tie_seen + __popcll(meq & ltmask)) < need);
                            const unsigned long long msel = __ballot(sel);
                            if (sel) out[base + __popcll(msel & ltmask)] = (unsigned short)(lane + 64 * i);
                            base += __popcll(msel); tie_seen += __popcll(meq);
                        }
                    }
                }
            }
        }
        __syncthreads();
    }
}

__device__ void phase_attn(const Params& p, LAS unsigned char* lds, bool dry, int wv) {
    unsigned char* ws = p.ws;
    const int tid = opaque_tid(wv), lane = tid & 63, wave = __builtin_amdgcn_readfirstlane(tid >> 6), g4 = lane >> 4, l15 = lane & 15, q = l15 >> 2, pp = lane & 3;
    bf16_t* din = (bf16_t*)(ws + WS_BIG); const bf16_t* cn = (const bf16_t*)(ws + WS_CN); const unsigned short* idx = (const unsigned short*)(ws + WS_IDX);
    LAS unsigned char* wl = lds + wave * 8192; const unsigned wbase = (unsigned)(size_t)(unsigned char*)lds + wave * 8192;
    const float scale = 0.08838834764f;
    for (int Q = blockIdx.x * 8 + wave; Q < MTOK; Q += gridDim.x * 8) {
        const int b = Q >> 12, qpos = Q & (SEQ - 1); const int nvalid = qpos + 1 < 256 ? qpos + 1 : 256;
        bf16_t* qrow = din + (size_t)Q * DSA_LD;
        bf16x8 Bq[4];
#pragma unroll
        for (int s = 0; s < 4; ++s) Bq[s] = *(const bf16x8*)(qrow + l15 * 128 + 32 * s + 8 * g4);
        f32x4 O[8];
#pragma unroll
        for (int mt = 0; mt < 8; ++mt) O[mt] = (f32x4){0.f, 0.f, 0.f, 0.f};
        float mrun = -1e30f, lrun = 0.f;
        unsigned kid[16];
#pragma unroll
        for (int i = 0; i < 16; ++i) { const int slot = i * 16 + l15; const unsigned v = idx[(size_t)Q * 256 + slot]; kid[i] = slot < nvalid ? v : 0u; }
        bf16x8 A[2][4], An[2][4];
#pragma unroll
        for (int tl = 0; tl < 2; ++tl) { const bf16_t* crow = cn + ((size_t)b * SEQ + kid[tl]) * 128;
#pragma unroll
            for (int s = 0; s < 4; ++s) A[tl][s] = *(const bf16x8*)(crow + 32 * s + 8 * g4); }
#pragma unroll
        for (int ck = 0; ck < 8; ++ck) {
            if (ck * 32 < nvalid) {
                if (ck < 7) {
#pragma unroll
                    for (int tl = 0; tl < 2; ++tl) { const bf16_t* crow = cn + ((size_t)b * SEQ + kid[(ck < 7 ? ck + 1 : ck) * 2 + tl]) * 128;
#pragma unroll
                        for (int s = 0; s < 4; ++s) An[tl][s] = *(const bf16x8*)(crow + 32 * s + 8 * g4); }
                }
                f32x4 S0 = (f32x4){0.f, 0.f, 0.f, 0.f}, S1 = (f32x4){0.f, 0.f, 0.f, 0.f};
#pragma unroll
                for (int s = 0; s < 4; ++s) { S0 = __builtin_amdgcn_mfma_f32_16x16x32_bf16(A[0][s], Bq[s], S0, 0, 0, 0); S1 = __builtin_amdgcn_mfma_f32_16x16x32_bf16(A[1][s], Bq[s], S1, 0, 0, 0); }
#pragma unroll
                for (int tl = 0; tl < 2; ++tl)
#pragma unroll
                    for (int s = 0; s < 4; ++s) *(LAS bf16x8*)(wl + off_b(16 * tl + l15, 4 * s + g4)) = A[tl][s];
                float sv[8];
#pragma unroll
                for (int j = 0; j < 4; ++j) { const int s0 = ck * 32 + 4 * g4 + j; sv[j] = s0 < nvalid ? S0[j] * scale : -1e30f; sv[4 + j] = (s0 + 16) < nvalid ? S1[j] * scale : -1e30f; }
                float cm = fmaxf(fmaxf(fmaxf(sv[0], sv[1]), fmaxf(sv[2], sv[3])), fmaxf(fmaxf(sv[4], sv[5]), fmaxf(sv[6], sv[7])));
                cm = xrow16_max(cm);
                const float mn = fmaxf(mrun, cm), alpha = __expf(mrun - mn);
                float pv[8], ps = 0.f;
#pragma unroll
                for (int j = 0; j < 8; ++j) { pv[j] = __expf(sv[j] - mn); ps += pv[j]; }
                lrun = lrun * alpha + ps; mrun = mn;
#pragma unroll
                for (int mt = 0; mt < 8; ++mt) O[mt] *= alpha;
                union { u32x4 u; bf16x8 h; } Pb;
                Pb.u.x = cvt_pk_bf16(pv[0], pv[1]); Pb.u.y = cvt_pk_bf16(pv[2], pv[3]); Pb.u.z = cvt_pk_bf16(pv[4], pv[5]); Pb.u.w = cvt_pk_bf16(pv[6], pv[7]);
                asm volatile("s_waitcnt lgkmcnt(0)" ::: "memory");
#pragma unroll
                for (int mb = 0; mb < 2; ++mb) {
                    unsigned ad[8]; bf16x8 Av[4];
#pragma unroll
                    for (int i = 0; i < 4; ++i) { const int mt = 4 * mb + i;
                        ad[2 * i] = wbase + off_b(4 * g4 + q, 2 * mt + (pp >> 1)) + 8 * (pp & 1); ad[2 * i + 1] = wbase + off_b(16 + 4 * g4 + q, 2 * mt + (pp >> 1)) + 8 * (pp & 1); }
                    tr_read8(ad, Av);
#pragma unroll
                    for (int i = 0; i < 4; ++i) O[4 * mb + i] = __builtin_amdgcn_mfma_f32_16x16x32_bf16(Av[i], Pb.h, O[4 * mb + i], 0, 0, 0);
                }
                if (ck < 7) {
#pragma unroll
                    for (int tl = 0; tl < 2; ++tl)
#pragma unroll
                        for (int s = 0; s < 4; ++s) A[tl][s] = An[tl][s];
                }
            }
        }
        lrun = xrow16_sum(lrun);
        const float inv = 1.0f / lrun;
#pragma unroll
        for (int mt = 0; mt < 8; ++mt) {
            u32x2 o; o.x = cvt_pk_bf16(O[mt][0] * inv, O[mt][1] * inv); o.y = cvt_pk_bf16(O[mt][2] * inv, O[mt][3] * inv);
            if (!dry) *(u32x2*)(qrow + l15 * 128 + 16 * mt + 4 * g4) = o;
        }
    }
}

__device__ void phase_final(const Params& p, int wv) {
    const int tid = opaque_tid(wv); const int lane = tid & 63, wave = tid >> 6;
    const float* ss = (const float*)(p.ws + WS_SS) + (size_t)8 * MTOK * 16; const bf16_t* xb = (const bf16_t*)(p.ws + WS_XB);
    for (int row = blockIdx.x * 8 + wave; row < MTOK; row += gridDim.x * 8) {
        const float rs = rsqrtf(sum16(ss + (size_t)row * 16) * (1.0f / 1024.0f) + 1e-6f);
        f32x4* orow = (f32x4*)(p.out + (size_t)row * DM);
#pragma unroll
        for (int i = 0; i < 4; ++i) { const f32x4 g = *(const f32x4*)(p.final_g + (lane + 64 * i) * 4); const u32x2 xw = *(const u32x2*)(xb + (size_t)row * DM + (lane + 64 * i) * 4);
            f32x4 v = (f32x4){bflo(xw.x), bfhi(xw.x), bflo(xw.y), bfhi(xw.y)}; v = v * rs * g; orow[lane + 64 * i] = v; }
    }
}

#define XB_TMO      128
#define XB_XCNT(j)  (256  + 64 * (j))
#define XB_XSUB(j)  (1280 + 64 * (j))
#define XB_XGEN(j)  (2304 + 64 * (j))
#define XB_TOP      3328
#define XB_TOPGEN   3392
#define XCD_BAR_WORDS 3456
#define XB_SPIN_CAP (1u << 20)
__device__ __forceinline__ unsigned xb_ld(unsigned* p)              { return __hip_atomic_load(p, __ATOMIC_RELAXED, __HIP_MEMORY_SCOPE_AGENT); }
__device__ __forceinline__ unsigned xb_add(unsigned* p, unsigned v) { return __hip_atomic_fetch_add(p, v, __ATOMIC_RELAXED, __HIP_MEMORY_SCOPE_AGENT); }
__device__ __forceinline__ unsigned xb_xcc_id() { return (unsigned)__builtin_amdgcn_s_getreg((3 << 11) | 20) & 0xFu; }
#define XB_SPIN(cond, bar) do { unsigned _sp = 0; while (cond) { __builtin_amdgcn_s_sleep(1); \
    if ((++_sp & 255u) == 0u) { if (xb_ld(&(bar)[XB_TMO])) break; if (_sp > XB_SPIN_CAP) { atomicAdd(&(bar)[XB_TMO], 1u); break; } } } } while (0)
struct XcdBarrier { unsigned* bar; unsigned x; volatile LAS unsigned* st; };
__device__ __forceinline__ XcdBarrier xcd_barrier_post(unsigned* bar, volatile LAS unsigned* st, bool is_t0) {
    XcdBarrier b; b.bar = bar; b.x = xb_xcc_id(); b.st = st;
    if (is_t0) (void)xb_add(&bar[XB_XCNT(b.x)], 1u);
    return b;
}
__device__ __forceinline__ void xcd_barrier_complete(unsigned* bar, unsigned x, unsigned& nloc, unsigned& nx) {
    const unsigned G = gridDim.x * gridDim.y * gridDim.z;
    unsigned sum, cnt, mine, sp = 0u;
    for (;;) {
        sum = 0u; cnt = 0u; mine = 0u;
#pragma unroll
        for (unsigned j = 0; j < 16; ++j) { const unsigned c = xb_ld(&bar[XB_XCNT(j)]); sum += c; cnt += (c > 0u) ? 1u : 0u; mine = (j == x) ? c : mine; }
        if (sum == G) break;
        __builtin_amdgcn_s_sleep(1);
        if ((++sp & 255u) == 0u) { if (xb_ld(&bar[XB_TMO])) break; if (sp > XB_SPIN_CAP) { atomicAdd(&bar[XB_TMO], 1u); break; } }
    }
    nloc = mine > 0u ? mine : 1u; nx = cnt > 0u ? cnt : 1u;
}
__device__ __forceinline__ void xcd_barrier(const XcdBarrier& b, bool is_t0) {
    asm volatile("s_waitcnt vmcnt(0)" ::: "memory");
    __syncthreads();
    if (is_t0) {
        unsigned* bar = b.bar;
        __builtin_amdgcn_s_waitcnt(0);
        unsigned nloc = b.st[0], nx = b.st[1];
        if (nloc == 0u) { xcd_barrier_complete(bar, b.x, nloc, nx); b.st[0] = nloc; b.st[1] = nx; }
        const unsigned old = xb_add(&bar[XB_XSUB(b.x)], 1u);
        const unsigned gen = old / nloc;
        if (old + 1u == (gen + 1u) * nloc) {
            __builtin_amdgcn_fence(__ATOMIC_RELEASE, "agent");
            asm volatile("s_waitcnt vmcnt(0)" ::: "memory");
            const unsigned og = xb_add(&bar[XB_TOP], 1u);
            const unsigned tg = og / nx;
            if (og + 1u == (tg + 1u) * nx) xb_add(&bar[XB_TOPGEN], 1u);
            else XB_SPIN(xb_ld(&bar[XB_TOPGEN]) == tg, bar);
            __builtin_amdgcn_fence(__ATOMIC_ACQUIRE, "agent");
            xb_add(&bar[XB_XGEN(b.x)], 1u);
            asm volatile("s_waitcnt vmcnt(0)" ::: "memory");
        } else {
            XB_SPIN(xb_ld(&bar[XB_XGEN(b.x)]) == gen, bar);
            __builtin_amdgcn_fence(__ATOMIC_ACQUIRE, "agent");
            asm volatile("s_waitcnt vmcnt(0)" ::: "memory");
        }
    }
    __syncthreads();
}

enum { K_PRO = 0, K_GACT, K_GRES, K_SGU, K_CONV, K_POOL, K_TOPK, K_ATTN, K_FINAL };
struct PhaseDesc { int kind, act, lda, apn, N, K, ldc, ss_idx, xin_is_x, pad; size_t a_off, w_off; };
__device__ __forceinline__ PhaseDesc mk_act(int act, size_t w_off, int N, int ss_idx) { PhaseDesc d{}; d.kind = K_GACT; d.act = act; d.lda = 1024; d.apn = 0; d.N = N; d.K = 1024; d.ldc = N; d.ss_idx = ss_idx; d.a_off = WS_XB; d.w_off = w_off; return d; }
__device__ __forceinline__ PhaseDesc mk_res(size_t a_off, int lda, int apn, size_t w_off, int K, int xin_is_x, int ss_idx) { PhaseDesc d{}; d.kind = K_GRES; d.lda = lda; d.apn = apn; d.N = 1024; d.K = K; d.ss_idx = ss_idx; d.xin_is_x = xin_is_x; d.a_off = a_off; d.w_off = w_off; return d; }
__device__ __forceinline__ PhaseDesc mk_kind(int kind) { PhaseDesc d{}; d.kind = kind; return d; }
__device__ __forceinline__ PhaseDesc phase_desc(int ph) {
    switch (ph) {
    case 0: return mk_kind(K_PRO);
    case 1: return mk_act(1, W_A_IN, 2048, 0);
    case 2: return mk_kind(K_SGU);
    case 3: return mk_res(WS_BIG + 256 * MiB, 1024, 0, W_A_OUT, 1024, 1, 1);
    case 4: return mk_act(2, W_1 + 0 * 8 * MiB, 4096, 1);
    case 5: return mk_res(WS_BIG, 4096, 0, W_2 + 0 * 8 * MiB, 4096, 0, 2);
    case 6: return mk_act(0, W_B_IN, 3072, 2);
    case 7: return mk_kind(K_CONV);
    case 8: return mk_res(WS_BIG + 384 * MiB, 1024, 0, W_B_OUT, 1024, 0, 3);
    case 9: return mk_act(2, W_1 + 1 * 8 * MiB, 4096, 3);
    case 10: return mk_res(WS_BIG, 4096, 0, W_2 + 1 * 8 * MiB, 4096, 0, 4);
    case 11: return mk_act(0, W_C_IN, 1024, 4);
    case 12: return mk_kind(K_POOL);
    case 13: return mk_res(WS_BIG + 128 * MiB, 1024, 512, W_C_GRP, 256, 0, 5);
    case 14: return mk_act(2, W_1 + 2 * 8 * MiB, 4096, 5);
    case 15: return mk_res(WS_BIG, 4096, 0, W_2 + 2 * 8 * MiB, 4096, 0, 6);
    case 16: return mk_act(0, W_D_IN, DSA_LD, 6);
    case 17: return mk_kind(K_TOPK);
    case 18: return mk_kind(K_ATTN);
    case 19: return mk_res(WS_BIG, DSA_LD, 0, W_D_COMB, 2048, 0, 7);
    case 20: return mk_act(2, W_1 + 3 * 8 * MiB, 4096, 7);
    case 21: return mk_res(WS_BIG, 4096, 0, W_2 + 3 * 8 * MiB, 4096, 0, 8);
    default: return mk_kind(K_FINAL);
    }
}

__device__ __forceinline__ void run_phase(int ph, const Params& p, LAS unsigned char* lds, bool dry, int wv) {
    const PhaseDesc d = phase_desc(ph);
    unsigned char* ws = p.ws; float* ss = (float*)(ws + WS_SS);
    if (d.kind == K_GACT || d.kind == K_GRES) {
        pg8::Gemm g; g.A = (const bf16_t*)(ws + d.a_off); g.Bt = (const bf16_t*)(ws + d.w_off); g.M = MTOK; g.N = d.N; g.K = d.K; g.lda = d.lda; g.apn = d.apn;
        pg8::StaticOrder S; S.init(MTOK, d.N, gridDim.x, blockIdx.x);
        if (d.kind == K_GACT) { pg8::EpiAct E; E.O = (bf16_t*)(ws + WS_BIG); E.ldc = d.ldc; E.ss_in = ss + (size_t)d.ss_idx * MTOK * 16; E.ssv = ss + (size_t)9 * MTOK * 16; E.ACT = d.act; pg8::gemm_phase(lds, g, S, E, wv); }
        else { pg8::EpiResid E; E.xb = (bf16_t*)(ws + WS_XB); E.ss_out = ss + (size_t)d.ss_idx * MTOK * 16; pg8::gemm_phase(lds, g, S, E, wv); }
    }
    else if (d.kind == K_PRO) phase_prologue(p, lds, wv);
    else if (d.kind == K_SGU) phase_sgu(p, lds, wv);
    else if (d.kind == K_CONV) phase_conv(p, wv);
    else if (d.kind == K_POOL) phase_pool(p, wv);
    else if (d.kind == K_TOPK) phase_topk(p, lds, wv);
    else if (d.kind == K_ATTN) phase_attn(p, lds, dry, wv);
    else phase_final(p, wv);
}

__global__ void __launch_bounds__(512, 2) fwd_megakernel(Params p) {
    extern __shared__ __attribute__((aligned(16))) unsigned char lds_raw[];
    LAS unsigned char* lds = (LAS unsigned char*)lds_raw;
    const int wv = __builtin_amdgcn_readfirstlane((int)threadIdx.x >> 6);
    volatile LAS unsigned* bst = (volatile LAS unsigned*)(lds + 131584);
    XcdBarrier xbar; xbar.bar = (unsigned*)(p.ws + WS_BAR); xbar.x = 0; xbar.st = bst;
    if (p.ph_hi - p.ph_lo > 1) {
        if (threadIdx.x == 0) { bst[0] = 0u; bst[1] = 0u; }
        __syncthreads();
        xbar = xcd_barrier_post((unsigned*)(p.ws + WS_BAR), bst, threadIdx.x == 0);
    }
    for (int ph = p.ph_lo; ph < p.ph_hi; ++ph) {
#if PROBE_DUP
        const int reps = ((PROBE_DUP >> ph) & 1) ? 2 : 1;
        for (int r = 0; r < reps; ++r) { run_phase(ph, p, lds, r + 1 < reps, wv); if (r + 1 < reps) cg::this_grid().sync(); }
#else
        run_phase(ph, p, lds, false, wv);
#endif
        if (ph + 1 < p.ph_hi) { if (ph == p.ph_lo) cg::this_grid().sync(); else xcd_barrier(xbar, opaque_tid(wv) == 0); }
    }
}

#ifndef MK_MULTI
#define MK_MULTI 0
#endif

extern "C" void kernel_launch(void* const* d_in, const int* in_sizes, int n_in, void* d_out, int out_size, void* d_ws, size_t ws_size, hipStream_t stream) {
    static int grid = 0;
    if (grid == 0) {
        int dev = 0, cus = 0, per_cu = 0;
        hipGetDevice(&dev);
        hipDeviceGetAttribute(&cus, hipDeviceAttributeMultiprocessorCount, dev);
        if (hipFuncSetAttribute((const void*)fwd_megakernel, hipFuncAttributeMaxDynamicSharedMemorySize, LDS_BYTES) != hipSuccess) { fprintf(stderr, "hipFuncSetAttribute failed\n"); grid = -1; return; }
        if (hipOccupancyMaxActiveBlocksPerMultiprocessor(&per_cu, (const void*)fwd_megakernel, 512, LDS_BYTES) != hipSuccess || per_cu < 1) { fprintf(stderr, "occupancy query: %d\n", per_cu); per_cu = 1; }
        (void)hipGetLastError();
        grid = cus * (per_cu > 1 ? 1 : per_cu);
        if (ws_size < 840 * MiB) { fprintf(stderr, "workspace too small\n"); grid = -1; return; }
    }
    if (grid < 0) return;
    Params p{};
    const float** pp = (const float**)&p;
    for (int i = 0; i < 21; ++i) pp[i] = (const float*)d_in[i];
    p.out = (float*)d_out; p.ws = (unsigned char*)d_ws;
#if MK_MULTI
    for (int ph = 0; ph < NPHASE; ++ph) {
        p.ph_lo = ph; p.ph_hi = ph + 1;
        hipLaunchKernelGGL(fwd_megakernel, dim3(grid), dim3(512), LDS_BYTES, stream, p);
    }
#else
    p.ph_lo = 0; p.ph_hi = NPHASE;
    if (hipMemsetAsync((unsigned char*)d_ws + WS_BAR, 0, XCD_BAR_WORDS * 4, stream) != hipSuccess) { fprintf(stderr, "barrier memset failed\n"); return; }
    void* args[] = {&p};
    hipError_t e = hipLaunchCooperativeKernel((const void*)fwd_megakernel, dim3(grid), dim3(512), args, LDS_BYTES, stream);
    if (e != hipSuccess) fprintf(stderr, "cooperative launch failed: %s (grid %d)\n", hipGetErrorString(e), grid);
#endif
}
```

```cpp
#include <hip/hip_runtime.h>
#include <hip/hip_cooperative_groups.h>
#include <cstdio>
namespace cg = cooperative_groups;

#ifndef PROBE_DUP
#define PROBE_DUP 0
#endif
#ifndef PROBE_TOPK
#define PROBE_TOPK 0
#endif
#define LAS __attribute__((address_space(3)))
typedef unsigned short bf16_t;
typedef short bf16x8 __attribute__((ext_vector_type(8)));
typedef float f32x4 __attribute__((ext_vector_type(4)));
typedef float f32x2 __attribute__((ext_vector_type(2)));
typedef unsigned u32x4 __attribute__((ext_vector_type(4)));
typedef unsigned u32x2 __attribute__((ext_vector_type(2)));
typedef unsigned short u16x4 __attribute__((ext_vector_type(4)));

constexpr int MTOK = 65536, DM = 1024, SEQ = 4096;
constexpr size_t MiB = 1ull << 20;
constexpr size_t WS_XB = 0;
constexpr size_t WS_BIG = 128 * MiB;
constexpr size_t WS_CN = 640 * MiB;
constexpr size_t WS_IDX = 656 * MiB;
constexpr size_t WS_SS = 800 * MiB;
constexpr size_t WS_BAR = 688 * MiB;
constexpr size_t WS_W = 692 * MiB;
constexpr size_t W_A_IN = WS_W + 0 * MiB, W_A_OUT = WS_W + 4 * MiB, W_A_S = WS_W + 6 * MiB, W_B_IN = WS_W + 7 * MiB, W_B_OUT = WS_W + 13 * MiB,
                 W_C_IN = WS_W + 15 * MiB, W_C_GRP = WS_W + 17 * MiB, W_D_IN = WS_W + 18 * MiB, W_D_COMB = WS_W + 24 * MiB, W_1 = WS_W + 28 * MiB, W_2 = WS_W + 60 * MiB;
constexpr int DSA_LD = 2816;
constexpr int LDS_BYTES = 131072 + 1024;
constexpr int NPHASE = 47;

struct Params {
    const float *x, *norm_mix_g, *norm_mlp_g, *final_g, *a_w_in, *a_v_g, *a_w_s, *a_b_s, *a_w_out, *b_w_in, *b_conv_w, *b_w_out, *c_w_in, *c_w_grp, *c_scale,
        *d_w_in, *d_kv_g, *d_w_uv, *d_w_out, *mlp_w1, *mlp_w2;
    float* out; unsigned char* ws; int ph_lo, ph_hi;
};

__device__ __forceinline__ unsigned cvt_pk_bf16(float lo, float hi) { unsigned r; asm volatile("v_cvt_pk_bf16_f32 %0, %1, %2" : "=v"(r) : "v"(lo), "v"(hi)); return r; }
__device__ __forceinline__ int opaque_tid(int wv) { int l; asm volatile("v_mbcnt_lo_u32_b32 %0, -1, 0\n\tv_mbcnt_hi_u32_b32 %0, -1, %0" : "=v"(l)); return wv * 64 + l; }
__device__ __forceinline__ float bflo(unsigned w) { return __uint_as_float(w << 16); }
__device__ __forceinline__ float bfhi(unsigned w) { return __uint_as_float(w & 0xffff0000u); }
__device__ __forceinline__ float wave_sum(float v) {
#pragma unroll
    for (int o = 32; o; o >>= 1) v += __shfl_xor(v, o);
    return v;
}
__device__ __forceinline__ float sum16(const float* p) { const f32x4 a = *(const f32x4*)p, b = *(const f32x4*)(p + 4), c = *(const f32x4*)(p + 8), d = *(const f32x4*)(p + 12);
    return (((a[0] + a[1]) + (a[2] + a[3])) + ((b[0] + b[1]) + (b[2] + b[3]))) + (((c[0] + c[1]) + (c[2] + c[3])) + ((d[0] + d[1]) + (d[2] + d[3]))); }
__device__ __forceinline__ float xrow16_max(float x) {
    auto s = __builtin_amdgcn_permlane16_swap(__float_as_uint(x), __float_as_uint(x), false, false);
    x = fmaxf(__uint_as_float(s[0]), __uint_as_float(s[1]));
    auto t = __builtin_amdgcn_permlane32_swap(__float_as_uint(x), __float_as_uint(x), false, false);
    return fmaxf(__uint_as_float(t[0]), __uint_as_float(t[1]));
}
__device__ __forceinline__ float xrow16_sum(float x) {
    auto s = __builtin_amdgcn_permlane16_swap(__float_as_uint(x), __float_as_uint(x), false, false);
    x = __uint_as_float(s[0]) + __uint_as_float(s[1]);
    auto t = __builtin_amdgcn_permlane32_swap(__float_as_uint(x), __float_as_uint(x), false, false);
    return __uint_as_float(t[0]) + __uint_as_float(t[1]);
}
__device__ __forceinline__ unsigned off_b(unsigned row, unsigned ch) { return 256u * row + 16u * (ch ^ (((row & 3) << 2) | ((row >> 2) & 3))); }
__device__ __forceinline__ bf16x8 tr_read2(unsigned a0, unsigned a1) {
    u16x4 lo, hi;
    asm volatile("ds_read_b64_tr_b16 %0, %2\n\tds_read_b64_tr_b16 %1, %3\n\ts_waitcnt lgkmcnt(0)" : "=&v"(lo), "=&v"(hi) : "v"(a0), "v"(a1) : "memory");
    bf16x8 r; r[0] = (short)lo[0]; r[1] = (short)lo[1]; r[2] = (short)lo[2]; r[3] = (short)lo[3]; r[4] = (short)hi[0]; r[5] = (short)hi[1]; r[6] = (short)hi[2]; r[7] = (short)hi[3];
    return r;
}
__device__ __forceinline__ void tr_read8(const unsigned (&a)[8], bf16x8 (&r)[4]) {
    u16x4 v0, v1, v2, v3, v4, v5, v6, v7;
    asm volatile("ds_read_b64_tr_b16 %0, %8\n\tds_read_b64_tr_b16 %1, %9\n\tds_read_b64_tr_b16 %2, %10\n\tds_read_b64_tr_b16 %3, %11\n\t"
                 "ds_read_b64_tr_b16 %4, %12\n\tds_read_b64_tr_b16 %5, %13\n\tds_read_b64_tr_b16 %6, %14\n\tds_read_b64_tr_b16 %7, %15\n\ts_waitcnt lgkmcnt(0)"
                 : "=&v"(v0), "=&v"(v1), "=&v"(v2), "=&v"(v3), "=&v"(v4), "=&v"(v5), "=&v"(v6), "=&v"(v7)
                 : "v"(a[0]), "v"(a[1]), "v"(a[2]), "v"(a[3]), "v"(a[4]), "v"(a[5]), "v"(a[6]), "v"(a[7]) : "memory");
    const u16x4 lo[4] = {v0, v2, v4, v6}, hi[4] = {v1, v3, v5, v7};
#pragma unroll
    for (int i = 0; i < 4; ++i) { r[i][0] = (short)lo[i][0]; r[i][1] = (short)lo[i][1]; r[i][2] = (short)lo[i][2]; r[i][3] = (short)lo[i][3]; r[i][4] = (short)hi[i][0]; r[i][5] = (short)hi[i][1]; r[i][6] = (short)hi[i][2]; r[i][7] = (short)hi[i][3]; }
}

namespace pg8 {
constexpr int BM = 256, BK = 64, HALF = 128, HTB = HALF * BK * 2, STAGE_BYTES = 8 * HTB, NXCD = 8, WGM = 8;
__device__ __forceinline__ int lds_byte(int r, int c) { const int st = (r >> 4) * 2 + (c >> 5), rr = r & 15, cc = c & 31, ob = rr * 64 + cc * 2; return st * 1024 + (ob ^ (((ob >> 9) & 1) << 5)); }
__device__ __forceinline__ void stage_rc(int b, int& R, int& C) { const int st = b / 1024, sb = b % 1024, swz = sb ^ (((sb >> 9) & 1) << 5); R = (st >> 1) * 16 + swz / 64; C = (st & 1) * 32 + (swz % 64) / 2; }
__device__ __forceinline__ int perm32(int rho) { const int n = rho >> 4, i = rho & 15; return 8 * (i >> 2) + 4 * n + (i & 3); }
struct Unit { int pm, pn; };
struct Gemm { const bf16_t* A; const bf16_t* Bt; int M, N, K, lda, apn; };
struct StaticOrder {
    int nM, nN, nwg, G, c;
    __device__ void init(int M, int N, int G_, int c_) { nM = M / BM; nN = N / BM; nwg = nM * nN; G = G_; c = c_; }
    __device__ bool next(int i, Unit& u) const {
        const long L = (long)i * G + c; if (L >= nwg) return false;
        int wgid = (int)L; { const int q = nwg / NXCD, r = nwg % NXCD, xcd = wgid % NXCD, off = wgid / NXCD; wgid = (xcd < r ? xcd * (q + 1) : r * (q + 1) + (xcd - r) * q) + off; }
        const int nig = WGM * nN, gid = wgid / nig, fm = gid * WGM, gsz = (nM - fm) < WGM ? (nM - fm) : WGM;
        u.pm = fm + ((wgid % nig) % gsz); u.pn = (wgid % nig) / gsz; return true;
    }
};

__device__ __forceinline__ float gelu_tanh(float x) {
    const float y = 0.7978845608f * (x + 0.044715f * x * x * x);
    const float e = __builtin_amdgcn_exp2f(-2.885390082f * y);
    return x * __builtin_amdgcn_rcpf(1.0f + e);
}
struct EpiAct {
    static constexpr bool PERM = true;
    bf16_t* O; int ldc; const float* ss_in; float* ssv; int ACT;
    __device__ __forceinline__ void operator()(const f32x4 (&acc)[2][2][4][2], const Unit& u, int wr, int wc, int fr, int fq) const {
        const int row0 = u.pm * BM + wr * 64 + fr, col0 = u.pn * BM + wc * 32 + 8 * fq;
        float rsv[2][4];
#pragma unroll
        for (int ai = 0; ai < 2; ++ai)
#pragma unroll
            for (int m = 0; m < 4; ++m) {
                const f32x4 pz = *(const f32x4*)(ss_in + (size_t)(row0 + ai * HALF + m * 16) * 16 + 4 * fq);
                float s = (pz[0] + pz[1]) + (pz[2] + pz[3]); s = xrow16_sum(s);
                rsv[ai][m] = rsqrtf(s * (1.0f / 1024.0f) + 1e-6f);
            }
#pragma unroll
        for (int ai = 0; ai < 2; ++ai)
#pragma unroll
            for (int m = 0; m < 4; ++m) {
                const int row = row0 + ai * HALF + m * 16;
                const float rs = rsv[ai][m];
                bf16_t* rowp = O + (size_t)row * ldc + col0; float sq = 0.f;
#pragma unroll
                for (int bj = 0; bj < 2; ++bj) {
                    f32x4 v0 = acc[ai][bj][m][0] * rs, v1 = acc[ai][bj][m][1] * rs;
                    if (ACT == 1) {
#pragma unroll
                        for (int j = 0; j < 4; ++j) { v0[j] = gelu_tanh(v0[j]); v1[j] = gelu_tanh(v1[j]); sq += v0[j] * v0[j] + v1[j] * v1[j]; }
                    }
                    if (ACT == 2) {
#pragma unroll
                        for (int j = 0; j < 4; ++j) { const float a = fmaxf(v0[j], 0.f), b = fmaxf(v1[j], 0.f); v0[j] = a * a; v1[j] = b * b; }
                    }
                    u32x4 w; w.x = cvt_pk_bf16(v0[0], v0[1]); w.y = cvt_pk_bf16(v0[2], v0[3]); w.z = cvt_pk_bf16(v1[0], v1[1]); w.w = cvt_pk_bf16(v1[2], v1[3]);
                    *(u32x4*)(rowp + bj * HALF) = w;
                }
                if (ACT == 1) {
                    sq = xrow16_sum(sq);
                    if (u.pn >= 4 && fq == 0) ssv[(size_t)row * 16 + (u.pn - 4) * 4 + wc] = sq;
                }
            }
    }
};
struct EpiResid {
    static constexpr bool PERM = false;
    bf16_t* xb; float* ss_out;
    __device__ __forceinline__ void operator()(const f32x4 (&acc)[2][2][4][2], const Unit& u, int wr, int wc, int fr, int fq) const {
        const int row0 = u.pm * BM + wr * 64 + fr, col0 = u.pn * BM + wc * 32 + 4 * fq;
#pragma unroll
        for (int ai = 0; ai < 2; ++ai) {
            u32x2 xo[4][2][2];
#pragma unroll
            for (int m = 0; m < 4; ++m)
#pragma unroll
                for (int bj = 0; bj < 2; ++bj)
#pragma unroll
                    for (int n = 0; n < 2; ++n) xo[m][bj][n] = *(const u32x2*)(xb + (size_t)(row0 + ai * HALF + m * 16) * DM + col0 + bj * HALF + n * 16);
#pragma unroll
            for (int m = 0; m < 4; ++m) {
                const int row = row0 + ai * HALF + m * 16; const size_t off = (size_t)row * DM + col0; float sq = 0.f;
#pragma unroll
                for (int bj = 0; bj < 2; ++bj)
#pragma unroll
                    for (int n = 0; n < 2; ++n) {
                        const u32x2 xw = xo[m][bj][n]; const f32x4 a = acc[ai][bj][m][n];
                        const float v0 = bflo(xw.x) + a[0], v1 = bfhi(xw.x) + a[1], v2 = bflo(xw.y) + a[2], v3 = bfhi(xw.y) + a[3];
                        u32x2 w; w.x = cvt_pk_bf16(v0, v1); w.y = cvt_pk_bf16(v2, v3); *(u32x2*)(xb + off + bj * HALF + n * 16) = w;
                        sq += (v0 * v0 + v1 * v1) + (v2 * v2 + v3 * v3);
                    }
                sq = xrow16_sum(sq);
                if (fq == 0) ss_out[(size_t)row * 16 + u.pn * 4 + wc] = sq;
            }
            asm volatile("" ::: "memory");
        }
    }
};

template <class Epi>
__device__ __forceinline__ void gemm_phase(LAS unsigned char* lds, const Gemm g, const StaticOrder& S, const Epi& E, int wv) {
    const int tid = opaque_tid(wv), wid = __builtin_amdgcn_readfirstlane(tid >> 6), lane = tid & 63, wr = wid >> 2, wc = wid & 3, fr = lane & 15, fq = lane >> 4;
    const int K = g.K, nt = K / BK, lda = g.lda;
    unsigned voffA[2], voffB[2];
#pragma unroll
    for (int i = 0; i < 2; ++i) { int R, C; stage_rc(tid * 16 + i * 8192, R, C); const int Rb = Epi::PERM ? ((R & ~31) + perm32(R & 31)) : R;
        voffA[i] = (unsigned)(R * lda + C) * 2u; voffB[i] = (unsigned)(Rb * K + C) * 2u; }
    const size_t kstep = (size_t)(BK * 2);
    const size_t hstepA = (size_t)HALF * lda * 2, hstepB = (size_t)HALF * K * 2;
    const size_t tstepA = 2 * hstepA, tstepB = 2 * hstepB;
    const unsigned ldsw = (unsigned)wid * 1024u;
    const int aoff = lds_byte(wr * 64 + fr, fq * 8), boff = lds_byte(wc * 32 + fr, fq * 8);
#define PG8_SA(b, h) (((b) * 2 + (h)) * HTB)
#define PG8_SB(b, h) ((4 + (b) * 2 + (h)) * HTB)
#define PG8_STAGE(bufoff, gbase, voff) do { _Pragma("unroll") for (int _i = 0; _i < 2; ++_i) \
        __builtin_amdgcn_global_load_lds((const unsigned*)((const char*)(gbase) + (voff)[_i]), (LAS unsigned*)(lds + (bufoff) + ldsw + _i * 8192), 16, 0, 0); } while (0)
#define PG8_LDA(dst, b, h) do { _Pragma("unroll") for (int m = 0; m < 4; ++m) _Pragma("unroll") for (int k = 0; k < 2; ++k) dst[m][k] = *(const LAS bf16x8*)(lds + PG8_SA(b, h) + aoff + m * 2048 + k * 1024); } while (0)
#define PG8_LDB(dst, b, h) do { _Pragma("unroll") for (int n = 0; n < 2; ++n) _Pragma("unroll") for (int k = 0; k < 2; ++k) dst[n][k] = *(const LAS bf16x8*)(lds + PG8_SB(b, h) + boff + n * 2048 + k * 1024); } while (0)
#define PG8_MMA(ai, bj, At, Bt) do { __builtin_amdgcn_s_setprio(1); _Pragma("unroll") for (int m = 0; m < 4; ++m) _Pragma("unroll") for (int n = 0; n < 2; ++n) _Pragma("unroll") for (int k = 0; k < 2; ++k) \
        acc[ai][bj][m][n] = __builtin_amdgcn_mfma_f32_16x16x32_bf16(Bt[n][k], At[m][k], acc[ai][bj][m][n], 0, 0, 0); __builtin_amdgcn_s_setprio(0); } while (0)
#define PG8_WAIT_V(n) asm volatile("s_waitcnt vmcnt(" #n ")" ::: "memory")
#define PG8_WAIT_L(n) asm volatile("s_waitcnt lgkmcnt(" #n ")" ::: "memory")
#define PG8_BAR __builtin_amdgcn_s_barrier()
#define PG8_SCHED __builtin_amdgcn_sched_barrier(0)
    Unit cur, nxt; int ui = 0;
    if (!S.next(0, cur)) return;
    f32x4 acc[2][2][4][2];
#pragma unroll
    for (int a = 0; a < 2; ++a)
#pragma unroll
        for (int b = 0; b < 2; ++b)
#pragma unroll
            for (int m = 0; m < 4; ++m)
#pragma unroll
                for (int n = 0; n < 2; ++n) acc[a][b][m][n] = (f32x4){0.f, 0.f, 0.f, 0.f};
    bf16x8 At[4][2], B0[2][2], B1[2][2];
    const char* cA = (const char*)g.A + (size_t)cur.pm * tstepA + (size_t)cur.pn * g.apn; const char* cB = (const char*)g.Bt + (size_t)cur.pn * tstepB;
    PG8_STAGE(PG8_SB(0, 0), cB, voffB); PG8_STAGE(PG8_SA(0, 0), cA, voffA); PG8_STAGE(PG8_SB(0, 1), cB + hstepB, voffB); PG8_STAGE(PG8_SA(0, 1), cA + hstepA, voffA);
    if (wr == 1) PG8_BAR;
    PG8_WAIT_V(4); PG8_BAR;
    PG8_STAGE(PG8_SB(1, 0), cB + kstep, voffB); PG8_STAGE(PG8_SA(1, 0), cA + kstep, voffA); PG8_STAGE(PG8_SB(1, 1), cB + hstepB + kstep, voffB);
    PG8_WAIT_V(6); PG8_BAR;
    for (;;) {
        const bool has_next = S.next(ui + 1, nxt);
        const char* nA = has_next ? (const char*)g.A + (size_t)nxt.pm * tstepA + (size_t)nxt.pn * g.apn : cA; const char* nB = has_next ? (const char*)g.Bt + (size_t)nxt.pn * tstepB : cB;
        for (int t = 0; t < nt; t += 2) {
            const bool last = (t == nt - 2);
            const char* a1 = cA + (size_t)(t + 1) * kstep;
            const char* a2 = last ? nA : cA + (size_t)(t + 2) * kstep; const char* b2 = last ? nB : cB + (size_t)(t + 2) * kstep;
            const char* a3 = a2 + kstep; const char* b3 = b2 + kstep;
            PG8_LDB(B0, 0, 0); PG8_SCHED; PG8_LDA(At, 0, 0); PG8_STAGE(PG8_SA(1, 1), a1 + hstepA, voffA);
            PG8_WAIT_L(8); PG8_BAR; PG8_WAIT_L(0); PG8_MMA(0, 0, At, B0); PG8_BAR; PG8_SCHED;
            PG8_LDB(B1, 0, 1); PG8_STAGE(PG8_SB(0, 0), b2, voffB);
            PG8_BAR; PG8_WAIT_L(0); PG8_MMA(0, 1, At, B1); PG8_BAR;
            PG8_LDA(At, 0, 1); PG8_STAGE(PG8_SA(0, 0), a2, voffA);
            PG8_BAR; PG8_WAIT_L(0); PG8_MMA(1, 0, At, B0); PG8_BAR; PG8_SCHED;
            PG8_STAGE(PG8_SB(0, 1), b2 + hstepB, voffB);
            PG8_WAIT_V(6); PG8_BAR; PG8_MMA(1, 1, At, B1); PG8_BAR;
            PG8_LDB(B0, 1, 0); PG8_SCHED; PG8_LDA(At, 1, 0); PG8_STAGE(PG8_SA(0, 1), a2 + hstepA, voffA);
            PG8_WAIT_L(8); PG8_BAR; PG8_WAIT_L(0); PG8_MMA(0, 0, At, B0); PG8_BAR; PG8_SCHED;
            PG8_LDB(B1, 1, 1); PG8_STAGE(PG8_SB(1, 0), b3, voffB);
            PG8_BAR; PG8_WAIT_L(0); PG8_MMA(0, 1, At, B1); PG8_BAR;
            PG8_LDA(At, 1, 1); PG8_STAGE(PG8_SA(1, 0), a3, voffA);
            PG8_BAR; PG8_WAIT_L(0); PG8_MMA(1, 0, At, B0); PG8_BAR; PG8_SCHED;
            PG8_STAGE(PG8_SB(1, 1), b3 + hstepB, voffB);
            PG8_WAIT_V(6); PG8_BAR; PG8_MMA(1, 1, At, B1); PG8_BAR;
        }
        E(acc, cur, wr, wc, fr, fq);
        if (!has_next) break;
#pragma unroll
        for (int a = 0; a < 2; ++a)
#pragma unroll
            for (int b = 0; b < 2; ++b)
#pragma unroll
                for (int m = 0; m < 4; ++m)
#pragma unroll
                    for (int n = 0; n < 2; ++n) acc[a][b][m][n] = (f32x4){0.f, 0.f, 0.f, 0.f};
        cur = nxt; cA = nA; cB = nB; ++ui;
    }
    PG8_WAIT_V(0);
    if (wr == 0) PG8_BAR;
    PG8_BAR;
#undef PG8_SA
#undef PG8_SB
#undef PG8_STAGE
#undef PG8_LDA
#undef PG8_LDB
#undef PG8_MMA
#undef PG8_WAIT_V
#undef PG8_WAIT_L
#undef PG8_BAR
#undef PG8_SCHED
}
}

__device__ void transpose_convert(int gw, int nw, int lane, const float* W, int K, int N, int Npad, bf16_t* Wt, int ldt, const float* rowgain, const float* colgain) {
    const int kb_n = K / 16, units = kb_n * (Npad / 256);
    for (int u = gw; u < units; u += nw) {
        const int k0 = (u % kb_n) * 16, n = (u / kb_n) * 256 + 4 * lane;
        f32x4 v[16];
        if (n < N) {
#pragma unroll
            for (int i = 0; i < 16; ++i) v[i] = *(const f32x4*)(W + (size_t)(k0 + i) * N + n);
            if (rowgain) {
#pragma unroll
                for (int i = 0; i < 16; ++i) v[i] *= rowgain[k0 + i];
            }
            if (colgain) { const f32x4 cgv = *(const f32x4*)(colgain + n);
#pragma unroll
                for (int i = 0; i < 16; ++i) v[i] *= cgv; }
        } else {
#pragma unroll
            for (int i = 0; i < 16; ++i) v[i] = (f32x4){0.f, 0.f, 0.f, 0.f};
        }
#pragma unroll
        for (int j = 0; j < 4; ++j) {
            u32x4 w0, w1; w0.x = cvt_pk_bf16(v[0][j], v[1][j]); w0.y = cvt_pk_bf16(v[2][j], v[3][j]); w0.z = cvt_pk_bf16(v[4][j], v[5][j]); w0.w = cvt_pk_bf16(v[6][j], v[7][j]);
            w1.x = cvt_pk_bf16(v[8][j], v[9][j]); w1.y = cvt_pk_bf16(v[10][j], v[11][j]); w1.z = cvt_pk_bf16(v[12][j], v[13][j]); w1.w = cvt_pk_bf16(v[14][j], v[15][j]);
            u32x4* dst = (u32x4*)(Wt + (size_t)(n + j) * ldt + k0); dst[0] = w0; dst[1] = w1;
        }
    }
}

__device__ void phase_prologue(const Params& p, LAS unsigned char* lds, int wv) {
    unsigned char* ws = p.ws;
    const int tid = opaque_tid(wv), lane = tid & 63, wave = tid >> 6;
    const int gw = blockIdx.x * 8 + wave, nw = gridDim.x * 8;
    const size_t gtid = (size_t)blockIdx.x * 512 + tid, gsz = (size_t)gridDim.x * 512;
    float* ss = (float*)(ws + WS_SS);
    bf16_t* xb = (bf16_t*)(ws + WS_XB);
    for (int row2 = (blockIdx.x * 8 + wave) * 2; row2 < MTOK; row2 += gridDim.x * 16) {
        f32x4 xv[2][4];
#pragma unroll
        for (int k = 0; k < 2; ++k)
#pragma unroll
            for (int i = 0; i < 4; ++i) xv[k][i] = ((const f32x4*)(p.x + (size_t)(row2 + k) * DM))[lane + 64 * i];
#pragma unroll
        for (int k = 0; k < 2; ++k) { const int row = row2 + k; float sq = 0.f;
#pragma unroll
            for (int i = 0; i < 4; ++i) { const f32x4 v = xv[k][i]; sq += (v[0] * v[0] + v[1] * v[1]) + (v[2] * v[2] + v[3] * v[3]);
                u32x2 w; w.x = cvt_pk_bf16(v[0], v[1]); w.y = cvt_pk_bf16(v[2], v[3]); *(u32x2*)(xb + (size_t)row * DM + (lane + 64 * i) * 4) = w; }
            sq = wave_sum(sq);
            if (lane < 16) ss[(size_t)row * 16 + lane] = lane == 0 ? sq : 0.f; }
    }
    transpose_convert(gw, nw, lane, p.a_w_in, 1024, 2048, 2048, (bf16_t*)(ws + W_A_IN), 1024, p.norm_mix_g + 0 * DM, nullptr);
    transpose_convert(gw, nw, lane, p.a_w_out, 1024, 1024, 1024, (bf16_t*)(ws + W_A_OUT), 1024, nullptr, nullptr);
    transpose_convert(gw, nw, lane, p.b_w_in, 1024, 3072, 3072, (bf16_t*)(ws + W_B_IN), 1024, p.norm_mix_g + 1 * DM, nullptr);
    transpose_convert(gw, nw, lane, p.b_w_out, 1024, 1024, 1024, (bf16_t*)(ws + W_B_OUT), 1024, nullptr, nullptr);
    transpose_convert(gw, nw, lane, p.c_w_in, 1024, 1024, 1024, (bf16_t*)(ws + W_C_IN), 1024, p.norm_mix_g + 2 * DM, nullptr);
    for (int g = 0; g < 4; ++g)
        transpose_convert(gw, nw, lane, p.c_w_grp + (size_t)g * 65536, 256, 256, 256, (bf16_t*)(ws + W_C_GRP) + (size_t)g * 65536, 256, nullptr, p.c_scale + g * 256);
    transpose_convert(gw, nw, lane, p.d_w_in, 1024, 2760, DSA_LD, (bf16_t*)(ws + W_D_IN), 1024, p.norm_mix_g + 3 * DM, nullptr);
    for (int l = 0; l < 4; ++l) {
        transpose_convert(gw, nw, lane, p.mlp_w1 + (size_t)l * 4194304, 1024, 4096, 4096, (bf16_t*)(ws + W_1) + (size_t)l * 4194304, 1024, p.norm_mlp_g + l * DM, nullptr);
        transpose_convert(gw, nw, lane, p.mlp_w2 + (size_t)l * 4194304, 4096, 1024, 1024, (bf16_t*)(ws + W_2) + (size_t)l * 4194304, 4096, nullptr, nullptr);
    }
    { bf16_t* wsm = (bf16_t*)(ws + W_A_S);
      for (size_t i = gtid; i < (size_t)8 * 128 * 128; i += gsz) { const int s = (int)(i & 127), t = (int)((i >> 7) & 127); const float v = (s <= t) ? p.a_w_s[i] : 0.f; wsm[i] = (bf16_t)(cvt_pk_bf16(v, 0.f) & 0xffffu); } }
    { bf16_t* wc = (bf16_t*)(ws + W_D_COMB);
      for (int u = gw; u < 256 * 4; u += nw) {
          const int k0 = (u >> 2) * 8, n = (u & 3) * 256 + 4 * lane, h = k0 >> 7;
          const float* uv = p.d_w_uv + (size_t)k0 * 64; const float* wo = p.d_w_out + (size_t)h * 64 * 1024 + n;
          f32x4 a[8];
#pragma unroll
          for (int i = 0; i < 8; ++i) a[i] = (f32x4){0.f, 0.f, 0.f, 0.f};
#pragma unroll 4
          for (int v = 0; v < 64; ++v) { const f32x4 w4 = *(const f32x4*)(wo + (size_t)v * 1024);
#pragma unroll
              for (int i = 0; i < 8; ++i) a[i] += w4 * uv[i * 64 + v]; }
#pragma unroll
          for (int j = 0; j < 4; ++j) {
              u32x4 w; w.x = cvt_pk_bf16(a[0][j], a[1][j]); w.y = cvt_pk_bf16(a[2][j], a[3][j]); w.z = cvt_pk_bf16(a[4][j], a[5][j]); w.w = cvt_pk_bf16(a[6][j], a[7][j]);
              *(u32x4*)(wc + (size_t)(n + j) * 2048 + k0) = w; } } }
}

__device__ void phase_sgu(const Params& p, LAS unsigned char* lds, int wv) {
    unsigned char* ws = p.ws;
    const int tid = opaque_tid(wv), lane = tid & 63, wave = __builtin_amdgcn_readfirstlane(tid >> 6), g4 = lane >> 4, l15 = lane & 15, q = l15 >> 2, pp = lane & 3;
    const bf16_t* z = (const bf16_t*)(ws + WS_BIG); bf16_t* us = (bf16_t*)(ws + WS_BIG + 256 * MiB);
    const float* ssv = (const float*)(ws + WS_SS) + (size_t)9 * MTOK * 16; const bf16_t* wsm = (const bf16_t*)(ws + W_A_S);
    const unsigned ldsbase = (unsigned)(size_t)(unsigned char*)lds;
    for (int unit = blockIdx.x; unit < 4096; unit += gridDim.x) {
        const int g = unit & 7, chunk = unit >> 3; const size_t row0 = (size_t)chunk * 128;
#pragma unroll
        for (int i = 0; i < 4; ++i) {
            const int e = tid + 512 * i, r = e >> 4, ch = e & 15;
            const u32x4 raw = *(const u32x4*)(z + (row0 + r) * 2048 + 1024 + g * 128 + ch * 8);
            const float rs = rsqrtf(sum16(ssv + (row0 + r) * 16) * (1.0f / 1024.0f) + 1e-6f);
            const f32x4 g0 = *(const f32x4*)(p.a_v_g + g * 128 + ch * 8), g1 = *(const f32x4*)(p.a_v_g + g * 128 + ch * 8 + 4);
            u32x4 o;
            o.x = cvt_pk_bf16(bflo(raw.x) * rs * g0[0], bfhi(raw.x) * rs * g0[1]); o.y = cvt_pk_bf16(bflo(raw.y) * rs * g0[2], bfhi(raw.y) * rs * g0[3]);
            o.z = cvt_pk_bf16(bflo(raw.z) * rs * g1[0], bfhi(raw.z) * rs * g1[1]); o.w = cvt_pk_bf16(bflo(raw.w) * rs * g1[2], bfhi(raw.w) * rs * g1[3]);
            *(LAS u32x4*)(lds + (r >> 5) * 8192 + off_b(r & 31, ch)) = o;
        }
        __syncthreads();
        const int t = 16 * wave + l15, nks = (wave >> 1) + 1;
        const float bias = p.a_b_s[g * 128 + t]; const size_t rowg = row0 + t;
        u32x2 uu8[8];
#pragma unroll
        for (int ct = 0; ct < 8; ++ct) uu8[ct] = *(const u32x2*)(z + rowg * 2048 + g * 128 + 16 * ct + 4 * g4);
        f32x4 acc[8];
#pragma unroll
        for (int ct = 0; ct < 8; ++ct) acc[ct] = (f32x4){0.f, 0.f, 0.f, 0.f};
        for (int ks = 0; ks < nks; ++ks) {
            const bf16x8 Bw = *(const bf16x8*)(wsm + ((size_t)g * 128 + t) * 128 + 32 * ks + 8 * g4);
#pragma unroll
            for (int cb = 0; cb < 2; ++cb) {
                unsigned ad[8]; bf16x8 Av[4];
#pragma unroll
                for (int i = 0; i < 4; ++i) { const int ct = 4 * cb + i;
                    ad[2 * i] = ldsbase + ks * 8192 + off_b(8 * g4 + q, 2 * ct + (pp >> 1)) + 8 * (pp & 1); ad[2 * i + 1] = ldsbase + ks * 8192 + off_b(8 * g4 + 4 + q, 2 * ct + (pp >> 1)) + 8 * (pp & 1); }
                tr_read8(ad, Av);
#pragma unroll
                for (int i = 0; i < 4; ++i) acc[4 * cb + i] = __builtin_amdgcn_mfma_f32_16x16x32_bf16(Av[i], Bw, acc[4 * cb + i], 0, 0, 0);
            }
        }
#pragma unroll
        for (int ct = 0; ct < 8; ++ct) {
            const u32x2 uu = uu8[ct];
            u32x2 o; o.x = cvt_pk_bf16(bflo(uu.x) * (acc[ct][0] + bias), bfhi(uu.x) * (acc[ct][1] + bias)); o.y = cvt_pk_bf16(bflo(uu.y) * (acc[ct][2] + bias), bfhi(uu.y) * (acc[ct][3] + bias));
            *(u32x2*)(us + rowg * 1024 + g * 128 + 16 * ct + 4 * g4) = o;
        }
        __syncthreads();
    }
}

__device__ void phase_conv(const Params& p, int wv) {
    unsigned char* ws = p.ws; const bf16_t* bch = (const bf16_t*)(ws + WS_BIG); bf16_t* gated = (bf16_t*)(ws + WS_BIG + 384 * MiB);
    const size_t gtid = (size_t)blockIdx.x * 512 + opaque_tid(wv), gsz = (size_t)gridDim.x * 512;
    for (size_t it = gtid; it < (size_t)4096 * 128; it += gsz) {
        const int ch = (int)(it & 127) * 8, rb = (int)(it >> 7); const int r0 = rb * 16;
        float w0[8], w1[8], w2[8], zm2[8], zm1[8];
#pragma unroll
        for (int j = 0; j < 8; ++j) { w0[j] = p.b_conv_w[ch + j]; w1[j] = p.b_conv_w[1024 + ch + j]; w2[j] = p.b_conv_w[2048 + ch + j]; zm2[j] = 0.f; zm1[j] = 0.f; }
        const int tpos0 = r0 & (SEQ - 1);
        for (int d = 2; d >= 1; --d) {
            if (tpos0 - d >= 0) {
                const bf16_t* rp = bch + (size_t)(r0 - d) * 3072; const u32x4 c = *(const u32x4*)(rp + 1024 + ch), h = *(const u32x4*)(rp + 2048 + ch);
                float zz[8] = {bflo(c.x) * bflo(h.x), bfhi(c.x) * bfhi(h.x), bflo(c.y) * bflo(h.y), bfhi(c.y) * bfhi(h.y), bflo(c.z) * bflo(h.z), bfhi(c.z) * bfhi(h.z), bflo(c.w) * bflo(h.w), bfhi(c.w) * bfhi(h.w)};
#pragma unroll
                for (int j = 0; j < 8; ++j) { if (d == 2) zm2[j] = zz[j]; else zm1[j] = zz[j]; }
            }
        }
        for (int r4 = r0; r4 < r0 + 16; r4 += 4) {
            u32x4 bq[4], cq[4], hq[4];
#pragma unroll
            for (int k = 0; k < 4; ++k) { const bf16_t* rp = bch + (size_t)(r4 + k) * 3072; bq[k] = *(const u32x4*)(rp + ch); cq[k] = *(const u32x4*)(rp + 1024 + ch); hq[k] = *(const u32x4*)(rp + 2048 + ch); }
#pragma unroll
            for (int k = 0; k < 4; ++k) {
                const u32x4 b = bq[k], c = cq[k], h = hq[k];
                float zz[8] = {bflo(c.x) * bflo(h.x), bfhi(c.x) * bfhi(h.x), bflo(c.y) * bflo(h.y), bfhi(c.y) * bfhi(h.y), bflo(c.z) * bflo(h.z), bfhi(c.z) * bfhi(h.z), bflo(c.w) * bflo(h.w), bfhi(c.w) * bfhi(h.w)};
                float bb[8] = {bflo(b.x), bfhi(b.x), bflo(b.y), bfhi(b.y), bflo(b.z), bfhi(b.z), bflo(b.w), bfhi(b.w)};
                float o[8];
#pragma unroll
                for (int j = 0; j < 8; ++j) { o[j] = bb[j] * (w0[j] * zm2[j] + w1[j] * zm1[j] + w2[j] * zz[j]); zm2[j] = zm1[j]; zm1[j] = zz[j]; }
                u32x4 w; w.x = cvt_pk_bf16(o[0], o[1]); w.y = cvt_pk_bf16(o[2], o[3]); w.z = cvt_pk_bf16(o[4], o[5]); w.w = cvt_pk_bf16(o[6], o[7]);
                *(u32x4*)(gated + (size_t)(r4 + k) * 1024 + ch) = w;
            }
        }
    }
}

__device__ __forceinline__ void ld8(const bf16_t* ptr, float (&f)[8]) {
    const u32x4 v = *(const u32x4*)ptr; f[0] = bflo(v.x); f[1] = bfhi(v.x); f[2] = bflo(v.y); f[3] = bfhi(v.y); f[4] = bflo(v.z); f[5] = bfhi(v.z); f[6] = bflo(v.w); f[7] = bfhi(v.w);
}
__device__ void phase_pool(const Params& p, int wv) {
    unsigned char* ws = p.ws; const bf16_t* z = (const bf16_t*)(ws + WS_BIG); bf16_t* pooled = (bf16_t*)(ws + WS_BIG + 128 * MiB);
    const size_t gtid = (size_t)blockIdx.x * 512 + opaque_tid(wv), gsz = (size_t)gridDim.x * 512;
    for (size_t it = gtid; it < (size_t)2048 * 128; it += gsz) {
        const int lane = (int)(it & 63), wv = (int)(it >> 6), chunk = (wv & 3) * 32 + (lane & 31), rb = (wv >> 2) * 2 + (lane >> 5);
        const int ch = chunk * 8, w = 2 << (ch >> 8), r0 = rb * 32;
        float S[8];
#pragma unroll
        for (int j = 0; j < 8; ++j) S[j] = 0.f;
        const int tpos0 = r0 & (SEQ - 1);
        for (int d = 1; d <= w; ++d) {
            if (tpos0 - d >= 0) { float f[8]; ld8(z + (size_t)(r0 - d) * 1024 + ch, f);
#pragma unroll
                for (int j = 0; j < 8; ++j) S[j] += f[j]; }
        }
        for (int r4 = r0; r4 < r0 + 32; r4 += 4) {
            u32x4 fa[4], oa[4];
#pragma unroll
            for (int k = 0; k < 4; ++k) { const int r = r4 + k; fa[k] = *(const u32x4*)(z + (size_t)r * 1024 + ch);
                const int rr = ((r & (SEQ - 1)) - w >= 0) ? r - w : r; oa[k] = *(const u32x4*)(z + (size_t)rr * 1024 + ch); }
#pragma unroll
            for (int k = 0; k < 4; ++k) {
                const int r = r4 + k, tpos = r & (SEQ - 1);
                float f[8] = {bflo(fa[k].x), bfhi(fa[k].x), bflo(fa[k].y), bfhi(fa[k].y), bflo(fa[k].z), bfhi(fa[k].z), bflo(fa[k].w), bfhi(fa[k].w)};
#pragma unroll
                for (int j = 0; j < 8; ++j) S[j] += f[j];
                if (tpos - w >= 0) { float o[8] = {bflo(oa[k].x), bfhi(oa[k].x), bflo(oa[k].y), bfhi(oa[k].y), bflo(oa[k].z), bfhi(oa[k].z), bflo(oa[k].w), bfhi(oa[k].w)};
#pragma unroll
                    for (int j = 0; j < 8; ++j) S[j] -= o[j]; }
                const int cnt = (tpos + 1 < w) ? tpos + 1 : w; const float inv = 1.0f / (float)cnt;
                u32x4 o; o.x = cvt_pk_bf16(S[0] * inv - f[0], S[1] * inv - f[1]); o.y = cvt_pk_bf16(S[2] * inv - f[2], S[3] * inv - f[3]);
                o.z = cvt_pk_bf16(S[4] * inv - f[4], S[5] * inv - f[5]); o.w = cvt_pk_bf16(S[6] * inv - f[6], S[7] * inv - f[7]);
                *(u32x4*)(pooled + (size_t)r * 1024 + ch) = o;
            }
        }
    }
}

__device__ __forceinline__ int cnt_ge8(const unsigned* v, unsigned cand) {
    unsigned long long m0, m1, m2, m3, m4, m5, m6, m7;
    asm("v_cmp_le_u32_e64 %0, %8, %9\n\tv_cmp_le_u32_e64 %1, %8, %10\n\tv_cmp_le_u32_e64 %2, %8, %11\n\tv_cmp_le_u32_e64 %3, %8, %12\n\t"
        "v_cmp_le_u32_e64 %4, %8, %13\n\tv_cmp_le_u32_e64 %5, %8, %14\n\tv_cmp_le_u32_e64 %6, %8, %15\n\tv_cmp_le_u32_e64 %7, %8, %16"
        : "=&s"(m0), "=&s"(m1), "=&s"(m2), "=&s"(m3), "=&s"(m4), "=&s"(m5), "=&s"(m6), "=&s"(m7)
        : "s"(cand), "v"(v[0]), "v"(v[1]), "v"(v[2]), "v"(v[3]), "v"(v[4]), "v"(v[5]), "v"(v[6]), "v"(v[7]));
    return (__builtin_popcountll(m0) + __builtin_popcountll(m1)) + (__builtin_popcountll(m2) + __builtin_popcountll(m3)) +
           (__builtin_popcountll(m4) + __builtin_popcountll(m5)) + (__builtin_popcountll(m6) + __builtin_popcountll(m7));
}
__device__ void phase_topk(const Params& p, LAS unsigned char* lds, int wv) {
    unsigned char* ws = p.ws;
    const int tid = opaque_tid(wv), lane = tid & 63, wave = __builtin_amdgcn_readfirstlane(tid >> 6), g4 = lane >> 4, l15 = lane & 15;
    const bf16_t* din = (const bf16_t*)(ws + WS_BIG); bf16_t* cn = (bf16_t*)(ws + WS_CN); unsigned short* idx = (unsigned short*)(ws + WS_IDX);
    LAS unsigned short* S16 = (LAS unsigned short*)lds;
    constexpr int SROW = 4112;
    { const float kg0 = p.d_kv_g[2 * lane], kg1 = p.d_kv_g[2 * lane + 1];
      for (int row4 = (blockIdx.x * 8 + wave) * 4; row4 < MTOK; row4 += gridDim.x * 32) {
        unsigned raw[4];
#pragma unroll
        for (int j = 0; j < 4; ++j) raw[j] = *(const unsigned*)(din + (size_t)(row4 + j) * DSA_LD + 2048 + 2 * lane);
#pragma unroll
        for (int j = 0; j < 4; ++j) { const float a = bflo(raw[j]), b = bfhi(raw[j]);
            const float sq = wave_sum(a * a + b * b); const float rs = rsqrtf(sq * (1.0f / 128.0f) + 1e-6f);
            *(unsigned*)(cn + (size_t)(row4 + j) * 128 + 2 * lane) = cvt_pk_bf16(a * rs * kg0, b * rs * kg1); }
      } }
    for (int unit = blockIdx.x; unit < 4096; unit += gridDim.x) {
        const int pi = (unit / (2 * (int)gridDim.x)) * (int)gridDim.x + (unit % (int)gridDim.x), hi = (unit / (int)gridDim.x) & 1;
        const int b = pi >> 7, cc = pi & 127, qt = hi ? 255 - cc : cc, qpos0 = qt * 16; const size_t rowq0 = (size_t)b * SEQ + qpos0;
        bf16x8 Aq[8][2]; float wv[8][4];
#pragma unroll
        for (int pr = 0; pr < 8; ++pr) {
            const int qg = pr >> 1, hh = pr & 1;
            const bf16_t* base = din + (rowq0 + 4 * qg + (l15 >> 2)) * DSA_LD + 2176 + (4 * hh + (l15 & 3)) * 64;
            Aq[pr][0] = *(const bf16x8*)(base + 8 * g4); Aq[pr][1] = *(const bf16x8*)(base + 32 + 8 * g4);
            const u32x2 wr = *(const u32x2*)(din + (rowq0 + 4 * qg + g4) * DSA_LD + 2752 + 4 * hh);
            wv[pr][0] = bflo(wr.x) * 0.04419417382f; wv[pr][1] = bfhi(wr.x) * 0.04419417382f; wv[pr][2] = bflo(wr.y) * 0.04419417382f; wv[pr][3] = bfhi(wr.y) * 0.04419417382f;
        }
        const int nkt = (qpos0 + 15) / 16 + 1;
        {
        bf16x8 B0[4], B1[4], N0[4], N1[4];
#pragma unroll
        for (int j = 0; j < 4; ++j) { const int kt = (wave + 8 * j < nkt) ? wave + 8 * j : 0;
            const bf16_t* kb = din + ((size_t)b * SEQ + 16 * kt + l15) * DSA_LD + 2688;
            B0[j] = *(const bf16x8*)(kb + 8 * g4); B1[j] = *(const bf16x8*)(kb + 32 + 8 * g4); }
        for (int kt0 = wave; kt0 < nkt; kt0 += 32) {
#pragma unroll
            for (int j = 0; j < 4; ++j) { const int kt = (kt0 + 32 + 8 * j < nkt) ? kt0 + 32 + 8 * j : 0;
                const bf16_t* kb = din + ((size_t)b * SEQ + 16 * kt + l15) * DSA_LD + 2688;
                N0[j] = *(const bf16x8*)(kb + 8 * g4); N1[j] = *(const bf16x8*)(kb + 32 + 8 * g4); }
#pragma unroll
            for (int j = 0; j < 4; ++j) {
                const int kt = kt0 + 8 * j;
                if (kt < nkt) {
#pragma unroll
                    for (int qg = 0; qg < 4; ++qg) {
                        float part = 0.f;
#pragma unroll
                        for (int hh = 0; hh < 2; ++hh) {
                            const int pr = 2 * qg + hh;
                            f32x4 c = (f32x4){0.f, 0.f, 0.f, 0.f};
                            c = __builtin_amdgcn_mfma_f32_16x16x32_bf16(Aq[pr][0], B0[j], c, 0, 0, 0);
                            c = __builtin_amdgcn_mfma_f32_16x16x32_bf16(Aq[pr][1], B1[j], c, 0, 0, 0);
                            part += (fmaxf(c[0], 0.f) * wv[pr][0] + fmaxf(c[1], 0.f) * wv[pr][1]) + (fmaxf(c[2], 0.f) * wv[pr][2] + fmaxf(c[3], 0.f) * wv[pr][3]);
                        }
                        const _Float16 hsc = (_Float16)(part + 0.0f);
                        S16[(4 * qg + g4) * SROW + 16 * kt + l15] = __builtin_bit_cast(unsigned short, hsc);
                    }
                }
            }
#pragma unroll
            for (int j = 0; j < 4; ++j) { B0[j] = N0[j]; B1[j] = N1[j]; }
        }
        }
        __syncthreads();
        for (int qi2 = 0; qi2 < 2; ++qi2) {
            const int ql = wave + 8 * qi2;
            const int qpos = qpos0 + ql, n = qpos + 1; unsigned short* out = idx + (rowq0 + ql) * 256;
            if (n <= 256) {
#pragma unroll
                for (int i = 0; i < 4; ++i) { const int j = lane + 64 * i; out[j] = (unsigned short)(j < n ? j : 0xFFFF); }
            } else {
                unsigned u[64];
                const int ni = (n + 63) >> 6;
#pragma unroll
                for (int blk = 0; blk < 8; ++blk) {
                    if (blk * 8 < ni) {
#pragma unroll
                        for (int i = blk * 8; i < blk * 8 + 8; ++i) { const int key = lane + 64 * i; unsigned bits = S16[ql * SROW + key]; bits ^= (bits & 0x8000u) ? 0xFFFFu : 0x8000u; u[i] = key < n ? bits : 0u; }
                    } else {
#pragma unroll
                        for (int i = blk * 8; i < blk * 8 + 8; ++i) u[i] = 0u;
                    }
                }
                unsigned T = 0u;
                for (int bit = 15; bit >= 0; --bit) {
                    const unsigned cand = __builtin_amdgcn_readfirstlane(T | (1u << bit)); int cnt = 0;
#pragma unroll
                    for (int blk = 0; blk < 8; ++blk) {
                        if (blk * 8 < ni) cnt += cnt_ge8(&u[blk * 8], cand);
                    }
                    if (cnt >= 256) T = cand;
                }
                int G = 0;
#pragma unroll
                for (int i = 0; i < 64; ++i) G += __popcll(__ballot(u[i] > T));
                const int need = 256 - G; int base = 0, tie_seen = 0;
                const unsigned long long ltmask = (1ull << lane) - 1ull;
#pragma unroll
                for (int blk = 0; blk < 8; ++blk) {
                    if (blk * 8 < ni) {
#pragma unroll
                        for (int i = blk * 8; i < blk * 8 + 8; ++i) {
                            const bool gt = u[i] > T, eq = u[i] == T;
                            const unsigned long long meq = __ballot(eq);
                            const bool sel = gt || (eq && (tie_seen + __popcll(meq & ltmask)) < need);
                            const unsigned long long msel = __ballot(sel);
                            if (sel) out[base + __popcll(msel & ltmask)] = (unsigned short)(lane + 64 * i);
                            base += __popcll(msel); tie_seen += __popcll(meq);
                        }
                    }
                }
            }
        }
        __syncthreads();
    }
}

__device__ void phase_attn(const Params& p, LAS unsigned char* lds, bool dry, int wv) {
    unsigned char* ws = p.ws;
    const int tid = opaque_tid(wv), lane = tid & 63, wave = __builtin_amdgcn_readfirstlane(tid >> 6), g4 = lane >> 4, l15 = lane & 15, q = l15 >> 2, pp = lane & 3;
    bf16_t* din = (bf16_t*)(ws + WS_BIG); const bf16_t* cn = (const bf16_t*)(ws + WS_CN); const unsigned short* idx = (const unsigned short*)(ws + WS_IDX);
    LAS unsigned char* wl = lds + wave * 8192; const unsigned wbase = (unsigned)(size_t)(unsigned char*)lds + wave * 8192;
    const float scale = 0.08838834764f;
    for (int Q = blockIdx.x * 8 + wave; Q < MTOK; Q += gridDim.x * 8) {
        const int b = Q >> 12, qpos = Q & (SEQ - 1); const int nvalid = qpos + 1 < 256 ? qpos + 1 : 256;
        bf16_t* qrow = din + (size_t)Q * DSA_LD;
        bf16x8 Bq[4];
#pragma unroll
        for (int s = 0; s < 4; ++s) Bq[s] = *(const bf16x8*)(qrow + l15 * 128 + 32 * s + 8 * g4);
        f32x4 O[8];
#pragma unroll
        for (int mt = 0; mt < 8; ++mt) O[mt] = (f32x4){0.f, 0.f, 0.f, 0.f};
        float mrun = -1e30f, lrun = 0.f;
        unsigned kid[16];
#pragma unroll
        for (int i = 0; i < 16; ++i) { const int slot = i * 16 + l15; const unsigned v = idx[(size_t)Q * 256 + slot]; kid[i] = slot < nvalid ? v : 0u; }
        bf16x8 A[2][4], An[2][4];
#pragma unroll
        for (int tl = 0; tl < 2; ++tl) { const bf16_t* crow = cn + ((size_t)b * SEQ + kid[tl]) * 128;
#pragma unroll
            for (int s = 0; s < 4; ++s) A[tl][s] = *(const bf16x8*)(crow + 32 * s + 8 * g4); }
#pragma unroll
        for (int ck = 0; ck < 8; ++ck) {
            if (ck * 32 < nvalid) {
                if (ck < 7) {
#pragma unroll
                    for (int tl = 0; tl < 2; ++tl) { const bf16_t* crow = cn + ((size_t)b * SEQ + kid[(ck < 7 ? ck + 1 : ck) * 2 + tl]) * 128;
#pragma unroll
                        for (int s = 0; s < 4; ++s) An[tl][s] = *(const bf16x8*)(crow + 32 * s + 8 * g4); }
                }
                f32x4 S0 = (f32x4){0.f, 0.f, 0.f, 0.f}, S1 = (f32x4){0.f, 0.f, 0.f, 0.f};
#pragma unroll
                for (int s = 0; s < 4; ++s) { S0 = __builtin_amdgcn_mfma_f32_16x16x32_bf16(A[0][s], Bq[s], S0, 0, 0, 0); S1 = __builtin_amdgcn_mfma_f32_16x16x32_bf16(A[1][s], Bq[s], S1, 0, 0, 0); }
#pragma unroll
                for (int tl = 0; tl < 2; ++tl)
#pragma unroll
                    for (int s = 0; s < 4; ++s) *(LAS bf16x8*)(wl + off_b(16 * tl + l15, 4 * s + g4)) = A[tl][s];
                float sv[8];
#pragma unroll
                for (int j = 0; j < 4; ++j) { const int s0 = ck * 32 + 4 * g4 + j; sv[j] = s0 < nvalid ? S0[j] * scale : -1e30f; sv[4 + j] = (s0 + 16) < nvalid ? S1[j] * scale : -1e30f; }
                float cm = fmaxf(fmaxf(fmaxf(sv[0], sv[1]), fmaxf(sv[2], sv[3])), fmaxf(fmaxf(sv[4], sv[5]), fmaxf(sv[6], sv[7])));
                cm = xrow16_max(cm);
                const float mn = fmaxf(mrun, cm), alpha = __expf(mrun - mn);
                float pv[8], ps = 0.f;
#pragma unroll
                for (int j = 0; j < 8; ++j) { pv[j] = __expf(sv[j] - mn); ps += pv[j]; }
                lrun = lrun * alpha + ps; mrun = mn;
#pragma unroll
                for (int mt = 0; mt < 8; ++mt) O[mt] *= alpha;
                union { u32x4 u; bf16x8 h; } Pb;
                Pb.u.x = cvt_pk_bf16(pv[0], pv[1]); Pb.u.y = cvt_pk_bf16(pv[2], pv[3]); Pb.u.z = cvt_pk_bf16(pv[4], pv[5]); Pb.u.w = cvt_pk_bf16(pv[6], pv[7]);
                asm volatile("s_waitcnt lgkmcnt(0)" ::: "memory");
#pragma unroll
                for (int mb = 0; mb < 2; ++mb) {
                    unsigned ad[8]; bf16x8 Av[4];
#pragma unroll
                    for (int i = 0; i < 4; ++i) { const int mt = 4 * mb + i;
                        ad[2 * i] = wbase + off_b(4 * g4 + q, 2 * mt + (pp >> 1)) + 8 * (pp & 1); ad[2 * i + 1] = wbase + off_b(16 + 4 * g4 + q, 2 * mt + (pp >> 1)) + 8 * (pp & 1); }
                    tr_read8(ad, Av);
#pragma unroll
                    for (int i = 0; i < 4; ++i) O[4 * mb + i] = __builtin_amdgcn_mfma_f32_16x16x32_bf16(Av[i], Pb.h, O[4 * mb + i], 0, 0, 0);
                }
                if (ck < 7) {
#pragma unroll
                    for (int tl = 0; tl < 2; ++tl)
#pragma unroll
                        for (int s = 0; s < 4; ++s) A[tl][s] = An[tl][s];
                }
            }
        }
        lrun = xrow16_sum(lrun);
        const float inv = 1.0f / lrun;
#pragma unroll
        for (int mt = 0; mt < 8; ++mt) {
            u32x2 o; o.x = cvt_pk_bf16(O[mt][0] * inv, O[mt][1] * inv); o.y = cvt_pk_bf16(O[mt][2] * inv, O[mt][3] * inv);
            if (!dry) *(u32x2*)(qrow + l15 * 128 + 16 * mt + 4 * g4) = o;
        }
    }
}

__device__ void phase_final(const Params& p, int wv) {
    const int tid = opaque_tid(wv); const int lane = tid & 63, wave = tid >> 6;
    const float* ss = (const float*)(p.ws + WS_SS) + (size_t)8 * MTOK * 16; const bf16_t* xb = (const bf16_t*)(p.ws + WS_XB);
    for (int row = blockIdx.x * 8 + wave; row < MTOK; row += gridDim.x * 8) {
        const float rs = rsqrtf(sum16(ss + (size_t)row * 16) * (1.0f / 1024.0f) + 1e-6f);
        f32x4* orow = (f32x4*)(p.out + (size_t)row * DM);
#pragma unroll
        for (int i = 0; i < 4; ++i) { const f32x4 g = *(const f32x4*)(p.final_g + (lane + 64 * i) * 4); const u32x2 xw = *(const u32x2*)(xb + (size_t)row * DM + (lane + 64 * i) * 4);
            f32x4 v = (f32x4){bflo(xw.x), bfhi(xw.x), bflo(xw.y), bfhi(xw.y)}; v = v * rs * g; orow[lane + 64 * i] = v; }
    }
}

#define XB_TMO      128
#define XB_XCNT(j)  (256  + 64 * (j))
#define XB_XSUB(j)  (1280 + 64 * (j))
#define XB_XGEN(j)  (2304 + 64 * (j))
#define XB_TOP      3328
#define XB_TOPGEN   3392
#define XCD_BAR_WORDS 3456
#define XB_SPIN_CAP (1u << 20)
__device__ __forceinline__ unsigned xb_ld(unsigned* p)              { return __hip_atomic_load(p, __ATOMIC_RELAXED, __HIP_MEMORY_SCOPE_AGENT); }
__device__ __forceinline__ unsigned xb_add(unsigned* p, unsigned v) { return __hip_atomic_fetch_add(p, v, __ATOMIC_RELAXED, __HIP_MEMORY_SCOPE_AGENT); }
__device__ __forceinline__ unsigned xb_xcc_id() { return (unsigned)__builtin_amdgcn_s_getreg((3 << 11) | 20) & 0xFu; }
#define XB_SPIN(cond, bar) do { unsigned _sp = 0; while (cond) { __builtin_amdgcn_s_sleep(1); \
    if ((++_sp & 255u) == 0u) { if (xb_ld(&(bar)[XB_TMO])) break; if (_sp > XB_SPIN_CAP) { atomicAdd(&(bar)[XB_TMO], 1u); break; } } } } while (0)
struct XcdBarrier { unsigned* bar; unsigned x; volatile LAS unsigned* st; };
__device__ __forceinline__ XcdBarrier xcd_barrier_post(unsigned* bar, volatile LAS unsigned* st, bool is_t0) {
    XcdBarrier b; b.bar = bar; b.x = xb_xcc_id(); b.st = st;
    if (is_t0) (void)xb_add(&bar[XB_XCNT(b.x)], 1u);
    return b;
}
__device__ __forceinline__ void xcd_barrier_complete(unsigned* bar, unsigned x, unsigned& nloc, unsigned& nx) {
    const unsigned G = gridDim.x * gridDim.y * gridDim.z;
    unsigned sum, cnt, mine, sp = 0u;
    for (;;) {
        sum = 0u; cnt = 0u; mine = 0u;
#pragma unroll
        for (unsigned j = 0; j < 16; ++j) { const unsigned c = xb_ld(&bar[XB_XCNT(j)]); sum += c; cnt += (c > 0u) ? 1u : 0u; mine = (j == x) ? c : mine; }
        if (sum == G) break;
        __builtin_amdgcn_s_sleep(1);
        if ((++sp & 255u) == 0u) { if (xb_ld(&bar[XB_TMO])) break; if (sp > XB_SPIN_CAP) { atomicAdd(&bar[XB_TMO], 1u); break; } }
    }
    nloc = mine > 0u ? mine : 1u; nx = cnt > 0u ? cnt : 1u;
}
__device__ __forceinline__ void xcd_barrier(const XcdBarrier& b, bool is_t0) {
    asm volatile("s_waitcnt vmcnt(0)" ::: "memory");
    __syncthreads();
    if (is_t0) {
        unsigned* bar = b.bar;
        __builtin_amdgcn_s_waitcnt(0);
        unsigned nloc = b.st[0], nx = b.st[1];
        if (nloc == 0u) { xcd_barrier_complete(bar, b.x, nloc, nx); b.st[0] = nloc; b.st[1] = nx; }
        const unsigned old = xb_add(&bar[XB_XSUB(b.x)], 1u);
        const unsigned gen = old / nloc;
        if (old + 1u == (gen + 1u) * nloc) {
            __builtin_amdgcn_fence(__ATOMIC_RELEASE, "agent");
            asm volatile("s_waitcnt vmcnt(0)" ::: "memory");
            const unsigned og = xb_add(&bar[XB_TOP], 1u);
            const unsigned tg = og / nx;
            if (og + 1u == (tg + 1u) * nx) xb_add(&bar[XB_TOPGEN], 1u);
            else XB_SPIN(xb_ld(&bar[XB_TOPGEN]) == tg, bar);
            __builtin_amdgcn_fence(__ATOMIC_ACQUIRE, "agent");
            xb_add(&bar[XB_XGEN(b.x)], 1u);
            asm volatile("s_waitcnt vmcnt(0)" ::: "memory");
        } else {
            XB_SPIN(xb_ld(&bar[XB_XGEN(b.x)]) == gen, bar);
            __builtin_amdgcn_fence(__ATOMIC_ACQUIRE, "agent");
            asm volatile("s_waitcnt vmcnt(0)" ::: "memory");
        }
    }
    __syncthreads();
}

enum { K_PRO = 0, K_GACT, K_GRES, K_SGU, K_CONV, K_POOL, K_TOPK, K_ATTN, K_FINAL };
struct PhaseDesc { int kind, act, lda, apn, N, K, ldc, ss_idx, m0, M; size_t a_off, w_off; };
__device__ __forceinline__ PhaseDesc mk_act(int act, size_t w_off, int N, int ss_idx) { PhaseDesc d{}; d.kind = K_GACT; d.act = act; d.lda = 1024; d.apn = 0; d.N = N; d.K = 1024; d.ldc = N; d.ss_idx = ss_idx; d.m0 = 0; d.M = MTOK; d.a_off = WS_XB; d.w_off = w_off; return d; }
__device__ __forceinline__ PhaseDesc mk_res(size_t a_off, int lda, int apn, size_t w_off, int K, int ss_idx) { PhaseDesc d{}; d.kind = K_GRES; d.lda = lda; d.apn = apn; d.N = 1024; d.K = K; d.ss_idx = ss_idx; d.m0 = 0; d.M = MTOK; d.a_off = a_off; d.w_off = w_off; return d; }
__device__ __forceinline__ PhaseDesc mk_kind(int kind) { PhaseDesc d{}; d.kind = kind; return d; }
constexpr int MLP_Q = 4, MQ = MTOK / MLP_Q;
__device__ __forceinline__ PhaseDesc mk_mlp(int l, int j) {
    const int q = j >> 1;
    if ((j & 1) == 0) { PhaseDesc d = mk_act(2, W_1 + (size_t)l * 8 * MiB, 4096, 2 * l + 1); d.m0 = q * MQ; d.M = MQ; d.a_off = WS_XB + (size_t)q * MQ * 1024 * 2; return d; }
    PhaseDesc d = mk_res(WS_BIG, 4096, 0, W_2 + (size_t)l * 8 * MiB, 4096, 2 * l + 2); d.m0 = q * MQ; d.M = MQ; return d;
}
__device__ __forceinline__ PhaseDesc phase_desc(int ph) {
    if (ph >= 4 && ph < 12) return mk_mlp(0, ph - 4);
    if (ph >= 15 && ph < 23) return mk_mlp(1, ph - 15);
    if (ph >= 26 && ph < 34) return mk_mlp(2, ph - 26);
    if (ph >= 38 && ph < 46) return mk_mlp(3, ph - 38);
    switch (ph) {
    case 0: return mk_kind(K_PRO);
    case 1: return mk_act(1, W_A_IN, 2048, 0);
    case 2: return mk_kind(K_SGU);
    case 3: return mk_res(WS_BIG + 256 * MiB, 1024, 0, W_A_OUT, 1024, 1);
    case 12: return mk_act(0, W_B_IN, 3072, 2);
    case 13: return mk_kind(K_CONV);
    case 14: return mk_res(WS_BIG + 384 * MiB, 1024, 0, W_B_OUT, 1024, 3);
    case 23: return mk_act(0, W_C_IN, 1024, 4);
    case 24: return mk_kind(K_POOL);
    case 25: return mk_res(WS_BIG + 128 * MiB, 1024, 512, W_C_GRP, 256, 5);
    case 34: return mk_act(0, W_D_IN, DSA_LD, 6);
    case 35: return mk_kind(K_TOPK);
    case 36: return mk_kind(K_ATTN);
    case 37: return mk_res(WS_BIG, DSA_LD, 0, W_D_COMB, 2048, 7);
    default: return mk_kind(K_FINAL);
    }
}

__device__ __forceinline__ void run_phase(int ph, const Params& p, LAS unsigned char* lds, bool dry, int wv) {
    const PhaseDesc d = phase_desc(ph);
    unsigned char* ws = p.ws; float* ss = (float*)(ws + WS_SS);
    if (d.kind == K_GACT || d.kind == K_GRES) {
        pg8::Gemm g; g.A = (const bf16_t*)(ws + d.a_off); g.Bt = (const bf16_t*)(ws + d.w_off); g.M = d.M; g.N = d.N; g.K = d.K; g.lda = d.lda; g.apn = d.apn;
        pg8::StaticOrder S; S.init(d.M, d.N, gridDim.x, blockIdx.x);
        if (d.kind == K_GACT) { pg8::EpiAct E; E.O = (bf16_t*)(ws + WS_BIG); E.ldc = d.ldc; E.ss_in = ss + ((size_t)d.ss_idx * MTOK + d.m0) * 16; E.ssv = ss + (size_t)9 * MTOK * 16; E.ACT = d.act; pg8::gemm_phase(lds, g, S, E, wv); }
        else { pg8::EpiResid E; E.xb = (bf16_t*)(ws + WS_XB) + (size_t)d.m0 * DM; E.ss_out = ss + ((size_t)d.ss_idx * MTOK + d.m0) * 16; pg8::gemm_phase(lds, g, S, E, wv); }
    }
    else if (d.kind == K_PRO) phase_prologue(p, lds, wv);
    else if (d.kind == K_SGU) phase_sgu(p, lds, wv);
    else if (d.kind == K_CONV) phase_conv(p, wv);
    else if (d.kind == K_POOL) phase_pool(p, wv);
    else if (d.kind == K_TOPK) phase_topk(p, lds, wv);
    else if (d.kind == K_ATTN) phase_attn(p, lds, dry, wv);
    else phase_final(p, wv);
}

__global__ void __launch_bounds__(512, 2) fwd_megakernel(Params p) {
    extern __shared__ __attribute__((aligned(16))) unsigned char lds_raw[];
    LAS unsigned char* lds = (LAS unsigned char*)lds_raw;
    const int wv = __builtin_amdgcn_readfirstlane((int)threadIdx.x >> 6);
    volatile LAS unsigned* bst = (volatile LAS unsigned*)(lds + 131584);
    XcdBarrier xbar; xbar.bar = (unsigned*)(p.ws + WS_BAR); xbar.x = 0; xbar.st = bst;
    if (p.ph_hi - p.ph_lo > 1) {
        if (threadIdx.x == 0) { bst[0] = 0u; bst[1] = 0u; }
        __syncthreads();
        xbar = xcd_barrier_post((unsigned*)(p.ws + WS_BAR), bst, threadIdx.x == 0);
    }
    for (int ph = p.ph_lo; ph < p.ph_hi; ++ph) {
#if PROBE_DUP
        const int reps = ((PROBE_DUP >> ph) & 1) ? 2 : 1;
        for (int r = 0; r < reps; ++r) { run_phase(ph, p, lds, r + 1 < reps, wv); if (r + 1 < reps) cg::this_grid().sync(); }
#else
        run_phase(ph, p, lds, false, wv);
#endif
        if (ph + 1 < p.ph_hi) { if (ph == p.ph_lo) cg::this_grid().sync(); else xcd_barrier(xbar, opaque_tid(wv) == 0); }
    }
}

#ifndef MK_MULTI
#define MK_MULTI 0
#endif

extern "C" void kernel_launch(void* const* d_in, const int* in_sizes, int n_in, void* d_out, int out_size, void* d_ws, size_t ws_size, hipStream_t stream) {
    static int grid = 0;
    if (grid == 0) {
        int dev = 0, cus = 0, per_cu = 0;
        hipGetDevice(&dev);
        hipDeviceGetAttribute(&cus, hipDeviceAttributeMultiprocessorCount, dev);
        if (hipFuncSetAttribute((const void*)fwd_megakernel, hipFuncAttributeMaxDynamicSharedMemorySize, LDS_BYTES) != hipSuccess) { fprintf(stderr, "hipFuncSetAttribute failed\n"); grid = -1; return; }
        if (hipOccupancyMaxActiveBlocksPerMultiprocessor(&per_cu, (const void*)fwd_megakernel, 512, LDS_BYTES) != hipSuccess || per_cu < 1) { fprintf(stderr, "occupancy query: %d\n", per_cu); per_cu = 1; }
        (void)hipGetLastError();
        grid = cus * (per_cu > 1 ? 1 : per_cu);
        if (ws_size < 840 * MiB) { fprintf(stderr, "workspace too small\n"); grid = -1; return; }
    }
    if (grid < 0) return;
    Params p{};
    const float** pp = (const float**)&p;
    for (int i = 0; i < 21; ++i) pp[i] = (const float*)d_in[i];
    p.out = (float*)d_out; p.ws = (unsigned char*)d_ws;
#if MK_MULTI
    for (int ph = 0; ph < NPHASE; ++ph) {
        p.ph_lo = ph; p.ph_hi = ph + 1;
        hipLaunchKernelGGL(fwd_megakernel, dim3(grid), dim3(512), LDS_BYTES, stream, p);
    }
#else
    p.ph_lo = 0; p.ph_hi = NPHASE;
    if (hipMemsetAsync((unsigned char*)d_ws + WS_BAR, 0, XCD_BAR_WORDS * 4, stream) != hipSuccess) { fprintf(stderr, "barrier memset failed\n"); return; }
    void* args[] = {&p};
    hipError_t e = hipLaunchCooperativeKernel((const void*)fwd_megakernel, dim3(grid), dim3(512), args, LDS_BYTES, stream);
    if (e != hipSuccess) fprintf(stderr, "cooperative launch failed: %s (grid %d)\n", hipGetErrorString(e), grid);
#endif
}
```

```cpp
#include <hip/hip_runtime.h>
#include <hip/hip_cooperative_groups.h>
#include <cstdio>
namespace cg = cooperative_groups;

#ifndef PROBE_DUP
#define PROBE_DUP 0
#endif
#ifndef TOPK_HIST
#define TOPK_HIST 1
#endif
#ifndef PROBE_TOPK
#define PROBE_TOPK 0
#endif
#define LAS __attribute__((address_space(3)))
typedef unsigned short bf16_t;
typedef short bf16x8 __attribute__((ext_vector_type(8)));
typedef float f32x4 __attribute__((ext_vector_type(4)));
typedef float f32x2 __attribute__((ext_vector_type(2)));
typedef unsigned u32x4 __attribute__((ext_vector_type(4)));
typedef unsigned u32x2 __attribute__((ext_vector_type(2)));
typedef unsigned short u16x4 __attribute__((ext_vector_type(4)));

constexpr int MTOK = 65536, DM = 1024, SEQ = 4096;
constexpr size_t MiB = 1ull << 20;
constexpr size_t WS_XB = 0;
constexpr size_t WS_BIG = 128 * MiB;
constexpr size_t WS_CN = 640 * MiB;
constexpr size_t WS_IDX = 656 * MiB;
constexpr size_t WS_SS = 800 * MiB;
constexpr size_t WS_BAR = 688 * MiB;
constexpr size_t WS_W = 692 * MiB;
constexpr size_t W_A_IN = WS_W + 0 * MiB, W_A_OUT = WS_W + 4 * MiB, W_A_S = WS_W + 6 * MiB, W_B_IN = WS_W + 7 * MiB, W_B_OUT = WS_W + 13 * MiB,
                 W_C_IN = WS_W + 15 * MiB, W_C_GRP = WS_W + 17 * MiB, W_D_IN = WS_W + 18 * MiB, W_D_COMB = WS_W + 24 * MiB, W_1 = WS_W + 28 * MiB, W_2 = WS_W + 60 * MiB;
constexpr int DSA_LD = 2816;
constexpr int LDS_BYTES = 131072 + 1024 + 8192;
constexpr int NPHASE = 47;

struct Params {
    const float *x, *norm_mix_g, *norm_mlp_g, *final_g, *a_w_in, *a_v_g, *a_w_s, *a_b_s, *a_w_out, *b_w_in, *b_conv_w, *b_w_out, *c_w_in, *c_w_grp, *c_scale,
        *d_w_in, *d_kv_g, *d_w_uv, *d_w_out, *mlp_w1, *mlp_w2;
    float* out; unsigned char* ws; int ph_lo, ph_hi;
};

__device__ __forceinline__ unsigned cvt_pk_bf16(float lo, float hi) { unsigned r; asm volatile("v_cvt_pk_bf16_f32 %0, %1, %2" : "=v"(r) : "v"(lo), "v"(hi)); return r; }
__device__ __forceinline__ int opaque_tid(int wv) { int l; asm volatile("v_mbcnt_lo_u32_b32 %0, -1, 0\n\tv_mbcnt_hi_u32_b32 %0, -1, %0" : "=v"(l)); return wv * 64 + l; }
__device__ __forceinline__ float bflo(unsigned w) { return __uint_as_float(w << 16); }
__device__ __forceinline__ float bfhi(unsigned w) { return __uint_as_float(w & 0xffff0000u); }
__device__ __forceinline__ float wave_sum(float v) {
#pragma unroll
    for (int o = 32; o; o >>= 1) v += __shfl_xor(v, o);
    return v;
}
__device__ __forceinline__ float sum16(const float* p) { const f32x4 a = *(const f32x4*)p, b = *(const f32x4*)(p + 4), c = *(const f32x4*)(p + 8), d = *(const f32x4*)(p + 12);
    return (((a[0] + a[1]) + (a[2] + a[3])) + ((b[0] + b[1]) + (b[2] + b[3]))) + (((c[0] + c[1]) + (c[2] + c[3])) + ((d[0] + d[1]) + (d[2] + d[3]))); }
__device__ __forceinline__ float xrow16_max(float x) {
    auto s = __builtin_amdgcn_permlane16_swap(__float_as_uint(x), __float_as_uint(x), false, false);
    x = fmaxf(__uint_as_float(s[0]), __uint_as_float(s[1]));
    auto t = __builtin_amdgcn_permlane32_swap(__float_as_uint(x), __float_as_uint(x), false, false);
    return fmaxf(__uint_as_float(t[0]), __uint_as_float(t[1]));
}
__device__ __forceinline__ float xrow16_sum(float x) {
    auto s = __builtin_amdgcn_permlane16_swap(__float_as_uint(x), __float_as_uint(x), false, false);
    x = __uint_as_float(s[0]) + __uint_as_float(s[1]);
    auto t = __builtin_amdgcn_permlane32_swap(__float_as_uint(x), __float_as_uint(x), false, false);
    return __uint_as_float(t[0]) + __uint_as_float(t[1]);
}
__device__ __forceinline__ unsigned off_b(unsigned row, unsigned ch) { return 256u * row + 16u * (ch ^ (((row & 3) << 2) | ((row >> 2) & 3))); }
__device__ __forceinline__ bf16x8 tr_read2(unsigned a0, unsigned a1) {
    u16x4 lo, hi;
    asm volatile("ds_read_b64_tr_b16 %0, %2\n\tds_read_b64_tr_b16 %1, %3\n\ts_waitcnt lgkmcnt(0)" : "=&v"(lo), "=&v"(hi) : "v"(a0), "v"(a1) : "memory");
    bf16x8 r; r[0] = (short)lo[0]; r[1] = (short)lo[1]; r[2] = (short)lo[2]; r[3] = (short)lo[3]; r[4] = (short)hi[0]; r[5] = (short)hi[1]; r[6] = (short)hi[2]; r[7] = (short)hi[3];
    return r;
}
__device__ __forceinline__ void tr_read8(const unsigned (&a)[8], bf16x8 (&r)[4]) {
    u16x4 v0, v1, v2, v3, v4, v5, v6, v7;
    asm volatile("ds_read_b64_tr_b16 %0, %8\n\tds_read_b64_tr_b16 %1, %9\n\tds_read_b64_tr_b16 %2, %10\n\tds_read_b64_tr_b16 %3, %11\n\t"
                 "ds_read_b64_tr_b16 %4, %12\n\tds_read_b64_tr_b16 %5, %13\n\tds_read_b64_tr_b16 %6, %14\n\tds_read_b64_tr_b16 %7, %15\n\ts_waitcnt lgkmcnt(0)"
                 : "=&v"(v0), "=&v"(v1), "=&v"(v2), "=&v"(v3), "=&v"(v4), "=&v"(v5), "=&v"(v6), "=&v"(v7)
                 : "v"(a[0]), "v"(a[1]), "v"(a[2]), "v"(a[3]), "v"(a[4]), "v"(a[5]), "v"(a[6]), "v"(a[7]) : "memory");
    const u16x4 lo[4] = {v0, v2, v4, v6}, hi[4] = {v1, v3, v5, v7};
#pragma unroll
    for (int i = 0; i < 4; ++i) { r[i][0] = (short)lo[i][0]; r[i][1] = (short)lo[i][1]; r[i][2] = (short)lo[i][2]; r[i][3] = (short)lo[i][3]; r[i][4] = (short)hi[i][0]; r[i][5] = (short)hi[i][1]; r[i][6] = (short)hi[i][2]; r[i][7] = (short)hi[i][3]; }
}

namespace pg8 {
constexpr int BM = 256, BK = 64, HALF = 128, HTB = HALF * BK * 2, STAGE_BYTES = 8 * HTB, NXCD = 8, WGM = 8;
__device__ __forceinline__ int lds_byte(int r, int c) { const int st = (r >> 4) * 2 + (c >> 5), rr = r & 15, cc = c & 31, ob = rr * 64 + cc * 2; return st * 1024 + (ob ^ (((ob >> 9) & 1) << 5)); }
__device__ __forceinline__ void stage_rc(int b, int& R, int& C) { const int st = b / 1024, sb = b % 1024, swz = sb ^ (((sb >> 9) & 1) << 5); R = (st >> 1) * 16 + swz / 64; C = (st & 1) * 32 + (swz % 64) / 2; }
__device__ __forceinline__ int perm32(int rho) { const int n = rho >> 4, i = rho & 15; return 8 * (i >> 2) + 4 * n + (i & 3); }
struct Unit { int pm, pn; };
struct Gemm { const bf16_t* A; const bf16_t* Bt; int M, N, K, lda, apn; };
struct StaticOrder {
    int nM, nN, nwg, G, c;
    __device__ void init(int M, int N, int G_, int c_) { nM = M / BM; nN = N / BM; nwg = nM * nN; G = G_; c = c_; }
    __device__ bool next(int i, Unit& u) const {
        const long L = (long)i * G + c; if (L >= nwg) return false;
        int wgid = (int)L; { const int q = nwg / NXCD, r = nwg % NXCD, xcd = wgid % NXCD, off = wgid / NXCD; wgid = (xcd < r ? xcd * (q + 1) : r * (q + 1) + (xcd - r) * q) + off; }
        const int nig = WGM * nN, gid = wgid / nig, fm = gid * WGM, gsz = (nM - fm) < WGM ? (nM - fm) : WGM;
        u.pm = fm + ((wgid % nig) % gsz); u.pn = (wgid % nig) / gsz; return true;
    }
};

__device__ __forceinline__ float gelu_tanh(float x) {
    const float y = 0.7978845608f * (x + 0.044715f * x * x * x);
    const float e = __builtin_amdgcn_exp2f(-2.885390082f * y);
    return x * __builtin_amdgcn_rcpf(1.0f + e);
}
struct EpiAct {
    static constexpr bool PERM = true;
    bf16_t* O; int ldc; const float* ss_in; float* ssv; int ACT;
    __device__ __forceinline__ void operator()(const f32x4 (&acc)[2][2][4][2], const Unit& u, int wr, int wc, int fr, int fq) const {
        const int row0 = u.pm * BM + wr * 64 + fr, col0 = u.pn * BM + wc * 32 + 8 * fq;
        float rsv[2][4];
#pragma unroll
        for (int ai = 0; ai < 2; ++ai)
#pragma unroll
            for (int m = 0; m < 4; ++m) {
                const f32x4 pz = *(const f32x4*)(ss_in + (size_t)(row0 + ai * HALF + m * 16) * 16 + 4 * fq);
                float s = (pz[0] + pz[1]) + (pz[2] + pz[3]); s = xrow16_sum(s);
                rsv[ai][m] = rsqrtf(s * (1.0f / 1024.0f) + 1e-6f);
            }
#pragma unroll
        for (int ai = 0; ai < 2; ++ai)
#pragma unroll
            for (int m = 0; m < 4; ++m) {
                const int row = row0 + ai * HALF + m * 16;
                const float rs = rsv[ai][m];
                bf16_t* rowp = O + (size_t)row * ldc + col0; float sq = 0.f;
#pragma unroll
                for (int bj = 0; bj < 2; ++bj) {
                    f32x4 v0 = acc[ai][bj][m][0] * rs, v1 = acc[ai][bj][m][1] * rs;
                    if (ACT == 1) {
#pragma unroll
                        for (int j = 0; j < 4; ++j) { v0[j] = gelu_tanh(v0[j]); v1[j] = gelu_tanh(v1[j]); sq += v0[j] * v0[j] + v1[j] * v1[j]; }
                    }
                    if (ACT == 2) {
#pragma unroll
                        for (int j = 0; j < 4; ++j) { const float a = fmaxf(v0[j], 0.f), b = fmaxf(v1[j], 0.f); v0[j] = a * a; v1[j] = b * b; }
                    }
                    u32x4 w; w.x = cvt_pk_bf16(v0[0], v0[1]); w.y = cvt_pk_bf16(v0[2], v0[3]); w.z = cvt_pk_bf16(v1[0], v1[1]); w.w = cvt_pk_bf16(v1[2], v1[3]);
                    *(u32x4*)(rowp + bj * HALF) = w;
                }
                if (ACT == 1) {
                    sq = xrow16_sum(sq);
                    if (u.pn >= 4 && fq == 0) ssv[(size_t)row * 16 + (u.pn - 4) * 4 + wc] = sq;
                }
            }
    }
};
struct EpiResid {
    static constexpr bool PERM = false;
    bf16_t* xb; float* ss_out;
    __device__ __forceinline__ void operator()(const f32x4 (&acc)[2][2][4][2], const Unit& u, int wr, int wc, int fr, int fq) const {
        const int row0 = u.pm * BM + wr * 64 + fr, col0 = u.pn * BM + wc * 32 + 4 * fq;
#pragma unroll
        for (int ai = 0; ai < 2; ++ai) {
            u32x2 xo[4][2][2];
#pragma unroll
            for (int m = 0; m < 4; ++m)
#pragma unroll
                for (int bj = 0; bj < 2; ++bj)
#pragma unroll
                    for (int n = 0; n < 2; ++n) xo[m][bj][n] = *(const u32x2*)(xb + (size_t)(row0 + ai * HALF + m * 16) * DM + col0 + bj * HALF + n * 16);
#pragma unroll
            for (int m = 0; m < 4; ++m) {
                const int row = row0 + ai * HALF + m * 16; const size_t off = (size_t)row * DM + col0; float sq = 0.f;
#pragma unroll
                for (int bj = 0; bj < 2; ++bj)
#pragma unroll
                    for (int n = 0; n < 2; ++n) {
                        const u32x2 xw = xo[m][bj][n]; const f32x4 a = acc[ai][bj][m][n];
                        const float v0 = bflo(xw.x) + a[0], v1 = bfhi(xw.x) + a[1], v2 = bflo(xw.y) + a[2], v3 = bfhi(xw.y) + a[3];
                        u32x2 w; w.x = cvt_pk_bf16(v0, v1); w.y = cvt_pk_bf16(v2, v3); *(u32x2*)(xb + off + bj * HALF + n * 16) = w;
                        sq += (v0 * v0 + v1 * v1) + (v2 * v2 + v3 * v3);
                    }
                sq = xrow16_sum(sq);
                if (fq == 0) ss_out[(size_t)row * 16 + u.pn * 4 + wc] = sq;
            }
            asm volatile("" ::: "memory");
        }
    }
};

template <class Epi>
__device__ __forceinline__ void gemm_phase(LAS unsigned char* lds, const Gemm g, const StaticOrder& S, const Epi& E, int wv) {
    const int tid = opaque_tid(wv), wid = __builtin_amdgcn_readfirstlane(tid >> 6), lane = tid & 63, wr = wid >> 2, wc = wid & 3, fr = lane & 15, fq = lane >> 4;
    const int K = g.K, nt = K / BK, lda = g.lda;
    unsigned voffA[2], voffB[2];
#pragma unroll
    for (int i = 0; i < 2; ++i) { int R, C; stage_rc(tid * 16 + i * 8192, R, C); const int Rb = Epi::PERM ? ((R & ~31) + perm32(R & 31)) : R;
        voffA[i] = (unsigned)(R * lda + C) * 2u; voffB[i] = (unsigned)(Rb * K + C) * 2u; }
    const size_t kstep = (size_t)(BK * 2);
    const size_t hstepA = (size_t)HALF * lda * 2, hstepB = (size_t)HALF * K * 2;
    const size_t tstepA = 2 * hstepA, tstepB = 2 * hstepB;
    const unsigned ldsw = (unsigned)wid * 1024u;
    const int aoff = lds_byte(wr * 64 + fr, fq * 8), boff = lds_byte(wc * 32 + fr, fq * 8);
#define PG8_SA(b, h) (((b) * 2 + (h)) * HTB)
#define PG8_SB(b, h) ((4 + (b) * 2 + (h)) * HTB)
#define PG8_STAGE(bufoff, gbase, voff) do { _Pragma("unroll") for (int _i = 0; _i < 2; ++_i) \
        __builtin_amdgcn_global_load_lds((const unsigned*)((const char*)(gbase) + (voff)[_i]), (LAS unsigned*)(lds + (bufoff) + ldsw + _i * 8192), 16, 0, 0); } while (0)
#define PG8_LDA(dst, b, h) do { _Pragma("unroll") for (int m = 0; m < 4; ++m) _Pragma("unroll") for (int k = 0; k < 2; ++k) dst[m][k] = *(const LAS bf16x8*)(lds + PG8_SA(b, h) + aoff + m * 2048 + k * 1024); } while (0)
#define PG8_LDB(dst, b, h) do { _Pragma("unroll") for (int n = 0; n < 2; ++n) _Pragma("unroll") for (int k = 0; k < 2; ++k) dst[n][k] = *(const LAS bf16x8*)(lds + PG8_SB(b, h) + boff + n * 2048 + k * 1024); } while (0)
#define PG8_MMA(ai, bj, At, Bt) do { __builtin_amdgcn_s_setprio(1); _Pragma("unroll") for (int m = 0; m < 4; ++m) _Pragma("unroll") for (int n = 0; n < 2; ++n) _Pragma("unroll") for (int k = 0; k < 2; ++k) \
        acc[ai][bj][m][n] = __builtin_amdgcn_mfma_f32_16x16x32_bf16(Bt[n][k], At[m][k], acc[ai][bj][m][n], 0, 0, 0); __builtin_amdgcn_s_setprio(0); } while (0)
#define PG8_WAIT_V(n) asm volatile("s_waitcnt vmcnt(" #n ")" ::: "memory")
#define PG8_WAIT_L(n) asm volatile("s_waitcnt lgkmcnt(" #n ")" ::: "memory")
#define PG8_BAR __builtin_amdgcn_s_barrier()
#define PG8_SCHED __builtin_amdgcn_sched_barrier(0)
    Unit cur, nxt; int ui = 0;
    if (!S.next(0, cur)) return;
    f32x4 acc[2][2][4][2];
#pragma unroll
    for (int a = 0; a < 2; ++a)
#pragma unroll
        for (int b = 0; b < 2; ++b)
#pragma unroll
            for (int m = 0; m < 4; ++m)
#pragma unroll
                for (int n = 0; n < 2; ++n) acc[a][b][m][n] = (f32x4){0.f, 0.f, 0.f, 0.f};
    bf16x8 At[4][2], B0[2][2], B1[2][2];
    const char* cA = (const char*)g.A + (size_t)cur.pm * tstepA + (size_t)cur.pn * g.apn; const char* cB = (const char*)g.Bt + (size_t)cur.pn * tstepB;
    PG8_STAGE(PG8_SB(0, 0), cB, voffB); PG8_STAGE(PG8_SA(0, 0), cA, voffA); PG8_STAGE(PG8_SB(0, 1), cB + hstepB, voffB); PG8_STAGE(PG8_SA(0, 1), cA + hstepA, voffA);
    if (wr == 1) PG8_BAR;
    PG8_WAIT_V(4); PG8_BAR;
    PG8_STAGE(PG8_SB(1, 0), cB + kstep, voffB); PG8_STAGE(PG8_SA(1, 0), cA + kstep, voffA); PG8_STAGE(PG8_SB(1, 1), cB + hstepB + kstep, voffB);
    PG8_WAIT_V(6); PG8_BAR;
    for (;;) {
        const bool has_next = S.next(ui + 1, nxt);
        const char* nA = has_next ? (const char*)g.A + (size_t)nxt.pm * tstepA + (size_t)nxt.pn * g.apn : cA; const char* nB = has_next ? (const char*)g.Bt + (size_t)nxt.pn * tstepB : cB;
        for (int t = 0; t < nt; t += 2) {
            const bool last = (t == nt - 2);
            const char* a1 = cA + (size_t)(t + 1) * kstep;
            const char* a2 = last ? nA : cA + (size_t)(t + 2) * kstep; const char* b2 = last ? nB : cB + (size_t)(t + 2) * kstep;
            const char* a3 = a2 + kstep; const char* b3 = b2 + kstep;
            PG8_LDB(B0, 0, 0); PG8_SCHED; PG8_LDA(At, 0, 0); PG8_STAGE(PG8_SA(1, 1), a1 + hstepA, voffA);
            PG8_WAIT_L(8); PG8_BAR; PG8_WAIT_L(0); PG8_MMA(0, 0, At, B0); PG8_BAR; PG8_SCHED;
            PG8_LDB(B1, 0, 1); PG8_STAGE(PG8_SB(0, 0), b2, voffB);
            PG8_BAR; PG8_WAIT_L(0); PG8_MMA(0, 1, At, B1); PG8_BAR;
            PG8_LDA(At, 0, 1); PG8_STAGE(PG8_SA(0, 0), a2, voffA);
            PG8_BAR; PG8_WAIT_L(0); PG8_MMA(1, 0, At, B0); PG8_BAR; PG8_SCHED;
            PG8_STAGE(PG8_SB(0, 1), b2 + hstepB, voffB);
            PG8_WAIT_V(6); PG8_BAR; PG8_MMA(1, 1, At, B1); PG8_BAR;
            PG8_LDB(B0, 1, 0); PG8_SCHED; PG8_LDA(At, 1, 0); PG8_STAGE(PG8_SA(0, 1), a2 + hstepA, voffA);
            PG8_WAIT_L(8); PG8_BAR; PG8_WAIT_L(0); PG8_MMA(0, 0, At, B0); PG8_BAR; PG8_SCHED;
            PG8_LDB(B1, 1, 1); PG8_STAGE(PG8_SB(1, 0), b3, voffB);
            PG8_BAR; PG8_WAIT_L(0); PG8_MMA(0, 1, At, B1); PG8_BAR;
            PG8_LDA(At, 1, 1); PG8_STAGE(PG8_SA(1, 0), a3, voffA);
            PG8_BAR; PG8_WAIT_L(0); PG8_MMA(1, 0, At, B0); PG8_BAR; PG8_SCHED;
            PG8_STAGE(PG8_SB(1, 1), b3 + hstepB, voffB);
            PG8_WAIT_V(6); PG8_BAR; PG8_MMA(1, 1, At, B1); PG8_BAR;
        }
        E(acc, cur, wr, wc, fr, fq);
        if (!has_next) break;
#pragma unroll
        for (int a = 0; a < 2; ++a)
#pragma unroll
            for (int b = 0; b < 2; ++b)
#pragma unroll
                for (int m = 0; m < 4; ++m)
#pragma unroll
                    for (int n = 0; n < 2; ++n) acc[a][b][m][n] = (f32x4){0.f, 0.f, 0.f, 0.f};
        cur = nxt; cA = nA; cB = nB; ++ui;
    }
    PG8_WAIT_V(0);
    if (wr == 0) PG8_BAR;
    PG8_BAR;
#undef PG8_SA
#undef PG8_SB
#undef PG8_STAGE
#undef PG8_LDA
#undef PG8_LDB
#undef PG8_MMA
#undef PG8_WAIT_V
#undef PG8_WAIT_L
#undef PG8_BAR
#undef PG8_SCHED
}
}

__device__ void transpose_convert(int gw, int nw, int lane, const float* W, int K, int N, int Npad, bf16_t* Wt, int ldt, const float* rowgain, const float* colgain) {
    const int kb_n = K / 16, units = kb_n * (Npad / 256);
    for (int u = gw; u < units; u += nw) {
        const int k0 = (u % kb_n) * 16, n = (u / kb_n) * 256 + 4 * lane;
        f32x4 v[16];
        if (n < N) {
#pragma unroll
            for (int i = 0; i < 16; ++i) v[i] = *(const f32x4*)(W + (size_t)(k0 + i) * N + n);
            if (rowgain) {
#pragma unroll
                for (int i = 0; i < 16; ++i) v[i] *= rowgain[k0 + i];
            }
            if (colgain) { const f32x4 cgv = *(const f32x4*)(colgain + n);
#pragma unroll
                for (int i = 0; i < 16; ++i) v[i] *= cgv; }
        } else {
#pragma unroll
            for (int i = 0; i < 16; ++i) v[i] = (f32x4){0.f, 0.f, 0.f, 0.f};
        }
#pragma unroll
        for (int j = 0; j < 4; ++j) {
            u32x4 w0, w1; w0.x = cvt_pk_bf16(v[0][j], v[1][j]); w0.y = cvt_pk_bf16(v[2][j], v[3][j]); w0.z = cvt_pk_bf16(v[4][j], v[5][j]); w0.w = cvt_pk_bf16(v[6][j], v[7][j]);
            w1.x = cvt_pk_bf16(v[8][j], v[9][j]); w1.y = cvt_pk_bf16(v[10][j], v[11][j]); w1.z = cvt_pk_bf16(v[12][j], v[13][j]); w1.w = cvt_pk_bf16(v[14][j], v[15][j]);
            u32x4* dst = (u32x4*)(Wt + (size_t)(n + j) * ldt + k0); dst[0] = w0; dst[1] = w1;
        }
    }
}

__device__ void phase_prologue(const Params& p, LAS unsigned char* lds, int wv) {
    unsigned char* ws = p.ws;
    const int tid = opaque_tid(wv), lane = tid & 63, wave = tid >> 6;
    const int gw = blockIdx.x * 8 + wave, nw = gridDim.x * 8;
    const size_t gtid = (size_t)blockIdx.x * 512 + tid, gsz = (size_t)gridDim.x * 512;
    float* ss = (float*)(ws + WS_SS);
    bf16_t* xb = (bf16_t*)(ws + WS_XB);
    for (int row2 = (blockIdx.x * 8 + wave) * 2; row2 < MTOK; row2 += gridDim.x * 16) {
        f32x4 xv[2][4];
#pragma unroll
        for (int k = 0; k < 2; ++k)
#pragma unroll
            for (int i = 0; i < 4; ++i) xv[k][i] = ((const f32x4*)(p.x + (size_t)(row2 + k) * DM))[lane + 64 * i];
#pragma unroll
        for (int k = 0; k < 2; ++k) { const int row = row2 + k; float sq = 0.f;
#pragma unroll
            for (int i = 0; i < 4; ++i) { const f32x4 v = xv[k][i]; sq += (v[0] * v[0] + v[1] * v[1]) + (v[2] * v[2] + v[3] * v[3]);
                u32x2 w; w.x = cvt_pk_bf16(v[0], v[1]); w.y = cvt_pk_bf16(v[2], v[3]); *(u32x2*)(xb + (size_t)row * DM + (lane + 64 * i) * 4) = w; }
            sq = wave_sum(sq);
            if (lane < 16) ss[(size_t)row * 16 + lane] = lane == 0 ? sq : 0.f; }
    }
    transpose_convert(gw, nw, lane, p.a_w_in, 1024, 2048, 2048, (bf16_t*)(ws + W_A_IN), 1024, p.norm_mix_g + 0 * DM, nullptr);
    transpose_convert(gw, nw, lane, p.a_w_out, 1024, 1024, 1024, (bf16_t*)(ws + W_A_OUT), 1024, nullptr, nullptr);
    transpose_convert(gw, nw, lane, p.b_w_in, 1024, 3072, 3072, (bf16_t*)(ws + W_B_IN), 1024, p.norm_mix_g + 1 * DM, nullptr);
    transpose_convert(gw, nw, lane, p.b_w_out, 1024, 1024, 1024, (bf16_t*)(ws + W_B_OUT), 1024, nullptr, nullptr);
    transpose_convert(gw, nw, lane, p.c_w_in, 1024, 1024, 1024, (bf16_t*)(ws + W_C_IN), 1024, p.norm_mix_g + 2 * DM, nullptr);
    for (int g = 0; g < 4; ++g)
        transpose_convert(gw, nw, lane, p.c_w_grp + (size_t)g * 65536, 256, 256, 256, (bf16_t*)(ws + W_C_GRP) + (size_t)g * 65536, 256, nullptr, p.c_scale + g * 256);
    transpose_convert(gw, nw, lane, p.d_w_in, 1024, 2760, DSA_LD, (bf16_t*)(ws + W_D_IN), 1024, p.norm_mix_g + 3 * DM, nullptr);
    for (int l = 0; l < 4; ++l) {
        transpose_convert(gw, nw, lane, p.mlp_w1 + (size_t)l * 4194304, 1024, 4096, 4096, (bf16_t*)(ws + W_1) + (size_t)l * 4194304, 1024, p.norm_mlp_g + l * DM, nullptr);
        transpose_convert(gw, nw, lane, p.mlp_w2 + (size_t)l * 4194304, 4096, 1024, 1024, (bf16_t*)(ws + W_2) + (size_t)l * 4194304, 4096, nullptr, nullptr);
    }
    { bf16_t* wsm = (bf16_t*)(ws + W_A_S);
      for (size_t i = gtid; i < (size_t)8 * 128 * 128; i += gsz) { const int s = (int)(i & 127), t = (int)((i >> 7) & 127); const float v = (s <= t) ? p.a_w_s[i] : 0.f; wsm[i] = (bf16_t)(cvt_pk_bf16(v, 0.f) & 0xffffu); } }
    { bf16_t* wc = (bf16_t*)(ws + W_D_COMB);
      for (int u = gw; u < 256 * 4; u += nw) {
          const int k0 = (u >> 2) * 8, n = (u & 3) * 256 + 4 * lane, h = k0 >> 7;
          const float* uv = p.d_w_uv + (size_t)k0 * 64; const float* wo = p.d_w_out + (size_t)h * 64 * 1024 + n;
          f32x4 a[8];
#pragma unroll
          for (int i = 0; i < 8; ++i) a[i] = (f32x4){0.f, 0.f, 0.f, 0.f};
#pragma unroll 4
          for (int v = 0; v < 64; ++v) { const f32x4 w4 = *(const f32x4*)(wo + (size_t)v * 1024);
#pragma unroll
              for (int i = 0; i < 8; ++i) a[i] += w4 * uv[i * 64 + v]; }
#pragma unroll
          for (int j = 0; j < 4; ++j) {
              u32x4 w; w.x = cvt_pk_bf16(a[0][j], a[1][j]); w.y = cvt_pk_bf16(a[2][j], a[3][j]); w.z = cvt_pk_bf16(a[4][j], a[5][j]); w.w = cvt_pk_bf16(a[6][j], a[7][j]);
              *(u32x4*)(wc + (size_t)(n + j) * 2048 + k0) = w; } } }
}

__device__ void phase_sgu(const Params& p, LAS unsigned char* lds, int wv) {
    unsigned char* ws = p.ws;
    const int tid = opaque_tid(wv), lane = tid & 63, wave = __builtin_amdgcn_readfirstlane(tid >> 6), g4 = lane >> 4, l15 = lane & 15, q = l15 >> 2, pp = lane & 3;
    const bf16_t* z = (const bf16_t*)(ws + WS_BIG); bf16_t* us = (bf16_t*)(ws + WS_BIG + 256 * MiB);
    const float* ssv = (const float*)(ws + WS_SS) + (size_t)9 * MTOK * 16; const bf16_t* wsm = (const bf16_t*)(ws + W_A_S);
    const unsigned ldsbase = (unsigned)(size_t)(unsigned char*)lds;
    for (int unit = blockIdx.x; unit < 4096; unit += gridDim.x) {
        const int g = unit & 7, chunk = unit >> 3; const size_t row0 = (size_t)chunk * 128;
#pragma unroll
        for (int i = 0; i < 4; ++i) {
            const int e = tid + 512 * i, r = e >> 4, ch = e & 15;
            const u32x4 raw = *(const u32x4*)(z + (row0 + r) * 2048 + 1024 + g * 128 + ch * 8);
            const float rs = rsqrtf(sum16(ssv + (row0 + r) * 16) * (1.0f / 1024.0f) + 1e-6f);
            const f32x4 g0 = *(const f32x4*)(p.a_v_g + g * 128 + ch * 8), g1 = *(const f32x4*)(p.a_v_g + g * 128 + ch * 8 + 4);
            u32x4 o;
            o.x = cvt_pk_bf16(bflo(raw.x) * rs * g0[0], bfhi(raw.x) * rs * g0[1]); o.y = cvt_pk_bf16(bflo(raw.y) * rs * g0[2], bfhi(raw.y) * rs * g0[3]);
            o.z = cvt_pk_bf16(bflo(raw.z) * rs * g1[0], bfhi(raw.z) * rs * g1[1]); o.w = cvt_pk_bf16(bflo(raw.w) * rs * g1[2], bfhi(raw.w) * rs * g1[3]);
            *(LAS u32x4*)(lds + (r >> 5) * 8192 + off_b(r & 31, ch)) = o;
        }
        __syncthreads();
        const int t = 16 * wave + l15, nks = (wave >> 1) + 1;
        const float bias = p.a_b_s[g * 128 + t]; const size_t rowg = row0 + t;
        u32x2 uu8[8];
#pragma unroll
        for (int ct = 0; ct < 8; ++ct) uu8[ct] = *(const u32x2*)(z + rowg * 2048 + g * 128 + 16 * ct + 4 * g4);
        f32x4 acc[8];
#pragma unroll
        for (int ct = 0; ct < 8; ++ct) acc[ct] = (f32x4){0.f, 0.f, 0.f, 0.f};
        for (int ks = 0; ks < nks; ++ks) {
            const bf16x8 Bw = *(const bf16x8*)(wsm + ((size_t)g * 128 + t) * 128 + 32 * ks + 8 * g4);
#pragma unroll
            for (int cb = 0; cb < 2; ++cb) {
                unsigned ad[8]; bf16x8 Av[4];
#pragma unroll
                for (int i = 0; i < 4; ++i) { const int ct = 4 * cb + i;
                    ad[2 * i] = ldsbase + ks * 8192 + off_b(8 * g4 + q, 2 * ct + (pp >> 1)) + 8 * (pp & 1); ad[2 * i + 1] = ldsbase + ks * 8192 + off_b(8 * g4 + 4 + q, 2 * ct + (pp >> 1)) + 8 * (pp & 1); }
                tr_read8(ad, Av);
#pragma unroll
                for (int i = 0; i < 4; ++i) acc[4 * cb + i] = __builtin_amdgcn_mfma_f32_16x16x32_bf16(Av[i], Bw, acc[4 * cb + i], 0, 0, 0);
            }
        }
#pragma unroll
        for (int ct = 0; ct < 8; ++ct) {
            const u32x2 uu = uu8[ct];
            u32x2 o; o.x = cvt_pk_bf16(bflo(uu.x) * (acc[ct][0] + bias), bfhi(uu.x) * (acc[ct][1] + bias)); o.y = cvt_pk_bf16(bflo(uu.y) * (acc[ct][2] + bias), bfhi(uu.y) * (acc[ct][3] + bias));
            *(u32x2*)(us + rowg * 1024 + g * 128 + 16 * ct + 4 * g4) = o;
        }
        __syncthreads();
    }
}

__device__ void phase_conv(const Params& p, int wv) {
    unsigned char* ws = p.ws; const bf16_t* bch = (const bf16_t*)(ws + WS_BIG); bf16_t* gated = (bf16_t*)(ws + WS_BIG + 384 * MiB);
    const size_t gtid = (size_t)blockIdx.x * 512 + opaque_tid(wv), gsz = (size_t)gridDim.x * 512;
    for (size_t it = gtid; it < (size_t)4096 * 128; it += gsz) {
        const int ch = (int)(it & 127) * 8, rb = (int)(it >> 7); const int r0 = rb * 16;
        float w0[8], w1[8], w2[8], zm2[8], zm1[8];
#pragma unroll
        for (int j = 0; j < 8; ++j) { w0[j] = p.b_conv_w[ch + j]; w1[j] = p.b_conv_w[1024 + ch + j]; w2[j] = p.b_conv_w[2048 + ch + j]; zm2[j] = 0.f; zm1[j] = 0.f; }
        const int tpos0 = r0 & (SEQ - 1);
        for (int d = 2; d >= 1; --d) {
            if (tpos0 - d >= 0) {
                const bf16_t* rp = bch + (size_t)(r0 - d) * 3072; const u32x4 c = *(const u32x4*)(rp + 1024 + ch), h = *(const u32x4*)(rp + 2048 + ch);
                float zz[8] = {bflo(c.x) * bflo(h.x), bfhi(c.x) * bfhi(h.x), bflo(c.y) * bflo(h.y), bfhi(c.y) * bfhi(h.y), bflo(c.z) * bflo(h.z), bfhi(c.z) * bfhi(h.z), bflo(c.w) * bflo(h.w), bfhi(c.w) * bfhi(h.w)};
#pragma unroll
                for (int j = 0; j < 8; ++j) { if (d == 2) zm2[j] = zz[j]; else zm1[j] = zz[j]; }
            }
        }
        for (int r4 = r0; r4 < r0 + 16; r4 += 4) {
            u32x4 bq[4], cq[4], hq[4];
#pragma unroll
            for (int k = 0; k < 4; ++k) { const bf16_t* rp = bch + (size_t)(r4 + k) * 3072; bq[k] = *(const u32x4*)(rp + ch); cq[k] = *(const u32x4*)(rp + 1024 + ch); hq[k] = *(const u32x4*)(rp + 2048 + ch); }
#pragma unroll
            for (int k = 0; k < 4; ++k) {
                const u32x4 b = bq[k], c = cq[k], h = hq[k];
                float zz[8] = {bflo(c.x) * bflo(h.x), bfhi(c.x) * bfhi(h.x), bflo(c.y) * bflo(h.y), bfhi(c.y) * bfhi(h.y), bflo(c.z) * bflo(h.z), bfhi(c.z) * bfhi(h.z), bflo(c.w) * bflo(h.w), bfhi(c.w) * bfhi(h.w)};
                float bb[8] = {bflo(b.x), bfhi(b.x), bflo(b.y), bfhi(b.y), bflo(b.z), bfhi(b.z), bflo(b.w), bfhi(b.w)};
                float o[8];
#pragma unroll
                for (int j = 0; j < 8; ++j) { o[j] = bb[j] * (w0[j] * zm2[j] + w1[j] * zm1[j] + w2[j] * zz[j]); zm2[j] = zm1[j]; zm1[j] = zz[j]; }
                u32x4 w; w.x = cvt_pk_bf16(o[0], o[1]); w.y = cvt_pk_bf16(o[2], o[3]); w.z = cvt_pk_bf16(o[4], o[5]); w.w = cvt_pk_bf16(o[6], o[7]);
                *(u32x4*)(gated + (size_t)(r4 + k) * 1024 + ch) = w;
            }
        }
    }
}

__device__ __forceinline__ void ld8(const bf16_t* ptr, float (&f)[8]) {
    const u32x4 v = *(const u32x4*)ptr; f[0] = bflo(v.x); f[1] = bfhi(v.x); f[2] = bflo(v.y); f[3] = bfhi(v.y); f[4] = bflo(v.z); f[5] = bfhi(v.z); f[6] = bflo(v.w); f[7] = bfhi(v.w);
}
__device__ void phase_pool(const Params& p, int wv) {
    unsigned char* ws = p.ws; const bf16_t* z = (const bf16_t*)(ws + WS_BIG); bf16_t* pooled = (bf16_t*)(ws + WS_BIG + 128 * MiB);
    const size_t gtid = (size_t)blockIdx.x * 512 + opaque_tid(wv), gsz = (size_t)gridDim.x * 512;
    for (size_t it = gtid; it < (size_t)2048 * 128; it += gsz) {
        const int lane = (int)(it & 63), wv = (int)(it >> 6), chunk = (wv & 3) * 32 + (lane & 31), rb = (wv >> 2) * 2 + (lane >> 5);
        const int ch = chunk * 8, w = 2 << (ch >> 8), r0 = rb * 32;
        float S[8];
#pragma unroll
        for (int j = 0; j < 8; ++j) S[j] = 0.f;
        const int tpos0 = r0 & (SEQ - 1);
        for (int d = 1; d <= w; ++d) {
            if (tpos0 - d >= 0) { float f[8]; ld8(z + (size_t)(r0 - d) * 1024 + ch, f);
#pragma unroll
                for (int j = 0; j < 8; ++j) S[j] += f[j]; }
        }
        for (int r4 = r0; r4 < r0 + 32; r4 += 4) {
            u32x4 fa[4], oa[4];
#pragma unroll
            for (int k = 0; k < 4; ++k) { const int r = r4 + k; fa[k] = *(const u32x4*)(z + (size_t)r * 1024 + ch);
                const int rr = ((r & (SEQ - 1)) - w >= 0) ? r - w : r; oa[k] = *(const u32x4*)(z + (size_t)rr * 1024 + ch); }
#pragma unroll
            for (int k = 0; k < 4; ++k) {
                const int r = r4 + k, tpos = r & (SEQ - 1);
                float f[8] = {bflo(fa[k].x), bfhi(fa[k].x), bflo(fa[k].y), bfhi(fa[k].y), bflo(fa[k].z), bfhi(fa[k].z), bflo(fa[k].w), bfhi(fa[k].w)};
#pragma unroll
                for (int j = 0; j < 8; ++j) S[j] += f[j];
                if (tpos - w >= 0) { float o[8] = {bflo(oa[k].x), bfhi(oa[k].x), bflo(oa[k].y), bfhi(oa[k].y), bflo(oa[k].z), bfhi(oa[k].z), bflo(oa[k].w), bfhi(oa[k].w)};
#pragma unroll
                    for (int j = 0; j < 8; ++j) S[j] -= o[j]; }
                const int cnt = (tpos + 1 < w) ? tpos + 1 : w; const float inv = 1.0f / (float)cnt;
                u32x4 o; o.x = cvt_pk_bf16(S[0] * inv - f[0], S[1] * inv - f[1]); o.y = cvt_pk_bf16(S[2] * inv - f[2], S[3] * inv - f[3]);
                o.z = cvt_pk_bf16(S[4] * inv - f[4], S[5] * inv - f[5]); o.w = cvt_pk_bf16(S[6] * inv - f[6], S[7] * inv - f[7]);
                *(u32x4*)(pooled + (size_t)r * 1024 + ch) = o;
            }
        }
    }
}

__device__ __forceinline__ int cnt_ge8(const unsigned* v, unsigned cand) {
    unsigned long long m0, m1, m2, m3, m4, m5, m6, m7;
    asm("v_cmp_le_u32_e64 %0, %8, %9\n\tv_cmp_le_u32_e64 %1, %8, %10\n\tv_cmp_le_u32_e64 %2, %8, %11\n\tv_cmp_le_u32_e64 %3, %8, %12\n\t"
        "v_cmp_le_u32_e64 %4, %8, %13\n\tv_cmp_le_u32_e64 %5, %8, %14\n\tv_cmp_le_u32_e64 %6, %8, %15\n\tv_cmp_le_u32_e64 %7, %8, %16"
        : "=&s"(m0), "=&s"(m1), "=&s"(m2), "=&s"(m3), "=&s"(m4), "=&s"(m5), "=&s"(m6), "=&s"(m7)
        : "s"(cand), "v"(v[0]), "v"(v[1]), "v"(v[2]), "v"(v[3]), "v"(v[4]), "v"(v[5]), "v"(v[6]), "v"(v[7]));
    return (__builtin_popcountll(m0) + __builtin_popcountll(m1)) + (__builtin_popcountll(m2) + __builtin_popcountll(m3)) +
           (__builtin_popcountll(m4) + __builtin_popcountll(m5)) + (__builtin_popcountll(m6) + __builtin_popcountll(m7));
}
__device__ __forceinline__ void hist_find(LAS unsigned* hist, int lane, int target, int& bin, int& above) {
    const u32x4 h = *(LAS u32x4*)(hist + 4 * lane);
    const int tot = (int)(h.x + h.y + h.z + h.w);
    int suf = tot;
#pragma unroll
    for (int o = 1; o < 64; o <<= 1) { const int t = __shfl_down(suf, o); if (lane + o < 64) suf += t; }
    const int excl = suf - tot;
    const bool mine = (excl < target) && (suf >= target);
    int b, ab, c = excl;
    if (c + (int)h.w >= target) { b = 3; ab = c; } else { c += (int)h.w;
        if (c + (int)h.z >= target) { b = 2; ab = c; } else { c += (int)h.z;
            if (c + (int)h.y >= target) { b = 1; ab = c; } else { c += (int)h.y; b = 0; ab = c; } } }
    const unsigned long long m = __ballot(mine);
    const int src = m ? (int)__ffsll((long long)m) - 1 : 0;
    bin = __builtin_amdgcn_readlane(4 * lane + b, src); above = __builtin_amdgcn_readlane(ab, src);
}
__device__ void phase_topk(const Params& p, LAS unsigned char* lds, int wv) {
    unsigned char* ws = p.ws;
    const int tid = opaque_tid(wv), lane = tid & 63, wave = __builtin_amdgcn_readfirstlane(tid >> 6), g4 = lane >> 4, l15 = lane & 15;
    const bf16_t* din = (const bf16_t*)(ws + WS_BIG); bf16_t* cn = (bf16_t*)(ws + WS_CN); unsigned short* idx = (unsigned short*)(ws + WS_IDX);
    LAS unsigned short* S16 = (LAS unsigned short*)lds;
    constexpr int SROW = 4112;
    { const float kg0 = p.d_kv_g[2 * lane], kg1 = p.d_kv_g[2 * lane + 1];
      for (int row4 = (blockIdx.x * 8 + wave) * 4; row4 < MTOK; row4 += gridDim.x * 32) {
        unsigned raw[4];
#pragma unroll
        for (int j = 0; j < 4; ++j) raw[j] = *(const unsigned*)(din + (size_t)(row4 + j) * DSA_LD + 2048 + 2 * lane);
#pragma unroll
        for (int j = 0; j < 4; ++j) { const float a = bflo(raw[j]), b = bfhi(raw[j]);
            const float sq = wave_sum(a * a + b * b); const float rs = rsqrtf(sq * (1.0f / 128.0f) + 1e-6f);
            *(unsigned*)(cn + (size_t)(row4 + j) * 128 + 2 * lane) = cvt_pk_bf16(a * rs * kg0, b * rs * kg1); }
      } }
    for (int unit = blockIdx.x; unit < 4096; unit += gridDim.x) {
        const bool tiled = (4096 % (2 * (int)gridDim.x)) == 0;
        const int pi = tiled ? (unit / (2 * (int)gridDim.x)) * (int)gridDim.x + (unit % (int)gridDim.x) : (unit >> 1), hi = tiled ? (unit / (int)gridDim.x) & 1 : (unit & 1);
        const int b = pi >> 7, cc = pi & 127, qt = hi ? 255 - cc : cc, qpos0 = qt * 16; const size_t rowq0 = (size_t)b * SEQ + qpos0;
        bf16x8 Aq[8][2]; float wv[8][4];
#pragma unroll
        for (int pr = 0; pr < 8; ++pr) {
            const int qg = pr >> 1, hh = pr & 1;
            const bf16_t* base = din + (rowq0 + 4 * qg + (l15 >> 2)) * DSA_LD + 2176 + (4 * hh + (l15 & 3)) * 64;
            Aq[pr][0] = *(const bf16x8*)(base + 8 * g4); Aq[pr][1] = *(const bf16x8*)(base + 32 + 8 * g4);
            const u32x2 wr = *(const u32x2*)(din + (rowq0 + 4 * qg + g4) * DSA_LD + 2752 + 4 * hh);
            wv[pr][0] = bflo(wr.x) * 0.04419417382f; wv[pr][1] = bfhi(wr.x) * 0.04419417382f; wv[pr][2] = bflo(wr.y) * 0.04419417382f; wv[pr][3] = bfhi(wr.y) * 0.04419417382f;
        }
        const int nkt = (qpos0 + 15) / 16 + 1;
        {
        bf16x8 B0[4], B1[4], N0[4], N1[4];
#pragma unroll
        for (int j = 0; j < 4; ++j) { const int kt = (wave + 8 * j < nkt) ? wave + 8 * j : 0;
            const bf16_t* kb = din + ((size_t)b * SEQ + 16 * kt + l15) * DSA_LD + 2688;
            B0[j] = *(const bf16x8*)(kb + 8 * g4); B1[j] = *(const bf16x8*)(kb + 32 + 8 * g4); }
        for (int kt0 = wave; kt0 < nkt; kt0 += 32) {
#pragma unroll
            for (int j = 0; j < 4; ++j) { const int kt = (kt0 + 32 + 8 * j < nkt) ? kt0 + 32 + 8 * j : 0;
                const bf16_t* kb = din + ((size_t)b * SEQ + 16 * kt + l15) * DSA_LD + 2688;
                N0[j] = *(const bf16x8*)(kb + 8 * g4); N1[j] = *(const bf16x8*)(kb + 32 + 8 * g4); }
#pragma unroll
            for (int j = 0; j < 4; ++j) {
                const int kt = kt0 + 8 * j;
                if (kt < nkt) {
#pragma unroll
                    for (int qg = 0; qg < 4; ++qg) {
                        float part = 0.f;
#pragma unroll
                        for (int hh = 0; hh < 2; ++hh) {
                            const int pr = 2 * qg + hh;
                            f32x4 c = (f32x4){0.f, 0.f, 0.f, 0.f};
                            c = __builtin_amdgcn_mfma_f32_16x16x32_bf16(Aq[pr][0], B0[j], c, 0, 0, 0);
                            c = __builtin_amdgcn_mfma_f32_16x16x32_bf16(Aq[pr][1], B1[j], c, 0, 0, 0);
                            part += (fmaxf(c[0], 0.f) * wv[pr][0] + fmaxf(c[1], 0.f) * wv[pr][1]) + (fmaxf(c[2], 0.f) * wv[pr][2] + fmaxf(c[3], 0.f) * wv[pr][3]);
                        }
                        const _Float16 hsc = (_Float16)(part + 0.0f);
                        S16[(4 * qg + g4) * SROW + 16 * kt + l15] = __builtin_bit_cast(unsigned short, hsc);
                    }
                }
            }
#pragma unroll
            for (int j = 0; j < 4; ++j) { B0[j] = N0[j]; B1[j] = N1[j]; }
        }
        }
        __syncthreads();
        for (int qi2 = 0; qi2 < 2; ++qi2) {
            const int ql = wave + 8 * qi2;
            const int qpos = qpos0 + ql, n = qpos + 1; unsigned short* out = idx + (rowq0 + ql) * 256;
            int lk = lane; asm volatile("" : "+v"(lk));
            if (n <= 256) {
#pragma unroll
                for (int i = 0; i < 4; ++i) { const int j = lane + 64 * i; out[j] = (unsigned short)(j < n ? j : 0xFFFF); }
            } else {
                unsigned u[64];
                const int ni = (n + 63) >> 6;
#pragma unroll
                for (int blk = 0; blk < 8; ++blk) {
                    if (blk * 8 < ni) {
#pragma unroll
                        for (int i = blk * 8; i < blk * 8 + 8; ++i) { const int key = lk + 64 * i; unsigned bits = S16[ql * SROW + key]; bits ^= (bits & 0x8000u) ? 0xFFFFu : 0x8000u; u[i] = key < n ? bits : 0u; }
                    } else {
#pragma unroll
                        for (int i = blk * 8; i < blk * 8 + 8; ++i) u[i] = 0u;
                    }
                }
#if TOPK_HIST
                LAS unsigned* hist = (LAS unsigned*)(lds + 131600 + wave * 1024);
                int b1, above1, b2, above2;
                *(LAS u32x4*)(hist + 4 * lane) = (u32x4){0u, 0u, 0u, 0u};
#pragma unroll
                for (int blk = 0; blk < 8; ++blk) {
                    if (blk * 8 < ni) {
#pragma unroll
                        for (int i = blk * 8; i < blk * 8 + 8; ++i) (void)__hip_atomic_fetch_add(hist + (u[i] >> 8), 1u, __ATOMIC_RELAXED, __HIP_MEMORY_SCOPE_WORKGROUP);
                    }
                }
                hist_find(hist, lane, 256, b1, above1);
                *(LAS u32x4*)(hist + 4 * lane) = (u32x4){0u, 0u, 0u, 0u};
#pragma unroll
                for (int blk = 0; blk < 8; ++blk) {
                    if (blk * 8 < ni) {
#pragma unroll
                        for (int i = blk * 8; i < blk * 8 + 8; ++i) { if ((int)(u[i] >> 8) == b1) (void)__hip_atomic_fetch_add(hist + (u[i] & 255u), 1u, __ATOMIC_RELAXED, __HIP_MEMORY_SCOPE_WORKGROUP); }
                    }
                }
                hist_find(hist, lane, 256 - above1, b2, above2);
                const unsigned T = ((unsigned)b1 << 8) | (unsigned)b2;
                const int G = above1 + above2;
#else
                unsigned T = 0u;
                for (int bit = 15; bit >= 0; --bit) {
                    const unsigned cand = __builtin_amdgcn_readfirstlane(T | (1u << bit)); int cnt = 0;
#pragma unroll
                    for (int blk = 0; blk < 8; ++blk) {
                        if (blk * 8 < ni) cnt += cnt_ge8(&u[blk * 8], cand);
                    }
                    if (cnt >= 256) T = cand;
                }
                int G = 0;
#pragma unroll
                for (int i = 0; i < 64; ++i) G += __popcll(__ballot(u[i] > T));
#endif
                const int need = 256 - G; int base = 0, tie_seen = 0;
                const unsigned long long ltmask = (1ull << lane) - 1ull;
#pragma unroll
                for (int blk = 0; blk < 8; ++blk) {
                    if (blk * 8 < ni) {
#pragma unroll
                        for (int i = blk * 8; i < blk * 8 + 8; ++i) {
                            const bool gt = u[i] > T, eq = u[i] == T;
                            const unsigned long long meq = __ballot(eq);
                            const bool sel = gt || (eq && (tie_seen + __popcll(meq & ltmask)) < need);
                            const unsigned long long msel = __ballot(sel);
                            if (sel) out[base + __popcll(msel & ltmask)] = (unsigned short)(lk + 64 * i);
                            base += __popcll(msel); tie_seen += __popcll(meq);
                        }
                    }
                }
            }
        }
        __syncthreads();
    }
}

__device__ void phase_attn(const Params& p, LAS unsigned char* lds, bool dry, int wv) {
    unsigned char* ws = p.ws;
    const int tid = opaque_tid(wv), lane = tid & 63, wave = __builtin_amdgcn_readfirstlane(tid >> 6), g4 = lane >> 4, l15 = lane & 15, q = l15 >> 2, pp = lane & 3;
    bf16_t* din = (bf16_t*)(ws + WS_BIG); const bf16_t* cn = (const bf16_t*)(ws + WS_CN); const unsigned short* idx = (const unsigned short*)(ws + WS_IDX);
    LAS unsigned char* wl = lds + wave * 8192; const unsigned wbase = (unsigned)(size_t)(unsigned char*)lds + wave * 8192;
    const float scale = 0.08838834764f;
    for (int Q = blockIdx.x * 8 + wave; Q < MTOK; Q += gridDim.x * 8) {
        const int b = Q >> 12, qpos = Q & (SEQ - 1); const int nvalid = qpos + 1 < 256 ? qpos + 1 : 256;
        bf16_t* qrow = din + (size_t)Q * DSA_LD;
        bf16x8 Bq[4];
#pragma unroll
        for (int s = 0; s < 4; ++s) Bq[s] = *(const bf16x8*)(qrow + l15 * 128 + 32 * s + 8 * g4);
        f32x4 O[8];
#pragma unroll
        for (int mt = 0; mt < 8; ++mt) O[mt] = (f32x4){0.f, 0.f, 0.f, 0.f};
        float mrun = -1e30f, lrun = 0.f;
        unsigned kid[16];
#pragma unroll
        for (int i = 0; i < 16; ++i) { const int slot = i * 16 + l15; const unsigned v = idx[(size_t)Q * 256 + slot]; kid[i] = slot < nvalid ? v : 0u; }
        bf16x8 A[2][4], An[2][4];
#pragma unroll
        for (int tl = 0; tl < 2; ++tl) { const bf16_t* crow = cn + ((size_t)b * SEQ + kid[tl]) * 128;
#pragma unroll
            for (int s = 0; s < 4; ++s) A[tl][s] = *(const bf16x8*)(crow + 32 * s + 8 * g4); }
#pragma unroll
        for (int ck = 0; ck < 8; ++ck) {
            if (ck * 32 < nvalid) {
                if (ck < 7) {
#pragma unroll
                    for (int tl = 0; tl < 2; ++tl) { const bf16_t* crow = cn + ((size_t)b * SEQ + kid[(ck < 7 ? ck + 1 : ck) * 2 + tl]) * 128;
#pragma unroll
                        for (int s = 0; s < 4; ++s) An[tl][s] = *(const bf16x8*)(crow + 32 * s + 8 * g4); }
                }
                f32x4 S0 = (f32x4){0.f, 0.f, 0.f, 0.f}, S1 = (f32x4){0.f, 0.f, 0.f, 0.f};
#pragma unroll
                for (int s = 0; s < 4; ++s) { S0 = __builtin_amdgcn_mfma_f32_16x16x32_bf16(A[0][s], Bq[s], S0, 0, 0, 0); S1 = __builtin_amdgcn_mfma_f32_16x16x32_bf16(A[1][s], Bq[s], S1, 0, 0, 0); }
#pragma unroll
                for (int tl = 0; tl < 2; ++tl)
#pragma unroll
                    for (int s = 0; s < 4; ++s) *(LAS bf16x8*)(wl + off_b(16 * tl + l15, 4 * s + g4)) = A[tl][s];
                float sv[8];
#pragma unroll
                for (int j = 0; j < 4; ++j) { const int s0 = ck * 32 + 4 * g4 + j; sv[j] = s0 < nvalid ? S0[j] * scale : -1e30f; sv[4 + j] = (s0 + 16) < nvalid ? S1[j] * scale : -1e30f; }
                float cm = fmaxf(fmaxf(fmaxf(sv[0], sv[1]), fmaxf(sv[2], sv[3])), fmaxf(fmaxf(sv[4], sv[5]), fmaxf(sv[6], sv[7])));
                cm = xrow16_max(cm);
                const float mn = fmaxf(mrun, cm), alpha = __expf(mrun - mn);
                float pv[8], ps = 0.f;
#pragma unroll
                for (int j = 0; j < 8; ++j) { pv[j] = __expf(sv[j] - mn); ps += pv[j]; }
                lrun = lrun * alpha + ps; mrun = mn;
#pragma unroll
                for (int mt = 0; mt < 8; ++mt) O[mt] *= alpha;
                union { u32x4 u; bf16x8 h; } Pb;
                Pb.u.x = cvt_pk_bf16(pv[0], pv[1]); Pb.u.y = cvt_pk_bf16(pv[2], pv[3]); Pb.u.z = cvt_pk_bf16(pv[4], pv[5]); Pb.u.w = cvt_pk_bf16(pv[6], pv[7]);
                asm volatile("s_waitcnt lgkmcnt(0)" ::: "memory");
#pragma unroll
                for (int mb = 0; mb < 2; ++mb) {
                    unsigned ad[8]; bf16x8 Av[4];
#pragma unroll
                    for (int i = 0; i < 4; ++i) { const int mt = 4 * mb + i;
                        ad[2 * i] = wbase + off_b(4 * g4 + q, 2 * mt + (pp >> 1)) + 8 * (pp & 1); ad[2 * i + 1] = wbase + off_b(16 + 4 * g4 + q, 2 * mt + (pp >> 1)) + 8 * (pp & 1); }
                    tr_read8(ad, Av);
#pragma unroll
                    for (int i = 0; i < 4; ++i) O[4 * mb + i] = __builtin_amdgcn_mfma_f32_16x16x32_bf16(Av[i], Pb.h, O[4 * mb + i], 0, 0, 0);
                }
                if (ck < 7) {
#pragma unroll
                    for (int tl = 0; tl < 2; ++tl)
#pragma unroll
                        for (int s = 0; s < 4; ++s) A[tl][s] = An[tl][s];
                }
            }
        }
        lrun = xrow16_sum(lrun);
        const float inv = 1.0f / lrun;
#pragma unroll
        for (int mt = 0; mt < 8; ++mt) {
            u32x2 o; o.x = cvt_pk_bf16(O[mt][0] * inv, O[mt][1] * inv); o.y = cvt_pk_bf16(O[mt][2] * inv, O[mt][3] * inv);
            if (!dry) *(u32x2*)(qrow + l15 * 128 + 16 * mt + 4 * g4) = o;
        }
    }
}

__device__ void phase_final(const Params& p, int wv) {
    const int tid = opaque_tid(wv); const int lane = tid & 63, wave = tid >> 6;
    const float* ss = (const float*)(p.ws + WS_SS) + (size_t)8 * MTOK * 16; const bf16_t* xb = (const bf16_t*)(p.ws + WS_XB);
    for (int row = blockIdx.x * 8 + wave; row < MTOK; row += gridDim.x * 8) {
        const float rs = rsqrtf(sum16(ss + (size_t)row * 16) * (1.0f / 1024.0f) + 1e-6f);
        f32x4* orow = (f32x4*)(p.out + (size_t)row * DM);
#pragma unroll
        for (int i = 0; i < 4; ++i) { const f32x4 g = *(const f32x4*)(p.final_g + (lane + 64 * i) * 4); const u32x2 xw = *(const u32x2*)(xb + (size_t)row * DM + (lane + 64 * i) * 4);
            f32x4 v = (f32x4){bflo(xw.x), bfhi(xw.x), bflo(xw.y), bfhi(xw.y)}; v = v * rs * g; orow[lane + 64 * i] = v; }
    }
}

#define XB_TMO      128
#define XB_XCNT(j)  (256  + 64 * (j))
#define XB_XSUB(j)  (1280 + 64 * (j))
#define XB_XGEN(j)  (2304 + 64 * (j))
#define XB_TOP      3328
#define XB_TOPGEN   3392
#define XCD_BAR_WORDS 3456
#define XB_SPIN_CAP (1u << 20)
__device__ __forceinline__ unsigned xb_ld(unsigned* p)              { return __hip_atomic_load(p, __ATOMIC_RELAXED, __HIP_MEMORY_SCOPE_AGENT); }
__device__ __forceinline__ unsigned xb_add(unsigned* p, unsigned v) { return __hip_atomic_fetch_add(p, v, __ATOMIC_RELAXED, __HIP_MEMORY_SCOPE_AGENT); }
__device__ __forceinline__ unsigned xb_xcc_id() { return (unsigned)__builtin_amdgcn_s_getreg((3 << 11) | 20) & 0xFu; }
#define XB_SPIN(cond, bar) do { unsigned _sp = 0; while (cond) { __builtin_amdgcn_s_sleep(1); \
    if ((++_sp & 255u) == 0u) { if (xb_ld(&(bar)[XB_TMO])) break; if (_sp > XB_SPIN_CAP) { atomicAdd(&(bar)[XB_TMO], 1u); break; } } } } while (0)
struct XcdBarrier { unsigned* bar; unsigned x; volatile LAS unsigned* st; };
__device__ __forceinline__ XcdBarrier xcd_barrier_post(unsigned* bar, volatile LAS unsigned* st, bool is_t0) {
    XcdBarrier b; b.bar = bar; b.x = xb_xcc_id(); b.st = st;
    if (is_t0) (void)xb_add(&bar[XB_XCNT(b.x)], 1u);
    return b;
}
__device__ __forceinline__ void xcd_barrier_complete(unsigned* bar, unsigned x, unsigned& nloc, unsigned& nx) {
    const unsigned G = gridDim.x * gridDim.y * gridDim.z;
    unsigned sum, cnt, mine, sp = 0u;
    for (;;) {
        sum = 0u; cnt = 0u; mine = 0u;
#pragma unroll
        for (unsigned j = 0; j < 16; ++j) { const unsigned c = xb_ld(&bar[XB_XCNT(j)]); sum += c; cnt += (c > 0u) ? 1u : 0u; mine = (j == x) ? c : mine; }
        if (sum == G) break;
        __builtin_amdgcn_s_sleep(1);
        if ((++sp & 255u) == 0u) { if (xb_ld(&bar[XB_TMO])) break; if (sp > XB_SPIN_CAP) { atomicAdd(&bar[XB_TMO], 1u); break; } }
    }
    nloc = mine > 0u ? mine : 1u; nx = cnt > 0u ? cnt : 1u;
}
__device__ __forceinline__ void xcd_barrier(const XcdBarrier& b, bool is_t0) {
    asm volatile("s_waitcnt vmcnt(0)" ::: "memory");
    __syncthreads();
    if (is_t0) {
        unsigned* bar = b.bar;
        __builtin_amdgcn_s_waitcnt(0);
        unsigned nloc = b.st[0], nx = b.st[1];
        if (nloc == 0u) { xcd_barrier_complete(bar, b.x, nloc, nx); b.st[0] = nloc; b.st[1] = nx; }
        const unsigned old = xb_add(&bar[XB_XSUB(b.x)], 1u);
        const unsigned gen = old / nloc;
        if (old + 1u == (gen + 1u) * nloc) {
            __builtin_amdgcn_fence(__ATOMIC_RELEASE, "agent");
            asm volatile("s_waitcnt vmcnt(0)" ::: "memory");
            const unsigned og = xb_add(&bar[XB_TOP], 1u);
            const unsigned tg = og / nx;
            if (og + 1u == (tg + 1u) * nx) xb_add(&bar[XB_TOPGEN], 1u);
            else XB_SPIN(xb_ld(&bar[XB_TOPGEN]) == tg, bar);
            __builtin_amdgcn_fence(__ATOMIC_ACQUIRE, "agent");
            xb_add(&bar[XB_XGEN(b.x)], 1u);
            asm volatile("s_waitcnt vmcnt(0)" ::: "memory");
        } else {
            XB_SPIN(xb_ld(&bar[XB_XGEN(b.x)]) == gen, bar);
            __builtin_amdgcn_fence(__ATOMIC_ACQUIRE, "agent");
            asm volatile("s_waitcnt vmcnt(0)" ::: "memory");
        }
    }
    __syncthreads();
}

enum { K_PRO = 0, K_GACT, K_GRES, K_SGU, K_CONV, K_POOL, K_TOPK, K_ATTN, K_FINAL };
struct PhaseDesc { int kind, act, lda, apn, N, K, ldc, ss_idx, m0, M; size_t a_off, w_off; };
__device__ __forceinline__ PhaseDesc mk_act(int act, size_t w_off, int N, int ss_idx) { PhaseDesc d{}; d.kind = K_GACT; d.act = act; d.lda = 1024; d.apn = 0; d.N = N; d.K = 1024; d.ldc = N; d.ss_idx = ss_idx; d.m0 = 0; d.M = MTOK; d.a_off = WS_XB; d.w_off = w_off; return d; }
__device__ __forceinline__ PhaseDesc mk_res(size_t a_off, int lda, int apn, size_t w_off, int K, int ss_idx) { PhaseDesc d{}; d.kind = K_GRES; d.lda = lda; d.apn = apn; d.N = 1024; d.K = K; d.ss_idx = ss_idx; d.m0 = 0; d.M = MTOK; d.a_off = a_off; d.w_off = w_off; return d; }
__device__ __forceinline__ PhaseDesc mk_kind(int kind) { PhaseDesc d{}; d.kind = kind; return d; }
constexpr int MLP_Q = 4, MQ = MTOK / MLP_Q;
__device__ __forceinline__ PhaseDesc mk_mlp(int l, int j) {
    const int q = j >> 1;
    if ((j & 1) == 0) { PhaseDesc d = mk_act(2, W_1 + (size_t)l * 8 * MiB, 4096, 2 * l + 1); d.m0 = q * MQ; d.M = MQ; d.a_off = WS_XB + (size_t)q * MQ * 1024 * 2; return d; }
    PhaseDesc d = mk_res(WS_BIG, 4096, 0, W_2 + (size_t)l * 8 * MiB, 4096, 2 * l + 2); d.m0 = q * MQ; d.M = MQ; return d;
}
__device__ __forceinline__ PhaseDesc phase_desc(int ph) {
    if (ph >= 4 && ph < 12) return mk_mlp(0, ph - 4);
    if (ph >= 15 && ph < 23) return mk_mlp(1, ph - 15);
    if (ph >= 26 && ph < 34) return mk_mlp(2, ph - 26);
    if (ph >= 38 && ph < 46) return mk_mlp(3, ph - 38);
    switch (ph) {
    case 0: return mk_kind(K_PRO);
    case 1: return mk_act(1, W_A_IN, 2048, 0);
    case 2: return mk_kind(K_SGU);
    case 3: return mk_res(WS_BIG + 256 * MiB, 1024, 0, W_A_OUT, 1024, 1);
    case 12: return mk_act(0, W_B_IN, 3072, 2);
    case 13: return mk_kind(K_CONV);
    case 14: return mk_res(WS_BIG + 384 * MiB, 1024, 0, W_B_OUT, 1024, 3);
    case 23: return mk_act(0, W_C_IN, 1024, 4);
    case 24: return mk_kind(K_POOL);
    case 25: return mk_res(WS_BIG + 128 * MiB, 1024, 512, W_C_GRP, 256, 5);
    case 34: return mk_act(0, W_D_IN, DSA_LD, 6);
    case 35: return mk_kind(K_TOPK);
    case 36: return mk_kind(K_ATTN);
    case 37: return mk_res(WS_BIG, DSA_LD, 0, W_D_COMB, 2048, 7);
    default: return mk_kind(K_FINAL);
    }
}

__device__ __forceinline__ void run_phase(int ph, const Params& p, LAS unsigned char* lds, bool dry, int wv) {
    const PhaseDesc d = phase_desc(ph);
    unsigned char* ws = p.ws; float* ss = (float*)(ws + WS_SS);
    if (d.kind == K_GACT || d.kind == K_GRES) {
        pg8::Gemm g; g.A = (const bf16_t*)(ws + d.a_off); g.Bt = (const bf16_t*)(ws + d.w_off); g.M = d.M; g.N = d.N; g.K = d.K; g.lda = d.lda; g.apn = d.apn;
        pg8::StaticOrder S; S.init(d.M, d.N, gridDim.x, blockIdx.x);
        if (d.kind == K_GACT) { pg8::EpiAct E; E.O = (bf16_t*)(ws + WS_BIG); E.ldc = d.ldc; E.ss_in = ss + ((size_t)d.ss_idx * MTOK + d.m0) * 16; E.ssv = ss + (size_t)9 * MTOK * 16; E.ACT = d.act; pg8::gemm_phase(lds, g, S, E, wv); }
        else { pg8::EpiResid E; E.xb = (bf16_t*)(ws + WS_XB) + (size_t)d.m0 * DM; E.ss_out = ss + ((size_t)d.ss_idx * MTOK + d.m0) * 16; pg8::gemm_phase(lds, g, S, E, wv); }
    }
    else if (d.kind == K_PRO) phase_prologue(p, lds, wv);
    else if (d.kind == K_SGU) phase_sgu(p, lds, wv);
    else if (d.kind == K_CONV) phase_conv(p, wv);
    else if (d.kind == K_POOL) phase_pool(p, wv);
    else if (d.kind == K_TOPK) phase_topk(p, lds, wv);
    else if (d.kind == K_ATTN) phase_attn(p, lds, dry, wv);
    else phase_final(p, wv);
}

__global__ void __launch_bounds__(512, 2) fwd_megakernel(Params p) {
    extern __shared__ __attribute__((aligned(16))) unsigned char lds_raw[];
    LAS unsigned char* lds = (LAS unsigned char*)lds_raw;
    const int wv = __builtin_amdgcn_readfirstlane((int)threadIdx.x >> 6);
    volatile LAS unsigned* bst = (volatile LAS unsigned*)(lds + 131584);
    XcdBarrier xbar; xbar.bar = (unsigned*)(p.ws + WS_BAR); xbar.x = 0; xbar.st = bst;
    if (p.ph_hi - p.ph_lo > 1) {
        if (threadIdx.x == 0) { bst[0] = 0u; bst[1] = 0u; }
        if (blockIdx.x == 0) { unsigned* bw = (unsigned*)(p.ws + WS_BAR); for (int i = threadIdx.x; i < XCD_BAR_WORDS; i += 512) bw[i] = 0u; }
        __syncthreads();
    }
    for (int ph = p.ph_lo; ph < p.ph_hi; ++ph) {
#if PROBE_DUP
        const int reps = ((PROBE_DUP >> ph) & 1) ? 2 : 1;
        for (int r = 0; r < reps; ++r) { run_phase(ph, p, lds, r + 1 < reps, wv); if (r + 1 < reps) cg::this_grid().sync(); }
#else
        run_phase(ph, p, lds, false, wv);
#endif
        if (ph + 1 < p.ph_hi) {
            if (ph == p.ph_lo) { cg::this_grid().sync(); xbar = xcd_barrier_post((unsigned*)(p.ws + WS_BAR), bst, opaque_tid(wv) == 0); }
            else xcd_barrier(xbar, opaque_tid(wv) == 0);
        }
    }
}

#ifndef MK_MULTI
#define MK_MULTI 0
#endif

extern "C" void kernel_launch(void* const* d_in, const int* in_sizes, int n_in, void* d_out, int out_size, void* d_ws, size_t ws_size, hipStream_t stream) {
    static int grid = 0;
    if (grid == 0) {
        int dev = 0, cus = 0, per_cu = 0;
        hipGetDevice(&dev);
        hipDeviceGetAttribute(&cus, hipDeviceAttributeMultiprocessorCount, dev);
        if (hipFuncSetAttribute((const void*)fwd_megakernel, hipFuncAttributeMaxDynamicSharedMemorySize, LDS_BYTES) != hipSuccess) { fprintf(stderr, "hipFuncSetAttribute failed\n"); grid = -1; return; }
        if (hipOccupancyMaxActiveBlocksPerMultiprocessor(&per_cu, (const void*)fwd_megakernel, 512, LDS_BYTES) != hipSuccess || per_cu < 1) { fprintf(stderr, "occupancy query: %d\n", per_cu); per_cu = 1; }
        (void)hipGetLastError();
        grid = cus * (per_cu > 1 ? 1 : per_cu);
        if (ws_size < 840 * MiB) { fprintf(stderr, "workspace too small\n"); grid = -1; return; }
    }
    if (grid < 0) return;
    Params p{};
    const float** pp = (const float**)&p;
    for (int i = 0; i < 21; ++i) pp[i] = (const float*)d_in[i];
    p.out = (float*)d_out; p.ws = (unsigned char*)d_ws;
#if MK_MULTI
    for (int ph = 0; ph < NPHASE; ++ph) {
        p.ph_lo = ph; p.ph_hi = ph + 1;
        hipLaunchKernelGGL(fwd_megakernel, dim3(grid), dim3(512), LDS_BYTES, stream, p);
    }
#else
    p.ph_lo = 0; p.ph_hi = NPHASE;
    void* args[] = {&p};
    hipError_t e = hipLaunchCooperativeKernel((const void*)fwd_megakernel, dim3(grid), dim3(512), args, LDS_BYTES, stream);
    if (e != hipSuccess) fprintf(stderr, "cooperative launch failed: %s (grid %d)\n", hipGetErrorString(e), grid);
#endif
}
```

```cpp
#include <hip/hip_runtime.h>
#include <hip/hip_cooperative_groups.h>
#include <cstdio>
namespace cg = cooperative_groups;

#ifndef PROBE_DUP
#define PROBE_DUP 0
#endif
#ifndef TOPK_HIST
#define TOPK_HIST 1
#endif
#ifndef PROBE_TOPK
#define PROBE_TOPK 0
#endif
#define LAS __attribute__((address_space(3)))
typedef unsigned short bf16_t;
typedef short bf16x8 __attribute__((ext_vector_type(8)));
typedef float f32x4 __attribute__((ext_vector_type(4)));
typedef float f32x2 __attribute__((ext_vector_type(2)));
typedef unsigned u32x4 __attribute__((ext_vector_type(4)));
typedef unsigned u32x2 __attribute__((ext_vector_type(2)));
typedef unsigned short u16x4 __attribute__((ext_vector_type(4)));

constexpr int MTOK = 65536, DM = 1024, SEQ = 4096;
constexpr size_t MiB = 1ull << 20;
constexpr size_t WS_XB = 0;
constexpr size_t WS_BIG = 128 * MiB;
constexpr size_t WS_CN = 640 * MiB;
constexpr size_t WS_IDX = 656 * MiB;
constexpr size_t WS_SS = 800 * MiB;
constexpr size_t WS_BAR = 688 * MiB;
constexpr size_t WS_W = 692 * MiB;
constexpr size_t W_A_IN = WS_W + 0 * MiB, W_A_OUT = WS_W + 4 * MiB, W_A_S = WS_W + 6 * MiB, W_B_IN = WS_W + 7 * MiB, W_B_OUT = WS_W + 13 * MiB,
                 W_C_IN = WS_W + 15 * MiB, W_C_GRP = WS_W + 17 * MiB, W_D_IN = WS_W + 18 * MiB, W_D_COMB = WS_W + 24 * MiB, W_1 = WS_W + 28 * MiB, W_2 = WS_W + 60 * MiB;
constexpr int DSA_LD = 2816;
constexpr int LDS_BYTES = 131072 + 1024 + 8192 + 4096;
constexpr int NPHASE = 47;

struct Params {
    const float *x, *norm_mix_g, *norm_mlp_g, *final_g, *a_w_in, *a_v_g, *a_w_s, *a_b_s, *a_w_out, *b_w_in, *b_conv_w, *b_w_out, *c_w_in, *c_w_grp, *c_scale,
        *d_w_in, *d_kv_g, *d_w_uv, *d_w_out, *mlp_w1, *mlp_w2;
    float* out; unsigned char* ws; int ph_lo, ph_hi;
};

__device__ __forceinline__ unsigned cvt_pk_bf16(float lo, float hi) { unsigned r; asm volatile("v_cvt_pk_bf16_f32 %0, %1, %2" : "=v"(r) : "v"(lo), "v"(hi)); return r; }
__device__ __forceinline__ int opaque_tid(int wv) { int l; asm volatile("v_mbcnt_lo_u32_b32 %0, -1, 0\n\tv_mbcnt_hi_u32_b32 %0, -1, %0" : "=v"(l)); return wv * 64 + l; }
__device__ __forceinline__ float bflo(unsigned w) { return __uint_as_float(w << 16); }
__device__ __forceinline__ float bfhi(unsigned w) { return __uint_as_float(w & 0xffff0000u); }
__device__ __forceinline__ float wave_sum(float v) {
#pragma unroll
    for (int o = 32; o; o >>= 1) v += __shfl_xor(v, o);
    return v;
}
__device__ __forceinline__ float sum16(const float* p) { const f32x4 a = *(const f32x4*)p, b = *(const f32x4*)(p + 4), c = *(const f32x4*)(p + 8), d = *(const f32x4*)(p + 12);
    return (((a[0] + a[1]) + (a[2] + a[3])) + ((b[0] + b[1]) + (b[2] + b[3]))) + (((c[0] + c[1]) + (c[2] + c[3])) + ((d[0] + d[1]) + (d[2] + d[3]))); }
__device__ __forceinline__ float xrow16_max(float x) {
    auto s = __builtin_amdgcn_permlane16_swap(__float_as_uint(x), __float_as_uint(x), false, false);
    x = fmaxf(__uint_as_float(s[0]), __uint_as_float(s[1]));
    auto t = __builtin_amdgcn_permlane32_swap(__float_as_uint(x), __float_as_uint(x), false, false);
    return fmaxf(__uint_as_float(t[0]), __uint_as_float(t[1]));
}
__device__ __forceinline__ float xrow16_sum(float x) {
    auto s = __builtin_amdgcn_permlane16_swap(__float_as_uint(x), __float_as_uint(x), false, false);
    x = __uint_as_float(s[0]) + __uint_as_float(s[1]);
    auto t = __builtin_amdgcn_permlane32_swap(__float_as_uint(x), __float_as_uint(x), false, false);
    return __uint_as_float(t[0]) + __uint_as_float(t[1]);
}
__device__ __forceinline__ unsigned off_b(unsigned row, unsigned ch) { return 256u * row + 16u * (ch ^ (((row & 3) << 2) | ((row >> 2) & 3))); }
__device__ __forceinline__ bf16x8 tr_read2(unsigned a0, unsigned a1) {
    u16x4 lo, hi;
    asm volatile("ds_read_b64_tr_b16 %0, %2\n\tds_read_b64_tr_b16 %1, %3\n\ts_waitcnt lgkmcnt(0)" : "=&v"(lo), "=&v"(hi) : "v"(a0), "v"(a1) : "memory");
    bf16x8 r; r[0] = (short)lo[0]; r[1] = (short)lo[1]; r[2] = (short)lo[2]; r[3] = (short)lo[3]; r[4] = (short)hi[0]; r[5] = (short)hi[1]; r[6] = (short)hi[2]; r[7] = (short)hi[3];
    return r;
}
__device__ __forceinline__ void tr_read8(const unsigned (&a)[8], bf16x8 (&r)[4]) {
    u16x4 v0, v1, v2, v3, v4, v5, v6, v7;
    asm volatile("ds_read_b64_tr_b16 %0, %8\n\tds_read_b64_tr_b16 %1, %9\n\tds_read_b64_tr_b16 %2, %10\n\tds_read_b64_tr_b16 %3, %11\n\t"
                 "ds_read_b64_tr_b16 %4, %12\n\tds_read_b64_tr_b16 %5, %13\n\tds_read_b64_tr_b16 %6, %14\n\tds_read_b64_tr_b16 %7, %15\n\ts_waitcnt lgkmcnt(0)"
                 : "=&v"(v0), "=&v"(v1), "=&v"(v2), "=&v"(v3), "=&v"(v4), "=&v"(v5), "=&v"(v6), "=&v"(v7)
                 : "v"(a[0]), "v"(a[1]), "v"(a[2]), "v"(a[3]), "v"(a[4]), "v"(a[5]), "v"(a[6]), "v"(a[7]) : "memory");
    const u16x4 lo[4] = {v0, v2, v4, v6}, hi[4] = {v1, v3, v5, v7};
#pragma unroll
    for (int i = 0; i < 4; ++i) { r[i][0] = (short)lo[i][0]; r[i][1] = (short)lo[i][1]; r[i][2] = (short)lo[i][2]; r[i][3] = (short)lo[i][3]; r[i][4] = (short)hi[i][0]; r[i][5] = (short)hi[i][1]; r[i][6] = (short)hi[i][2]; r[i][7] = (short)hi[i][3]; }
}

namespace pg8 {
constexpr int BM = 256, BK = 64, HALF = 128, HTB = HALF * BK * 2, STAGE_BYTES = 8 * HTB, NXCD = 8, WGM = 8;
__device__ __forceinline__ int lds_byte(int r, int c) { const int st = (r >> 4) * 2 + (c >> 5), rr = r & 15, cc = c & 31, ob = rr * 64 + cc * 2; return st * 1024 + (ob ^ (((ob >> 9) & 1) << 5)); }
__device__ __forceinline__ void stage_rc(int b, int& R, int& C) { const int st = b / 1024, sb = b % 1024, swz = sb ^ (((sb >> 9) & 1) << 5); R = (st >> 1) * 16 + swz / 64; C = (st & 1) * 32 + (swz % 64) / 2; }
__device__ __forceinline__ int perm32(int rho) { const int n = rho >> 4, i = rho & 15; return 8 * (i >> 2) + 4 * n + (i & 3); }
struct Unit { int pm, pn; };
struct Gemm { const bf16_t* A; const bf16_t* Bt; int M, N, K, lda, apn; };
struct StaticOrder {
    int nM, nN, nwg, G, c;
    __device__ void init(int M, int N, int G_, int c_) { nM = M / BM; nN = N / BM; nwg = nM * nN; G = G_; c = c_; }
    __device__ bool next(int i, Unit& u) const {
        const long L = (long)i * G + c; if (L >= nwg) return false;
        int wgid = (int)L; { const int q = nwg / NXCD, r = nwg % NXCD, xcd = wgid % NXCD, off = wgid / NXCD; wgid = (xcd < r ? xcd * (q + 1) : r * (q + 1) + (xcd - r) * q) + off; }
        const int nig = WGM * nN, gid = wgid / nig, fm = gid * WGM, gsz = (nM - fm) < WGM ? (nM - fm) : WGM;
        u.pm = fm + ((wgid % nig) % gsz); u.pn = (wgid % nig) / gsz; return true;
    }
};

__device__ __forceinline__ float gelu_tanh(float x) {
    const float y = 0.7978845608f * (x + 0.044715f * x * x * x);
    const float e = __builtin_amdgcn_exp2f(-2.885390082f * y);
    return x * __builtin_amdgcn_rcpf(1.0f + e);
}
struct EpiAct {
    static constexpr bool PERM = true;
    bf16_t* O; int ldc; const float* ss_in; float* ssv; int ACT;
    __device__ __forceinline__ void operator()(const f32x4 (&acc)[2][2][4][2], const Unit& u, int wr, int wc, int fr, int fq) const {
        const int row0 = u.pm * BM + wr * 64 + fr, col0 = u.pn * BM + wc * 32 + 8 * fq;
        float rsv[2][4];
#pragma unroll
        for (int ai = 0; ai < 2; ++ai)
#pragma unroll
            for (int m = 0; m < 4; ++m) {
                const f32x4 pz = *(const f32x4*)(ss_in + (size_t)(row0 + ai * HALF + m * 16) * 16 + 4 * fq);
                float s = (pz[0] + pz[1]) + (pz[2] + pz[3]); s = xrow16_sum(s);
                rsv[ai][m] = rsqrtf(s * (1.0f / 1024.0f) + 1e-6f);
            }
#pragma unroll
        for (int ai = 0; ai < 2; ++ai)
#pragma unroll
            for (int m = 0; m < 4; ++m) {
                const int row = row0 + ai * HALF + m * 16;
                const float rs = rsv[ai][m];
                bf16_t* rowp = O + (size_t)row * ldc + col0; float sq = 0.f;
#pragma unroll
                for (int bj = 0; bj < 2; ++bj) {
                    f32x4 v0 = acc[ai][bj][m][0] * rs, v1 = acc[ai][bj][m][1] * rs;
                    if (ACT == 1) {
#pragma unroll
                        for (int j = 0; j < 4; ++j) { v0[j] = gelu_tanh(v0[j]); v1[j] = gelu_tanh(v1[j]); sq += v0[j] * v0[j] + v1[j] * v1[j]; }
                    }
                    if (ACT == 2) {
#pragma unroll
                        for (int j = 0; j < 4; ++j) { const float a = fmaxf(v0[j], 0.f), b = fmaxf(v1[j], 0.f); v0[j] = a * a; v1[j] = b * b; }
                    }
                    u32x4 w; w.x = cvt_pk_bf16(v0[0], v0[1]); w.y = cvt_pk_bf16(v0[2], v0[3]); w.z = cvt_pk_bf16(v1[0], v1[1]); w.w = cvt_pk_bf16(v1[2], v1[3]);
                    *(u32x4*)(rowp + bj * HALF) = w;
                }
                if (ACT == 1) {
                    sq = xrow16_sum(sq);
                    if (u.pn >= 4 && fq == 0) ssv[(size_t)row * 16 + (u.pn - 4) * 4 + wc] = sq;
                }
            }
    }
};
struct EpiResid {
    static constexpr bool PERM = false;
    bf16_t* xb; float* ss_out;
    __device__ __forceinline__ void operator()(const f32x4 (&acc)[2][2][4][2], const Unit& u, int wr, int wc, int fr, int fq) const {
        const int row0 = u.pm * BM + wr * 64 + fr, col0 = u.pn * BM + wc * 32 + 4 * fq;
#pragma unroll
        for (int ai = 0; ai < 2; ++ai) {
            u32x2 xo[4][2][2];
#pragma unroll
            for (int m = 0; m < 4; ++m)
#pragma unroll
                for (int bj = 0; bj < 2; ++bj)
#pragma unroll
                    for (int n = 0; n < 2; ++n) xo[m][bj][n] = *(const u32x2*)(xb + (size_t)(row0 + ai * HALF + m * 16) * DM + col0 + bj * HALF + n * 16);
#pragma unroll
            for (int m = 0; m < 4; ++m) {
                const int row = row0 + ai * HALF + m * 16; const size_t off = (size_t)row * DM + col0; float sq = 0.f;
#pragma unroll
                for (int bj = 0; bj < 2; ++bj)
#pragma unroll
                    for (int n = 0; n < 2; ++n) {
                        const u32x2 xw = xo[m][bj][n]; const f32x4 a = acc[ai][bj][m][n];
                        const float v0 = bflo(xw.x) + a[0], v1 = bfhi(xw.x) + a[1], v2 = bflo(xw.y) + a[2], v3 = bfhi(xw.y) + a[3];
                        u32x2 w; w.x = cvt_pk_bf16(v0, v1); w.y = cvt_pk_bf16(v2, v3); *(u32x2*)(xb + off + bj * HALF + n * 16) = w;
                        sq += (v0 * v0 + v1 * v1) + (v2 * v2 + v3 * v3);
                    }
                sq = xrow16_sum(sq);
                if (fq == 0) ss_out[(size_t)row * 16 + u.pn * 4 + wc] = sq;
            }
            asm volatile("" ::: "memory");
        }
    }
};

template <class Epi>
__device__ __forceinline__ void gemm_phase(LAS unsigned char* lds, const Gemm g, const StaticOrder& S, const Epi& E, int wv) {
    const int tid = opaque_tid(wv), wid = __builtin_amdgcn_readfirstlane(tid >> 6), lane = tid & 63, wr = wid >> 2, wc = wid & 3, fr = lane & 15, fq = lane >> 4;
    const int K = g.K, nt = K / BK, lda = g.lda;
    unsigned voffA[2], voffB[2];
#pragma unroll
    for (int i = 0; i < 2; ++i) { int R, C; stage_rc(tid * 16 + i * 8192, R, C); const int Rb = Epi::PERM ? ((R & ~31) + perm32(R & 31)) : R;
        voffA[i] = (unsigned)(R * lda + C) * 2u; voffB[i] = (unsigned)(Rb * K + C) * 2u; }
    const size_t kstep = (size_t)(BK * 2);
    const size_t hstepA = (size_t)HALF * lda * 2, hstepB = (size_t)HALF * K * 2;
    const size_t tstepA = 2 * hstepA, tstepB = 2 * hstepB;
    const unsigned ldsw = (unsigned)wid * 1024u;
    const int aoff = lds_byte(wr * 64 + fr, fq * 8), boff = lds_byte(wc * 32 + fr, fq * 8);
#define PG8_SA(b, h) (((b) * 2 + (h)) * HTB)
#define PG8_SB(b, h) ((4 + (b) * 2 + (h)) * HTB)
#define PG8_STAGE(bufoff, gbase, voff) do { _Pragma("unroll") for (int _i = 0; _i < 2; ++_i) \
        __builtin_amdgcn_global_load_lds((const unsigned*)((const char*)(gbase) + (voff)[_i]), (LAS unsigned*)(lds + (bufoff) + ldsw + _i * 8192), 16, 0, 0); } while (0)
#define PG8_LDA(dst, b, h) do { _Pragma("unroll") for (int m = 0; m < 4; ++m) _Pragma("unroll") for (int k = 0; k < 2; ++k) dst[m][k] = *(const LAS bf16x8*)(lds + PG8_SA(b, h) + aoff + m * 2048 + k * 1024); } while (0)
#define PG8_LDB(dst, b, h) do { _Pragma("unroll") for (int n = 0; n < 2; ++n) _Pragma("unroll") for (int k = 0; k < 2; ++k) dst[n][k] = *(const LAS bf16x8*)(lds + PG8_SB(b, h) + boff + n * 2048 + k * 1024); } while (0)
#define PG8_MMA(ai, bj, At, Bt) do { __builtin_amdgcn_s_setprio(1); _Pragma("unroll") for (int m = 0; m < 4; ++m) _Pragma("unroll") for (int n = 0; n < 2; ++n) _Pragma("unroll") for (int k = 0; k < 2; ++k) \
        acc[ai][bj][m][n] = __builtin_amdgcn_mfma_f32_16x16x32_bf16(Bt[n][k], At[m][k], acc[ai][bj][m][n], 0, 0, 0); __builtin_amdgcn_s_setprio(0); } while (0)
#define PG8_WAIT_V(n) asm volatile("s_waitcnt vmcnt(" #n ")" ::: "memory")
#define PG8_WAIT_L(n) asm volatile("s_waitcnt lgkmcnt(" #n ")" ::: "memory")
#define PG8_BAR __builtin_amdgcn_s_barrier()
#define PG8_SCHED __builtin_amdgcn_sched_barrier(0)
    Unit cur, nxt; int ui = 0;
    if (!S.next(0, cur)) return;
    f32x4 acc[2][2][4][2];
#pragma unroll
    for (int a = 0; a < 2; ++a)
#pragma unroll
        for (int b = 0; b < 2; ++b)
#pragma unroll
            for (int m = 0; m < 4; ++m)
#pragma unroll
                for (int n = 0; n < 2; ++n) acc[a][b][m][n] = (f32x4){0.f, 0.f, 0.f, 0.f};
    bf16x8 At[4][2], B0[2][2], B1[2][2];
    const char* cA = (const char*)g.A + (size_t)cur.pm * tstepA + (size_t)cur.pn * g.apn; const char* cB = (const char*)g.Bt + (size_t)cur.pn * tstepB;
    PG8_STAGE(PG8_SB(0, 0), cB, voffB); PG8_STAGE(PG8_SA(0, 0), cA, voffA); PG8_STAGE(PG8_SB(0, 1), cB + hstepB, voffB); PG8_STAGE(PG8_SA(0, 1), cA + hstepA, voffA);
    if (wr == 1) PG8_BAR;
    PG8_WAIT_V(4); PG8_BAR;
    PG8_STAGE(PG8_SB(1, 0), cB + kstep, voffB); PG8_STAGE(PG8_SA(1, 0), cA + kstep, voffA); PG8_STAGE(PG8_SB(1, 1), cB + hstepB + kstep, voffB);
    PG8_WAIT_V(6); PG8_BAR;
    for (;;) {
        const bool has_next = S.next(ui + 1, nxt);
        const char* nA = has_next ? (const char*)g.A + (size_t)nxt.pm * tstepA + (size_t)nxt.pn * g.apn : cA; const char* nB = has_next ? (const char*)g.Bt + (size_t)nxt.pn * tstepB : cB;
        for (int t = 0; t < nt; t += 2) {
            const bool last = (t == nt - 2);
            const char* a1 = cA + (size_t)(t + 1) * kstep;
            const char* a2 = last ? nA : cA + (size_t)(t + 2) * kstep; const char* b2 = last ? nB : cB + (size_t)(t + 2) * kstep;
            const char* a3 = a2 + kstep; const char* b3 = b2 + kstep;
            PG8_LDB(B0, 0, 0); PG8_SCHED; PG8_LDA(At, 0, 0); PG8_STAGE(PG8_SA(1, 1), a1 + hstepA, voffA);
            PG8_WAIT_L(8); PG8_BAR; PG8_WAIT_L(0); PG8_MMA(0, 0, At, B0); PG8_BAR; PG8_SCHED;
            PG8_LDB(B1, 0, 1); PG8_STAGE(PG8_SB(0, 0), b2, voffB);
            PG8_BAR; PG8_WAIT_L(0); PG8_MMA(0, 1, At, B1); PG8_BAR;
            PG8_LDA(At, 0, 1); PG8_STAGE(PG8_SA(0, 0), a2, voffA);
            PG8_BAR; PG8_WAIT_L(0); PG8_MMA(1, 0, At, B0); PG8_BAR; PG8_SCHED;
            PG8_STAGE(PG8_SB(0, 1), b2 + hstepB, voffB);
            PG8_WAIT_V(6); PG8_BAR; PG8_MMA(1, 1, At, B1); PG8_BAR;
            PG8_LDB(B0, 1, 0); PG8_SCHED; PG8_LDA(At, 1, 0); PG8_STAGE(PG8_SA(0, 1), a2 + hstepA, voffA);
            PG8_WAIT_L(8); PG8_BAR; PG8_WAIT_L(0); PG8_MMA(0, 0, At, B0); PG8_BAR; PG8_SCHED;
            PG8_LDB(B1, 1, 1); PG8_STAGE(PG8_SB(1, 0), b3, voffB);
            PG8_BAR; PG8_WAIT_L(0); PG8_MMA(0, 1, At, B1); PG8_BAR;
            PG8_LDA(At, 1, 1); PG8_STAGE(PG8_SA(1, 0), a3, voffA);
            PG8_BAR; PG8_WAIT_L(0); PG8_MMA(1, 0, At, B0); PG8_BAR; PG8_SCHED;
            PG8_STAGE(PG8_SB(1, 1), b3 + hstepB, voffB);
            PG8_WAIT_V(6); PG8_BAR; PG8_MMA(1, 1, At, B1); PG8_BAR;
        }
        E(acc, cur, wr, wc, fr, fq);
        if (!has_next) break;
#pragma unroll
        for (int a = 0; a < 2; ++a)
#pragma unroll
            for (int b = 0; b < 2; ++b)
#pragma unroll
                for (int m = 0; m < 4; ++m)
#pragma unroll
                    for (int n = 0; n < 2; ++n) acc[a][b][m][n] = (f32x4){0.f, 0.f, 0.f, 0.f};
        cur = nxt; cA = nA; cB = nB; ++ui;
    }
    PG8_WAIT_V(0);
    if (wr == 0) PG8_BAR;
    PG8_BAR;
#undef PG8_SA
#undef PG8_SB
#undef PG8_STAGE
#undef PG8_LDA
#undef PG8_LDB
#undef PG8_MMA
#undef PG8_WAIT_V
#undef PG8_WAIT_L
#undef PG8_BAR
#undef PG8_SCHED
}
}

__device__ void transpose_convert(int gw, int nw, int lane, const float* W, int K, int N, int Npad, bf16_t* Wt, int ldt, const float* rowgain, const float* colgain) {
    const int kb_n = K / 16, units = kb_n * (Npad / 256);
    for (int u = gw; u < units; u += nw) {
        const int k0 = (u % kb_n) * 16, n = (u / kb_n) * 256 + 4 * lane;
        f32x4 v[16];
        if (n < N) {
#pragma unroll
            for (int i = 0; i < 16; ++i) v[i] = *(const f32x4*)(W + (size_t)(k0 + i) * N + n);
            if (rowgain) {
#pragma unroll
                for (int i = 0; i < 16; ++i) v[i] *= rowgain[k0 + i];
            }
            if (colgain) { const f32x4 cgv = *(const f32x4*)(colgain + n);
#pragma unroll
                for (int i = 0; i < 16; ++i) v[i] *= cgv; }
        } else {
#pragma unroll
            for (int i = 0; i < 16; ++i) v[i] = (f32x4){0.f, 0.f, 0.f, 0.f};
        }
#pragma unroll
        for (int j = 0; j < 4; ++j) {
            u32x4 w0, w1; w0.x = cvt_pk_bf16(v[0][j], v[1][j]); w0.y = cvt_pk_bf16(v[2][j], v[3][j]); w0.z = cvt_pk_bf16(v[4][j], v[5][j]); w0.w = cvt_pk_bf16(v[6][j], v[7][j]);
            w1.x = cvt_pk_bf16(v[8][j], v[9][j]); w1.y = cvt_pk_bf16(v[10][j], v[11][j]); w1.z = cvt_pk_bf16(v[12][j], v[13][j]); w1.w = cvt_pk_bf16(v[14][j], v[15][j]);
            u32x4* dst = (u32x4*)(Wt + (size_t)(n + j) * ldt + k0); dst[0] = w0; dst[1] = w1;
        }
    }
}

__device__ void phase_prologue(const Params& p, LAS unsigned char* lds, int wv) {
    unsigned char* ws = p.ws;
    const int tid = opaque_tid(wv), lane = tid & 63, wave = tid >> 6;
    const int gw = blockIdx.x * 8 + wave, nw = gridDim.x * 8;
    const size_t gtid = (size_t)blockIdx.x * 512 + tid, gsz = (size_t)gridDim.x * 512;
    float* ss = (float*)(ws + WS_SS);
    bf16_t* xb = (bf16_t*)(ws + WS_XB);
    for (int row2 = (blockIdx.x * 8 + wave) * 2; row2 < MTOK; row2 += gridDim.x * 16) {
        f32x4 xv[2][4];
#pragma unroll
        for (int k = 0; k < 2; ++k)
#pragma unroll
            for (int i = 0; i < 4; ++i) xv[k][i] = ((const f32x4*)(p.x + (size_t)(row2 + k) * DM))[lane + 64 * i];
#pragma unroll
        for (int k = 0; k < 2; ++k) { const int row = row2 + k; float sq = 0.f;
#pragma unroll
            for (int i = 0; i < 4; ++i) { const f32x4 v = xv[k][i]; sq += (v[0] * v[0] + v[1] * v[1]) + (v[2] * v[2] + v[3] * v[3]);
                u32x2 w; w.x = cvt_pk_bf16(v[0], v[1]); w.y = cvt_pk_bf16(v[2], v[3]); *(u32x2*)(xb + (size_t)row * DM + (lane + 64 * i) * 4) = w; }
            sq = wave_sum(sq);
            if (lane < 16) ss[(size_t)row * 16 + lane] = lane == 0 ? sq : 0.f; }
    }
    transpose_convert(gw, nw, lane, p.a_w_in, 1024, 2048, 2048, (bf16_t*)(ws + W_A_IN), 1024, p.norm_mix_g + 0 * DM, nullptr);
    transpose_convert(gw, nw, lane, p.a_w_out, 1024, 1024, 1024, (bf16_t*)(ws + W_A_OUT), 1024, nullptr, nullptr);
    transpose_convert(gw, nw, lane, p.b_w_in, 1024, 3072, 3072, (bf16_t*)(ws + W_B_IN), 1024, p.norm_mix_g + 1 * DM, nullptr);
    transpose_convert(gw, nw, lane, p.b_w_out, 1024, 1024, 1024, (bf16_t*)(ws + W_B_OUT), 1024, nullptr, nullptr);
    transpose_convert(gw, nw, lane, p.c_w_in, 1024, 1024, 1024, (bf16_t*)(ws + W_C_IN), 1024, p.norm_mix_g + 2 * DM, nullptr);
    for (int g = 0; g < 4; ++g)
        transpose_convert(gw, nw, lane, p.c_w_grp + (size_t)g * 65536, 256, 256, 256, (bf16_t*)(ws + W_C_GRP) + (size_t)g * 65536, 256, nullptr, p.c_scale + g * 256);
    transpose_convert(gw, nw, lane, p.d_w_in, 1024, 2760, DSA_LD, (bf16_t*)(ws + W_D_IN), 1024, p.norm_mix_g + 3 * DM, nullptr);
    for (int l = 0; l < 4; ++l) {
        transpose_convert(gw, nw, lane, p.mlp_w1 + (size_t)l * 4194304, 1024, 4096, 4096, (bf16_t*)(ws + W_1) + (size_t)l * 4194304, 1024, p.norm_mlp_g + l * DM, nullptr);
        transpose_convert(gw, nw, lane, p.mlp_w2 + (size_t)l * 4194304, 4096, 1024, 1024, (bf16_t*)(ws + W_2) + (size_t)l * 4194304, 4096, nullptr, nullptr);
    }
    { bf16_t* wsm = (bf16_t*)(ws + W_A_S);
      for (size_t i = gtid; i < (size_t)8 * 128 * 128; i += gsz) { const int s = (int)(i & 127), t = (int)((i >> 7) & 127); const float v = (s <= t) ? p.a_w_s[i] : 0.f; wsm[i] = (bf16_t)(cvt_pk_bf16(v, 0.f) & 0xffffu); } }
    { bf16_t* wc = (bf16_t*)(ws + W_D_COMB);
      for (int u = gw; u < 256 * 4; u += nw) {
          const int k0 = (u >> 2) * 8, n = (u & 3) * 256 + 4 * lane, h = k0 >> 7;
          const float* uv = p.d_w_uv + (size_t)k0 * 64; const float* wo = p.d_w_out + (size_t)h * 64 * 1024 + n;
          f32x4 a[8]; float uvr[8];
#pragma unroll
          for (int i = 0; i < 8; ++i) { a[i] = (f32x4){0.f, 0.f, 0.f, 0.f}; uvr[i] = uv[i * 64 + lane]; }
#pragma unroll 8
          for (int v = 0; v < 64; ++v) { const f32x4 w4 = *(const f32x4*)(wo + (size_t)v * 1024);
#pragma unroll
              for (int i = 0; i < 8; ++i) a[i] += w4 * __uint_as_float(__builtin_amdgcn_readlane(__float_as_uint(uvr[i]), v)); }
#pragma unroll
          for (int j = 0; j < 4; ++j) {
              u32x4 w; w.x = cvt_pk_bf16(a[0][j], a[1][j]); w.y = cvt_pk_bf16(a[2][j], a[3][j]); w.z = cvt_pk_bf16(a[4][j], a[5][j]); w.w = cvt_pk_bf16(a[6][j], a[7][j]);
              *(u32x4*)(wc + (size_t)(n + j) * 2048 + k0) = w; } } }
}

__device__ void phase_sgu(const Params& p, LAS unsigned char* lds, int wv) {
    unsigned char* ws = p.ws;
    const int tid = opaque_tid(wv), lane = tid & 63, wave = __builtin_amdgcn_readfirstlane(tid >> 6), g4 = lane >> 4, l15 = lane & 15, q = l15 >> 2, pp = lane & 3;
    const bf16_t* z = (const bf16_t*)(ws + WS_BIG); bf16_t* us = (bf16_t*)(ws + WS_BIG + 256 * MiB);
    const float* ssv = (const float*)(ws + WS_SS) + (size_t)9 * MTOK * 16; const bf16_t* wsm = (const bf16_t*)(ws + W_A_S);
    const unsigned ldsbase = (unsigned)(size_t)(unsigned char*)lds;
    u32x4 raw[4]; float ssum[4];
    if ((int)blockIdx.x < 4096) { const int g = blockIdx.x & 7; const size_t row0 = (size_t)(blockIdx.x >> 3) * 128;
#pragma unroll
        for (int i = 0; i < 4; ++i) { const int e = tid + 512 * i, r = e >> 4, ch = e & 15;
            raw[i] = *(const u32x4*)(z + (row0 + r) * 2048 + 1024 + g * 128 + ch * 8); ssum[i] = sum16(ssv + (row0 + r) * 16); } }
    for (int unit = blockIdx.x; unit < 4096; unit += gridDim.x) {
        const int g = unit & 7, chunk = unit >> 3; const size_t row0 = (size_t)chunk * 128;
#pragma unroll
        for (int i = 0; i < 4; ++i) {
            const int e = tid + 512 * i, r = e >> 4, ch = e & 15;
            const float rs = rsqrtf(ssum[i] * (1.0f / 1024.0f) + 1e-6f);
            const f32x4 g0 = *(const f32x4*)(p.a_v_g + g * 128 + ch * 8), g1 = *(const f32x4*)(p.a_v_g + g * 128 + ch * 8 + 4);
            u32x4 o;
            o.x = cvt_pk_bf16(bflo(raw[i].x) * rs * g0[0], bfhi(raw[i].x) * rs * g0[1]); o.y = cvt_pk_bf16(bflo(raw[i].y) * rs * g0[2], bfhi(raw[i].y) * rs * g0[3]);
            o.z = cvt_pk_bf16(bflo(raw[i].z) * rs * g1[0], bfhi(raw[i].z) * rs * g1[1]); o.w = cvt_pk_bf16(bflo(raw[i].w) * rs * g1[2], bfhi(raw[i].w) * rs * g1[3]);
            *(LAS u32x4*)(lds + (r >> 5) * 8192 + off_b(r & 31, ch)) = o;
        }
        __syncthreads();
        const int t = 16 * wave + l15, nks = (wave >> 1) + 1;
        const float bias = p.a_b_s[g * 128 + t]; const size_t rowg = row0 + t;
        u32x2 uu8[8]; bf16x8 Bw4[4];
#pragma unroll
        for (int ks = 0; ks < 4; ++ks) Bw4[ks] = *(const bf16x8*)(wsm + ((size_t)g * 128 + t) * 128 + 32 * (ks < nks ? ks : 0) + 8 * g4);
#pragma unroll
        for (int ct = 0; ct < 8; ++ct) uu8[ct] = *(const u32x2*)(z + rowg * 2048 + g * 128 + 16 * ct + 4 * g4);
        { const int nu = unit + (int)gridDim.x;
          if (nu < 4096) { const int g2 = nu & 7; const size_t r2 = (size_t)(nu >> 3) * 128;
#pragma unroll
              for (int i = 0; i < 4; ++i) { const int e = tid + 512 * i, r = e >> 4, ch = e & 15;
                  raw[i] = *(const u32x4*)(z + (r2 + r) * 2048 + 1024 + g2 * 128 + ch * 8); ssum[i] = sum16(ssv + (r2 + r) * 16); } } }
        f32x4 acc[8];
#pragma unroll
        for (int ct = 0; ct < 8; ++ct) acc[ct] = (f32x4){0.f, 0.f, 0.f, 0.f};
#pragma unroll
        for (int ks = 0; ks < 4; ++ks) {
            if (ks < nks) {
                const bf16x8 Bw = Bw4[ks];
#pragma unroll
                for (int cb = 0; cb < 2; ++cb) {
                    unsigned ad[8]; bf16x8 Av[4];
#pragma unroll
                    for (int i = 0; i < 4; ++i) { const int ct = 4 * cb + i;
                        ad[2 * i] = ldsbase + ks * 8192 + off_b(8 * g4 + q, 2 * ct + (pp >> 1)) + 8 * (pp & 1); ad[2 * i + 1] = ldsbase + ks * 8192 + off_b(8 * g4 + 4 + q, 2 * ct + (pp >> 1)) + 8 * (pp & 1); }
                    tr_read8(ad, Av);
#pragma unroll
                    for (int i = 0; i < 4; ++i) acc[4 * cb + i] = __builtin_amdgcn_mfma_f32_16x16x32_bf16(Av[i], Bw, acc[4 * cb + i], 0, 0, 0);
                }
            }
        }
#pragma unroll
        for (int ct = 0; ct < 8; ++ct) {
            const u32x2 uu = uu8[ct];
            u32x2 o; o.x = cvt_pk_bf16(bflo(uu.x) * (acc[ct][0] + bias), bfhi(uu.x) * (acc[ct][1] + bias)); o.y = cvt_pk_bf16(bflo(uu.y) * (acc[ct][2] + bias), bfhi(uu.y) * (acc[ct][3] + bias));
            *(u32x2*)(us + rowg * 1024 + g * 128 + 16 * ct + 4 * g4) = o;
        }
        __syncthreads();
    }
}

__device__ void phase_conv(const Params& p, int wv) {
    unsigned char* ws = p.ws; const bf16_t* bch = (const bf16_t*)(ws + WS_BIG); bf16_t* gated = (bf16_t*)(ws + WS_BIG + 384 * MiB);
    const size_t gtid = (size_t)blockIdx.x * 512 + opaque_tid(wv), gsz = (size_t)gridDim.x * 512;
    for (size_t it = gtid; it < (size_t)4096 * 128; it += gsz) {
        const int ch = (int)(it & 127) * 8, rb = (int)(it >> 7); const int r0 = rb * 16;
        float w0[8], w1[8], w2[8], zm2[8], zm1[8];
#pragma unroll
        for (int j = 0; j < 8; ++j) { w0[j] = p.b_conv_w[ch + j]; w1[j] = p.b_conv_w[1024 + ch + j]; w2[j] = p.b_conv_w[2048 + ch + j]; zm2[j] = 0.f; zm1[j] = 0.f; }
        const int tpos0 = r0 & (SEQ - 1);
        for (int d = 2; d >= 1; --d) {
            if (tpos0 - d >= 0) {
                const bf16_t* rp = bch + (size_t)(r0 - d) * 3072; const u32x4 c = *(const u32x4*)(rp + 1024 + ch), h = *(const u32x4*)(rp + 2048 + ch);
                float zz[8] = {bflo(c.x) * bflo(h.x), bfhi(c.x) * bfhi(h.x), bflo(c.y) * bflo(h.y), bfhi(c.y) * bfhi(h.y), bflo(c.z) * bflo(h.z), bfhi(c.z) * bfhi(h.z), bflo(c.w) * bflo(h.w), bfhi(c.w) * bfhi(h.w)};
#pragma unroll
                for (int j = 0; j < 8; ++j) { if (d == 2) zm2[j] = zz[j]; else zm1[j] = zz[j]; }
            }
        }
        for (int r4 = r0; r4 < r0 + 16; r4 += 4) {
            u32x4 bq[4], cq[4], hq[4];
#pragma unroll
            for (int k = 0; k < 4; ++k) { const bf16_t* rp = bch + (size_t)(r4 + k) * 3072; bq[k] = *(const u32x4*)(rp + ch); cq[k] = *(const u32x4*)(rp + 1024 + ch); hq[k] = *(const u32x4*)(rp + 2048 + ch); }
#pragma unroll
            for (int k = 0; k < 4; ++k) {
                const u32x4 b = bq[k], c = cq[k], h = hq[k];
                float zz[8] = {bflo(c.x) * bflo(h.x), bfhi(c.x) * bfhi(h.x), bflo(c.y) * bflo(h.y), bfhi(c.y) * bfhi(h.y), bflo(c.z) * bflo(h.z), bfhi(c.z) * bfhi(h.z), bflo(c.w) * bflo(h.w), bfhi(c.w) * bfhi(h.w)};
                float bb[8] = {bflo(b.x), bfhi(b.x), bflo(b.y), bfhi(b.y), bflo(b.z), bfhi(b.z), bflo(b.w), bfhi(b.w)};
                float o[8];
#pragma unroll
                for (int j = 0; j < 8; ++j) { o[j] = bb[j] * (w0[j] * zm2[j] + w1[j] * zm1[j] + w2[j] * zz[j]); zm2[j] = zm1[j]; zm1[j] = zz[j]; }
                u32x4 w; w.x = cvt_pk_bf16(o[0], o[1]); w.y = cvt_pk_bf16(o[2], o[3]); w.z = cvt_pk_bf16(o[4], o[5]); w.w = cvt_pk_bf16(o[6], o[7]);
                *(u32x4*)(gated + (size_t)(r4 + k) * 1024 + ch) = w;
            }
        }
    }
}

__device__ __forceinline__ void ld8(const bf16_t* ptr, float (&f)[8]) {
    const u32x4 v = *(const u32x4*)ptr; f[0] = bflo(v.x); f[1] = bfhi(v.x); f[2] = bflo(v.y); f[3] = bfhi(v.y); f[4] = bflo(v.z); f[5] = bfhi(v.z); f[6] = bflo(v.w); f[7] = bfhi(v.w);
}
__device__ void phase_pool(const Params& p, int wv) {
    unsigned char* ws = p.ws; const bf16_t* z = (const bf16_t*)(ws + WS_BIG); bf16_t* pooled = (bf16_t*)(ws + WS_BIG + 128 * MiB);
    const size_t gtid = (size_t)blockIdx.x * 512 + opaque_tid(wv), gsz = (size_t)gridDim.x * 512;
    for (size_t it = gtid; it < (size_t)2048 * 128; it += gsz) {
        const int lane = (int)(it & 63), wv = (int)(it >> 6), chunk = (wv & 3) * 32 + (lane & 31), rb = (wv >> 2) * 2 + (lane >> 5);
        const int ch = chunk * 8, w = 2 << (ch >> 8), r0 = rb * 32;
        float S[8];
#pragma unroll
        for (int j = 0; j < 8; ++j) S[j] = 0.f;
        const int tpos0 = r0 & (SEQ - 1);
        for (int d = 1; d <= w; ++d) {
            if (tpos0 - d >= 0) { float f[8]; ld8(z + (size_t)(r0 - d) * 1024 + ch, f);
#pragma unroll
                for (int j = 0; j < 8; ++j) S[j] += f[j]; }
        }
        for (int r4 = r0; r4 < r0 + 32; r4 += 4) {
            u32x4 fa[4], oa[4];
#pragma unroll
            for (int k = 0; k < 4; ++k) { const int r = r4 + k; fa[k] = *(const u32x4*)(z + (size_t)r * 1024 + ch);
                const int rr = ((r & (SEQ - 1)) - w >= 0) ? r - w : r; oa[k] = *(const u32x4*)(z + (size_t)rr * 1024 + ch); }
#pragma unroll
            for (int k = 0; k < 4; ++k) {
                const int r = r4 + k, tpos = r & (SEQ - 1);
                float f[8] = {bflo(fa[k].x), bfhi(fa[k].x), bflo(fa[k].y), bfhi(fa[k].y), bflo(fa[k].z), bfhi(fa[k].z), bflo(fa[k].w), bfhi(fa[k].w)};
#pragma unroll
                for (int j = 0; j < 8; ++j) S[j] += f[j];
                if (tpos - w >= 0) { float o[8] = {bflo(oa[k].x), bfhi(oa[k].x), bflo(oa[k].y), bfhi(oa[k].y), bflo(oa[k].z), bfhi(oa[k].z), bflo(oa[k].w), bfhi(oa[k].w)};
#pragma unroll
                    for (int j = 0; j < 8; ++j) S[j] -= o[j]; }
                const int cnt = (tpos + 1 < w) ? tpos + 1 : w; const float inv = 1.0f / (float)cnt;
                u32x4 o; o.x = cvt_pk_bf16(S[0] * inv - f[0], S[1] * inv - f[1]); o.y = cvt_pk_bf16(S[2] * inv - f[2], S[3] * inv - f[3]);
                o.z = cvt_pk_bf16(S[4] * inv - f[4], S[5] * inv - f[5]); o.w = cvt_pk_bf16(S[6] * inv - f[6], S[7] * inv - f[7]);
                *(u32x4*)(pooled + (size_t)r * 1024 + ch) = o;
            }
        }
    }
}

__device__ __forceinline__ int cnt_ge8(const unsigned* v, unsigned cand) {
    unsigned long long m0, m1, m2, m3, m4, m5, m6, m7;
    asm("v_cmp_le_u32_e64 %0, %8, %9\n\tv_cmp_le_u32_e64 %1, %8, %10\n\tv_cmp_le_u32_e64 %2, %8, %11\n\tv_cmp_le_u32_e64 %3, %8, %12\n\t"
        "v_cmp_le_u32_e64 %4, %8, %13\n\tv_cmp_le_u32_e64 %5, %8, %14\n\tv_cmp_le_u32_e64 %6, %8, %15\n\tv_cmp_le_u32_e64 %7, %8, %16"
        : "=&s"(m0), "=&s"(m1), "=&s"(m2), "=&s"(m3), "=&s"(m4), "=&s"(m5), "=&s"(m6), "=&s"(m7)
        : "s"(cand), "v"(v[0]), "v"(v[1]), "v"(v[2]), "v"(v[3]), "v"(v[4]), "v"(v[5]), "v"(v[6]), "v"(v[7]));
    return (__builtin_popcountll(m0) + __builtin_popcountll(m1)) + (__builtin_popcountll(m2) + __builtin_popcountll(m3)) +
           (__builtin_popcountll(m4) + __builtin_popcountll(m5)) + (__builtin_popcountll(m6) + __builtin_popcountll(m7));
}
__device__ __forceinline__ void hist_find(LAS unsigned* hist, int lane, int target, int& bin, int& above) {
    const u32x4 h = *(LAS u32x4*)(hist + 4 * lane);
    const int tot = (int)(h.x + h.y + h.z + h.w);
    int suf = tot;
    suf += __builtin_amdgcn_update_dpp(0, suf, 0x101, 0xf, 0xf, true);
    suf += __builtin_amdgcn_update_dpp(0, suf, 0x102, 0xf, 0xf, true);
    suf += __builtin_amdgcn_update_dpp(0, suf, 0x104, 0xf, 0xf, true);
    suf += __builtin_amdgcn_update_dpp(0, suf, 0x108, 0xf, 0xf, true);
    { const int r1 = __builtin_amdgcn_readlane(suf, 16), r2 = __builtin_amdgcn_readlane(suf, 32), r3 = __builtin_amdgcn_readlane(suf, 48); const int g = lane >> 4;
      suf += (g == 0) ? (r1 + r2 + r3) : (g == 1) ? (r2 + r3) : (g == 2) ? r3 : 0; }
    const int excl = suf - tot;
    const bool mine = (excl < target) && (suf >= target);
    int b, ab, c = excl;
    if (c + (int)h.w >= target) { b = 3; ab = c; } else { c += (int)h.w;
        if (c + (int)h.z >= target) { b = 2; ab = c; } else { c += (int)h.z;
            if (c + (int)h.y >= target) { b = 1; ab = c; } else { c += (int)h.y; b = 0; ab = c; } } }
    const unsigned long long m = __ballot(mine);
    const int src = m ? (int)__ffsll((long long)m) - 1 : 0;
    bin = __builtin_amdgcn_readlane(4 * lane + b, src); above = __builtin_amdgcn_readlane(ab, src);
}
__device__ void phase_topk(const Params& p, LAS unsigned char* lds, int wv) {
    unsigned char* ws = p.ws;
    const int tid = opaque_tid(wv), lane = tid & 63, wave = __builtin_amdgcn_readfirstlane(tid >> 6), g4 = lane >> 4, l15 = lane & 15;
    const bf16_t* din = (const bf16_t*)(ws + WS_BIG); bf16_t* cn = (bf16_t*)(ws + WS_CN); unsigned short* idx = (unsigned short*)(ws + WS_IDX);
    LAS unsigned short* S16 = (LAS unsigned short*)lds;
    constexpr int SROW = 4112;
    { const float kg0 = p.d_kv_g[2 * lane], kg1 = p.d_kv_g[2 * lane + 1];
      for (int row4 = (blockIdx.x * 8 + wave) * 4; row4 < MTOK; row4 += gridDim.x * 32) {
        unsigned raw[4];
#pragma unroll
        for (int j = 0; j < 4; ++j) raw[j] = *(const unsigned*)(din + (size_t)(row4 + j) * DSA_LD + 2048 + 2 * lane);
#pragma unroll
        for (int j = 0; j < 4; ++j) { const float a = bflo(raw[j]), b = bfhi(raw[j]);
            const float sq = wave_sum(a * a + b * b); const float rs = rsqrtf(sq * (1.0f / 128.0f) + 1e-6f);
            *(unsigned*)(cn + (size_t)(row4 + j) * 128 + 2 * lane) = cvt_pk_bf16(a * rs * kg0, b * rs * kg1); }
      } }
    for (int unit = blockIdx.x; unit < 4096; unit += gridDim.x) {
        const bool tiled = (4096 % (2 * (int)gridDim.x)) == 0;
        const int pi = tiled ? (unit / (2 * (int)gridDim.x)) * (int)gridDim.x + (unit % (int)gridDim.x) : (unit >> 1), hi = tiled ? (unit / (int)gridDim.x) & 1 : (unit & 1);
        const int b = pi >> 7, cc = pi & 127, qt = hi ? 255 - cc : cc, qpos0 = qt * 16; const size_t rowq0 = (size_t)b * SEQ + qpos0;
        bf16x8 Aq[8][2]; float wv[8][4];
#pragma unroll
        for (int pr = 0; pr < 8; ++pr) {
            const int qg = pr >> 1, hh = pr & 1;
            const bf16_t* base = din + (rowq0 + 4 * qg + (l15 >> 2)) * DSA_LD + 2176 + (4 * hh + (l15 & 3)) * 64;
            Aq[pr][0] = *(const bf16x8*)(base + 8 * g4); Aq[pr][1] = *(const bf16x8*)(base + 32 + 8 * g4);
            const u32x2 wr = *(const u32x2*)(din + (rowq0 + 4 * qg + g4) * DSA_LD + 2752 + 4 * hh);
            wv[pr][0] = bflo(wr.x) * 0.04419417382f; wv[pr][1] = bfhi(wr.x) * 0.04419417382f; wv[pr][2] = bflo(wr.y) * 0.04419417382f; wv[pr][3] = bfhi(wr.y) * 0.04419417382f;
        }
        const int nkt = (qpos0 + 15) / 16 + 1;
        {
        bf16x8 B0[4], B1[4], N0[4], N1[4];
#pragma unroll
        for (int j = 0; j < 4; ++j) { const int kt = (wave + 8 * j < nkt) ? wave + 8 * j : 0;
            const bf16_t* kb = din + ((size_t)b * SEQ + 16 * kt + l15) * DSA_LD + 2688;
            B0[j] = *(const bf16x8*)(kb + 8 * g4); B1[j] = *(const bf16x8*)(kb + 32 + 8 * g4); }
        for (int kt0 = wave; kt0 < nkt; kt0 += 32) {
#pragma unroll
            for (int j = 0; j < 4; ++j) { const int kt = (kt0 + 32 + 8 * j < nkt) ? kt0 + 32 + 8 * j : 0;
                const bf16_t* kb = din + ((size_t)b * SEQ + 16 * kt + l15) * DSA_LD + 2688;
                N0[j] = *(const bf16x8*)(kb + 8 * g4); N1[j] = *(const bf16x8*)(kb + 32 + 8 * g4); }
#pragma unroll
            for (int j = 0; j < 4; ++j) {
                const int kt = kt0 + 8 * j;
                if (kt < nkt) {
#pragma unroll
                    for (int qg = 0; qg < 4; ++qg) {
                        float part = 0.f;
#pragma unroll
                        for (int hh = 0; hh < 2; ++hh) {
                            const int pr = 2 * qg + hh;
                            f32x4 c = (f32x4){0.f, 0.f, 0.f, 0.f};
                            c = __builtin_amdgcn_mfma_f32_16x16x32_bf16(Aq[pr][0], B0[j], c, 0, 0, 0);
                            c = __builtin_amdgcn_mfma_f32_16x16x32_bf16(Aq[pr][1], B1[j], c, 0, 0, 0);
                            part += (fmaxf(c[0], 0.f) * wv[pr][0] + fmaxf(c[1], 0.f) * wv[pr][1]) + (fmaxf(c[2], 0.f) * wv[pr][2] + fmaxf(c[3], 0.f) * wv[pr][3]);
                        }
                        const _Float16 hsc = (_Float16)(part + 0.0f);
                        S16[(4 * qg + g4) * SROW + 16 * kt + l15] = __builtin_bit_cast(unsigned short, hsc);
                    }
                }
            }
#pragma unroll
            for (int j = 0; j < 4; ++j) { B0[j] = N0[j]; B1[j] = N1[j]; }
        }
        }
        __syncthreads();
        for (int qi2 = 0; qi2 < 2; ++qi2) {
            const int ql = wave + 8 * qi2;
            const int qpos = qpos0 + ql, n = qpos + 1; unsigned short* out = idx + (rowq0 + ql) * 256;
            int lk = lane; asm volatile("" : "+v"(lk));
            if (n <= 256) {
#pragma unroll
                for (int i = 0; i < 4; ++i) { const int j = lane + 64 * i; out[j] = (unsigned short)(j < n ? j : 0xFFFF); }
            } else {
                const int ni4 = (((n + 63) >> 6) + 3) & ~3;
                const LAS unsigned short* srow = S16 + ql * SROW;
                LAS unsigned* hist = (LAS unsigned*)(lds + 131600 + wave * 1024);
                LAS unsigned short* orow = (LAS unsigned short*)(lds + 139792 + wave * 512);
#define TOPK_KEY(i_) ({ const int key_ = lk + 64 * (i_); unsigned b_ = srow[key_]; b_ ^= (b_ & 0x8000u) ? 0xFFFFu : 0x8000u; (key_ < n) ? b_ : 0u; })
                int b1, above1, b2, above2;
                *(LAS u32x4*)(hist + 4 * lane) = (u32x4){0u, 0u, 0u, 0u};
                for (int i0 = 0; i0 < ni4; i0 += 4) {
#pragma unroll
                    for (int j = 0; j < 4; ++j) { const unsigned uk = TOPK_KEY(i0 + j); (void)__hip_atomic_fetch_add(hist + (uk >> 8), 1u, __ATOMIC_RELAXED, __HIP_MEMORY_SCOPE_WORKGROUP); }
                }
                hist_find(hist, lane, 256, b1, above1);
                *(LAS u32x4*)(hist + 4 * lane) = (u32x4){0u, 0u, 0u, 0u};
                for (int i0 = 0; i0 < ni4; i0 += 4) {
#pragma unroll
                    for (int j = 0; j < 4; ++j) { const unsigned uk = TOPK_KEY(i0 + j); if ((int)(uk >> 8) == b1) (void)__hip_atomic_fetch_add(hist + (uk & 255u), 1u, __ATOMIC_RELAXED, __HIP_MEMORY_SCOPE_WORKGROUP); }
                }
                hist_find(hist, lane, 256 - above1, b2, above2);
                const unsigned T = ((unsigned)b1 << 8) | (unsigned)b2;
                const int G = above1 + above2;
                const int need = 256 - G; int base = 0, tie_seen = 0;
                const unsigned long long ltmask = (1ull << lane) - 1ull;
                for (int i0 = 0; i0 < ni4; i0 += 4) {
#pragma unroll
                    for (int j = 0; j < 4; ++j) {
                        const unsigned uk = TOPK_KEY(i0 + j);
                        const bool gt = uk > T, eq = uk == T;
                        const unsigned long long meq = __ballot(eq);
                        const bool sel = gt || (eq && (tie_seen + __popcll(meq & ltmask)) < need);
                        const unsigned long long msel = __ballot(sel);
                        if (sel) orow[base + __popcll(msel & ltmask)] = (unsigned short)(lk + 64 * (i0 + j));
                        base += __popcll(msel); tie_seen += __popcll(meq);
                    }
                }
#undef TOPK_KEY
                *(u32x2*)(out + 4 * lane) = *(LAS u32x2*)(orow + 4 * lane);
            }
        }
        __syncthreads();
    }
}

__device__ void phase_attn(const Params& p, LAS unsigned char* lds, bool dry, int wv) {
    unsigned char* ws = p.ws;
    const int tid = opaque_tid(wv), lane = tid & 63, wave = __builtin_amdgcn_readfirstlane(tid >> 6), g4 = lane >> 4, l15 = lane & 15, q = l15 >> 2, pp = lane & 3;
    bf16_t* din = (bf16_t*)(ws + WS_BIG); const bf16_t* cn = (const bf16_t*)(ws + WS_CN); const unsigned short* idx = (const unsigned short*)(ws + WS_IDX);
    LAS unsigned char* wl = lds + wave * 8192; const unsigned wbase = (unsigned)(size_t)(unsigned char*)lds + wave * 8192;
    const float scale = 0.08838834764f;
    for (int Q = blockIdx.x * 8 + wave; Q < MTOK; Q += gridDim.x * 8) {
        const int b = Q >> 12, qpos = Q & (SEQ - 1); const int nvalid = qpos + 1 < 256 ? qpos + 1 : 256;
        bf16_t* qrow = din + (size_t)Q * DSA_LD;
        bf16x8 Bq[4];
#pragma unroll
        for (int s = 0; s < 4; ++s) Bq[s] = *(const bf16x8*)(qrow + l15 * 128 + 32 * s + 8 * g4);
        f32x4 O[8];
#pragma unroll
        for (int mt = 0; mt < 8; ++mt) O[mt] = (f32x4){0.f, 0.f, 0.f, 0.f};
        float mrun = -1e30f, lrun = 0.f;
        unsigned kid[16];
#pragma unroll
        for (int i = 0; i < 16; ++i) { const int slot = i * 16 + l15; const unsigned v = idx[(size_t)Q * 256 + slot]; kid[i] = slot < nvalid ? v : 0u; }
        bf16x8 A[2][4], An[2][4];
#pragma unroll
        for (int tl = 0; tl < 2; ++tl) { const bf16_t* crow = cn + ((size_t)b * SEQ + kid[tl]) * 128;
#pragma unroll
            for (int s = 0; s < 4; ++s) A[tl][s] = *(const bf16x8*)(crow + 32 * s + 8 * g4); }
#pragma unroll
        for (int ck = 0; ck < 8; ++ck) {
            if (ck * 32 < nvalid) {
                if (ck < 7) {
#pragma unroll
                    for (int tl = 0; tl < 2; ++tl) { const bf16_t* crow = cn + ((size_t)b * SEQ + kid[(ck < 7 ? ck + 1 : ck) * 2 + tl]) * 128;
#pragma unroll
                        for (int s = 0; s < 4; ++s) An[tl][s] = *(const bf16x8*)(crow + 32 * s + 8 * g4); }
                }
                f32x4 S0 = (f32x4){0.f, 0.f, 0.f, 0.f}, S1 = (f32x4){0.f, 0.f, 0.f, 0.f};
#pragma unroll
                for (int s = 0; s < 4; ++s) { S0 = __builtin_amdgcn_mfma_f32_16x16x32_bf16(A[0][s], Bq[s], S0, 0, 0, 0); S1 = __builtin_amdgcn_mfma_f32_16x16x32_bf16(A[1][s], Bq[s], S1, 0, 0, 0); }
#pragma unroll
                for (int tl = 0; tl < 2; ++tl)
#pragma unroll
                    for (int s = 0; s < 4; ++s) *(LAS bf16x8*)(wl + off_b(16 * tl + l15, 4 * s + g4)) = A[tl][s];
                float sv[8];
#pragma unroll
                for (int j = 0; j < 4; ++j) { const int s0 = ck * 32 + 4 * g4 + j; sv[j] = s0 < nvalid ? S0[j] * scale : -1e30f; sv[4 + j] = (s0 + 16) < nvalid ? S1[j] * scale : -1e30f; }
                float cm = fmaxf(fmaxf(fmaxf(sv[0], sv[1]), fmaxf(sv[2], sv[3])), fmaxf(fmaxf(sv[4], sv[5]), fmaxf(sv[6], sv[7])));
                cm = xrow16_max(cm);
                const float mn = fmaxf(mrun, cm), alpha = __expf(mrun - mn);
                float pv[8], ps = 0.f;
#pragma unroll
                for (int j = 0; j < 8; ++j) { pv[j] = __expf(sv[j] - mn); ps += pv[j]; }
                lrun = lrun * alpha + ps; mrun = mn;
#pragma unroll
                for (int mt = 0; mt < 8; ++mt) O[mt] *= alpha;
                union { u32x4 u; bf16x8 h; } Pb;
                Pb.u.x = cvt_pk_bf16(pv[0], pv[1]); Pb.u.y = cvt_pk_bf16(pv[2], pv[3]); Pb.u.z = cvt_pk_bf16(pv[4], pv[5]); Pb.u.w = cvt_pk_bf16(pv[6], pv[7]);
                asm volatile("s_waitcnt lgkmcnt(0)" ::: "memory");
#pragma unroll
                for (int mb = 0; mb < 2; ++mb) {
                    unsigned ad[8]; bf16x8 Av[4];
#pragma unroll
                    for (int i = 0; i < 4; ++i) { const int mt = 4 * mb + i;
                        ad[2 * i] = wbase + off_b(4 * g4 + q, 2 * mt + (pp >> 1)) + 8 * (pp & 1); ad[2 * i + 1] = wbase + off_b(16 + 4 * g4 + q, 2 * mt + (pp >> 1)) + 8 * (pp & 1); }
                    tr_read8(ad, Av);
#pragma unroll
                    for (int i = 0; i < 4; ++i) O[4 * mb + i] = __builtin_amdgcn_mfma_f32_16x16x32_bf16(Av[i], Pb.h, O[4 * mb + i], 0, 0, 0);
                }
                if (ck < 7) {
#pragma unroll
                    for (int tl = 0; tl < 2; ++tl)
#pragma unroll
                        for (int s = 0; s < 4; ++s) A[tl][s] = An[tl][s];
                }
            }
        }
        lrun = xrow16_sum(lrun);
        const float inv = 1.0f / lrun;
#pragma unroll
        for (int mt = 0; mt < 8; ++mt) {
            u32x2 o; o.x = cvt_pk_bf16(O[mt][0] * inv, O[mt][1] * inv); o.y = cvt_pk_bf16(O[mt][2] * inv, O[mt][3] * inv);
            if (!dry) *(u32x2*)(qrow + l15 * 128 + 16 * mt + 4 * g4) = o;
        }
    }
}

__device__ void phase_final(const Params& p, int wv) {
    const int tid = opaque_tid(wv); const int lane = tid & 63, wave = tid >> 6;
    const float* ss = (const float*)(p.ws + WS_SS) + (size_t)8 * MTOK * 16; const bf16_t* xb = (const bf16_t*)(p.ws + WS_XB);
    for (int row = blockIdx.x * 8 + wave; row < MTOK; row += gridDim.x * 8) {
        const float rs = rsqrtf(sum16(ss + (size_t)row * 16) * (1.0f / 1024.0f) + 1e-6f);
        f32x4* orow = (f32x4*)(p.out + (size_t)row * DM);
#pragma unroll
        for (int i = 0; i < 4; ++i) { const f32x4 g = *(const f32x4*)(p.final_g + (lane + 64 * i) * 4); const u32x2 xw = *(const u32x2*)(xb + (size_t)row * DM + (lane + 64 * i) * 4);
            f32x4 v = (f32x4){bflo(xw.x), bfhi(xw.x), bflo(xw.y), bfhi(xw.y)}; v = v * rs * g; orow[lane + 64 * i] = v; }
    }
}

#define XB_TMO      128
#define XB_XCNT(j)  (256  + 64 * (j))
#define XB_XSUB(j)  (1280 + 64 * (j))
#define XB_XGEN(j)  (2304 + 64 * (j))
#define XB_TOP      3328
#define XB_TOPGEN   3392
#define XCD_BAR_WORDS 3456
#define XB_SPIN_CAP (1u << 20)
__device__ __forceinline__ unsigned xb_ld(unsigned* p)              { return __hip_atomic_load(p, __ATOMIC_RELAXED, __HIP_MEMORY_SCOPE_AGENT); }
__device__ __forceinline__ unsigned xb_add(unsigned* p, unsigned v) { return __hip_atomic_fetch_add(p, v, __ATOMIC_RELAXED, __HIP_MEMORY_SCOPE_AGENT); }
__device__ __forceinline__ unsigned xb_xcc_id() { return (unsigned)__builtin_amdgcn_s_getreg((3 << 11) | 20) & 0xFu; }
#define XB_SPIN(cond, bar) do { unsigned _sp = 0; while (cond) { __builtin_amdgcn_s_sleep(1); \
    if ((++_sp & 255u) == 0u) { if (xb_ld(&(bar)[XB_TMO])) break; if (_sp > XB_SPIN_CAP) { atomicAdd(&(bar)[XB_TMO], 1u); break; } } } } while (0)
struct XcdBarrier { unsigned* bar; unsigned x; volatile LAS unsigned* st; };
__device__ __forceinline__ XcdBarrier xcd_barrier_post(unsigned* bar, volatile LAS unsigned* st, bool is_t0) {
    XcdBarrier b; b.bar = bar; b.x = xb_xcc_id(); b.st = st;
    if (is_t0) (void)xb_add(&bar[XB_XCNT(b.x)], 1u);
    return b;
}
__device__ __forceinline__ void xcd_barrier_complete(unsigned* bar, unsigned x, unsigned& nloc, unsigned& nx) {
    const unsigned G = gridDim.x * gridDim.y * gridDim.z;
    unsigned sum, cnt, mine, sp = 0u;
    for (;;) {
        sum = 0u; cnt = 0u; mine = 0u;
#pragma unroll
        for (unsigned j = 0; j < 16; ++j) { const unsigned c = xb_ld(&bar[XB_XCNT(j)]); sum += c; cnt += (c > 0u) ? 1u : 0u; mine = (j == x) ? c : mine; }
        if (sum == G) break;
        __builtin_amdgcn_s_sleep(1);
        if ((++sp & 255u) == 0u) { if (xb_ld(&bar[XB_TMO])) break; if (sp > XB_SPIN_CAP) { atomicAdd(&bar[XB_TMO], 1u); break; } }
    }
    nloc = mine > 0u ? mine : 1u; nx = cnt > 0u ? cnt : 1u;
}
__device__ __forceinline__ void xcd_barrier(const XcdBarrier& b, bool is_t0) {
    asm volatile("s_waitcnt vmcnt(0)" ::: "memory");
    __syncthreads();
    if (is_t0) {
        unsigned* bar = b.bar;
        __builtin_amdgcn_s_waitcnt(0);
        unsigned nloc = b.st[0], nx = b.st[1];
        if (nloc == 0u) { xcd_barrier_complete(bar, b.x, nloc, nx); b.st[0] = nloc; b.st[1] = nx; }
        const unsigned old = xb_add(&bar[XB_XSUB(b.x)], 1u);
        const unsigned gen = old / nloc;
        if (old + 1u == (gen + 1u) * nloc) {
            __builtin_amdgcn_fence(__ATOMIC_RELEASE, "agent");
            asm volatile("s_waitcnt vmcnt(0)" ::: "memory");
            const unsigned og = xb_add(&bar[XB_TOP], 1u);
            const unsigned tg = og / nx;
            if (og + 1u == (tg + 1u) * nx) xb_add(&bar[XB_TOPGEN], 1u);
            else XB_SPIN(xb_ld(&bar[XB_TOPGEN]) == tg, bar);
            __builtin_amdgcn_fence(__ATOMIC_ACQUIRE, "agent");
            xb_add(&bar[XB_XGEN(b.x)], 1u);
            asm volatile("s_waitcnt vmcnt(0)" ::: "memory");
        } else {
            XB_SPIN(xb_ld(&bar[XB_XGEN(b.x)]) == gen, bar);
            __builtin_amdgcn_fence(__ATOMIC_ACQUIRE, "agent");
            asm volatile("s_waitcnt vmcnt(0)" ::: "memory");
        }
    }
    __syncthreads();
}

enum { K_PRO = 0, K_GACT, K_GRES, K_SGU, K_CONV, K_POOL, K_TOPK, K_ATTN, K_FINAL };
struct PhaseDesc { int kind, act, lda, apn, N, K, ldc, ss_idx, m0, M; size_t a_off, w_off; };
__device__ __forceinline__ PhaseDesc mk_act(int act, size_t w_off, int N, int ss_idx) { PhaseDesc d{}; d.kind = K_GACT; d.act = act; d.lda = 1024; d.apn = 0; d.N = N; d.K = 1024; d.ldc = N; d.ss_idx = ss_idx; d.m0 = 0; d.M = MTOK; d.a_off = WS_XB; d.w_off = w_off; return d; }
__device__ __forceinline__ PhaseDesc mk_res(size_t a_off, int lda, int apn, size_t w_off, int K, int ss_idx) { PhaseDesc d{}; d.kind = K_GRES; d.lda = lda; d.apn = apn; d.N = 1024; d.K = K; d.ss_idx = ss_idx; d.m0 = 0; d.M = MTOK; d.a_off = a_off; d.w_off = w_off; return d; }
__device__ __forceinline__ PhaseDesc mk_kind(int kind) { PhaseDesc d{}; d.kind = kind; return d; }
constexpr int MLP_Q = 4, MQ = MTOK / MLP_Q;
__device__ __forceinline__ PhaseDesc mk_mlp(int l, int j) {
    const int q = j >> 1;
    if ((j & 1) == 0) { PhaseDesc d = mk_act(2, W_1 + (size_t)l * 8 * MiB, 4096, 2 * l + 1); d.m0 = q * MQ; d.M = MQ; d.a_off = WS_XB + (size_t)q * MQ * 1024 * 2; return d; }
    PhaseDesc d = mk_res(WS_BIG, 4096, 0, W_2 + (size_t)l * 8 * MiB, 4096, 2 * l + 2); d.m0 = q * MQ; d.M = MQ; return d;
}
__device__ __forceinline__ PhaseDesc phase_desc(int ph) {
    if (ph >= 4 && ph < 12) return mk_mlp(0, ph - 4);
    if (ph >= 15 && ph < 23) return mk_mlp(1, ph - 15);
    if (ph >= 26 && ph < 34) return mk_mlp(2, ph - 26);
    if (ph >= 38 && ph < 46) return mk_mlp(3, ph - 38);
    switch (ph) {
    case 0: return mk_kind(K_PRO);
    case 1: return mk_act(1, W_A_IN, 2048, 0);
    case 2: return mk_kind(K_SGU);
    case 3: return mk_res(WS_BIG + 256 * MiB, 1024, 0, W_A_OUT, 1024, 1);
    case 12: return mk_act(0, W_B_IN, 3072, 2);
    case 13: return mk_kind(K_CONV);
    case 14: return mk_res(WS_BIG + 384 * MiB, 1024, 0, W_B_OUT, 1024, 3);
    case 23: return mk_act(0, W_C_IN, 1024, 4);
    case 24: return mk_kind(K_POOL);
    case 25: return mk_res(WS_BIG + 128 * MiB, 1024, 512, W_C_GRP, 256, 5);
    case 34: return mk_act(0, W_D_IN, DSA_LD, 6);
    case 35: return mk_kind(K_TOPK);
    case 36: return mk_kind(K_ATTN);
    case 37: return mk_res(WS_BIG, DSA_LD, 0, W_D_COMB, 2048, 7);
    default: return mk_kind(K_FINAL);
    }
}

__device__ __forceinline__ void run_phase(int ph, const Params& p, LAS unsigned char* lds, bool dry, int wv) {
    const PhaseDesc d = phase_desc(ph);
    unsigned char* ws = p.ws; float* ss = (float*)(ws + WS_SS);
    if (d.kind == K_GACT || d.kind == K_GRES) {
        pg8::Gemm g; g.A = (const bf16_t*)(ws + d.a_off); g.Bt = (const bf16_t*)(ws + d.w_off); g.M = d.M; g.N = d.N; g.K = d.K; g.lda = d.lda; g.apn = d.apn;
        pg8::StaticOrder S; S.init(d.M, d.N, gridDim.x, blockIdx.x);
        if (d.kind == K_GACT) { pg8::EpiAct E; E.O = (bf16_t*)(ws + WS_BIG); E.ldc = d.ldc; E.ss_in = ss + ((size_t)d.ss_idx * MTOK + d.m0) * 16; E.ssv = ss + (size_t)9 * MTOK * 16; E.ACT = d.act; pg8::gemm_phase(lds, g, S, E, wv); }
        else { pg8::EpiResid E; E.xb = (bf16_t*)(ws + WS_XB) + (size_t)d.m0 * DM; E.ss_out = ss + ((size_t)d.ss_idx * MTOK + d.m0) * 16; pg8::gemm_phase(lds, g, S, E, wv); }
    }
    else if (d.kind == K_PRO) phase_prologue(p, lds, wv);
    else if (d.kind == K_SGU) phase_sgu(p, lds, wv);
    else if (d.kind == K_CONV) phase_conv(p, wv);
    else if (d.kind == K_POOL) phase_pool(p, wv);
    else if (d.kind == K_TOPK) phase_topk(p, lds, wv);
    else if (d.kind == K_ATTN) phase_attn(p, lds, dry, wv);
    else phase_final(p, wv);
}

__global__ void __launch_bounds__(512, 2) fwd_megakernel(Params p) {
    extern __shared__ __attribute__((aligned(16))) unsigned char lds_raw[];
    LAS unsigned char* lds = (LAS unsigned char*)lds_raw;
    const int wv = __builtin_amdgcn_readfirstlane((int)threadIdx.x >> 6);
    volatile LAS unsigned* bst = (volatile LAS unsigned*)(lds + 131584);
    XcdBarrier xbar; xbar.bar = (unsigned*)(p.ws + WS_BAR); xbar.x = 0; xbar.st = bst;
    if (p.ph_hi - p.ph_lo > 1) {
        if (threadIdx.x == 0) { bst[0] = 0u; bst[1] = 0u; }
        if (blockIdx.x == 0) { unsigned* bw = (unsigned*)(p.ws + WS_BAR); for (int i = threadIdx.x; i < XCD_BAR_WORDS; i += 512) bw[i] = 0u; }
        __syncthreads();
    }
    for (int ph = p.ph_lo; ph < p.ph_hi; ++ph) {
#if PROBE_DUP
        const int reps = ((PROBE_DUP >> ph) & 1) ? 2 : 1;
        for (int r = 0; r < reps; ++r) { run_phase(ph, p, lds, r + 1 < reps, wv); if (r + 1 < reps) cg::this_grid().sync(); }
#else
        run_phase(ph, p, lds, false, wv);
#endif
        if (ph + 1 < p.ph_hi) {
            if (ph == p.ph_lo) { cg::this_grid().sync(); xbar = xcd_barrier_post((unsigned*)(p.ws + WS_BAR), bst, opaque_tid(wv) == 0); }
            else xcd_barrier(xbar, opaque_tid(wv) == 0);
        }
    }
}

#ifndef MK_MULTI
#define MK_MULTI 0
#endif

extern "C" void kernel_launch(void* const* d_in, const int* in_sizes, int n_in, void* d_out, int out_size, void* d_ws, size_t ws_size, hipStream_t stream) {
    static int grid = 0;
    if (grid == 0) {
        int dev = 0, cus = 0, per_cu = 0;
        hipGetDevice(&dev);
        hipDeviceGetAttribute(&cus, hipDeviceAttributeMultiprocessorCount, dev);
        if (hipFuncSetAttribute((const void*)fwd_megakernel, hipFuncAttributeMaxDynamicSharedMemorySize, LDS_BYTES) != hipSuccess) { fprintf(stderr, "hipFuncSetAttribute failed\n"); grid = -1; return; }
        if (hipOccupancyMaxActiveBlocksPerMultiprocessor(&per_cu, (const void*)fwd_megakernel, 512, LDS_BYTES) != hipSuccess || per_cu < 1) { fprintf(stderr, "occupancy query: %d\n", per_cu); per_cu = 1; }
        (void)hipGetLastError();
        grid = cus * (per_cu > 1 ? 1 : per_cu);
        if (ws_size < 840 * MiB) { fprintf(stderr, "workspace too small\n"); grid = -1; return; }
    }
    if (grid < 0) return;
    Params p{};
    const float** pp = (const float**)&p;
    for (int i = 0; i < 21; ++i) pp[i] = (const float*)d_in[i];
    p.out = (float*)d_out; p.ws = (unsigned char*)d_ws;
#if MK_MULTI
    for (int ph = 0; ph < NPHASE; ++ph) {
        p.ph_lo = ph; p.ph_hi = ph + 1;
        hipLaunchKernelGGL(fwd_megakernel, dim3(grid), dim3(512), LDS_BYTES, stream, p);
    }
#else
    p.ph_lo = 0; p.ph_hi = NPHASE;
    void* args[] = {&p};
    hipError_t e = hipLaunchCooperativeKernel((const void*)fwd_megakernel, dim3(grid), dim3(512), args, LDS_BYTES, stream);
    if (e != hipSuccess) fprintf(stderr, "cooperative launch failed: %s (grid %d)\n", hipGetErrorString(e), grid);
#endif
}
```

```cpp
#include <hip/hip_runtime.h>
#include <hip/hip_cooperative_groups.h>
#include <cstdio>
namespace cg = cooperative_groups;

#ifndef PROBE_DUP
#define PROBE_DUP 0
#endif
#ifndef TOPK_HIST
#define TOPK_HIST 1
#endif
#ifndef PROBE_TOPK
#define PROBE_TOPK 0
#endif
#define LAS __attribute__((address_space(3)))
typedef unsigned short bf16_t;
typedef short bf16x8 __attribute__((ext_vector_type(8)));
typedef float f32x4 __attribute__((ext_vector_type(4)));
typedef float f32x2 __attribute__((ext_vector_type(2)));
typedef unsigned u32x4 __attribute__((ext_vector_type(4)));
typedef unsigned u32x2 __attribute__((ext_vector_type(2)));
typedef unsigned short u16x4 __attribute__((ext_vector_type(4)));

constexpr int MTOK = 65536, DM = 1024, SEQ = 4096;
constexpr size_t MiB = 1ull << 20;
constexpr size_t WS_XB = 0;
constexpr size_t WS_BIG = 128 * MiB;
constexpr size_t WS_CN = 640 * MiB;
constexpr size_t WS_IDX = 656 * MiB;
constexpr size_t WS_SS = 800 * MiB;
constexpr size_t WS_BAR = 688 * MiB;
constexpr size_t WS_W = 692 * MiB;
constexpr size_t W_A_IN = WS_W + 0 * MiB, W_A_OUT = WS_W + 4 * MiB, W_A_S = WS_W + 6 * MiB, W_B_IN = WS_W + 7 * MiB, W_B_OUT = WS_W + 13 * MiB,
                 W_C_IN = WS_W + 15 * MiB, W_C_GRP = WS_W + 17 * MiB, W_D_IN = WS_W + 18 * MiB, W_D_COMB = WS_W + 24 * MiB, W_1 = WS_W + 28 * MiB, W_2 = WS_W + 60 * MiB;
constexpr int DSA_LD = 2816;
constexpr int LDS_BYTES = 131072 + 1024 + 8192 + 4096;
constexpr int NPHASE = 47;

struct Params {
    const float *x, *norm_mix_g, *norm_mlp_g, *final_g, *a_w_in, *a_v_g, *a_w_s, *a_b_s, *a_w_out, *b_w_in, *b_conv_w, *b_w_out, *c_w_in, *c_w_grp, *c_scale,
        *d_w_in, *d_kv_g, *d_w_uv, *d_w_out, *mlp_w1, *mlp_w2;
    float* out; unsigned char* ws; int ph_lo, ph_hi;
};

__device__ __forceinline__ unsigned cvt_pk_bf16(float lo, float hi) { unsigned r; asm volatile("v_cvt_pk_bf16_f32 %0, %1, %2" : "=v"(r) : "v"(lo), "v"(hi)); return r; }
__device__ __forceinline__ int opaque_tid(int wv) { int l; asm volatile("v_mbcnt_lo_u32_b32 %0, -1, 0\n\tv_mbcnt_hi_u32_b32 %0, -1, %0" : "=v"(l)); return wv * 64 + l; }
__device__ __forceinline__ float bflo(unsigned w) { return __uint_as_float(w << 16); }
__device__ __forceinline__ float bfhi(unsigned w) { return __uint_as_float(w & 0xffff0000u); }
__device__ __forceinline__ float wave_sum(float v) {
#pragma unroll
    for (int o = 32; o; o >>= 1) v += __shfl_xor(v, o);
    return v;
}
__device__ __forceinline__ float sum16(const float* p) { const f32x4 a = *(const f32x4*)p, b = *(const f32x4*)(p + 4), c = *(const f32x4*)(p + 8), d = *(const f32x4*)(p + 12);
    return (((a[0] + a[1]) + (a[2] + a[3])) + ((b[0] + b[1]) + (b[2] + b[3]))) + (((c[0] + c[1]) + (c[2] + c[3])) + ((d[0] + d[1]) + (d[2] + d[3]))); }
__device__ __forceinline__ float xrow16_max(float x) {
    auto s = __builtin_amdgcn_permlane16_swap(__float_as_uint(x), __float_as_uint(x), false, false);
    x = fmaxf(__uint_as_float(s[0]), __uint_as_float(s[1]));
    auto t = __builtin_amdgcn_permlane32_swap(__float_as_uint(x), __float_as_uint(x), false, false);
    return fmaxf(__uint_as_float(t[0]), __uint_as_float(t[1]));
}
__device__ __forceinline__ float xrow16_sum(float x) {
    auto s = __builtin_amdgcn_permlane16_swap(__float_as_uint(x), __float_as_uint(x), false, false);
    x = __uint_as_float(s[0]) + __uint_as_float(s[1]);
    auto t = __builtin_amdgcn_permlane32_swap(__float_as_uint(x), __float_as_uint(x), false, false);
    return __uint_as_float(t[0]) + __uint_as_float(t[1]);
}
__device__ __forceinline__ unsigned off_b(unsigned row, unsigned ch) { return 256u * row + 16u * (ch ^ (((row & 3) << 2) | ((row >> 2) & 3))); }
__device__ __forceinline__ bf16x8 tr_read2(unsigned a0, unsigned a1) {
    u16x4 lo, hi;
    asm volatile("ds_read_b64_tr_b16 %0, %2\n\tds_read_b64_tr_b16 %1, %3\n\ts_waitcnt lgkmcnt(0)" : "=&v"(lo), "=&v"(hi) : "v"(a0), "v"(a1) : "memory");
    bf16x8 r; r[0] = (short)lo[0]; r[1] = (short)lo[1]; r[2] = (short)lo[2]; r[3] = (short)lo[3]; r[4] = (short)hi[0]; r[5] = (short)hi[1]; r[6] = (short)hi[2]; r[7] = (short)hi[3];
    return r;
}
__device__ __forceinline__ void tr_read8(const unsigned (&a)[8], bf16x8 (&r)[4]) {
    u16x4 v0, v1, v2, v3, v4, v5, v6, v7;
    asm volatile("ds_read_b64_tr_b16 %0, %8\n\tds_read_b64_tr_b16 %1, %9\n\tds_read_b64_tr_b16 %2, %10\n\tds_read_b64_tr_b16 %3, %11\n\t"
                 "ds_read_b64_tr_b16 %4, %12\n\tds_read_b64_tr_b16 %5, %13\n\tds_read_b64_tr_b16 %6, %14\n\tds_read_b64_tr_b16 %7, %15\n\ts_waitcnt lgkmcnt(0)"
                 : "=&v"(v0), "=&v"(v1), "=&v"(v2), "=&v"(v3), "=&v"(v4), "=&v"(v5), "=&v"(v6), "=&v"(v7)
                 : "v"(a[0]), "v"(a[1]), "v"(a[2]), "v"(a[3]), "v"(a[4]), "v"(a[5]), "v"(a[6]), "v"(a[7]) : "memory");
    const u16x4 lo[4] = {v0, v2, v4, v6}, hi[4] = {v1, v3, v5, v7};
#pragma unroll
    for (int i = 0; i < 4; ++i) { r[i][0] = (short)lo[i][0]; r[i][1] = (short)lo[i][1]; r[i][2] = (short)lo[i][2]; r[i][3] = (short)lo[i][3]; r[i][4] = (short)hi[i][0]; r[i][5] = (short)hi[i][1]; r[i][6] = (short)hi[i][2]; r[i][7] = (short)hi[i][3]; }
}

namespace pg8 {
constexpr int BM = 256, BK = 64, HALF = 128, HTB = HALF * BK * 2, STAGE_BYTES = 8 * HTB, NXCD = 8, WGM = 8;
__device__ __forceinline__ int lds_byte(int r, int c) { const int st = (r >> 4) * 2 + (c >> 5), rr = r & 15, cc = c & 31, ob = rr * 64 + cc * 2; return st * 1024 + (ob ^ (((ob >> 9) & 1) << 5)); }
__device__ __forceinline__ void stage_rc(int b, int& R, int& C) { const int st = b / 1024, sb = b % 1024, swz = sb ^ (((sb >> 9) & 1) << 5); R = (st >> 1) * 16 + swz / 64; C = (st & 1) * 32 + (swz % 64) / 2; }
__device__ __forceinline__ int perm32(int rho) { const int n = rho >> 4, i = rho & 15; return 8 * (i >> 2) + 4 * n + (i & 3); }
struct Unit { int pm, pn; };
struct Gemm { const bf16_t* A; const bf16_t* Bt; int M, N, K, lda, apn; };
struct StaticOrder {
    int nM, nN, nwg, G, c;
    __device__ void init(int M, int N, int G_, int c_) { nM = M / BM; nN = N / BM; nwg = nM * nN; G = G_; c = c_; }
    __device__ bool next(int i, Unit& u) const {
        const long L = (long)i * G + c; if (L >= nwg) return false;
        int wgid = (int)L; { const int q = nwg / NXCD, r = nwg % NXCD, xcd = wgid % NXCD, off = wgid / NXCD; wgid = (xcd < r ? xcd * (q + 1) : r * (q + 1) + (xcd - r) * q) + off; }
        const int nig = WGM * nN, gid = wgid / nig, fm = gid * WGM, gsz = (nM - fm) < WGM ? (nM - fm) : WGM;
        u.pm = fm + ((wgid % nig) % gsz); u.pn = (wgid % nig) / gsz; return true;
    }
};

__device__ __forceinline__ float gelu_tanh(float x) {
    const float y = 0.7978845608f * (x + 0.044715f * x * x * x);
    const float e = __builtin_amdgcn_exp2f(-2.885390082f * y);
    return x * __builtin_amdgcn_rcpf(1.0f + e);
}
struct EpiAct {
    static constexpr bool PERM = true;
    bf16_t* O; int ldc; const float* ss_in; float* ssv; int ACT;
    __device__ __forceinline__ void operator()(const f32x4 (&acc)[2][2][4][2], const Unit& u, int wr, int wc, int fr, int fq) const {
        const int row0 = u.pm * BM + wr * 64 + fr, col0 = u.pn * BM + wc * 32 + 8 * fq;
        float rsv[2][4];
#pragma unroll
        for (int ai = 0; ai < 2; ++ai)
#pragma unroll
            for (int m = 0; m < 4; ++m) {
                const f32x4 pz = *(const f32x4*)(ss_in + (size_t)(row0 + ai * HALF + m * 16) * 16 + 4 * fq);
                float s = (pz[0] + pz[1]) + (pz[2] + pz[3]); s = xrow16_sum(s);
                rsv[ai][m] = rsqrtf(s * (1.0f / 1024.0f) + 1e-6f);
            }
#pragma unroll
        for (int ai = 0; ai < 2; ++ai)
#pragma unroll
            for (int m = 0; m < 4; ++m) {
                const int row = row0 + ai * HALF + m * 16;
                const float rs = rsv[ai][m];
                bf16_t* rowp = O + (size_t)row * ldc + col0; float sq = 0.f;
#pragma unroll
                for (int bj = 0; bj < 2; ++bj) {
                    f32x4 v0 = acc[ai][bj][m][0] * rs, v1 = acc[ai][bj][m][1] * rs;
                    if (ACT == 1) {
#pragma unroll
                        for (int j = 0; j < 4; ++j) { v0[j] = gelu_tanh(v0[j]); v1[j] = gelu_tanh(v1[j]); sq += v0[j] * v0[j] + v1[j] * v1[j]; }
                    }
                    if (ACT == 2) {
#pragma unroll
                        for (int j = 0; j < 4; ++j) { const float a = fmaxf(v0[j], 0.f), b = fmaxf(v1[j], 0.f); v0[j] = a * a; v1[j] = b * b; }
                    }
                    u32x4 w; w.x = cvt_pk_bf16(v0[0], v0[1]); w.y = cvt_pk_bf16(v0[2], v0[3]); w.z = cvt_pk_bf16(v1[0], v1[1]); w.w = cvt_pk_bf16(v1[2], v1[3]);
                    *(u32x4*)(rowp + bj * HALF) = w;
                }
                if (ACT == 1) {
                    sq = xrow16_sum(sq);
                    if (u.pn >= 4 && fq == 0) ssv[(size_t)row * 16 + (u.pn - 4) * 4 + wc] = sq;
                }
            }
    }
};
struct EpiResid {
    static constexpr bool PERM = true;
    bf16_t* xb; float* ss_out;
    __device__ __forceinline__ void operator()(const f32x4 (&acc)[2][2][4][2], const Unit& u, int wr, int wc, int fr, int fq) const {
        const int row0 = u.pm * BM + wr * 64 + fr, col0 = u.pn * BM + wc * 32 + 8 * fq;
#pragma unroll
        for (int ai = 0; ai < 2; ++ai) {
            u32x4 xo[4][2];
#pragma unroll
            for (int m = 0; m < 4; ++m)
#pragma unroll
                for (int bj = 0; bj < 2; ++bj) xo[m][bj] = *(const u32x4*)(xb + (size_t)(row0 + ai * HALF + m * 16) * DM + col0 + bj * HALF);
#pragma unroll
            for (int m = 0; m < 4; ++m) {
                const int row = row0 + ai * HALF + m * 16; const size_t off = (size_t)row * DM + col0; float sq = 0.f;
#pragma unroll
                for (int bj = 0; bj < 2; ++bj) {
                    const u32x4 xw = xo[m][bj]; const f32x4 a0 = acc[ai][bj][m][0], a1 = acc[ai][bj][m][1];
                    const float v0 = bflo(xw.x) + a0[0], v1 = bfhi(xw.x) + a0[1], v2 = bflo(xw.y) + a0[2], v3 = bfhi(xw.y) + a0[3];
                    const float v4 = bflo(xw.z) + a1[0], v5 = bfhi(xw.z) + a1[1], v6 = bflo(xw.w) + a1[2], v7 = bfhi(xw.w) + a1[3];
                    u32x4 w; w.x = cvt_pk_bf16(v0, v1); w.y = cvt_pk_bf16(v2, v3); w.z = cvt_pk_bf16(v4, v5); w.w = cvt_pk_bf16(v6, v7);
                    *(u32x4*)(xb + off + bj * HALF) = w;
                    sq += ((v0 * v0 + v1 * v1) + (v2 * v2 + v3 * v3)) + ((v4 * v4 + v5 * v5) + (v6 * v6 + v7 * v7));
                }
                sq = xrow16_sum(sq);
                if (fq == 0) ss_out[(size_t)row * 16 + u.pn * 4 + wc] = sq;
            }
            asm volatile("" ::: "memory");
        }
    }
};

template <class Epi>
__device__ __forceinline__ void gemm_phase(LAS unsigned char* lds, const Gemm g, const StaticOrder& S, const Epi& E, int wv) {
    const int tid = opaque_tid(wv), wid = __builtin_amdgcn_readfirstlane(tid >> 6), lane = tid & 63, wr = wid >> 2, wc = wid & 3, fr = lane & 15, fq = lane >> 4;
    const int K = g.K, nt = K / BK, lda = g.lda;
    unsigned voffA[2], voffB[2];
#pragma unroll
    for (int i = 0; i < 2; ++i) { int R, C; stage_rc(tid * 16 + i * 8192, R, C); const int Rb = Epi::PERM ? ((R & ~31) + perm32(R & 31)) : R;
        voffA[i] = (unsigned)(R * lda + C) * 2u; voffB[i] = (unsigned)(Rb * K + C) * 2u; }
    const size_t kstep = (size_t)(BK * 2);
    const size_t hstepA = (size_t)HALF * lda * 2, hstepB = (size_t)HALF * K * 2;
    const size_t tstepA = 2 * hstepA, tstepB = 2 * hstepB;
    const unsigned ldsw = (unsigned)wid * 1024u;
    const int aoff = lds_byte(wr * 64 + fr, fq * 8), boff = lds_byte(wc * 32 + fr, fq * 8);
#define PG8_SA(b, h) (((b) * 2 + (h)) * HTB)
#define PG8_SB(b, h) ((4 + (b) * 2 + (h)) * HTB)
#define PG8_STAGE(bufoff, gbase, voff) do { _Pragma("unroll") for (int _i = 0; _i < 2; ++_i) \
        __builtin_amdgcn_global_load_lds((const unsigned*)((const char*)(gbase) + (voff)[_i]), (LAS unsigned*)(lds + (bufoff) + ldsw + _i * 8192), 16, 0, 0); } while (0)
#define PG8_LDA(dst, b, h) do { _Pragma("unroll") for (int m = 0; m < 4; ++m) _Pragma("unroll") for (int k = 0; k < 2; ++k) dst[m][k] = *(const LAS bf16x8*)(lds + PG8_SA(b, h) + aoff + m * 2048 + k * 1024); } while (0)
#define PG8_LDB(dst, b, h) do { _Pragma("unroll") for (int n = 0; n < 2; ++n) _Pragma("unroll") for (int k = 0; k < 2; ++k) dst[n][k] = *(const LAS bf16x8*)(lds + PG8_SB(b, h) + boff + n * 2048 + k * 1024); } while (0)
#define PG8_MMA(ai, bj, At, Bt) do { __builtin_amdgcn_s_setprio(1); _Pragma("unroll") for (int m = 0; m < 4; ++m) _Pragma("unroll") for (int n = 0; n < 2; ++n) _Pragma("unroll") for (int k = 0; k < 2; ++k) \
        acc[ai][bj][m][n] = __builtin_amdgcn_mfma_f32_16x16x32_bf16(Bt[n][k], At[m][k], acc[ai][bj][m][n], 0, 0, 0); __builtin_amdgcn_s_setprio(0); } while (0)
#define PG8_WAIT_V(n) asm volatile("s_waitcnt vmcnt(" #n ")" ::: "memory")
#define PG8_WAIT_L(n) asm volatile("s_waitcnt lgkmcnt(" #n ")" ::: "memory")
#define PG8_BAR __builtin_amdgcn_s_barrier()
#define PG8_SCHED __builtin_amdgcn_sched_barrier(0)
    Unit cur, nxt; int ui = 0;
    if (!S.next(0, cur)) return;
    f32x4 acc[2][2][4][2];
#pragma unroll
    for (int a = 0; a < 2; ++a)
#pragma unroll
        for (int b = 0; b < 2; ++b)
#pragma unroll
            for (int m = 0; m < 4; ++m)
#pragma unroll
                for (int n = 0; n < 2; ++n) acc[a][b][m][n] = (f32x4){0.f, 0.f, 0.f, 0.f};
    bf16x8 At[4][2], B0[2][2], B1[2][2];
    const char* cA = (const char*)g.A + (size_t)cur.pm * tstepA + (size_t)cur.pn * g.apn; const char* cB = (const char*)g.Bt + (size_t)cur.pn * tstepB;
    PG8_STAGE(PG8_SB(0, 0), cB, voffB); PG8_STAGE(PG8_SA(0, 0), cA, voffA); PG8_STAGE(PG8_SB(0, 1), cB + hstepB, voffB); PG8_STAGE(PG8_SA(0, 1), cA + hstepA, voffA);
    if (wr == 1) PG8_BAR;
    PG8_WAIT_V(4); PG8_BAR;
    PG8_STAGE(PG8_SB(1, 0), cB + kstep, voffB); PG8_STAGE(PG8_SA(1, 0), cA + kstep, voffA); PG8_STAGE(PG8_SB(1, 1), cB + hstepB + kstep, voffB);
    PG8_WAIT_V(6); PG8_BAR;
    for (;;) {
        const bool has_next = S.next(ui + 1, nxt);
        const char* nA = has_next ? (const char*)g.A + (size_t)nxt.pm * tstepA + (size_t)nxt.pn * g.apn : cA; const char* nB = has_next ? (const char*)g.Bt + (size_t)nxt.pn * tstepB : cB;
        for (int t = 0; t < nt; t += 2) {
            const bool last = (t == nt - 2);
            const char* a1 = cA + (size_t)(t + 1) * kstep;
            const char* a2 = last ? nA : cA + (size_t)(t + 2) * kstep; const char* b2 = last ? nB : cB + (size_t)(t + 2) * kstep;
            const char* a3 = a2 + kstep; const char* b3 = b2 + kstep;
            PG8_LDB(B0, 0, 0); PG8_SCHED; PG8_LDA(At, 0, 0); PG8_STAGE(PG8_SA(1, 1), a1 + hstepA, voffA);
            PG8_WAIT_L(8); PG8_BAR; PG8_WAIT_L(0); PG8_MMA(0, 0, At, B0); PG8_BAR; PG8_SCHED;
            PG8_LDB(B1, 0, 1); PG8_STAGE(PG8_SB(0, 0), b2, voffB);
            PG8_BAR; PG8_WAIT_L(0); PG8_MMA(0, 1, At, B1); PG8_BAR;
            PG8_LDA(At, 0, 1); PG8_STAGE(PG8_SA(0, 0), a2, voffA);
            PG8_BAR; PG8_WAIT_L(0); PG8_MMA(1, 0, At, B0); PG8_BAR; PG8_SCHED;
            PG8_STAGE(PG8_SB(0, 1), b2 + hstepB, voffB);
            PG8_WAIT_V(6); PG8_BAR; PG8_MMA(1, 1, At, B1); PG8_BAR;
            PG8_LDB(B0, 1, 0); PG8_SCHED; PG8_LDA(At, 1, 0); PG8_STAGE(PG8_SA(0, 1), a2 + hstepA, voffA);
            PG8_WAIT_L(8); PG8_BAR; PG8_WAIT_L(0); PG8_MMA(0, 0, At, B0); PG8_BAR; PG8_SCHED;
            PG8_LDB(B1, 1, 1); PG8_STAGE(PG8_SB(1, 0), b3, voffB);
            PG8_BAR; PG8_WAIT_L(0); PG8_MMA(0, 1, At, B1); PG8_BAR;
            PG8_LDA(At, 1, 1); PG8_STAGE(PG8_SA(1, 0), a3, voffA);
            PG8_BAR; PG8_WAIT_L(0); PG8_MMA(1, 0, At, B0); PG8_BAR; PG8_SCHED;
            PG8_STAGE(PG8_SB(1, 1), b3 + hstepB, voffB);
            PG8_WAIT_V(6); PG8_BAR; PG8_MMA(1, 1, At, B1); PG8_BAR;
        }
        E(acc, cur, wr, wc, fr, fq);
        if (!has_next) break;
#pragma unroll
        for (int a = 0; a < 2; ++a)
#pragma unroll
            for (int b = 0; b < 2; ++b)
#pragma unroll
                for (int m = 0; m < 4; ++m)
#pragma unroll
                    for (int n = 0; n < 2; ++n) acc[a][b][m][n] = (f32x4){0.f, 0.f, 0.f, 0.f};
        cur = nxt; cA = nA; cB = nB; ++ui;
    }
    PG8_WAIT_V(0);
    if (wr == 0) PG8_BAR;
    PG8_BAR;
#undef PG8_SA
#undef PG8_SB
#undef PG8_STAGE
#undef PG8_LDA
#undef PG8_LDB
#undef PG8_MMA
#undef PG8_WAIT_V
#undef PG8_WAIT_L
#undef PG8_BAR
#undef PG8_SCHED
}
}

__device__ void transpose_convert(int gw, int nw, int lane, const float* W, int K, int N, int Npad, bf16_t* Wt, int ldt, const float* rowgain, const float* colgain) {
    const int kb_n = K / 16, units = kb_n * (Npad / 256);
    for (int u = gw; u < units; u += nw) {
        const int k0 = (u % kb_n) * 16, n = (u / kb_n) * 256 + 4 * lane;
        f32x4 v[16];
        if (n < N) {
#pragma unroll
            for (int i = 0; i < 16; ++i) v[i] = *(const f32x4*)(W + (size_t)(k0 + i) * N + n);
            if (rowgain) {
#pragma unroll
                for (int i = 0; i < 16; ++i) v[i] *= rowgain[k0 + i];
            }
            if (colgain) { const f32x4 cgv = *(const f32x4*)(colgain + n);
#pragma unroll
                for (int i = 0; i < 16; ++i) v[i] *= cgv; }
        } else {
#pragma unroll
            for (int i = 0; i < 16; ++i) v[i] = (f32x4){0.f, 0.f, 0.f, 0.f};
        }
#pragma unroll
        for (int j = 0; j < 4; ++j) {
            u32x4 w0, w1; w0.x = cvt_pk_bf16(v[0][j], v[1][j]); w0.y = cvt_pk_bf16(v[2][j], v[3][j]); w0.z = cvt_pk_bf16(v[4][j], v[5][j]); w0.w = cvt_pk_bf16(v[6][j], v[7][j]);
            w1.x = cvt_pk_bf16(v[8][j], v[9][j]); w1.y = cvt_pk_bf16(v[10][j], v[11][j]); w1.z = cvt_pk_bf16(v[12][j], v[13][j]); w1.w = cvt_pk_bf16(v[14][j], v[15][j]);
            u32x4* dst = (u32x4*)(Wt + (size_t)(n + j) * ldt + k0); dst[0] = w0; dst[1] = w1;
        }
    }
}

__device__ void phase_prologue(const Params& p, LAS unsigned char* lds, int wv) {
    unsigned char* ws = p.ws;
    const int tid = opaque_tid(wv), lane = tid & 63, wave = tid >> 6;
    const int gw = blockIdx.x * 8 + wave, nw = gridDim.x * 8;
    const size_t gtid = (size_t)blockIdx.x * 512 + tid, gsz = (size_t)gridDim.x * 512;
    float* ss = (float*)(ws + WS_SS);
    bf16_t* xb = (bf16_t*)(ws + WS_XB);
    for (int row2 = (blockIdx.x * 8 + wave) * 2; row2 < MTOK; row2 += gridDim.x * 16) {
        f32x4 xv[2][4];
#pragma unroll
        for (int k = 0; k < 2; ++k)
#pragma unroll
            for (int i = 0; i < 4; ++i) xv[k][i] = ((const f32x4*)(p.x + (size_t)(row2 + k) * DM))[lane + 64 * i];
#pragma unroll
        for (int k = 0; k < 2; ++k) { const int row = row2 + k; float sq = 0.f;
#pragma unroll
            for (int i = 0; i < 4; ++i) { const f32x4 v = xv[k][i]; sq += (v[0] * v[0] + v[1] * v[1]) + (v[2] * v[2] + v[3] * v[3]);
                u32x2 w; w.x = cvt_pk_bf16(v[0], v[1]); w.y = cvt_pk_bf16(v[2], v[3]); *(u32x2*)(xb + (size_t)row * DM + (lane + 64 * i) * 4) = w; }
            sq = wave_sum(sq);
            if (lane < 16) ss[(size_t)row * 16 + lane] = lane == 0 ? sq : 0.f; }
    }
    transpose_convert(gw, nw, lane, p.a_w_in, 1024, 2048, 2048, (bf16_t*)(ws + W_A_IN), 1024, p.norm_mix_g + 0 * DM, nullptr);
    transpose_convert(gw, nw, lane, p.a_w_out, 1024, 1024, 1024, (bf16_t*)(ws + W_A_OUT), 1024, nullptr, nullptr);
    transpose_convert(gw, nw, lane, p.b_w_in, 1024, 3072, 3072, (bf16_t*)(ws + W_B_IN), 1024, p.norm_mix_g + 1 * DM, nullptr);
    transpose_convert(gw, nw, lane, p.b_w_out, 1024, 1024, 1024, (bf16_t*)(ws + W_B_OUT), 1024, nullptr, nullptr);
    transpose_convert(gw, nw, lane, p.c_w_in, 1024, 1024, 1024, (bf16_t*)(ws + W_C_IN), 1024, p.norm_mix_g + 2 * DM, nullptr);
    for (int g = 0; g < 4; ++g)
        transpose_convert(gw, nw, lane, p.c_w_grp + (size_t)g * 65536, 256, 256, 256, (bf16_t*)(ws + W_C_GRP) + (size_t)g * 65536, 256, nullptr, p.c_scale + g * 256);
    transpose_convert(gw, nw, lane, p.d_w_in, 1024, 2760, DSA_LD, (bf16_t*)(ws + W_D_IN), 1024, p.norm_mix_g + 3 * DM, nullptr);
    for (int l = 0; l < 4; ++l) {
        transpose_convert(gw, nw, lane, p.mlp_w1 + (size_t)l * 4194304, 1024, 4096, 4096, (bf16_t*)(ws + W_1) + (size_t)l * 4194304, 1024, p.norm_mlp_g + l * DM, nullptr);
        transpose_convert(gw, nw, lane, p.mlp_w2 + (size_t)l * 4194304, 4096, 1024, 1024, (bf16_t*)(ws + W_2) + (size_t)l * 4194304, 4096, nullptr, nullptr);
    }
    { bf16_t* wsm = (bf16_t*)(ws + W_A_S);
      for (size_t i = gtid; i < (size_t)8 * 128 * 128; i += gsz) { const int s = (int)(i & 127), t = (int)((i >> 7) & 127); const float v = (s <= t) ? p.a_w_s[i] : 0.f; wsm[i] = (bf16_t)(cvt_pk_bf16(v, 0.f) & 0xffffu); } }
    { bf16_t* wc = (bf16_t*)(ws + W_D_COMB);
      for (int u = gw; u < 256 * 4; u += nw) {
          const int k0 = (u >> 2) * 8, n = (u & 3) * 256 + 4 * lane, h = k0 >> 7;
          const float* uv = p.d_w_uv + (size_t)k0 * 64; const float* wo = p.d_w_out + (size_t)h * 64 * 1024 + n;
          f32x4 a[8]; float uvr[8];
#pragma unroll
          for (int i = 0; i < 8; ++i) { a[i] = (f32x4){0.f, 0.f, 0.f, 0.f}; uvr[i] = uv[i * 64 + lane]; }
#pragma unroll 8
          for (int v = 0; v < 64; ++v) { const f32x4 w4 = *(const f32x4*)(wo + (size_t)v * 1024);
#pragma unroll
              for (int i = 0; i < 8; ++i) a[i] += w4 * __uint_as_float(__builtin_amdgcn_readlane(__float_as_uint(uvr[i]), v)); }
#pragma unroll
          for (int j = 0; j < 4; ++j) {
              u32x4 w; w.x = cvt_pk_bf16(a[0][j], a[1][j]); w.y = cvt_pk_bf16(a[2][j], a[3][j]); w.z = cvt_pk_bf16(a[4][j], a[5][j]); w.w = cvt_pk_bf16(a[6][j], a[7][j]);
              *(u32x4*)(wc + (size_t)(n + j) * 2048 + k0) = w; } } }
}

__device__ void phase_sgu(const Params& p, LAS unsigned char* lds, int wv) {
    unsigned char* ws = p.ws;
    const int tid = opaque_tid(wv), lane = tid & 63, wave = __builtin_amdgcn_readfirstlane(tid >> 6), g4 = lane >> 4, l15 = lane & 15, q = l15 >> 2, pp = lane & 3;
    const bf16_t* z = (const bf16_t*)(ws + WS_BIG); bf16_t* us = (bf16_t*)(ws + WS_BIG + 256 * MiB);
    const float* ssv = (const float*)(ws + WS_SS) + (size_t)9 * MTOK * 16; const bf16_t* wsm = (const bf16_t*)(ws + W_A_S);
    const unsigned ldsbase = (unsigned)(size_t)(unsigned char*)lds;
    u32x4 raw[4]; float ssum[4];
    if ((int)blockIdx.x < 4096) { const int g = blockIdx.x & 7; const size_t row0 = (size_t)(blockIdx.x >> 3) * 128;
#pragma unroll
        for (int i = 0; i < 4; ++i) { const int e = tid + 512 * i, r = e >> 4, ch = e & 15;
            raw[i] = *(const u32x4*)(z + (row0 + r) * 2048 + 1024 + g * 128 + ch * 8); ssum[i] = sum16(ssv + (row0 + r) * 16); } }
    for (int unit = blockIdx.x; unit < 4096; unit += gridDim.x) {
        const int g = unit & 7, chunk = unit >> 3; const size_t row0 = (size_t)chunk * 128;
#pragma unroll
        for (int i = 0; i < 4; ++i) {
            const int e = tid + 512 * i, r = e >> 4, ch = e & 15;
            const float rs = rsqrtf(ssum[i] * (1.0f / 1024.0f) + 1e-6f);
            const f32x4 g0 = *(const f32x4*)(p.a_v_g + g * 128 + ch * 8), g1 = *(const f32x4*)(p.a_v_g + g * 128 + ch * 8 + 4);
            u32x4 o;
            o.x = cvt_pk_bf16(bflo(raw[i].x) * rs * g0[0], bfhi(raw[i].x) * rs * g0[1]); o.y = cvt_pk_bf16(bflo(raw[i].y) * rs * g0[2], bfhi(raw[i].y) * rs * g0[3]);
            o.z = cvt_pk_bf16(bflo(raw[i].z) * rs * g1[0], bfhi(raw[i].z) * rs * g1[1]); o.w = cvt_pk_bf16(bflo(raw[i].w) * rs * g1[2], bfhi(raw[i].w) * rs * g1[3]);
            *(LAS u32x4*)(lds + (r >> 5) * 8192 + off_b(r & 31, ch)) = o;
        }
        __syncthreads();
        const int t = 16 * wave + l15, nks = (wave >> 1) + 1;
        const float bias = p.a_b_s[g * 128 + t]; const size_t rowg = row0 + t;
        u32x2 uu8[8]; bf16x8 Bw4[4];
#pragma unroll
        for (int ks = 0; ks < 4; ++ks) Bw4[ks] = *(const bf16x8*)(wsm + ((size_t)g * 128 + t) * 128 + 32 * (ks < nks ? ks : 0) + 8 * g4);
#pragma unroll
        for (int ct = 0; ct < 8; ++ct) uu8[ct] = *(const u32x2*)(z + rowg * 2048 + g * 128 + 16 * ct + 4 * g4);
        { const int nu = unit + (int)gridDim.x;
          if (nu < 4096) { const int g2 = nu & 7; const size_t r2 = (size_t)(nu >> 3) * 128;
#pragma unroll
              for (int i = 0; i < 4; ++i) { const int e = tid + 512 * i, r = e >> 4, ch = e & 15;
                  raw[i] = *(const u32x4*)(z + (r2 + r) * 2048 + 1024 + g2 * 128 + ch * 8); ssum[i] = sum16(ssv + (r2 + r) * 16); } } }
        f32x4 acc[8];
#pragma unroll
        for (int ct = 0; ct < 8; ++ct) acc[ct] = (f32x4){0.f, 0.f, 0.f, 0.f};
#pragma unroll
        for (int ks = 0; ks < 4; ++ks) {
            if (ks < nks) {
                const bf16x8 Bw = Bw4[ks];
#pragma unroll
                for (int cb = 0; cb < 2; ++cb) {
                    unsigned ad[8]; bf16x8 Av[4];
#pragma unroll
                    for (int i = 0; i < 4; ++i) { const int ct = 4 * cb + i;
                        ad[2 * i] = ldsbase + ks * 8192 + off_b(8 * g4 + q, 2 * ct + (pp >> 1)) + 8 * (pp & 1); ad[2 * i + 1] = ldsbase + ks * 8192 + off_b(8 * g4 + 4 + q, 2 * ct + (pp >> 1)) + 8 * (pp & 1); }
                    tr_read8(ad, Av);
#pragma unroll
                    for (int i = 0; i < 4; ++i) acc[4 * cb + i] = __builtin_amdgcn_mfma_f32_16x16x32_bf16(Av[i], Bw, acc[4 * cb + i], 0, 0, 0);
                }
            }
        }
#pragma unroll
        for (int ct = 0; ct < 8; ++ct) {
            const u32x2 uu = uu8[ct];
            u32x2 o; o.x = cvt_pk_bf16(bflo(uu.x) * (acc[ct][0] + bias), bfhi(uu.x) * (acc[ct][1] + bias)); o.y = cvt_pk_bf16(bflo(uu.y) * (acc[ct][2] + bias), bfhi(uu.y) * (acc[ct][3] + bias));
            *(u32x2*)(us + rowg * 1024 + g * 128 + 16 * ct + 4 * g4) = o;
        }
        __syncthreads();
    }
}

__device__ void phase_conv(const Params& p, int wv) {
    unsigned char* ws = p.ws; const bf16_t* bch = (const bf16_t*)(ws + WS_BIG); bf16_t* gated = (bf16_t*)(ws + WS_BIG + 384 * MiB);
    const size_t gtid = (size_t)blockIdx.x * 512 + opaque_tid(wv), gsz = (size_t)gridDim.x * 512;
    for (size_t it = gtid; it < (size_t)4096 * 128; it += gsz) {
        const int ch = (int)(it & 127) * 8, rb = (int)(it >> 7); const int r0 = rb * 16;
        float w0[8], w1[8], w2[8], zm2[8], zm1[8];
#pragma unroll
        for (int j = 0; j < 8; ++j) { w0[j] = p.b_conv_w[ch + j]; w1[j] = p.b_conv_w[1024 + ch + j]; w2[j] = p.b_conv_w[2048 + ch + j]; zm2[j] = 0.f; zm1[j] = 0.f; }
        const int tpos0 = r0 & (SEQ - 1);
        for (int d = 2; d >= 1; --d) {
            if (tpos0 - d >= 0) {
                const bf16_t* rp = bch + (size_t)(r0 - d) * 3072; const u32x4 c = *(const u32x4*)(rp + 1024 + ch), h = *(const u32x4*)(rp + 2048 + ch);
                float zz[8] = {bflo(c.x) * bflo(h.x), bfhi(c.x) * bfhi(h.x), bflo(c.y) * bflo(h.y), bfhi(c.y) * bfhi(h.y), bflo(c.z) * bflo(h.z), bfhi(c.z) * bfhi(h.z), bflo(c.w) * bflo(h.w), bfhi(c.w) * bfhi(h.w)};
#pragma unroll
                for (int j = 0; j < 8; ++j) { if (d == 2) zm2[j] = zz[j]; else zm1[j] = zz[j]; }
            }
        }
        for (int r4 = r0; r4 < r0 + 16; r4 += 4) {
            u32x4 bq[4], cq[4], hq[4];
#pragma unroll
            for (int k = 0; k < 4; ++k) { const bf16_t* rp = bch + (size_t)(r4 + k) * 3072; bq[k] = *(const u32x4*)(rp + ch); cq[k] = *(const u32x4*)(rp + 1024 + ch); hq[k] = *(const u32x4*)(rp + 2048 + ch); }
#pragma unroll
            for (int k = 0; k < 4; ++k) {
                const u32x4 b = bq[k], c = cq[k], h = hq[k];
                float zz[8] = {bflo(c.x) * bflo(h.x), bfhi(c.x) * bfhi(h.x), bflo(c.y) * bflo(h.y), bfhi(c.y) * bfhi(h.y), bflo(c.z) * bflo(h.z), bfhi(c.z) * bfhi(h.z), bflo(c.w) * bflo(h.w), bfhi(c.w) * bfhi(h.w)};
                float bb[8] = {bflo(b.x), bfhi(b.x), bflo(b.y), bfhi(b.y), bflo(b.z), bfhi(b.z), bflo(b.w), bfhi(b.w)};
                float o[8];
#pragma unroll
                for (int j = 0; j < 8; ++j) { o[j] = bb[j] * (w0[j] * zm2[j] + w1[j] * zm1[j] + w2[j] * zz[j]); zm2[j] = zm1[j]; zm1[j] = zz[j]; }
                u32x4 w; w.x = cvt_pk_bf16(o[0], o[1]); w.y = cvt_pk_bf16(o[2], o[3]); w.z = cvt_pk_bf16(o[4], o[5]); w.w = cvt_pk_bf16(o[6], o[7]);
                *(u32x4*)(gated + (size_t)(r4 + k) * 1024 + ch) = w;
            }
        }
    }
}

__device__ __forceinline__ void ld8(const bf16_t* ptr, float (&f)[8]) {
    const u32x4 v = *(const u32x4*)ptr; f[0] = bflo(v.x); f[1] = bfhi(v.x); f[2] = bflo(v.y); f[3] = bfhi(v.y); f[4] = bflo(v.z); f[5] = bfhi(v.z); f[6] = bflo(v.w); f[7] = bfhi(v.w);
}
__device__ void phase_pool(const Params& p, int wv) {
    unsigned char* ws = p.ws; const bf16_t* z = (const bf16_t*)(ws + WS_BIG); bf16_t* pooled = (bf16_t*)(ws + WS_BIG + 128 * MiB);
    const size_t gtid = (size_t)blockIdx.x * 512 + opaque_tid(wv), gsz = (size_t)gridDim.x * 512;
    for (size_t it = gtid; it < (size_t)2048 * 128; it += gsz) {
        const int lane = (int)(it & 63), wv = (int)(it >> 6), chunk = (wv & 3) * 32 + (lane & 31), rb = (wv >> 2) * 2 + (lane >> 5);
        const int ch = chunk * 8, w = 2 << (ch >> 8), r0 = rb * 32;
        float S[8];
#pragma unroll
        for (int j = 0; j < 8; ++j) S[j] = 0.f;
        const int tpos0 = r0 & (SEQ - 1);
        for (int d = 1; d <= w; ++d) {
            if (tpos0 - d >= 0) { float f[8]; ld8(z + (size_t)(r0 - d) * 1024 + ch, f);
#pragma unroll
                for (int j = 0; j < 8; ++j) S[j] += f[j]; }
        }
        for (int r4 = r0; r4 < r0 + 32; r4 += 4) {
            u32x4 fa[4], oa[4];
#pragma unroll
            for (int k = 0; k < 4; ++k) { const int r = r4 + k; fa[k] = *(const u32x4*)(z + (size_t)r * 1024 + ch);
                const int rr = ((r & (SEQ - 1)) - w >= 0) ? r - w : r; oa[k] = *(const u32x4*)(z + (size_t)rr * 1024 + ch); }
#pragma unroll
            for (int k = 0; k < 4; ++k) {
                const int r = r4 + k, tpos = r & (SEQ - 1);
                float f[8] = {bflo(fa[k].x), bfhi(fa[k].x), bflo(fa[k].y), bfhi(fa[k].y), bflo(fa[k].z), bfhi(fa[k].z), bflo(fa[k].w), bfhi(fa[k].w)};
#pragma unroll
                for (int j = 0; j < 8; ++j) S[j] += f[j];
                if (tpos - w >= 0) { float o[8] = {bflo(oa[k].x), bfhi(oa[k].x), bflo(oa[k].y), bfhi(oa[k].y), bflo(oa[k].z), bfhi(oa[k].z), bflo(oa[k].w), bfhi(oa[k].w)};
#pragma unroll
                    for (int j = 0; j < 8; ++j) S[j] -= o[j]; }
                const int cnt = (tpos + 1 < w) ? tpos + 1 : w; const float inv = 1.0f / (float)cnt;
                u32x4 o; o.x = cvt_pk_bf16(S[0] * inv - f[0], S[1] * inv - f[1]); o.y = cvt_pk_bf16(S[2] * inv - f[2], S[3] * inv - f[3]);
                o.z = cvt_pk_bf16(S[4] * inv - f[4], S[5] * inv - f[5]); o.w = cvt_pk_bf16(S[6] * inv - f[6], S[7] * inv - f[7]);
                *(u32x4*)(pooled + (size_t)r * 1024 + ch) = o;
            }
        }
    }
}

__device__ __forceinline__ int cnt_ge8(const unsigned* v, unsigned cand) {
    unsigned long long m0, m1, m2, m3, m4, m5, m6, m7;
    asm("v_cmp_le_u32_e64 %0, %8, %9\n\tv_cmp_le_u32_e64 %1, %8, %10\n\tv_cmp_le_u32_e64 %2, %8, %11\n\tv_cmp_le_u32_e64 %3, %8, %12\n\t"
        "v_cmp_le_u32_e64 %4, %8, %13\n\tv_cmp_le_u32_e64 %5, %8, %14\n\tv_cmp_le_u32_e64 %6, %8, %15\n\tv_cmp_le_u32_e64 %7, %8, %16"
        : "=&s"(m0), "=&s"(m1), "=&s"(m2), "=&s"(m3), "=&s"(m4), "=&s"(m5), "=&s"(m6), "=&s"(m7)
        : "s"(cand), "v"(v[0]), "v"(v[1]), "v"(v[2]), "v"(v[3]), "v"(v[4]), "v"(v[5]), "v"(v[6]), "v"(v[7]));
    return (__builtin_popcountll(m0) + __builtin_popcountll(m1)) + (__builtin_popcountll(m2) + __builtin_popcountll(m3)) +
           (__builtin_popcountll(m4) + __builtin_popcountll(m5)) + (__builtin_popcountll(m6) + __builtin_popcountll(m7));
}
__device__ __forceinline__ void hist_find(LAS unsigned* hist, int lane, int target, int& bin, int& above) {
    const u32x4 h = *(LAS u32x4*)(hist + 4 * lane);
    const int tot = (int)(h.x + h.y + h.z + h.w);
    int suf = tot;
    suf += __builtin_amdgcn_update_dpp(0, suf, 0x101, 0xf, 0xf, true);
    suf += __builtin_amdgcn_update_dpp(0, suf, 0x102, 0xf, 0xf, true);
    suf += __builtin_amdgcn_update_dpp(0, suf, 0x104, 0xf, 0xf, true);
    suf += __builtin_amdgcn_update_dpp(0, suf, 0x108, 0xf, 0xf, true);
    { const int r1 = __builtin_amdgcn_readlane(suf, 16), r2 = __builtin_amdgcn_readlane(suf, 32), r3 = __builtin_amdgcn_readlane(suf, 48); const int g = lane >> 4;
      suf += (g == 0) ? (r1 + r2 + r3) : (g == 1) ? (r2 + r3) : (g == 2) ? r3 : 0; }
    const int excl = suf - tot;
    const bool mine = (excl < target) && (suf >= target);
    int b, ab, c = excl;
    if (c + (int)h.w >= target) { b = 3; ab = c; } else { c += (int)h.w;
        if (c + (int)h.z >= target) { b = 2; ab = c; } else { c += (int)h.z;
            if (c + (int)h.y >= target) { b = 1; ab = c; } else { c += (int)h.y; b = 0; ab = c; } } }
    const unsigned long long m = __ballot(mine);
    const int src = m ? (int)__ffsll((long long)m) - 1 : 0;
    bin = __builtin_amdgcn_readlane(4 * lane + b, src); above = __builtin_amdgcn_readlane(ab, src);
}
__device__ void phase_topk(const Params& p, LAS unsigned char* lds, int wv) {
    unsigned char* ws = p.ws;
    const int tid = opaque_tid(wv), lane = tid & 63, wave = __builtin_amdgcn_readfirstlane(tid >> 6), g4 = lane >> 4, l15 = lane & 15;
    const bf16_t* din = (const bf16_t*)(ws + WS_BIG); bf16_t* cn = (bf16_t*)(ws + WS_CN); unsigned short* idx = (unsigned short*)(ws + WS_IDX);
    LAS unsigned short* S16 = (LAS unsigned short*)lds;
    constexpr int SROW = 4112;
    { const float kg0 = p.d_kv_g[2 * lane], kg1 = p.d_kv_g[2 * lane + 1];
      for (int row4 = (blockIdx.x * 8 + wave) * 4; row4 < MTOK; row4 += gridDim.x * 32) {
        unsigned raw[4];
#pragma unroll
        for (int j = 0; j < 4; ++j) raw[j] = *(const unsigned*)(din + (size_t)(row4 + j) * DSA_LD + 2048 + 2 * lane);
#pragma unroll
        for (int j = 0; j < 4; ++j) { const float a = bflo(raw[j]), b = bfhi(raw[j]);
            const float sq = wave_sum(a * a + b * b); const float rs = rsqrtf(sq * (1.0f / 128.0f) + 1e-6f);
            *(unsigned*)(cn + (size_t)(row4 + j) * 128 + 2 * lane) = cvt_pk_bf16(a * rs * kg0, b * rs * kg1); }
      } }
    for (int unit = blockIdx.x; unit < 4096; unit += gridDim.x) {
        const bool tiled = (4096 % (2 * (int)gridDim.x)) == 0;
        const int pi = tiled ? (unit / (2 * (int)gridDim.x)) * (int)gridDim.x + (unit % (int)gridDim.x) : (unit >> 1), hi = tiled ? (unit / (int)gridDim.x) & 1 : (unit & 1);
        const int b = pi >> 7, cc = pi & 127, qt = hi ? 255 - cc : cc, qpos0 = qt * 16; const size_t rowq0 = (size_t)b * SEQ + qpos0;
        bf16x8 Aq[8][2]; float wv[8][4];
#pragma unroll
        for (int pr = 0; pr < 8; ++pr) {
            const int qg = pr >> 1, hh = pr & 1;
            const bf16_t* base = din + (rowq0 + 4 * qg + (l15 >> 2)) * DSA_LD + 2176 + (4 * hh + (l15 & 3)) * 64;
            Aq[pr][0] = *(const bf16x8*)(base + 8 * g4); Aq[pr][1] = *(const bf16x8*)(base + 32 + 8 * g4);
            const u32x2 wr = *(const u32x2*)(din + (rowq0 + 4 * qg + g4) * DSA_LD + 2752 + 4 * hh);
            wv[pr][0] = bflo(wr.x) * 0.04419417382f; wv[pr][1] = bfhi(wr.x) * 0.04419417382f; wv[pr][2] = bflo(wr.y) * 0.04419417382f; wv[pr][3] = bfhi(wr.y) * 0.04419417382f;
        }
        const int nkt = (qpos0 + 15) / 16 + 1;
        {
        bf16x8 B0[4], B1[4], N0[4], N1[4];
#pragma unroll
        for (int j = 0; j < 4; ++j) { const int kt = (wave + 8 * j < nkt) ? wave + 8 * j : 0;
            const bf16_t* kb = din + ((size_t)b * SEQ + 16 * kt + l15) * DSA_LD + 2688;
            B0[j] = *(const bf16x8*)(kb + 8 * g4); B1[j] = *(const bf16x8*)(kb + 32 + 8 * g4); }
        for (int kt0 = wave; kt0 < nkt; kt0 += 32) {
#pragma unroll
            for (int j = 0; j < 4; ++j) { const int kt = (kt0 + 32 + 8 * j < nkt) ? kt0 + 32 + 8 * j : 0;
                const bf16_t* kb = din + ((size_t)b * SEQ + 16 * kt + l15) * DSA_LD + 2688;
                N0[j] = *(const bf16x8*)(kb + 8 * g4); N1[j] = *(const bf16x8*)(kb + 32 + 8 * g4); }
#pragma unroll
            for (int j = 0; j < 4; ++j) {
                const int kt = kt0 + 8 * j;
                if (kt < nkt) {
#pragma unroll
                    for (int qg = 0; qg < 4; ++qg) {
                        float part = 0.f;
#pragma unroll
                        for (int hh = 0; hh < 2; ++hh) {
                            const int pr = 2 * qg + hh;
                            f32x4 c = (f32x4){0.f, 0.f, 0.f, 0.f};
                            c = __builtin_amdgcn_mfma_f32_16x16x32_bf16(Aq[pr][0], B0[j], c, 0, 0, 0);
                            c = __builtin_amdgcn_mfma_f32_16x16x32_bf16(Aq[pr][1], B1[j], c, 0, 0, 0);
                            part += (fmaxf(c[0], 0.f) * wv[pr][0] + fmaxf(c[1], 0.f) * wv[pr][1]) + (fmaxf(c[2], 0.f) * wv[pr][2] + fmaxf(c[3], 0.f) * wv[pr][3]);
                        }
                        const _Float16 hsc = (_Float16)(part + 0.0f);
                        S16[(4 * qg + g4) * SROW + 16 * kt + l15] = __builtin_bit_cast(unsigned short, hsc);
                    }
                }
            }
#pragma unroll
            for (int j = 0; j < 4; ++j) { B0[j] = N0[j]; B1[j] = N1[j]; }
        }
        }
        __syncthreads();
        for (int qi2 = 0; qi2 < 2; ++qi2) {
            const int ql = wave + 8 * qi2;
            const int qpos = qpos0 + ql, n = qpos + 1; unsigned short* out = idx + (rowq0 + ql) * 256;
            int lk = lane; asm volatile("" : "+v"(lk));
            if (n <= 256) {
#pragma unroll
                for (int i = 0; i < 4; ++i) { const int j = lane + 64 * i; out[j] = (unsigned short)(j < n ? j : 0xFFFF); }
            } else {
                const int ni4 = (((n + 63) >> 6) + 3) & ~3;
                const LAS unsigned short* srow = S16 + ql * SROW;
                LAS unsigned* hist = (LAS unsigned*)(lds + 131600 + wave * 1024);
                LAS unsigned short* orow = (LAS unsigned short*)(lds + 139792 + wave * 512);
#define TOPK_KEY(i_) ({ const int key_ = lk + 64 * (i_); unsigned b_ = srow[key_]; b_ ^= (b_ & 0x8000u) ? 0xFFFFu : 0x8000u; (key_ < n) ? b_ : 0u; })
                int b1, above1, b2, above2;
                *(LAS u32x4*)(hist + 4 * lane) = (u32x4){0u, 0u, 0u, 0u};
                for (int i0 = 0; i0 < ni4; i0 += 4) {
#pragma unroll
                    for (int j = 0; j < 4; ++j) { const unsigned uk = TOPK_KEY(i0 + j); (void)__hip_atomic_fetch_add(hist + (uk >> 8), 1u, __ATOMIC_RELAXED, __HIP_MEMORY_SCOPE_WORKGROUP); }
                }
                hist_find(hist, lane, 256, b1, above1);
                *(LAS u32x4*)(hist + 4 * lane) = (u32x4){0u, 0u, 0u, 0u};
                for (int i0 = 0; i0 < ni4; i0 += 4) {
#pragma unroll
                    for (int j = 0; j < 4; ++j) { const unsigned uk = TOPK_KEY(i0 + j); if ((int)(uk >> 8) == b1) (void)__hip_atomic_fetch_add(hist + (uk & 255u), 1u, __ATOMIC_RELAXED, __HIP_MEMORY_SCOPE_WORKGROUP); }
                }
                hist_find(hist, lane, 256 - above1, b2, above2);
                const unsigned T = ((unsigned)b1 << 8) | (unsigned)b2;
                const int G = above1 + above2;
                const int need = 256 - G; int base = 0, tie_seen = 0;
                const unsigned long long ltmask = (1ull << lane) - 1ull;
                for (int i0 = 0; i0 < ni4; i0 += 4) {
#pragma unroll
                    for (int j = 0; j < 4; ++j) {
                        const unsigned uk = TOPK_KEY(i0 + j);
                        const bool gt = uk > T, eq = uk == T;
                        const unsigned long long meq = __ballot(eq);
                        const bool sel = gt || (eq && (tie_seen + __popcll(meq & ltmask)) < need);
                        const unsigned long long msel = __ballot(sel);
                        if (sel) orow[base + __popcll(msel & ltmask)] = (unsigned short)(lk + 64 * (i0 + j));
                        base += __popcll(msel); tie_seen += __popcll(meq);
                    }
                }
#undef TOPK_KEY
                *(u32x2*)(out + 4 * lane) = *(LAS u32x2*)(orow + 4 * lane);
            }
        }
        __syncthreads();
    }
}

__device__ void phase_attn(const Params& p, LAS unsigned char* lds, bool dry, int wv) {
    unsigned char* ws = p.ws;
    const int tid = opaque_tid(wv), lane = tid & 63, wave = __builtin_amdgcn_readfirstlane(tid >> 6), g4 = lane >> 4, l15 = lane & 15, q = l15 >> 2, pp = lane & 3;
    bf16_t* din = (bf16_t*)(ws + WS_BIG); const bf16_t* cn = (const bf16_t*)(ws + WS_CN); const unsigned short* idx = (const unsigned short*)(ws + WS_IDX);
    LAS unsigned char* wl = lds + wave * 8192; const unsigned wbase = (unsigned)(size_t)(unsigned char*)lds + wave * 8192;
    const float scale = 0.08838834764f;
    for (int Q = blockIdx.x * 8 + wave; Q < MTOK; Q += gridDim.x * 8) {
        const int b = Q >> 12, qpos = Q & (SEQ - 1); const int nvalid = qpos + 1 < 256 ? qpos + 1 : 256;
        bf16_t* qrow = din + (size_t)Q * DSA_LD;
        bf16x8 Bq[4];
#pragma unroll
        for (int s = 0; s < 4; ++s) Bq[s] = *(const bf16x8*)(qrow + l15 * 128 + 32 * s + 8 * g4);
        f32x4 O[8];
#pragma unroll
        for (int mt = 0; mt < 8; ++mt) O[mt] = (f32x4){0.f, 0.f, 0.f, 0.f};
        float mrun = -1e30f, lrun = 0.f;
        unsigned kid[16];
#pragma unroll
        for (int i = 0; i < 16; ++i) { const int slot = i * 16 + (lane >> 2); const unsigned v = idx[(size_t)Q * 256 + slot]; kid[i] = slot < nvalid ? v : 0u; }
        bf16x8 A[2][4], An[2][4];
#pragma unroll
        for (int tl = 0; tl < 2; ++tl) { const bf16_t* crow = cn + ((size_t)b * SEQ + kid[tl]) * 128;
#pragma unroll
            for (int s = 0; s < 4; ++s) A[tl][s] = *(const bf16x8*)(crow + 32 * s + 8 * (lane & 3)); }
#pragma unroll
        for (int ck = 0; ck < 8; ++ck) {
            if (ck * 32 < nvalid) {
                if (ck < 7) {
#pragma unroll
                    for (int tl = 0; tl < 2; ++tl) { const bf16_t* crow = cn + ((size_t)b * SEQ + kid[(ck < 7 ? ck + 1 : ck) * 2 + tl]) * 128;
#pragma unroll
                        for (int s = 0; s < 4; ++s) An[tl][s] = *(const bf16x8*)(crow + 32 * s + 8 * (lane & 3)); }
                }
#pragma unroll
                for (int tl = 0; tl < 2; ++tl)
#pragma unroll
                    for (int s = 0; s < 4; ++s) *(LAS bf16x8*)(wl + off_b(16 * tl + (lane >> 2), 4 * s + (lane & 3))) = A[tl][s];
                bf16x8 Af[2][4];
#pragma unroll
                for (int tl = 0; tl < 2; ++tl)
#pragma unroll
                    for (int s = 0; s < 4; ++s) Af[tl][s] = *(const LAS bf16x8*)(wl + off_b(16 * tl + l15, 4 * s + g4));
                f32x4 S0 = (f32x4){0.f, 0.f, 0.f, 0.f}, S1 = (f32x4){0.f, 0.f, 0.f, 0.f};
#pragma unroll
                for (int s = 0; s < 4; ++s) { S0 = __builtin_amdgcn_mfma_f32_16x16x32_bf16(Af[0][s], Bq[s], S0, 0, 0, 0); S1 = __builtin_amdgcn_mfma_f32_16x16x32_bf16(Af[1][s], Bq[s], S1, 0, 0, 0); }
                float sv[8];
#pragma unroll
                for (int j = 0; j < 4; ++j) { const int s0 = ck * 32 + 4 * g4 + j; sv[j] = s0 < nvalid ? S0[j] * scale : -1e30f; sv[4 + j] = (s0 + 16) < nvalid ? S1[j] * scale : -1e30f; }
                float cm = fmaxf(fmaxf(fmaxf(sv[0], sv[1]), fmaxf(sv[2], sv[3])), fmaxf(fmaxf(sv[4], sv[5]), fmaxf(sv[6], sv[7])));
                cm = xrow16_max(cm);
                const float mn = fmaxf(mrun, cm), alpha = __expf(mrun - mn);
                float pv[8], ps = 0.f;
#pragma unroll
                for (int j = 0; j < 8; ++j) { pv[j] = __expf(sv[j] - mn); ps += pv[j]; }
                lrun = lrun * alpha + ps; mrun = mn;
#pragma unroll
                for (int mt = 0; mt < 8; ++mt) O[mt] *= alpha;
                union { u32x4 u; bf16x8 h; } Pb;
                Pb.u.x = cvt_pk_bf16(pv[0], pv[1]); Pb.u.y = cvt_pk_bf16(pv[2], pv[3]); Pb.u.z = cvt_pk_bf16(pv[4], pv[5]); Pb.u.w = cvt_pk_bf16(pv[6], pv[7]);
                asm volatile("s_waitcnt lgkmcnt(0)" ::: "memory");
#pragma unroll
                for (int mb = 0; mb < 2; ++mb) {
                    unsigned ad[8]; bf16x8 Av[4];
#pragma unroll
                    for (int i = 0; i < 4; ++i) { const int mt = 4 * mb + i;
                        ad[2 * i] = wbase + off_b(4 * g4 + q, 2 * mt + (pp >> 1)) + 8 * (pp & 1); ad[2 * i + 1] = wbase + off_b(16 + 4 * g4 + q, 2 * mt + (pp >> 1)) + 8 * (pp & 1); }
                    tr_read8(ad, Av);
#pragma unroll
                    for (int i = 0; i < 4; ++i) O[4 * mb + i] = __builtin_amdgcn_mfma_f32_16x16x32_bf16(Av[i], Pb.h, O[4 * mb + i], 0, 0, 0);
                }
                if (ck < 7) {
#pragma unroll
                    for (int tl = 0; tl < 2; ++tl)
#pragma unroll
                        for (int s = 0; s < 4; ++s) A[tl][s] = An[tl][s];
                }
            }
        }
        lrun = xrow16_sum(lrun);
        const float inv = 1.0f / lrun;
#pragma unroll
        for (int mt = 0; mt < 8; ++mt) {
            u32x2 o; o.x = cvt_pk_bf16(O[mt][0] * inv, O[mt][1] * inv); o.y = cvt_pk_bf16(O[mt][2] * inv, O[mt][3] * inv);
            if (!dry) *(u32x2*)(qrow + l15 * 128 + 16 * mt + 4 * g4) = o;
        }
    }
}

__device__ void phase_final(const Params& p, int wv) {
    const int tid = opaque_tid(wv); const int lane = tid & 63, wave = tid >> 6;
    const float* ss = (const float*)(p.ws + WS_SS) + (size_t)8 * MTOK * 16; const bf16_t* xb = (const bf16_t*)(p.ws + WS_XB);
    for (int row = blockIdx.x * 8 + wave; row < MTOK; row += gridDim.x * 8) {
        const float rs = rsqrtf(sum16(ss + (size_t)row * 16) * (1.0f / 1024.0f) + 1e-6f);
        f32x4* orow = (f32x4*)(p.out + (size_t)row * DM);
#pragma unroll
        for (int i = 0; i < 4; ++i) { const f32x4 g = *(const f32x4*)(p.final_g + (lane + 64 * i) * 4); const u32x2 xw = *(const u32x2*)(xb + (size_t)row * DM + (lane + 64 * i) * 4);
            f32x4 v = (f32x4){bflo(xw.x), bfhi(xw.x), bflo(xw.y), bfhi(xw.y)}; v = v * rs * g; orow[lane + 64 * i] = v; }
    }
}

#define XB_TMO      128
#define XB_XCNT(j)  (256  + 64 * (j))
#define XB_XSUB(j)  (1280 + 64 * (j))
#define XB_XGEN(j)  (2304 + 64 * (j))
#define XB_TOP      3328
#define XB_TOPGEN   3392
#define XCD_BAR_WORDS 3456
#define XB_SPIN_CAP (1u << 20)
__device__ __forceinline__ unsigned xb_ld(unsigned* p)              { return __hip_atomic_load(p, __ATOMIC_RELAXED, __HIP_MEMORY_SCOPE_AGENT); }
__device__ __forceinline__ unsigned xb_add(unsigned* p, unsigned v) { return __hip_atomic_fetch_add(p, v, __ATOMIC_RELAXED, __HIP_MEMORY_SCOPE_AGENT); }
__device__ __forceinline__ unsigned xb_xcc_id() { return (unsigned)__builtin_amdgcn_s_getreg((3 << 11) | 20) & 0xFu; }
#define XB_SPIN(cond, bar) do { unsigned _sp = 0; while (cond) { __builtin_amdgcn_s_sleep(1); \
    if ((++_sp & 255u) == 0u) { if (xb_ld(&(bar)[XB_TMO])) break; if (_sp > XB_SPIN_CAP) { atomicAdd(&(bar)[XB_TMO], 1u); break; } } } } while (0)
struct XcdBarrier { unsigned* bar; unsigned x; volatile LAS unsigned* st; };
__device__ __forceinline__ XcdBarrier xcd_barrier_post(unsigned* bar, volatile LAS unsigned* st, bool is_t0) {
    XcdBarrier b; b.bar = bar; b.x = xb_xcc_id(); b.st = st;
    if (is_t0) (void)xb_add(&bar[XB_XCNT(b.x)], 1u);
    return b;
}
__device__ __forceinline__ void xcd_barrier_complete(unsigned* bar, unsigned x, unsigned& nloc, unsigned& nx) {
    const unsigned G = gridDim.x * gridDim.y * gridDim.z;
    unsigned sum, cnt, mine, sp = 0u;
    for (;;) {
        sum = 0u; cnt = 0u; mine = 0u;
#pragma unroll
        for (unsigned j = 0; j < 16; ++j) { const unsigned c = xb_ld(&bar[XB_XCNT(j)]); sum += c; cnt += (c > 0u) ? 1u : 0u; mine = (j == x) ? c : mine; }
        if (sum == G) break;
        __builtin_amdgcn_s_sleep(1);
        if ((++sp & 255u) == 0u) { if (xb_ld(&bar[XB_TMO])) break; if (sp > XB_SPIN_CAP) { atomicAdd(&bar[XB_TMO], 1u); break; } }
    }
    nloc = mine > 0u ? mine : 1u; nx = cnt > 0u ? cnt : 1u;
}
__device__ __forceinline__ void xcd_barrier(const XcdBarrier& b, bool is_t0) {
    asm volatile("s_waitcnt vmcnt(0)" ::: "memory");
    __syncthreads();
    if (is_t0) {
        unsigned* bar = b.bar;
        __builtin_amdgcn_s_waitcnt(0);
        unsigned nloc = b.st[0], nx = b.st[1];
        if (nloc == 0u) { xcd_barrier_complete(bar, b.x, nloc, nx); b.st[0] = nloc; b.st[1] = nx; }
        const unsigned old = xb_add(&bar[XB_XSUB(b.x)], 1u);
        const unsigned gen = old / nloc;
        if (old + 1u == (gen + 1u) * nloc) {
            __builtin_amdgcn_fence(__ATOMIC_RELEASE, "agent");
            asm volatile("s_waitcnt vmcnt(0)" ::: "memory");
            const unsigned og = xb_add(&bar[XB_TOP], 1u);
            const unsigned tg = og / nx;
            if (og + 1u == (tg + 1u) * nx) xb_add(&bar[XB_TOPGEN], 1u);
            else XB_SPIN(xb_ld(&bar[XB_TOPGEN]) == tg, bar);
            __builtin_amdgcn_fence(__ATOMIC_ACQUIRE, "agent");
            xb_add(&bar[XB_XGEN(b.x)], 1u);
            asm volatile("s_waitcnt vmcnt(0)" ::: "memory");
        } else {
            XB_SPIN(xb_ld(&bar[XB_XGEN(b.x)]) == gen, bar);
            __builtin_amdgcn_fence(__ATOMIC_ACQUIRE, "agent");
            asm volatile("s_waitcnt vmcnt(0)" ::: "memory");
        }
    }
    __syncthreads();
}

enum { K_PRO = 0, K_GACT, K_GRES, K_SGU, K_CONV, K_POOL, K_TOPK, K_ATTN, K_FINAL };
struct PhaseDesc { int kind, act, lda, apn, N, K, ldc, ss_idx, m0, M; size_t a_off, w_off; };
__device__ __forceinline__ PhaseDesc mk_act(int act, size_t w_off, int N, int ss_idx) { PhaseDesc d{}; d.kind = K_GACT; d.act = act; d.lda = 1024; d.apn = 0; d.N = N; d.K = 1024; d.ldc = N; d.ss_idx = ss_idx; d.m0 = 0; d.M = MTOK; d.a_off = WS_XB; d.w_off = w_off; return d; }
__device__ __forceinline__ PhaseDesc mk_res(size_t a_off, int lda, int apn, size_t w_off, int K, int ss_idx) { PhaseDesc d{}; d.kind = K_GRES; d.lda = lda; d.apn = apn; d.N = 1024; d.K = K; d.ss_idx = ss_idx; d.m0 = 0; d.M = MTOK; d.a_off = a_off; d.w_off = w_off; return d; }
__device__ __forceinline__ PhaseDesc mk_kind(int kind) { PhaseDesc d{}; d.kind = kind; return d; }
constexpr int MLP_Q = 4, MQ = MTOK / MLP_Q;
__device__ __forceinline__ PhaseDesc mk_mlp(int l, int j) {
    const int q = j >> 1;
    if ((j & 1) == 0) { PhaseDesc d = mk_act(2, W_1 + (size_t)l * 8 * MiB, 4096, 2 * l + 1); d.m0 = q * MQ; d.M = MQ; d.a_off = WS_XB + (size_t)q * MQ * 1024 * 2; return d; }
    PhaseDesc d = mk_res(WS_BIG, 4096, 0, W_2 + (size_t)l * 8 * MiB, 4096, 2 * l + 2); d.m0 = q * MQ; d.M = MQ; return d;
}
__device__ __forceinline__ PhaseDesc phase_desc(int ph) {
    if (ph >= 4 && ph < 12) return mk_mlp(0, ph - 4);
    if (ph >= 15 && ph < 23) return mk_mlp(1, ph - 15);
    if (ph >= 26 && ph < 34) return mk_mlp(2, ph - 26);
    if (ph >= 38 && ph < 46) return mk_mlp(3, ph - 38);
    switch (ph) {
    case 0: return mk_kind(K_PRO);
    case 1: return mk_act(1, W_A_IN, 2048, 0);
    case 2: return mk_kind(K_SGU);
    case 3: return mk_res(WS_BIG + 256 * MiB, 1024, 0, W_A_OUT, 1024, 1);
    case 12: return mk_act(0, W_B_IN, 3072, 2);
    case 13: return mk_kind(K_CONV);
    case 14: return mk_res(WS_BIG + 384 * MiB, 1024, 0, W_B_OUT, 1024, 3);
    case 23: return mk_act(0, W_C_IN, 1024, 4);
    case 24: return mk_kind(K_POOL);
    case 25: return mk_res(WS_BIG + 128 * MiB, 1024, 512, W_C_GRP, 256, 5);
    case 34: return mk_act(0, W_D_IN, DSA_LD, 6);
    case 35: return mk_kind(K_TOPK);
    case 36: return mk_kind(K_ATTN);
    case 37: return mk_res(WS_BIG, DSA_LD, 0, W_D_COMB, 2048, 7);
    default: return mk_kind(K_FINAL);
    }
}

__device__ __forceinline__ void run_phase(int ph, const Params& p, LAS unsigned char* lds, bool dry, int wv) {
    const PhaseDesc d = phase_desc(ph);
    unsigned char* ws = p.ws; float* ss = (float*)(ws + WS_SS);
    if (d.kind == K_GACT || d.kind == K_GRES) {
        pg8::Gemm g; g.A = (const bf16_t*)(ws + d.a_off); g.Bt = (const bf16_t*)(ws + d.w_off); g.M = d.M; g.N = d.N; g.K = d.K; g.lda = d.lda; g.apn = d.apn;
        pg8::StaticOrder S; S.init(d.M, d.N, gridDim.x, blockIdx.x);
        if (d.kind == K_GACT) { pg8::EpiAct E; E.O = (bf16_t*)(ws + WS_BIG); E.ldc = d.ldc; E.ss_in = ss + ((size_t)d.ss_idx * MTOK + d.m0) * 16; E.ssv = ss + (size_t)9 * MTOK * 16; E.ACT = d.act; pg8::gemm_phase(lds, g, S, E, wv); }
        else { pg8::EpiResid E; E.xb = (bf16_t*)(ws + WS_XB) + (size_t)d.m0 * DM; E.ss_out = ss + ((size_t)d.ss_idx * MTOK + d.m0) * 16; pg8::gemm_phase(lds, g, S, E, wv); }
    }
    else if (d.kind == K_PRO) phase_prologue(p, lds, wv);
    else if (d.kind == K_SGU) phase_sgu(p, lds, wv);
    else if (d.kind == K_CONV) phase_conv(p, wv);
    else if (d.kind == K_POOL) phase_pool(p, wv);
    else if (d.kind == K_TOPK) phase_topk(p, lds, wv);
    else if (d.kind == K_ATTN) phase_attn(p, lds, dry, wv);
    else phase_final(p, wv);
}

__global__ void __launch_bounds__(512, 2) fwd_megakernel(Params p) {
    extern __shared__ __attribute__((aligned(16))) unsigned char lds_raw[];
    LAS unsigned char* lds = (LAS unsigned char*)lds_raw;
    const int wv = __builtin_amdgcn_readfirstlane((int)threadIdx.x >> 6);
    volatile LAS unsigned* bst = (volatile LAS unsigned*)(lds + 131584);
    XcdBarrier xbar; xbar.bar = (unsigned*)(p.ws + WS_BAR); xbar.x = 0; xbar.st = bst;
    if (p.ph_hi - p.ph_lo > 1) {
        if (threadIdx.x == 0) { bst[0] = 0u; bst[1] = 0u; }
        if (blockIdx.x == 0) { unsigned* bw = (unsigned*)(p.ws + WS_BAR); for (int i = threadIdx.x; i < XCD_BAR_WORDS; i += 512) bw[i] = 0u; }
        __syncthreads();
    }
    for (int ph = p.ph_lo; ph < p.ph_hi; ++ph) {
#if PROBE_DUP
        const int reps = ((PROBE_DUP >> ph) & 1) ? 2 : 1;
        for (int r = 0; r < reps; ++r) { run_phase(ph, p, lds, r + 1 < reps, wv); if (r + 1 < reps) cg::this_grid().sync(); }
#else
        run_phase(ph, p, lds, false, wv);
#endif
        if (ph + 1 < p.ph_hi) {
            if (ph == p.ph_lo) { cg::this_grid().sync(); xbar = xcd_barrier_post((unsigned*)(p.ws + WS_BAR), bst, opaque_tid(wv) == 0); }
            else xcd_barrier(xbar, opaque_tid(wv) == 0);
        }
    }
}

#ifndef MK_MULTI
#define MK_MULTI 0
#endif

extern "C" void kernel_launch(void* const* d_in, const int* in_sizes, int n_in, void* d_out, int out_size, void* d_ws, size_t ws_size, hipStream_t stream) {
    static int grid = 0;
    if (grid == 0) {
        int dev = 0, cus = 0, per_cu = 0;
        hipGetDevice(&dev);
        hipDeviceGetAttribute(&cus, hipDeviceAttributeMultiprocessorCount, dev);
        if (hipFuncSetAttribute((const void*)fwd_megakernel, hipFuncAttributeMaxDynamicSharedMemorySize, LDS_BYTES) != hipSuccess) { fprintf(stderr, "hipFuncSetAttribute failed\n"); grid = -1; return; }
        if (hipOccupancyMaxActiveBlocksPerMultiprocessor(&per_cu, (const void*)fwd_megakernel, 512, LDS_BYTES) != hipSuccess || per_cu < 1) { fprintf(stderr, "occupancy query: %d\n", per_cu); per_cu = 1; }
        (void)hipGetLastError();
        grid = cus * (per_cu > 1 ? 1 : per_cu);
        if (ws_size < 840 * MiB) { fprintf(stderr, "workspace too small\n"); grid = -1; return; }
    }
    if (grid < 0) return;
    Params p{};
    const float** pp = (const float**)&p;
    for (int i = 0; i < 21; ++i) pp[i] = (const float*)d_in[i];
    p.out = (float*)d_out; p.ws = (unsigned char*)d_ws;
#if MK_MULTI
    for (int ph = 0; ph < NPHASE; ++ph) {
        p.ph_lo = ph; p.ph_hi = ph + 1;
        hipLaunchKernelGGL(fwd_megakernel, dim3(grid), dim3(512), LDS_BYTES, stream, p);
    }
#else
    p.ph_lo = 0; p.ph_hi = NPHASE;
    void* args[] = {&p};
    hipError_t e = hipLaunchCooperativeKernel((const void*)fwd_megakernel, dim3(grid), dim3(512), args, LDS_BYTES, stream);
    if (e != hipSuccess) fprintf(stderr, "cooperative launch failed: %s (grid %d)\n", hipGetErrorString(e), grid);
#endif
}
```

```cpp
#include <hip/hip_runtime.h>
#include <hip/hip_cooperative_groups.h>
#include <cstdio>
namespace cg = cooperative_groups;

#ifndef PROBE_DUP
#define PROBE_DUP 0
#endif
#ifndef TOPK_HIST
#define TOPK_HIST 1
#endif
#ifndef PROBE_TOPK
#define PROBE_TOPK 0
#endif
#define LAS __attribute__((address_space(3)))
typedef unsigned short bf16_t;
typedef short bf16x8 __attribute__((ext_vector_type(8)));
typedef float f32x4 __attribute__((ext_vector_type(4)));
typedef float f32x2 __attribute__((ext_vector_type(2)));
typedef unsigned u32x4 __attribute__((ext_vector_type(4)));
typedef unsigned u32x2 __attribute__((ext_vector_type(2)));
typedef unsigned short u16x4 __attribute__((ext_vector_type(4)));

constexpr int MTOK = 65536, DM = 1024, SEQ = 4096;
constexpr size_t MiB = 1ull << 20;
constexpr size_t WS_XB = 0;
constexpr size_t WS_BIG = 128 * MiB;
constexpr size_t WS_CN = 640 * MiB;
constexpr size_t WS_IDX = 656 * MiB;
constexpr size_t WS_SS = 800 * MiB;
constexpr size_t WS_BAR = 688 * MiB;
constexpr size_t WS_W = 692 * MiB;
constexpr size_t W_A_IN = WS_W + 0 * MiB, W_A_OUT = WS_W + 4 * MiB, W_A_S = WS_W + 6 * MiB, W_B_IN = WS_W + 7 * MiB, W_B_OUT = WS_W + 13 * MiB,
                 W_C_IN = WS_W + 15 * MiB, W_C_GRP = WS_W + 17 * MiB, W_D_IN = WS_W + 18 * MiB, W_D_COMB = WS_W + 24 * MiB, W_1 = WS_W + 28 * MiB, W_2 = WS_W + 60 * MiB;
constexpr int DSA_LD = 2816;
constexpr int LDS_BYTES = 131072 + 1024 + 8192 + 4096 + 18432;
constexpr int LDS_STG = 143888;
constexpr int NPHASE = 47;

struct Params {
    const float *x, *norm_mix_g, *norm_mlp_g, *final_g, *a_w_in, *a_v_g, *a_w_s, *a_b_s, *a_w_out, *b_w_in, *b_conv_w, *b_w_out, *c_w_in, *c_w_grp, *c_scale,
        *d_w_in, *d_kv_g, *d_w_uv, *d_w_out, *mlp_w1, *mlp_w2;
    float* out; unsigned char* ws; int ph_lo, ph_hi;
};

__device__ __forceinline__ unsigned cvt_pk_bf16(float lo, float hi) { unsigned r; asm volatile("v_cvt_pk_bf16_f32 %0, %1, %2" : "=v"(r) : "v"(lo), "v"(hi)); return r; }
__device__ __forceinline__ int opaque_tid(int wv) { int l; asm volatile("v_mbcnt_lo_u32_b32 %0, -1, 0\n\tv_mbcnt_hi_u32_b32 %0, -1, %0" : "=v"(l)); return wv * 64 + l; }
__device__ __forceinline__ float bflo(unsigned w) { return __uint_as_float(w << 16); }
__device__ __forceinline__ float bfhi(unsigned w) { return __uint_as_float(w & 0xffff0000u); }
__device__ __forceinline__ float wave_sum(float v) {
#pragma unroll
    for (int o = 32; o; o >>= 1) v += __shfl_xor(v, o);
    return v;
}
__device__ __forceinline__ float sum16(const float* p) { const f32x4 a = *(const f32x4*)p, b = *(const f32x4*)(p + 4), c = *(const f32x4*)(p + 8), d = *(const f32x4*)(p + 12);
    return (((a[0] + a[1]) + (a[2] + a[3])) + ((b[0] + b[1]) + (b[2] + b[3]))) + (((c[0] + c[1]) + (c[2] + c[3])) + ((d[0] + d[1]) + (d[2] + d[3]))); }
__device__ __forceinline__ float xrow16_max(float x) {
    auto s = __builtin_amdgcn_permlane16_swap(__float_as_uint(x), __float_as_uint(x), false, false);
    x = fmaxf(__uint_as_float(s[0]), __uint_as_float(s[1]));
    auto t = __builtin_amdgcn_permlane32_swap(__float_as_uint(x), __float_as_uint(x), false, false);
    return fmaxf(__uint_as_float(t[0]), __uint_as_float(t[1]));
}
__device__ __forceinline__ float xrow16_sum(float x) {
    auto s = __builtin_amdgcn_permlane16_swap(__float_as_uint(x), __float_as_uint(x), false, false);
    x = __uint_as_float(s[0]) + __uint_as_float(s[1]);
    auto t = __builtin_amdgcn_permlane32_swap(__float_as_uint(x), __float_as_uint(x), false, false);
    return __uint_as_float(t[0]) + __uint_as_float(t[1]);
}
__device__ __forceinline__ unsigned off_b(unsigned row, unsigned ch) { return 256u * row + 16u * (ch ^ (((row & 3) << 2) | ((row >> 2) & 3))); }
__device__ __forceinline__ bf16x8 tr_read2(unsigned a0, unsigned a1) {
    u16x4 lo, hi;
    asm volatile("ds_read_b64_tr_b16 %0, %2\n\tds_read_b64_tr_b16 %1, %3\n\ts_waitcnt lgkmcnt(0)" : "=&v"(lo), "=&v"(hi) : "v"(a0), "v"(a1) : "memory");
    bf16x8 r; r[0] = (short)lo[0]; r[1] = (short)lo[1]; r[2] = (short)lo[2]; r[3] = (short)lo[3]; r[4] = (short)hi[0]; r[5] = (short)hi[1]; r[6] = (short)hi[2]; r[7] = (short)hi[3];
    return r;
}
__device__ __forceinline__ void tr_read8(const unsigned (&a)[8], bf16x8 (&r)[4]) {
    u16x4 v0, v1, v2, v3, v4, v5, v6, v7;
    asm volatile("ds_read_b64_tr_b16 %0, %8\n\tds_read_b64_tr_b16 %1, %9\n\tds_read_b64_tr_b16 %2, %10\n\tds_read_b64_tr_b16 %3, %11\n\t"
                 "ds_read_b64_tr_b16 %4, %12\n\tds_read_b64_tr_b16 %5, %13\n\tds_read_b64_tr_b16 %6, %14\n\tds_read_b64_tr_b16 %7, %15\n\ts_waitcnt lgkmcnt(0)"
                 : "=&v"(v0), "=&v"(v1), "=&v"(v2), "=&v"(v3), "=&v"(v4), "=&v"(v5), "=&v"(v6), "=&v"(v7)
                 : "v"(a[0]), "v"(a[1]), "v"(a[2]), "v"(a[3]), "v"(a[4]), "v"(a[5]), "v"(a[6]), "v"(a[7]) : "memory");
    const u16x4 lo[4] = {v0, v2, v4, v6}, hi[4] = {v1, v3, v5, v7};
#pragma unroll
    for (int i = 0; i < 4; ++i) { r[i][0] = (short)lo[i][0]; r[i][1] = (short)lo[i][1]; r[i][2] = (short)lo[i][2]; r[i][3] = (short)lo[i][3]; r[i][4] = (short)hi[i][0]; r[i][5] = (short)hi[i][1]; r[i][6] = (short)hi[i][2]; r[i][7] = (short)hi[i][3]; }
}

namespace pg8 {
constexpr int BM = 256, BK = 64, HALF = 128, HTB = HALF * BK * 2, STAGE_BYTES = 8 * HTB, NXCD = 8, WGM = 8;
__device__ __forceinline__ int lds_byte(int r, int c) { const int st = (r >> 4) * 2 + (c >> 5), rr = r & 15, cc = c & 31, ob = rr * 64 + cc * 2; return st * 1024 + (ob ^ (((ob >> 9) & 1) << 5)); }
__device__ __forceinline__ void stage_rc(int b, int& R, int& C) { const int st = b / 1024, sb = b % 1024, swz = sb ^ (((sb >> 9) & 1) << 5); R = (st >> 1) * 16 + swz / 64; C = (st & 1) * 32 + (swz % 64) / 2; }
__device__ __forceinline__ int perm32(int rho) { const int n = rho >> 4, i = rho & 15; return 8 * (i >> 2) + 4 * n + (i & 3); }
struct Unit { int pm, pn; };
struct Gemm { const bf16_t* A; const bf16_t* Bt; int M, N, K, lda, apn; };
struct StaticOrder {
    int nM, nN, nwg, G, c;
    __device__ void init(int M, int N, int G_, int c_) { nM = M / BM; nN = N / BM; nwg = nM * nN; G = G_; c = c_; }
    __device__ bool next(int i, Unit& u) const {
        const long L = (long)i * G + c; if (L >= nwg) return false;
        int wgid = (int)L; { const int q = nwg / NXCD, r = nwg % NXCD, xcd = wgid % NXCD, off = wgid / NXCD; wgid = (xcd < r ? xcd * (q + 1) : r * (q + 1) + (xcd - r) * q) + off; }
        const int nig = WGM * nN, gid = wgid / nig, fm = gid * WGM, gsz = (nM - fm) < WGM ? (nM - fm) : WGM;
        u.pm = fm + ((wgid % nig) % gsz); u.pn = (wgid % nig) / gsz; return true;
    }
};

__device__ __forceinline__ float gelu_tanh(float x) {
    const float y = 0.7978845608f * (x + 0.044715f * x * x * x);
    const float e = __builtin_amdgcn_exp2f(-2.885390082f * y);
    return x * __builtin_amdgcn_rcpf(1.0f + e);
}
struct EpiAct {
    static constexpr bool PERM = true;
    bf16_t* O; int ldc; const float* ss_in; float* ssv; int ACT; const LAS float* rstab;
    __device__ __forceinline__ void operator()(const f32x4 (&acc)[2][2][4][2], const Unit& u, int ui, int wr, int wc, int fr, int fq) const {
        const int row0 = u.pm * BM + wr * 64 + fr, col0 = u.pn * BM + wc * 32 + 8 * fq;
        float rsv[2][4];
#pragma unroll
        for (int ai = 0; ai < 2; ++ai)
#pragma unroll
            for (int m = 0; m < 4; ++m) {
                rsv[ai][m] = rstab[ui * 256 + ai * HALF + wr * 64 + m * 16 + fr];
            }
#pragma unroll
        for (int ai = 0; ai < 2; ++ai)
#pragma unroll
            for (int m = 0; m < 4; ++m) {
                const int row = row0 + ai * HALF + m * 16;
                const float rs = rsv[ai][m];
                bf16_t* rowp = O + (size_t)row * ldc + col0; float sq = 0.f;
#pragma unroll
                for (int bj = 0; bj < 2; ++bj) {
                    f32x4 v0 = acc[ai][bj][m][0] * rs, v1 = acc[ai][bj][m][1] * rs;
                    if (ACT == 1) {
#pragma unroll
                        for (int j = 0; j < 4; ++j) { v0[j] = gelu_tanh(v0[j]); v1[j] = gelu_tanh(v1[j]); sq += v0[j] * v0[j] + v1[j] * v1[j]; }
                    }
                    if (ACT == 2) {
#pragma unroll
                        for (int j = 0; j < 4; ++j) { const float a = fmaxf(v0[j], 0.f), b = fmaxf(v1[j], 0.f); v0[j] = a * a; v1[j] = b * b; }
                    }
                    u32x4 w; w.x = cvt_pk_bf16(v0[0], v0[1]); w.y = cvt_pk_bf16(v0[2], v0[3]); w.z = cvt_pk_bf16(v1[0], v1[1]); w.w = cvt_pk_bf16(v1[2], v1[3]);
                    *(u32x4*)(rowp + bj * HALF) = w;
                }
                if (ACT == 1) {
                    sq = xrow16_sum(sq);
                    if (u.pn >= 4 && fq == 0) ssv[(size_t)row * 16 + (u.pn - 4) * 4 + wc] = sq;
                }
            }
    }
};
struct EpiResid {
    static constexpr bool PERM = true;
    bf16_t* xb; float* ss_out;
    __device__ __forceinline__ void operator()(const f32x4 (&acc)[2][2][4][2], const Unit& u, int ui, int wr, int wc, int fr, int fq) const {
        const int row0 = u.pm * BM + wr * 64 + fr, col0 = u.pn * BM + wc * 32 + 8 * fq;
#pragma unroll
        for (int ai = 0; ai < 2; ++ai) {
            u32x4 xo[4][2];
#pragma unroll
            for (int m = 0; m < 4; ++m)
#pragma unroll
                for (int bj = 0; bj < 2; ++bj) xo[m][bj] = *(const u32x4*)(xb + (size_t)(row0 + ai * HALF + m * 16) * DM + col0 + bj * HALF);
#pragma unroll
            for (int m = 0; m < 4; ++m) {
                const int row = row0 + ai * HALF + m * 16; const size_t off = (size_t)row * DM + col0; float sq = 0.f;
#pragma unroll
                for (int bj = 0; bj < 2; ++bj) {
                    const u32x4 xw = xo[m][bj]; const f32x4 a0 = acc[ai][bj][m][0], a1 = acc[ai][bj][m][1];
                    const float v0 = bflo(xw.x) + a0[0], v1 = bfhi(xw.x) + a0[1], v2 = bflo(xw.y) + a0[2], v3 = bfhi(xw.y) + a0[3];
                    const float v4 = bflo(xw.z) + a1[0], v5 = bfhi(xw.z) + a1[1], v6 = bflo(xw.w) + a1[2], v7 = bfhi(xw.w) + a1[3];
                    u32x4 w; w.x = cvt_pk_bf16(v0, v1); w.y = cvt_pk_bf16(v2, v3); w.z = cvt_pk_bf16(v4, v5); w.w = cvt_pk_bf16(v6, v7);
                    *(u32x4*)(xb + off + bj * HALF) = w;
                    sq += ((v0 * v0 + v1 * v1) + (v2 * v2 + v3 * v3)) + ((v4 * v4 + v5 * v5) + (v6 * v6 + v7 * v7));
                }
                sq = xrow16_sum(sq);
                if (fq == 0) ss_out[(size_t)row * 16 + u.pn * 4 + wc] = sq;
            }
            asm volatile("" ::: "memory");
        }
    }
};

__device__ __forceinline__ void act_rs_table(LAS float* tab, const StaticOrder& S, const float* ss_in, int tid) {
    Unit u;
    for (int i = 0; S.next(i, u); ++i) {
        if (tid < 256) tab[i * 256 + tid] = rsqrtf(sum16(ss_in + (size_t)(u.pm * BM + tid) * 16) * (1.0f / 1024.0f) + 1e-6f);
    }
    __syncthreads();
}
template <class Epi>
__device__ __forceinline__ void gemm_phase(LAS unsigned char* lds, const Gemm g, const StaticOrder& S, const Epi& E, int wv) {
    const int tid = opaque_tid(wv), wid = __builtin_amdgcn_readfirstlane(tid >> 6), lane = tid & 63, wr = wid >> 2, wc = wid & 3, fr = lane & 15, fq = lane >> 4;
    const int K = g.K, nt = K / BK, lda = g.lda;
    unsigned voffA[2], voffB[2];
#pragma unroll
    for (int i = 0; i < 2; ++i) { int R, C; stage_rc(tid * 16 + i * 8192, R, C); const int Rb = Epi::PERM ? ((R & ~31) + perm32(R & 31)) : R;
        voffA[i] = (unsigned)(R * lda + C) * 2u; voffB[i] = (unsigned)(Rb * K + C) * 2u; }
    const size_t kstep = (size_t)(BK * 2);
    const size_t hstepA = (size_t)HALF * lda * 2, hstepB = (size_t)HALF * K * 2;
    const size_t tstepA = 2 * hstepA, tstepB = 2 * hstepB;
    const unsigned ldsw = (unsigned)wid * 1024u;
    const int aoff = lds_byte(wr * 64 + fr, fq * 8), boff = lds_byte(wc * 32 + fr, fq * 8);
#define PG8_SA(b, h) (((b) * 2 + (h)) * HTB)
#define PG8_SB(b, h) ((4 + (b) * 2 + (h)) * HTB)
#define PG8_STAGE(bufoff, gbase, voff) do { _Pragma("unroll") for (int _i = 0; _i < 2; ++_i) \
        __builtin_amdgcn_global_load_lds((const unsigned*)((const char*)(gbase) + (voff)[_i]), (LAS unsigned*)(lds + (bufoff) + ldsw + _i * 8192), 16, 0, 0); } while (0)
#define PG8_LDA(dst, b, h) do { _Pragma("unroll") for (int m = 0; m < 4; ++m) _Pragma("unroll") for (int k = 0; k < 2; ++k) dst[m][k] = *(const LAS bf16x8*)(lds + PG8_SA(b, h) + aoff + m * 2048 + k * 1024); } while (0)
#define PG8_LDB(dst, b, h) do { _Pragma("unroll") for (int n = 0; n < 2; ++n) _Pragma("unroll") for (int k = 0; k < 2; ++k) dst[n][k] = *(const LAS bf16x8*)(lds + PG8_SB(b, h) + boff + n * 2048 + k * 1024); } while (0)
#define PG8_MMA(ai, bj, At, Bt) do { __builtin_amdgcn_s_setprio(1); _Pragma("unroll") for (int m = 0; m < 4; ++m) _Pragma("unroll") for (int n = 0; n < 2; ++n) _Pragma("unroll") for (int k = 0; k < 2; ++k) \
        acc[ai][bj][m][n] = __builtin_amdgcn_mfma_f32_16x16x32_bf16(Bt[n][k], At[m][k], acc[ai][bj][m][n], 0, 0, 0); __builtin_amdgcn_s_setprio(0); } while (0)
#define PG8_WAIT_V(n) asm volatile("s_waitcnt vmcnt(" #n ")" ::: "memory")
#define PG8_WAIT_L(n) asm volatile("s_waitcnt lgkmcnt(" #n ")" ::: "memory")
#define PG8_BAR __builtin_amdgcn_s_barrier()
#define PG8_SCHED __builtin_amdgcn_sched_barrier(0)
    Unit cur, nxt; int ui = 0;
    if (!S.next(0, cur)) return;
    f32x4 acc[2][2][4][2];
#pragma unroll
    for (int a = 0; a < 2; ++a)
#pragma unroll
        for (int b = 0; b < 2; ++b)
#pragma unroll
            for (int m = 0; m < 4; ++m)
#pragma unroll
                for (int n = 0; n < 2; ++n) acc[a][b][m][n] = (f32x4){0.f, 0.f, 0.f, 0.f};
    bf16x8 At[4][2], B0[2][2], B1[2][2];
    const char* cA = (const char*)g.A + (size_t)cur.pm * tstepA + (size_t)cur.pn * g.apn; const char* cB = (const char*)g.Bt + (size_t)cur.pn * tstepB;
    PG8_STAGE(PG8_SB(0, 0), cB, voffB); PG8_STAGE(PG8_SA(0, 0), cA, voffA); PG8_STAGE(PG8_SB(0, 1), cB + hstepB, voffB); PG8_STAGE(PG8_SA(0, 1), cA + hstepA, voffA);
    if (wr == 1) PG8_BAR;
    PG8_WAIT_V(4); PG8_BAR;
    PG8_STAGE(PG8_SB(1, 0), cB + kstep, voffB); PG8_STAGE(PG8_SA(1, 0), cA + kstep, voffA); PG8_STAGE(PG8_SB(1, 1), cB + hstepB + kstep, voffB);
    PG8_WAIT_V(6); PG8_BAR;
    for (;;) {
        const bool has_next = S.next(ui + 1, nxt);
        const char* nA = has_next ? (const char*)g.A + (size_t)nxt.pm * tstepA + (size_t)nxt.pn * g.apn : cA; const char* nB = has_next ? (const char*)g.Bt + (size_t)nxt.pn * tstepB : cB;
        for (int t = 0; t < nt; t += 2) {
            const bool last = (t == nt - 2);
            const char* a1 = cA + (size_t)(t + 1) * kstep;
            const char* a2 = last ? nA : cA + (size_t)(t + 2) * kstep; const char* b2 = last ? nB : cB + (size_t)(t + 2) * kstep;
            const char* a3 = a2 + kstep; const char* b3 = b2 + kstep;
            PG8_LDB(B0, 0, 0); PG8_SCHED; PG8_LDA(At, 0, 0); PG8_STAGE(PG8_SA(1, 1), a1 + hstepA, voffA);
            PG8_WAIT_L(8); PG8_BAR; PG8_WAIT_L(0); PG8_MMA(0, 0, At, B0); PG8_BAR; PG8_SCHED;
            PG8_LDB(B1, 0, 1); PG8_STAGE(PG8_SB(0, 0), b2, voffB);
            PG8_BAR; PG8_WAIT_L(0); PG8_MMA(0, 1, At, B1); PG8_BAR;
            PG8_LDA(At, 0, 1); PG8_STAGE(PG8_SA(0, 0), a2, voffA);
            PG8_BAR; PG8_WAIT_L(0); PG8_MMA(1, 0, At, B0); PG8_BAR; PG8_SCHED;
            PG8_STAGE(PG8_SB(0, 1), b2 + hstepB, voffB);
            PG8_WAIT_V(6); PG8_BAR; PG8_MMA(1, 1, At, B1); PG8_BAR;
            PG8_LDB(B0, 1, 0); PG8_SCHED; PG8_LDA(At, 1, 0); PG8_STAGE(PG8_SA(0, 1), a2 + hstepA, voffA);
            PG8_WAIT_L(8); PG8_BAR; PG8_WAIT_L(0); PG8_MMA(0, 0, At, B0); PG8_BAR; PG8_SCHED;
            PG8_LDB(B1, 1, 1); PG8_STAGE(PG8_SB(1, 0), b3, voffB);
            PG8_BAR; PG8_WAIT_L(0); PG8_MMA(0, 1, At, B1); PG8_BAR;
            PG8_LDA(At, 1, 1); PG8_STAGE(PG8_SA(1, 0), a3, voffA);
            PG8_BAR; PG8_WAIT_L(0); PG8_MMA(1, 0, At, B0); PG8_BAR; PG8_SCHED;
            PG8_STAGE(PG8_SB(1, 1), b3 + hstepB, voffB);
            PG8_WAIT_V(6); PG8_BAR; PG8_MMA(1, 1, At, B1); PG8_BAR;
        }
        E(acc, cur, ui, wr, wc, fr, fq);
        if (!has_next) break;
#pragma unroll
        for (int a = 0; a < 2; ++a)
#pragma unroll
            for (int b = 0; b < 2; ++b)
#pragma unroll
                for (int m = 0; m < 4; ++m)
#pragma unroll
                    for (int n = 0; n < 2; ++n) acc[a][b][m][n] = (f32x4){0.f, 0.f, 0.f, 0.f};
        cur = nxt; cA = nA; cB = nB; ++ui;
    }
    PG8_WAIT_V(0);
    if (wr == 0) PG8_BAR;
    PG8_BAR;
#undef PG8_SA
#undef PG8_SB
#undef PG8_STAGE
#undef PG8_LDA
#undef PG8_LDB
#undef PG8_MMA
#undef PG8_WAIT_V
#undef PG8_WAIT_L
#undef PG8_BAR
#undef PG8_SCHED
}
}

__device__ void transpose_convert(int gw, int nw, int lane, const float* W, int K, int N, int Npad, bf16_t* Wt, int ldt, const float* rowgain, const float* colgain) {
    const int kb_n = K / 16, units = kb_n * (Npad / 256);
    for (int u = gw; u < units; u += nw) {
        const int k0 = (u % kb_n) * 16, n = (u / kb_n) * 256 + 4 * lane;
        f32x4 v[16];
        if (n < N) {
#pragma unroll
            for (int i = 0; i < 16; ++i) v[i] = *(const f32x4*)(W + (size_t)(k0 + i) * N + n);
            if (rowgain) {
#pragma unroll
                for (int i = 0; i < 16; ++i) v[i] *= rowgain[k0 + i];
            }
            if (colgain) { const f32x4 cgv = *(const f32x4*)(colgain + n);
#pragma unroll
                for (int i = 0; i < 16; ++i) v[i] *= cgv; }
        } else {
#pragma unroll
            for (int i = 0; i < 16; ++i) v[i] = (f32x4){0.f, 0.f, 0.f, 0.f};
        }
#pragma unroll
        for (int j = 0; j < 4; ++j) {
            u32x4 w0, w1; w0.x = cvt_pk_bf16(v[0][j], v[1][j]); w0.y = cvt_pk_bf16(v[2][j], v[3][j]); w0.z = cvt_pk_bf16(v[4][j], v[5][j]); w0.w = cvt_pk_bf16(v[6][j], v[7][j]);
            w1.x = cvt_pk_bf16(v[8][j], v[9][j]); w1.y = cvt_pk_bf16(v[10][j], v[11][j]); w1.z = cvt_pk_bf16(v[12][j], v[13][j]); w1.w = cvt_pk_bf16(v[14][j], v[15][j]);
            u32x4* dst = (u32x4*)(Wt + (size_t)(n + j) * ldt + k0); dst[0] = w0; dst[1] = w1;
        }
    }
}

__device__ void phase_prologue(const Params& p, LAS unsigned char* lds, int wv) {
    unsigned char* ws = p.ws;
    const int tid = opaque_tid(wv), lane = tid & 63, wave = tid >> 6;
    const int gw = blockIdx.x * 8 + wave, nw = gridDim.x * 8;
    const size_t gtid = (size_t)blockIdx.x * 512 + tid, gsz = (size_t)gridDim.x * 512;
    float* ss = (float*)(ws + WS_SS);
    bf16_t* xb = (bf16_t*)(ws + WS_XB);
    for (int row2 = (blockIdx.x * 8 + wave) * 2; row2 < MTOK; row2 += gridDim.x * 16) {
        f32x4 xv[2][4];
#pragma unroll
        for (int k = 0; k < 2; ++k)
#pragma unroll
            for (int i = 0; i < 4; ++i) xv[k][i] = ((const f32x4*)(p.x + (size_t)(row2 + k) * DM))[lane + 64 * i];
#pragma unroll
        for (int k = 0; k < 2; ++k) { const int row = row2 + k; float sq = 0.f;
#pragma unroll
            for (int i = 0; i < 4; ++i) { const f32x4 v = xv[k][i]; sq += (v[0] * v[0] + v[1] * v[1]) + (v[2] * v[2] + v[3] * v[3]);
                u32x2 w; w.x = cvt_pk_bf16(v[0], v[1]); w.y = cvt_pk_bf16(v[2], v[3]); *(u32x2*)(xb + (size_t)row * DM + (lane + 64 * i) * 4) = w; }
            sq = wave_sum(sq);
            if (lane < 16) ss[(size_t)row * 16 + lane] = lane == 0 ? sq : 0.f; }
    }
    transpose_convert(gw, nw, lane, p.a_w_in, 1024, 2048, 2048, (bf16_t*)(ws + W_A_IN), 1024, p.norm_mix_g + 0 * DM, nullptr);
    transpose_convert(gw, nw, lane, p.a_w_out, 1024, 1024, 1024, (bf16_t*)(ws + W_A_OUT), 1024, nullptr, nullptr);
    transpose_convert(gw, nw, lane, p.b_w_in, 1024, 3072, 3072, (bf16_t*)(ws + W_B_IN), 1024, p.norm_mix_g + 1 * DM, nullptr);
    transpose_convert(gw, nw, lane, p.b_w_out, 1024, 1024, 1024, (bf16_t*)(ws + W_B_OUT), 1024, nullptr, nullptr);
    transpose_convert(gw, nw, lane, p.c_w_in, 1024, 1024, 1024, (bf16_t*)(ws + W_C_IN), 1024, p.norm_mix_g + 2 * DM, nullptr);
    for (int g = 0; g < 4; ++g)
        transpose_convert(gw, nw, lane, p.c_w_grp + (size_t)g * 65536, 256, 256, 256, (bf16_t*)(ws + W_C_GRP) + (size_t)g * 65536, 256, nullptr, p.c_scale + g * 256);
    transpose_convert(gw, nw, lane, p.d_w_in, 1024, 2760, DSA_LD, (bf16_t*)(ws + W_D_IN), 1024, p.norm_mix_g + 3 * DM, nullptr);
    for (int l = 0; l < 4; ++l) {
        transpose_convert(gw, nw, lane, p.mlp_w1 + (size_t)l * 4194304, 1024, 4096, 4096, (bf16_t*)(ws + W_1) + (size_t)l * 4194304, 1024, p.norm_mlp_g + l * DM, nullptr);
        transpose_convert(gw, nw, lane, p.mlp_w2 + (size_t)l * 4194304, 4096, 1024, 1024, (bf16_t*)(ws + W_2) + (size_t)l * 4194304, 4096, nullptr, nullptr);
    }
    { bf16_t* wsm = (bf16_t*)(ws + W_A_S);
      for (size_t i = gtid; i < (size_t)8 * 128 * 128; i += gsz) { const int s = (int)(i & 127), t = (int)((i >> 7) & 127); const float v = (s <= t) ? p.a_w_s[i] : 0.f; wsm[i] = (bf16_t)(cvt_pk_bf16(v, 0.f) & 0xffffu); } }
    { bf16_t* wc = (bf16_t*)(ws + W_D_COMB);
      for (int u = gw; u < 256 * 4; u += nw) {
          const int k0 = (u >> 2) * 8, n = (u & 3) * 256 + 4 * lane, h = k0 >> 7;
          const float* uv = p.d_w_uv + (size_t)k0 * 64; const float* wo = p.d_w_out + (size_t)h * 64 * 1024 + n;
          f32x4 a[8]; float uvr[8];
#pragma unroll
          for (int i = 0; i < 8; ++i) { a[i] = (f32x4){0.f, 0.f, 0.f, 0.f}; uvr[i] = uv[i * 64 + lane]; }
#pragma unroll 8
          for (int v = 0; v < 64; ++v) { const f32x4 w4 = *(const f32x4*)(wo + (size_t)v * 1024);
#pragma unroll
              for (int i = 0; i < 8; ++i) a[i] += w4 * __uint_as_float(__builtin_amdgcn_readlane(__float_as_uint(uvr[i]), v)); }
#pragma unroll
          for (int j = 0; j < 4; ++j) {
              u32x4 w; w.x = cvt_pk_bf16(a[0][j], a[1][j]); w.y = cvt_pk_bf16(a[2][j], a[3][j]); w.z = cvt_pk_bf16(a[4][j], a[5][j]); w.w = cvt_pk_bf16(a[6][j], a[7][j]);
              *(u32x4*)(wc + (size_t)(n + j) * 2048 + k0) = w; } } }
}

__device__ void phase_sgu(const Params& p, LAS unsigned char* lds, int wv) {
    unsigned char* ws = p.ws;
    const int tid = opaque_tid(wv), lane = tid & 63, wave = __builtin_amdgcn_readfirstlane(tid >> 6), g4 = lane >> 4, l15 = lane & 15, q = l15 >> 2, pp = lane & 3;
    const bf16_t* z = (const bf16_t*)(ws + WS_BIG); bf16_t* us = (bf16_t*)(ws + WS_BIG + 256 * MiB);
    const float* ssv = (const float*)(ws + WS_SS) + (size_t)9 * MTOK * 16; const bf16_t* wsm = (const bf16_t*)(ws + W_A_S);
    const unsigned ldsbase = (unsigned)(size_t)(unsigned char*)lds;
    u32x4 raw[4]; float ssum[4];
    if ((int)blockIdx.x < 4096) { const int g = blockIdx.x & 7; const size_t row0 = (size_t)(blockIdx.x >> 3) * 128;
#pragma unroll
        for (int i = 0; i < 4; ++i) { const int e = tid + 512 * i, r = e >> 4, ch = e & 15;
            raw[i] = *(const u32x4*)(z + (row0 + r) * 2048 + 1024 + g * 128 + ch * 8); ssum[i] = sum16(ssv + (row0 + r) * 16); } }
    for (int unit = blockIdx.x; unit < 4096; unit += gridDim.x) {
        const int g = unit & 7, chunk = unit >> 3; const size_t row0 = (size_t)chunk * 128;
#pragma unroll
        for (int i = 0; i < 4; ++i) {
            const int e = tid + 512 * i, r = e >> 4, ch = e & 15;
            const float rs = rsqrtf(ssum[i] * (1.0f / 1024.0f) + 1e-6f);
            const f32x4 g0 = *(const f32x4*)(p.a_v_g + g * 128 + ch * 8), g1 = *(const f32x4*)(p.a_v_g + g * 128 + ch * 8 + 4);
            u32x4 o;
            o.x = cvt_pk_bf16(bflo(raw[i].x) * rs * g0[0], bfhi(raw[i].x) * rs * g0[1]); o.y = cvt_pk_bf16(bflo(raw[i].y) * rs * g0[2], bfhi(raw[i].y) * rs * g0[3]);
            o.z = cvt_pk_bf16(bflo(raw[i].z) * rs * g1[0], bfhi(raw[i].z) * rs * g1[1]); o.w = cvt_pk_bf16(bflo(raw[i].w) * rs * g1[2], bfhi(raw[i].w) * rs * g1[3]);
            *(LAS u32x4*)(lds + (r >> 5) * 8192 + off_b(r & 31, ch)) = o;
        }
        __syncthreads();
        const int t = 16 * wave + l15, nks = (wave >> 1) + 1;
        const float bias = p.a_b_s[g * 128 + t]; const size_t rowg = row0 + t;
        u32x2 uu8[8]; bf16x8 Bw4[4];
#pragma unroll
        for (int ks = 0; ks < 4; ++ks) Bw4[ks] = *(const bf16x8*)(wsm + ((size_t)g * 128 + t) * 128 + 32 * (ks < nks ? ks : 0) + 8 * g4);
#pragma unroll
        for (int ct = 0; ct < 8; ++ct) uu8[ct] = *(const u32x2*)(z + rowg * 2048 + g * 128 + 16 * ct + 4 * g4);
        { const int nu = unit + (int)gridDim.x;
          if (nu < 4096) { const int g2 = nu & 7; const size_t r2 = (size_t)(nu >> 3) * 128;
#pragma unroll
              for (int i = 0; i < 4; ++i) { const int e = tid + 512 * i, r = e >> 4, ch = e & 15;
                  raw[i] = *(const u32x4*)(z + (r2 + r) * 2048 + 1024 + g2 * 128 + ch * 8); ssum[i] = sum16(ssv + (r2 + r) * 16); } } }
        f32x4 acc[8];
#pragma unroll
        for (int ct = 0; ct < 8; ++ct) acc[ct] = (f32x4){0.f, 0.f, 0.f, 0.f};
#pragma unroll
        for (int ks = 0; ks < 4; ++ks) {
            if (ks < nks) {
                const bf16x8 Bw = Bw4[ks];
#pragma unroll
                for (int cb = 0; cb < 2; ++cb) {
                    unsigned ad[8]; bf16x8 Av[4];
#pragma unroll
                    for (int i = 0; i < 4; ++i) { const int ct = 4 * cb + i;
                        ad[2 * i] = ldsbase + ks * 8192 + off_b(8 * g4 + q, 2 * ct + (pp >> 1)) + 8 * (pp & 1); ad[2 * i + 1] = ldsbase + ks * 8192 + off_b(8 * g4 + 4 + q, 2 * ct + (pp >> 1)) + 8 * (pp & 1); }
                    tr_read8(ad, Av);
#pragma unroll
                    for (int i = 0; i < 4; ++i) acc[4 * cb + i] = __builtin_amdgcn_mfma_f32_16x16x32_bf16(Av[i], Bw, acc[4 * cb + i], 0, 0, 0);
                }
            }
        }
#pragma unroll
        for (int ct = 0; ct < 8; ++ct) {
            const u32x2 uu = uu8[ct];
            u32x2 o; o.x = cvt_pk_bf16(bflo(uu.x) * (acc[ct][0] + bias), bfhi(uu.x) * (acc[ct][1] + bias)); o.y = cvt_pk_bf16(bflo(uu.y) * (acc[ct][2] + bias), bfhi(uu.y) * (acc[ct][3] + bias));
            *(u32x2*)(us + rowg * 1024 + g * 128 + 16 * ct + 4 * g4) = o;
        }
        __syncthreads();
    }
}

__device__ void phase_conv(const Params& p, int wv) {
    unsigned char* ws = p.ws; const bf16_t* bch = (const bf16_t*)(ws + WS_BIG); bf16_t* gated = (bf16_t*)(ws + WS_BIG + 384 * MiB);
    const size_t gtid = (size_t)blockIdx.x * 512 + opaque_tid(wv), gsz = (size_t)gridDim.x * 512;
    for (size_t it = gtid; it < (size_t)4096 * 128; it += gsz) {
        const int ch = (int)(it & 127) * 8, rb = (int)(it >> 7); const int r0 = rb * 16;
        float w0[8], w1[8], w2[8], zm2[8], zm1[8];
#pragma unroll
        for (int j = 0; j < 8; ++j) { w0[j] = p.b_conv_w[ch + j]; w1[j] = p.b_conv_w[1024 + ch + j]; w2[j] = p.b_conv_w[2048 + ch + j]; zm2[j] = 0.f; zm1[j] = 0.f; }
        const int tpos0 = r0 & (SEQ - 1);
        for (int d = 2; d >= 1; --d) {
            if (tpos0 - d >= 0) {
                const bf16_t* rp = bch + (size_t)(r0 - d) * 3072; const u32x4 c = *(const u32x4*)(rp + 1024 + ch), h = *(const u32x4*)(rp + 2048 + ch);
                float zz[8] = {bflo(c.x) * bflo(h.x), bfhi(c.x) * bfhi(h.x), bflo(c.y) * bflo(h.y), bfhi(c.y) * bfhi(h.y), bflo(c.z) * bflo(h.z), bfhi(c.z) * bfhi(h.z), bflo(c.w) * bflo(h.w), bfhi(c.w) * bfhi(h.w)};
#pragma unroll
                for (int j = 0; j < 8; ++j) { if (d == 2) zm2[j] = zz[j]; else zm1[j] = zz[j]; }
            }
        }
        for (int r4 = r0; r4 < r0 + 16; r4 += 4) {
            u32x4 bq[4], cq[4], hq[4];
#pragma unroll
            for (int k = 0; k < 4; ++k) { const bf16_t* rp = bch + (size_t)(r4 + k) * 3072; bq[k] = *(const u32x4*)(rp + ch); cq[k] = *(const u32x4*)(rp + 1024 + ch); hq[k] = *(const u32x4*)(rp + 2048 + ch); }
#pragma unroll
            for (int k = 0; k < 4; ++k) {
                const u32x4 b = bq[k], c = cq[k], h = hq[k];
                float zz[8] = {bflo(c.x) * bflo(h.x), bfhi(c.x) * bfhi(h.x), bflo(c.y) * bflo(h.y), bfhi(c.y) * bfhi(h.y), bflo(c.z) * bflo(h.z), bfhi(c.z) * bfhi(h.z), bflo(c.w) * bflo(h.w), bfhi(c.w) * bfhi(h.w)};
                float bb[8] = {bflo(b.x), bfhi(b.x), bflo(b.y), bfhi(b.y), bflo(b.z), bfhi(b.z), bflo(b.w), bfhi(b.w)};
                float o[8];
#pragma unroll
                for (int j = 0; j < 8; ++j) { o[j] = bb[j] * (w0[j] * zm2[j] + w1[j] * zm1[j] + w2[j] * zz[j]); zm2[j] = zm1[j]; zm1[j] = zz[j]; }
                u32x4 w; w.x = cvt_pk_bf16(o[0], o[1]); w.y = cvt_pk_bf16(o[2], o[3]); w.z = cvt_pk_bf16(o[4], o[5]); w.w = cvt_pk_bf16(o[6], o[7]);
                *(u32x4*)(gated + (size_t)(r4 + k) * 1024 + ch) = w;
            }
        }
    }
}

__device__ __forceinline__ void ld8(const bf16_t* ptr, float (&f)[8]) {
    const u32x4 v = *(const u32x4*)ptr; f[0] = bflo(v.x); f[1] = bfhi(v.x); f[2] = bflo(v.y); f[3] = bfhi(v.y); f[4] = bflo(v.z); f[5] = bfhi(v.z); f[6] = bflo(v.w); f[7] = bfhi(v.w);
}
__device__ void phase_pool(const Params& p, int wv) {
    unsigned char* ws = p.ws; const bf16_t* z = (const bf16_t*)(ws + WS_BIG); bf16_t* pooled = (bf16_t*)(ws + WS_BIG + 128 * MiB);
    const size_t gtid = (size_t)blockIdx.x * 512 + opaque_tid(wv), gsz = (size_t)gridDim.x * 512;
    for (size_t it = gtid; it < (size_t)2048 * 128; it += gsz) {
        const int lane = (int)(it & 63), wv = (int)(it >> 6), chunk = (wv & 3) * 32 + (lane & 31), rb = (wv >> 2) * 2 + (lane >> 5);
        const int ch = chunk * 8, w = 2 << (ch >> 8), r0 = rb * 32;
        float S[8];
#pragma unroll
        for (int j = 0; j < 8; ++j) S[j] = 0.f;
        const int tpos0 = r0 & (SEQ - 1);
        for (int d = 1; d <= w; ++d) {
            if (tpos0 - d >= 0) { float f[8]; ld8(z + (size_t)(r0 - d) * 1024 + ch, f);
#pragma unroll
                for (int j = 0; j < 8; ++j) S[j] += f[j]; }
        }
        for (int r4 = r0; r4 < r0 + 32; r4 += 4) {
            u32x4 fa[4], oa[4];
#pragma unroll
            for (int k = 0; k < 4; ++k) { const int r = r4 + k; fa[k] = *(const u32x4*)(z + (size_t)r * 1024 + ch);
                const int rr = ((r & (SEQ - 1)) - w >= 0) ? r - w : r; oa[k] = *(const u32x4*)(z + (size_t)rr * 1024 + ch); }
#pragma unroll
            for (int k = 0; k < 4; ++k) {
                const int r = r4 + k, tpos = r & (SEQ - 1);
                float f[8] = {bflo(fa[k].x), bfhi(fa[k].x), bflo(fa[k].y), bfhi(fa[k].y), bflo(fa[k].z), bfhi(fa[k].z), bflo(fa[k].w), bfhi(fa[k].w)};
#pragma unroll
                for (int j = 0; j < 8; ++j) S[j] += f[j];
                if (tpos - w >= 0) { float o[8] = {bflo(oa[k].x), bfhi(oa[k].x), bflo(oa[k].y), bfhi(oa[k].y), bflo(oa[k].z), bfhi(oa[k].z), bflo(oa[k].w), bfhi(oa[k].w)};
#pragma unroll
                    for (int j = 0; j < 8; ++j) S[j] -= o[j]; }
                const int cnt = (tpos + 1 < w) ? tpos + 1 : w; const float inv = 1.0f / (float)cnt;
                u32x4 o; o.x = cvt_pk_bf16(S[0] * inv - f[0], S[1] * inv - f[1]); o.y = cvt_pk_bf16(S[2] * inv - f[2], S[3] * inv - f[3]);
                o.z = cvt_pk_bf16(S[4] * inv - f[4], S[5] * inv - f[5]); o.w = cvt_pk_bf16(S[6] * inv - f[6], S[7] * inv - f[7]);
                *(u32x4*)(pooled + (size_t)r * 1024 + ch) = o;
            }
        }
    }
}

__device__ __forceinline__ int cnt_ge8(const unsigned* v, unsigned cand) {
    unsigned long long m0, m1, m2, m3, m4, m5, m6, m7;
    asm("v_cmp_le_u32_e64 %0, %8, %9\n\tv_cmp_le_u32_e64 %1, %8, %10\n\tv_cmp_le_u32_e64 %2, %8, %11\n\tv_cmp_le_u32_e64 %3, %8, %12\n\t"
        "v_cmp_le_u32_e64 %4, %8, %13\n\tv_cmp_le_u32_e64 %5, %8, %14\n\tv_cmp_le_u32_e64 %6, %8, %15\n\tv_cmp_le_u32_e64 %7, %8, %16"
        : "=&s"(m0), "=&s"(m1), "=&s"(m2), "=&s"(m3), "=&s"(m4), "=&s"(m5), "=&s"(m6), "=&s"(m7)
        : "s"(cand), "v"(v[0]), "v"(v[1]), "v"(v[2]), "v"(v[3]), "v"(v[4]), "v"(v[5]), "v"(v[6]), "v"(v[7]));
    return (__builtin_popcountll(m0) + __builtin_popcountll(m1)) + (__builtin_popcountll(m2) + __builtin_popcountll(m3)) +
           (__builtin_popcountll(m4) + __builtin_popcountll(m5)) + (__builtin_popcountll(m6) + __builtin_popcountll(m7));
}
__device__ __forceinline__ void hist_find(LAS unsigned* hist, int lane, int target, int& bin, int& above) {
    const u32x4 h = *(LAS u32x4*)(hist + 4 * lane);
    const int tot = (int)(h.x + h.y + h.z + h.w);
    int suf = tot;
    suf += __builtin_amdgcn_update_dpp(0, suf, 0x101, 0xf, 0xf, true);
    suf += __builtin_amdgcn_update_dpp(0, suf, 0x102, 0xf, 0xf, true);
    suf += __builtin_amdgcn_update_dpp(0, suf, 0x104, 0xf, 0xf, true);
    suf += __builtin_amdgcn_update_dpp(0, suf, 0x108, 0xf, 0xf, true);
    { const int r1 = __builtin_amdgcn_readlane(suf, 16), r2 = __builtin_amdgcn_readlane(suf, 32), r3 = __builtin_amdgcn_readlane(suf, 48); const int g = lane >> 4;
      suf += (g == 0) ? (r1 + r2 + r3) : (g == 1) ? (r2 + r3) : (g == 2) ? r3 : 0; }
    const int excl = suf - tot;
    const bool mine = (excl < target) && (suf >= target);
    int b, ab, c = excl;
    if (c + (int)h.w >= target) { b = 3; ab = c; } else { c += (int)h.w;
        if (c + (int)h.z >= target) { b = 2; ab = c; } else { c += (int)h.z;
            if (c + (int)h.y >= target) { b = 1; ab = c; } else { c += (int)h.y; b = 0; ab = c; } } }
    const unsigned long long m = __ballot(mine);
    const int src = m ? (int)__ffsll((long long)m) - 1 : 0;
    bin = __builtin_amdgcn_readlane(4 * lane + b, src); above = __builtin_amdgcn_readlane(ab, src);
}
__device__ void phase_topk(const Params& p, LAS unsigned char* lds, int wv) {
    unsigned char* ws = p.ws;
    const int tid = opaque_tid(wv), lane = tid & 63, wave = __builtin_amdgcn_readfirstlane(tid >> 6), g4 = lane >> 4, l15 = lane & 15;
    const bf16_t* din = (const bf16_t*)(ws + WS_BIG); bf16_t* cn = (bf16_t*)(ws + WS_CN); unsigned short* idx = (unsigned short*)(ws + WS_IDX);
    LAS unsigned short* S16 = (LAS unsigned short*)lds;
    constexpr int SROW = 4112;
    { const float kg0 = p.d_kv_g[2 * lane], kg1 = p.d_kv_g[2 * lane + 1];
      for (int row4 = (blockIdx.x * 8 + wave) * 4; row4 < MTOK; row4 += gridDim.x * 32) {
        unsigned raw[4];
#pragma unroll
        for (int j = 0; j < 4; ++j) raw[j] = *(const unsigned*)(din + (size_t)(row4 + j) * DSA_LD + 2048 + 2 * lane);
#pragma unroll
        for (int j = 0; j < 4; ++j) { const float a = bflo(raw[j]), b = bfhi(raw[j]);
            const float sq = wave_sum(a * a + b * b); const float rs = rsqrtf(sq * (1.0f / 128.0f) + 1e-6f);
            *(unsigned*)(cn + (size_t)(row4 + j) * 128 + 2 * lane) = cvt_pk_bf16(a * rs * kg0, b * rs * kg1); }
      } }
    for (int unit = blockIdx.x; unit < 4096; unit += gridDim.x) {
        const bool tiled = (4096 % (2 * (int)gridDim.x)) == 0;
        const int pi = tiled ? (unit / (2 * (int)gridDim.x)) * (int)gridDim.x + (unit % (int)gridDim.x) : (unit >> 1), hi = tiled ? (unit / (int)gridDim.x) & 1 : (unit & 1);
        const int b = pi >> 7, cc = pi & 127, qt = hi ? 255 - cc : cc, qpos0 = qt * 16; const size_t rowq0 = (size_t)b * SEQ + qpos0;
        bf16x8 Aq[8][2]; float wv[8][4];
#pragma unroll
        for (int pr = 0; pr < 8; ++pr) {
            const int qg = pr >> 1, hh = pr & 1;
            const bf16_t* base = din + (rowq0 + 4 * qg + (l15 >> 2)) * DSA_LD + 2176 + (4 * hh + (l15 & 3)) * 64;
            Aq[pr][0] = *(const bf16x8*)(base + 8 * g4); Aq[pr][1] = *(const bf16x8*)(base + 32 + 8 * g4);
            const u32x2 wr = *(const u32x2*)(din + (rowq0 + 4 * qg + g4) * DSA_LD + 2752 + 4 * hh);
            wv[pr][0] = bflo(wr.x) * 0.04419417382f; wv[pr][1] = bfhi(wr.x) * 0.04419417382f; wv[pr][2] = bflo(wr.y) * 0.04419417382f; wv[pr][3] = bfhi(wr.y) * 0.04419417382f;
        }
        const int nkt = (qpos0 + 15) / 16 + 1;
        {
        bf16x8 B0[4], B1[4], N0[4], N1[4];
        LAS unsigned char* kst = lds + LDS_STG + wave * 2304;
#pragma unroll
        for (int j = 0; j < 4; ++j) { const int kt = (wave + 8 * j < nkt) ? wave + 8 * j : 0;
            const bf16_t* kb = din + ((size_t)b * SEQ + 16 * kt + (lane >> 3)) * DSA_LD + 2688 + 8 * (lane & 7);
            B0[j] = *(const bf16x8*)(kb); B1[j] = *(const bf16x8*)(kb + (size_t)8 * DSA_LD); }
        for (int kt0 = wave; kt0 < nkt; kt0 += 32) {
#pragma unroll
            for (int j = 0; j < 4; ++j) { const int kt = (kt0 + 32 + 8 * j < nkt) ? kt0 + 32 + 8 * j : 0;
                const bf16_t* kb = din + ((size_t)b * SEQ + 16 * kt + (lane >> 3)) * DSA_LD + 2688 + 8 * (lane & 7);
                N0[j] = *(const bf16x8*)(kb); N1[j] = *(const bf16x8*)(kb + (size_t)8 * DSA_LD); }
#pragma unroll
            for (int j = 0; j < 4; ++j) {
                const int kt = kt0 + 8 * j;
                if (kt < nkt) {
                    *(LAS bf16x8*)(kst + (lane >> 3) * 144 + (lane & 7) * 16) = B0[j]; *(LAS bf16x8*)(kst + (8 + (lane >> 3)) * 144 + (lane & 7) * 16) = B1[j];
                    const bf16x8 F0 = *(const LAS bf16x8*)(kst + l15 * 144 + g4 * 16), F1 = *(const LAS bf16x8*)(kst + l15 * 144 + 64 + g4 * 16);
#pragma unroll
                    for (int qg = 0; qg < 4; ++qg) {
                        float part = 0.f;
#pragma unroll
                        for (int hh = 0; hh < 2; ++hh) {
                            const int pr = 2 * qg + hh;
                            f32x4 c = (f32x4){0.f, 0.f, 0.f, 0.f};
                            c = __builtin_amdgcn_mfma_f32_16x16x32_bf16(Aq[pr][0], F0, c, 0, 0, 0);
                            c = __builtin_amdgcn_mfma_f32_16x16x32_bf16(Aq[pr][1], F1, c, 0, 0, 0);
                            part += (fmaxf(c[0], 0.f) * wv[pr][0] + fmaxf(c[1], 0.f) * wv[pr][1]) + (fmaxf(c[2], 0.f) * wv[pr][2] + fmaxf(c[3], 0.f) * wv[pr][3]);
                        }
                        const _Float16 hsc = (_Float16)(part + 0.0f);
                        S16[(4 * qg + g4) * SROW + 16 * kt + l15] = __builtin_bit_cast(unsigned short, hsc);
                    }
                }
            }
#pragma unroll
            for (int j = 0; j < 4; ++j) { B0[j] = N0[j]; B1[j] = N1[j]; }
        }
        }
        __syncthreads();
        for (int qi2 = 0; qi2 < 2; ++qi2) {
            const int ql = wave + 8 * qi2;
            const int qpos = qpos0 + ql, n = qpos + 1; unsigned short* out = idx + (rowq0 + ql) * 256;
            int lk = lane; asm volatile("" : "+v"(lk));
            if (n <= 256) {
#pragma unroll
                for (int i = 0; i < 4; ++i) { const int j = lane + 64 * i; out[j] = (unsigned short)(j < n ? j : 0xFFFF); }
            } else {
                const int ni4 = (((n + 63) >> 6) + 3) & ~3;
                const LAS unsigned short* srow = S16 + ql * SROW;
                LAS unsigned* hist = (LAS unsigned*)(lds + 131600 + wave * 1024);
                LAS unsigned short* orow = (LAS unsigned short*)(lds + 139792 + wave * 512);
#define TOPK_KEY(i_) ({ const int key_ = lk + 64 * (i_); unsigned b_ = srow[key_]; b_ ^= (b_ & 0x8000u) ? 0xFFFFu : 0x8000u; (key_ < n) ? b_ : 0u; })
                int b1, above1, b2, above2;
                *(LAS u32x4*)(hist + 4 * lane) = (u32x4){0u, 0u, 0u, 0u};
                for (int i0 = 0; i0 < ni4; i0 += 4) {
#pragma unroll
                    for (int j = 0; j < 4; ++j) { const unsigned uk = TOPK_KEY(i0 + j); (void)__hip_atomic_fetch_add(hist + (uk >> 8), 1u, __ATOMIC_RELAXED, __HIP_MEMORY_SCOPE_WORKGROUP); }
                }
                hist_find(hist, lane, 256, b1, above1);
                *(LAS u32x4*)(hist + 4 * lane) = (u32x4){0u, 0u, 0u, 0u};
                for (int i0 = 0; i0 < ni4; i0 += 4) {
#pragma unroll
                    for (int j = 0; j < 4; ++j) { const unsigned uk = TOPK_KEY(i0 + j); if ((int)(uk >> 8) == b1) (void)__hip_atomic_fetch_add(hist + (uk & 255u), 1u, __ATOMIC_RELAXED, __HIP_MEMORY_SCOPE_WORKGROUP); }
                }
                hist_find(hist, lane, 256 - above1, b2, above2);
                const unsigned T = ((unsigned)b1 << 8) | (unsigned)b2;
                const int G = above1 + above2;
                const int need = 256 - G; int base = 0, tie_seen = 0;
                const unsigned long long ltmask = (1ull << lane) - 1ull;
                for (int i0 = 0; i0 < ni4; i0 += 4) {
#pragma unroll
                    for (int j = 0; j < 4; ++j) {
                        const unsigned uk = TOPK_KEY(i0 + j);
                        const bool gt = uk > T, eq = uk == T;
                        const unsigned long long meq = __ballot(eq);
                        const bool sel = gt || (eq && (tie_seen + __popcll(meq & ltmask)) < need);
                        const unsigned long long msel = __ballot(sel);
                        if (sel) orow[base + __popcll(msel & ltmask)] = (unsigned short)(lk + 64 * (i0 + j));
                        base += __popcll(msel); tie_seen += __popcll(meq);
                    }
                }
#undef TOPK_KEY
                *(u32x2*)(out + 4 * lane) = *(LAS u32x2*)(orow + 4 * lane);
            }
        }
        __syncthreads();
    }
}

__device__ void phase_attn(const Params& p, LAS unsigned char* lds, bool dry, int wv) {
    unsigned char* ws = p.ws;
    const int tid = opaque_tid(wv), lane = tid & 63, wave = __builtin_amdgcn_readfirstlane(tid >> 6), g4 = lane >> 4, l15 = lane & 15, q = l15 >> 2, pp = lane & 3;
    bf16_t* din = (bf16_t*)(ws + WS_BIG); const bf16_t* cn = (const bf16_t*)(ws + WS_CN); const unsigned short* idx = (const unsigned short*)(ws + WS_IDX);
    LAS unsigned char* wl = lds + wave * 8192; const unsigned wbase = (unsigned)(size_t)(unsigned char*)lds + wave * 8192;
    const float scale = 0.08838834764f;
    for (int Q = blockIdx.x * 8 + wave; Q < MTOK; Q += gridDim.x * 8) {
        const int b = Q >> 12, qpos = Q & (SEQ - 1); const int nvalid = qpos + 1 < 256 ? qpos + 1 : 256;
        bf16_t* qrow = din + (size_t)Q * DSA_LD;
        bf16x8 Bq[4];
#pragma unroll
        for (int s = 0; s < 4; ++s) Bq[s] = *(const bf16x8*)(qrow + l15 * 128 + 32 * s + 8 * g4);
        f32x4 O[8];
#pragma unroll
        for (int mt = 0; mt < 8; ++mt) O[mt] = (f32x4){0.f, 0.f, 0.f, 0.f};
        float mrun = -1e30f, lrun = 0.f;
        unsigned kid[16];
#pragma unroll
        for (int i = 0; i < 16; ++i) { const int slot = i * 16 + (lane >> 2); const unsigned v = idx[(size_t)Q * 256 + slot]; kid[i] = slot < nvalid ? v : 0u; }
        bf16x8 A[2][4], An[2][4];
#pragma unroll
        for (int tl = 0; tl < 2; ++tl) { const bf16_t* crow = cn + ((size_t)b * SEQ + kid[tl]) * 128;
#pragma unroll
            for (int s = 0; s < 4; ++s) A[tl][s] = *(const bf16x8*)(crow + 32 * s + 8 * (lane & 3)); }
#pragma unroll
        for (int ck = 0; ck < 8; ++ck) {
            if (ck * 32 < nvalid) {
                if (ck < 7) {
#pragma unroll
                    for (int tl = 0; tl < 2; ++tl) { const bf16_t* crow = cn + ((size_t)b * SEQ + kid[(ck < 7 ? ck + 1 : ck) * 2 + tl]) * 128;
#pragma unroll
                        for (int s = 0; s < 4; ++s) An[tl][s] = *(const bf16x8*)(crow + 32 * s + 8 * (lane & 3)); }
                }
#pragma unroll
                for (int tl = 0; tl < 2; ++tl)
#pragma unroll
                    for (int s = 0; s < 4; ++s) *(LAS bf16x8*)(wl + off_b(16 * tl + (lane >> 2), 4 * s + (lane & 3))) = A[tl][s];
                bf16x8 Af[2][4];
#pragma unroll
                for (int tl = 0; tl < 2; ++tl)
#pragma unroll
                    for (int s = 0; s < 4; ++s) Af[tl][s] = *(const LAS bf16x8*)(wl + off_b(16 * tl + l15, 4 * s + g4));
                f32x4 S0 = (f32x4){0.f, 0.f, 0.f, 0.f}, S1 = (f32x4){0.f, 0.f, 0.f, 0.f};
#pragma unroll
                for (int s = 0; s < 4; ++s) { S0 = __builtin_amdgcn_mfma_f32_16x16x32_bf16(Af[0][s], Bq[s], S0, 0, 0, 0); S1 = __builtin_amdgcn_mfma_f32_16x16x32_bf16(Af[1][s], Bq[s], S1, 0, 0, 0); }
                float sv[8];
#pragma unroll
                for (int j = 0; j < 4; ++j) { const int s0 = ck * 32 + 4 * g4 + j; sv[j] = s0 < nvalid ? S0[j] * scale : -1e30f; sv[4 + j] = (s0 + 16) < nvalid ? S1[j] * scale : -1e30f; }
                float cm = fmaxf(fmaxf(fmaxf(sv[0], sv[1]), fmaxf(sv[2], sv[3])), fmaxf(fmaxf(sv[4], sv[5]), fmaxf(sv[6], sv[7])));
                cm = xrow16_max(cm);
                const float mn = fmaxf(mrun, cm), alpha = __expf(mrun - mn);
                float pv[8], ps = 0.f;
#pragma unroll
                for (int j = 0; j < 8; ++j) { pv[j] = __expf(sv[j] - mn); ps += pv[j]; }
                lrun = lrun * alpha + ps; mrun = mn;
#pragma unroll
                for (int mt = 0; mt < 8; ++mt) O[mt] *= alpha;
                union { u32x4 u; bf16x8 h; } Pb;
                Pb.u.x = cvt_pk_bf16(pv[0], pv[1]); Pb.u.y = cvt_pk_bf16(pv[2], pv[3]); Pb.u.z = cvt_pk_bf16(pv[4], pv[5]); Pb.u.w = cvt_pk_bf16(pv[6], pv[7]);
                asm volatile("s_waitcnt lgkmcnt(0)" ::: "memory");
#pragma unroll
                for (int mb = 0; mb < 2; ++mb) {
                    unsigned ad[8]; bf16x8 Av[4];
#pragma unroll
                    for (int i = 0; i < 4; ++i) { const int mt = 4 * mb + i;
                        ad[2 * i] = wbase + off_b(4 * g4 + q, 2 * mt + (pp >> 1)) + 8 * (pp & 1); ad[2 * i + 1] = wbase + off_b(16 + 4 * g4 + q, 2 * mt + (pp >> 1)) + 8 * (pp & 1); }
                    tr_read8(ad, Av);
#pragma unroll
                    for (int i = 0; i < 4; ++i) O[4 * mb + i] = __builtin_amdgcn_mfma_f32_16x16x32_bf16(Av[i], Pb.h, O[4 * mb + i], 0, 0, 0);
                }
                if (ck < 7) {
#pragma unroll
                    for (int tl = 0; tl < 2; ++tl)
#pragma unroll
                        for (int s = 0; s < 4; ++s) A[tl][s] = An[tl][s];
                }
            }
        }
        lrun = xrow16_sum(lrun);
        const float inv = 1.0f / lrun;
#pragma unroll
        for (int mt = 0; mt < 8; ++mt) {
            u32x2 o; o.x = cvt_pk_bf16(O[mt][0] * inv, O[mt][1] * inv); o.y = cvt_pk_bf16(O[mt][2] * inv, O[mt][3] * inv);
            if (!dry) *(u32x2*)(qrow + l15 * 128 + 16 * mt + 4 * g4) = o;
        }
    }
}

__device__ void phase_final(const Params& p, int wv) {
    const int tid = opaque_tid(wv); const int lane = tid & 63, wave = tid >> 6;
    const float* ss = (const float*)(p.ws + WS_SS) + (size_t)8 * MTOK * 16; const bf16_t* xb = (const bf16_t*)(p.ws + WS_XB);
    for (int row = blockIdx.x * 8 + wave; row < MTOK; row += gridDim.x * 8) {
        const float rs = rsqrtf(sum16(ss + (size_t)row * 16) * (1.0f / 1024.0f) + 1e-6f);
        f32x4* orow = (f32x4*)(p.out + (size_t)row * DM);
#pragma unroll
        for (int i = 0; i < 4; ++i) { const f32x4 g = *(const f32x4*)(p.final_g + (lane + 64 * i) * 4); const u32x2 xw = *(const u32x2*)(xb + (size_t)row * DM + (lane + 64 * i) * 4);
            f32x4 v = (f32x4){bflo(xw.x), bfhi(xw.x), bflo(xw.y), bfhi(xw.y)}; v = v * rs * g; orow[lane + 64 * i] = v; }
    }
}

#define XB_TMO      128
#define XB_XCNT(j)  (256  + 64 * (j))
#define XB_XSUB(j)  (1280 + 64 * (j))
#define XB_XGEN(j)  (2304 + 64 * (j))
#define XB_TOP      3328
#define XB_TOPGEN   3392
#define XCD_BAR_WORDS 3456
#define XB_SPIN_CAP (1u << 20)
__device__ __forceinline__ unsigned xb_ld(unsigned* p)              { return __hip_atomic_load(p, __ATOMIC_RELAXED, __HIP_MEMORY_SCOPE_AGENT); }
__device__ __forceinline__ unsigned xb_add(unsigned* p, unsigned v) { return __hip_atomic_fetch_add(p, v, __ATOMIC_RELAXED, __HIP_MEMORY_SCOPE_AGENT); }
__device__ __forceinline__ unsigned xb_xcc_id() { return (unsigned)__builtin_amdgcn_s_getreg((3 << 11) | 20) & 0xFu; }
#define XB_SPIN(cond, bar) do { unsigned _sp = 0; while (cond) { __builtin_amdgcn_s_sleep(1); \
    if ((++_sp & 255u) == 0u) { if (xb_ld(&(bar)[XB_TMO])) break; if (_sp > XB_SPIN_CAP) { atomicAdd(&(bar)[XB_TMO], 1u); break; } } } } while (0)
struct XcdBarrier { unsigned* bar; unsigned x; volatile LAS unsigned* st; };
__device__ __forceinline__ XcdBarrier xcd_barrier_post(unsigned* bar, volatile LAS unsigned* st, bool is_t0) {
    XcdBarrier b; b.bar = bar; b.x = xb_xcc_id(); b.st = st;
    if (is_t0) (void)xb_add(&bar[XB_XCNT(b.x)], 1u);
    return b;
}
__device__ __forceinline__ void xcd_barrier_complete(unsigned* bar, unsigned x, unsigned& nloc, unsigned& nx) {
    const unsigned G = gridDim.x * gridDim.y * gridDim.z;
    unsigned sum, cnt, mine, sp = 0u;
    for (;;) {
        sum = 0u; cnt = 0u; mine = 0u;
#pragma unroll
        for (unsigned j = 0; j < 16; ++j) { const unsigned c = xb_ld(&bar[XB_XCNT(j)]); sum += c; cnt += (c > 0u) ? 1u : 0u; mine = (j == x) ? c : mine; }
        if (sum == G) break;
        __builtin_amdgcn_s_sleep(1);
        if ((++sp & 255u) == 0u) { if (xb_ld(&bar[XB_TMO])) break; if (sp > XB_SPIN_CAP) { atomicAdd(&bar[XB_TMO], 1u); break; } }
    }
    nloc = mine > 0u ? mine : 1u; nx = cnt > 0u ? cnt : 1u;
}
__device__ __forceinline__ void xcd_barrier(const XcdBarrier& b, bool is_t0) {
    asm volatile("s_waitcnt vmcnt(0)" ::: "memory");
    __syncthreads();
    if (is_t0) {
        unsigned* bar = b.bar;
        __builtin_amdgcn_s_waitcnt(0);
        unsigned nloc = b.st[0], nx = b.st[1];
        if (nloc == 0u) { xcd_barrier_complete(bar, b.x, nloc, nx); b.st[0] = nloc; b.st[1] = nx; }
        const unsigned old = xb_add(&bar[XB_XSUB(b.x)], 1u);
        const unsigned gen = old / nloc;
        if (old + 1u == (gen + 1u) * nloc) {
            __builtin_amdgcn_fence(__ATOMIC_RELEASE, "agent");
            asm volatile("s_waitcnt vmcnt(0)" ::: "memory");
            const unsigned og = xb_add(&bar[XB_TOP], 1u);
            const unsigned tg = og / nx;
            if (og + 1u == (tg + 1u) * nx) xb_add(&bar[XB_TOPGEN], 1u);
            else XB_SPIN(xb_ld(&bar[XB_TOPGEN]) == tg, bar);
            __builtin_amdgcn_fence(__ATOMIC_ACQUIRE, "agent");
            xb_add(&bar[XB_XGEN(b.x)], 1u);
            asm volatile("s_waitcnt vmcnt(0)" ::: "memory");
        } else {
            XB_SPIN(xb_ld(&bar[XB_XGEN(b.x)]) == gen, bar);
            __builtin_amdgcn_fence(__ATOMIC_ACQUIRE, "agent");
            asm volatile("s_waitcnt vmcnt(0)" ::: "memory");
        }
    }
    __syncthreads();
}

enum { K_PRO = 0, K_GACT, K_GRES, K_SGU, K_CONV, K_POOL, K_TOPK, K_ATTN, K_FINAL };
struct PhaseDesc { int kind, act, lda, apn, N, K, ldc, ss_idx, m0, M; size_t a_off, w_off; };
__device__ __forceinline__ PhaseDesc mk_act(int act, size_t w_off, int N, int ss_idx) { PhaseDesc d{}; d.kind = K_GACT; d.act = act; d.lda = 1024; d.apn = 0; d.N = N; d.K = 1024; d.ldc = N; d.ss_idx = ss_idx; d.m0 = 0; d.M = MTOK; d.a_off = WS_XB; d.w_off = w_off; return d; }
__device__ __forceinline__ PhaseDesc mk_res(size_t a_off, int lda, int apn, size_t w_off, int K, int ss_idx) { PhaseDesc d{}; d.kind = K_GRES; d.lda = lda; d.apn = apn; d.N = 1024; d.K = K; d.ss_idx = ss_idx; d.m0 = 0; d.M = MTOK; d.a_off = a_off; d.w_off = w_off; return d; }
__device__ __forceinline__ PhaseDesc mk_kind(int kind) { PhaseDesc d{}; d.kind = kind; return d; }
constexpr int MLP_Q = 4, MQ = MTOK / MLP_Q;
__device__ __forceinline__ PhaseDesc mk_mlp(int l, int j) {
    const int q = j >> 1;
    if ((j & 1) == 0) { PhaseDesc d = mk_act(2, W_1 + (size_t)l * 8 * MiB, 4096, 2 * l + 1); d.m0 = q * MQ; d.M = MQ; d.a_off = WS_XB + (size_t)q * MQ * 1024 * 2; return d; }
    PhaseDesc d = mk_res(WS_BIG, 4096, 0, W_2 + (size_t)l * 8 * MiB, 4096, 2 * l + 2); d.m0 = q * MQ; d.M = MQ; return d;
}
__device__ __forceinline__ PhaseDesc phase_desc(int ph) {
    if (ph >= 4 && ph < 12) return mk_mlp(0, ph - 4);
    if (ph >= 15 && ph < 23) return mk_mlp(1, ph - 15);
    if (ph >= 26 && ph < 34) return mk_mlp(2, ph - 26);
    if (ph >= 38 && ph < 46) return mk_mlp(3, ph - 38);
    switch (ph) {
    case 0: return mk_kind(K_PRO);
    case 1: return mk_act(1, W_A_IN, 2048, 0);
    case 2: return mk_kind(K_SGU);
    case 3: return mk_res(WS_BIG + 256 * MiB, 1024, 0, W_A_OUT, 1024, 1);
    case 12: return mk_act(0, W_B_IN, 3072, 2);
    case 13: return mk_kind(K_CONV);
    case 14: return mk_res(WS_BIG + 384 * MiB, 1024, 0, W_B_OUT, 1024, 3);
    case 23: return mk_act(0, W_C_IN, 1024, 4);
    case 24: return mk_kind(K_POOL);
    case 25: return mk_res(WS_BIG + 128 * MiB, 1024, 512, W_C_GRP, 256, 5);
    case 34: return mk_act(0, W_D_IN, DSA_LD, 6);
    case 35: return mk_kind(K_TOPK);
    case 36: return mk_kind(K_ATTN);
    case 37: return mk_res(WS_BIG, DSA_LD, 0, W_D_COMB, 2048, 7);
    default: return mk_kind(K_FINAL);
    }
}

__device__ __forceinline__ void run_phase(int ph, const Params& p, LAS unsigned char* lds, bool dry, int wv) {
    const PhaseDesc d = phase_desc(ph);
    unsigned char* ws = p.ws; float* ss = (float*)(ws + WS_SS);
    if (d.kind == K_GACT || d.kind == K_GRES) {
        pg8::Gemm g; g.A = (const bf16_t*)(ws + d.a_off); g.Bt = (const bf16_t*)(ws + d.w_off); g.M = d.M; g.N = d.N; g.K = d.K; g.lda = d.lda; g.apn = d.apn;
        pg8::StaticOrder S; S.init(d.M, d.N, gridDim.x, blockIdx.x);
        if (d.kind == K_GACT) { pg8::EpiAct E; E.O = (bf16_t*)(ws + WS_BIG); E.ldc = d.ldc; E.ss_in = ss + ((size_t)d.ss_idx * MTOK + d.m0) * 16; E.ssv = ss + (size_t)9 * MTOK * 16; E.ACT = d.act; E.rstab = (const LAS float*)(lds + LDS_STG);
            pg8::act_rs_table((LAS float*)(lds + LDS_STG), S, E.ss_in, opaque_tid(wv)); pg8::gemm_phase(lds, g, S, E, wv); }
        else { pg8::EpiResid E; E.xb = (bf16_t*)(ws + WS_XB) + (size_t)d.m0 * DM; E.ss_out = ss + ((size_t)d.ss_idx * MTOK + d.m0) * 16; pg8::gemm_phase(lds, g, S, E, wv); }
    }
    else if (d.kind == K_PRO) phase_prologue(p, lds, wv);
    else if (d.kind == K_SGU) phase_sgu(p, lds, wv);
    else if (d.kind == K_CONV) phase_conv(p, wv);
    else if (d.kind == K_POOL) phase_pool(p, wv);
    else if (d.kind == K_TOPK) phase_topk(p, lds, wv);
    else if (d.kind == K_ATTN) phase_attn(p, lds, dry, wv);
    else phase_final(p, wv);
}

__global__ void __launch_bounds__(512, 2) fwd_megakernel(Params p) {
    extern __shared__ __attribute__((aligned(16))) unsigned char lds_raw[];
    LAS unsigned char* lds = (LAS unsigned char*)lds_raw;
    const int wv = __builtin_amdgcn_readfirstlane((int)threadIdx.x >> 6);
    volatile LAS unsigned* bst = (volatile LAS unsigned*)(lds + 131584);
    XcdBarrier xbar; xbar.bar = (unsigned*)(p.ws + WS_BAR); xbar.x = 0; xbar.st = bst;
    if (p.ph_hi - p.ph_lo > 1) {
        if (threadIdx.x == 0) { bst[0] = 0u; bst[1] = 0u; }
        if (blockIdx.x == 0) { unsigned* bw = (unsigned*)(p.ws + WS_BAR); for (int i = threadIdx.x; i < XCD_BAR_WORDS; i += 512) bw[i] = 0u; }
        __syncthreads();
    }
    for (int ph = p.ph_lo; ph < p.ph_hi; ++ph) {
#if PROBE_DUP
        const int reps = ((PROBE_DUP >> ph) & 1) ? 2 : 1;
        for (int r = 0; r < reps; ++r) { run_phase(ph, p, lds, r + 1 < reps, wv); if (r + 1 < reps) cg::this_grid().sync(); }
#else
        run_phase(ph, p, lds, false, wv);
#endif
        if (ph + 1 < p.ph_hi) {
            if (ph == p.ph_lo) { cg::this_grid().sync(); xbar = xcd_barrier_post((unsigned*)(p.ws + WS_BAR), bst, opaque_tid(wv) == 0); }
            else xcd_barrier(xbar, opaque_tid(wv) == 0);
        }
    }
}

#ifndef MK_MULTI
#define MK_MULTI 0
#endif

extern "C" void kernel_launch(void* const* d_in, const int* in_sizes, int n_in, void* d_out, int out_size, void* d_ws, size_t ws_size, hipStream_t stream) {
    static int grid = 0;
    if (grid == 0) {
        int dev = 0, cus = 0, per_cu = 0;
        hipGetDevice(&dev);
        hipDeviceGetAttribute(&cus, hipDeviceAttributeMultiprocessorCount, dev);
        if (hipFuncSetAttribute((const void*)fwd_megakernel, hipFuncAttributeMaxDynamicSharedMemorySize, LDS_BYTES) != hipSuccess) { fprintf(stderr, "hipFuncSetAttribute failed\n"); grid = -1; return; }
        if (hipOccupancyMaxActiveBlocksPerMultiprocessor(&per_cu, (const void*)fwd_megakernel, 512, LDS_BYTES) != hipSuccess || per_cu < 1) { fprintf(stderr, "occupancy query: %d\n", per_cu); per_cu = 1; }
        (void)hipGetLastError();
        grid = cus * (per_cu > 1 ? 1 : per_cu);
        if (ws_size < 840 * MiB) { fprintf(stderr, "workspace too small\n"); grid = -1; return; }
    }
    if (grid < 0) return;
    Params p{};
    const float** pp = (const float**)&p;
    for (int i = 0; i < 21; ++i) pp[i] = (const float*)d_in[i];
    p.out = (float*)d_out; p.ws = (unsigned char*)d_ws;
#if MK_MULTI
    for (int ph = 0; ph < NPHASE; ++ph) {
        p.ph_lo = ph; p.ph_hi = ph + 1;
        hipLaunchKernelGGL(fwd_megakernel, dim3(grid), dim3(512), LDS_BYTES, stream, p);
    }
#else
    p.ph_lo = 0; p.ph_hi = NPHASE;
    void* args[] = {&p};
    hipError_t e = hipLaunchCooperativeKernel((const void*)fwd_megakernel, dim3(grid), dim3(512), args, LDS_BYTES, stream);
    if (e != hipSuccess) fprintf(stderr, "cooperative launch failed: %s (grid %d)\n", hipGetErrorString(e), grid);
#endif
}
```

```cpp
#include <hip/hip_runtime.h>
#include <hip/hip_cooperative_groups.h>
#include <cstdio>
namespace cg = cooperative_groups;

#ifndef PROBE_DUP
#define PROBE_DUP 0
#endif
#ifndef TOPK_HIST
#define TOPK_HIST 1
#endif
#ifndef PROBE_TOPK
#define PROBE_TOPK 0
#endif
#define LAS __attribute__((address_space(3)))
typedef unsigned short bf16_t;
typedef short bf16x8 __attribute__((ext_vector_type(8)));
typedef float f32x4 __attribute__((ext_vector_type(4)));
typedef float f32x2 __attribute__((ext_vector_type(2)));
typedef unsigned u32x4 __attribute__((ext_vector_type(4)));
typedef unsigned u32x2 __attribute__((ext_vector_type(2)));
typedef unsigned short u16x4 __attribute__((ext_vector_type(4)));

constexpr int MTOK = 65536, DM = 1024, SEQ = 4096;
constexpr size_t MiB = 1ull << 20;
constexpr size_t WS_XB = 0;
constexpr size_t WS_BIG = 128 * MiB;
constexpr size_t WS_CN = 640 * MiB;
constexpr size_t WS_IDX = 656 * MiB;
constexpr size_t WS_SS = 800 * MiB;
constexpr size_t WS_BAR = 688 * MiB;
constexpr size_t WS_W = 692 * MiB;
constexpr size_t W_A_IN = WS_W + 0 * MiB, W_A_OUT = WS_W + 4 * MiB, W_A_S = WS_W + 6 * MiB, W_B_IN = WS_W + 7 * MiB, W_B_OUT = WS_W + 13 * MiB,
                 W_C_IN = WS_W + 15 * MiB, W_C_GRP = WS_W + 17 * MiB, W_D_IN = WS_W + 18 * MiB, W_D_COMB = WS_W + 24 * MiB, W_1 = WS_W + 28 * MiB, W_2 = WS_W + 60 * MiB;
constexpr int DSA_LD = 2816;
constexpr int LDS_BYTES = 131072 + 1024 + 8192 + 4096 + 18432;
constexpr int LDS_STG = 143888;
constexpr int NPHASE = 47;

struct Params {
    const float *x, *norm_mix_g, *norm_mlp_g, *final_g, *a_w_in, *a_v_g, *a_w_s, *a_b_s, *a_w_out, *b_w_in, *b_conv_w, *b_w_out, *c_w_in, *c_w_grp, *c_scale,
        *d_w_in, *d_kv_g, *d_w_uv, *d_w_out, *mlp_w1, *mlp_w2;
    float* out; unsigned char* ws; int ph_lo, ph_hi;
};

__device__ __forceinline__ unsigned cvt_pk_bf16(float lo, float hi) { unsigned r; asm volatile("v_cvt_pk_bf16_f32 %0, %1, %2" : "=v"(r) : "v"(lo), "v"(hi)); return r; }
__device__ __forceinline__ int opaque_tid(int wv) { int l; asm volatile("v_mbcnt_lo_u32_b32 %0, -1, 0\n\tv_mbcnt_hi_u32_b32 %0, -1, %0" : "=v"(l)); return wv * 64 + l; }
__device__ __forceinline__ float bflo(unsigned w) { return __uint_as_float(w << 16); }
__device__ __forceinline__ float bfhi(unsigned w) { return __uint_as_float(w & 0xffff0000u); }
__device__ __forceinline__ float wave_sum(float v) {
#pragma unroll
    for (int o = 32; o; o >>= 1) v += __shfl_xor(v, o);
    return v;
}
__device__ __forceinline__ float sum16(const float* p) { const f32x4 a = *(const f32x4*)p, b = *(const f32x4*)(p + 4), c = *(const f32x4*)(p + 8), d = *(const f32x4*)(p + 12);
    return (((a[0] + a[1]) + (a[2] + a[3])) + ((b[0] + b[1]) + (b[2] + b[3]))) + (((c[0] + c[1]) + (c[2] + c[3])) + ((d[0] + d[1]) + (d[2] + d[3]))); }
__device__ __forceinline__ float xrow16_max(float x) {
    auto s = __builtin_amdgcn_permlane16_swap(__float_as_uint(x), __float_as_uint(x), false, false);
    x = fmaxf(__uint_as_float(s[0]), __uint_as_float(s[1]));
    auto t = __builtin_amdgcn_permlane32_swap(__float_as_uint(x), __float_as_uint(x), false, false);
    return fmaxf(__uint_as_float(t[0]), __uint_as_float(t[1]));
}
__device__ __forceinline__ float xrow16_sum(float x) {
    auto s = __builtin_amdgcn_permlane16_swap(__float_as_uint(x), __float_as_uint(x), false, false);
    x = __uint_as_float(s[0]) + __uint_as_float(s[1]);
    auto t = __builtin_amdgcn_permlane32_swap(__float_as_uint(x), __float_as_uint(x), false, false);
    return __uint_as_float(t[0]) + __uint_as_float(t[1]);
}
__device__ __forceinline__ unsigned off_b(unsigned row, unsigned ch) { return 256u * row + 16u * (ch ^ (((row & 3) << 2) | ((row >> 2) & 3))); }
__device__ __forceinline__ bf16x8 tr_read2(unsigned a0, unsigned a1) {
    u16x4 lo, hi;
    asm volatile("ds_read_b64_tr_b16 %0, %2\n\tds_read_b64_tr_b16 %1, %3\n\ts_waitcnt lgkmcnt(0)" : "=&v"(lo), "=&v"(hi) : "v"(a0), "v"(a1) : "memory");
    bf16x8 r; r[0] = (short)lo[0]; r[1] = (short)lo[1]; r[2] = (short)lo[2]; r[3] = (short)lo[3]; r[4] = (short)hi[0]; r[5] = (short)hi[1]; r[6] = (short)hi[2]; r[7] = (short)hi[3];
    return r;
}
__device__ __forceinline__ void tr_read8(const unsigned (&a)[8], bf16x8 (&r)[4]) {
    u16x4 v0, v1, v2, v3, v4, v5, v6, v7;
    asm volatile("ds_read_b64_tr_b16 %0, %8\n\tds_read_b64_tr_b16 %1, %9\n\tds_read_b64_tr_b16 %2, %10\n\tds_read_b64_tr_b16 %3, %11\n\t"
                 "ds_read_b64_tr_b16 %4, %12\n\tds_read_b64_tr_b16 %5, %13\n\tds_read_b64_tr_b16 %6, %14\n\tds_read_b64_tr_b16 %7, %15\n\ts_waitcnt lgkmcnt(0)"
                 : "=&v"(v0), "=&v"(v1), "=&v"(v2), "=&v"(v3), "=&v"(v4), "=&v"(v5), "=&v"(v6), "=&v"(v7)
                 : "v"(a[0]), "v"(a[1]), "v"(a[2]), "v"(a[3]), "v"(a[4]), "v"(a[5]), "v"(a[6]), "v"(a[7]) : "memory");
    const u16x4 lo[4] = {v0, v2, v4, v6}, hi[4] = {v1, v3, v5, v7};
#pragma unroll
    for (int i = 0; i < 4; ++i) { r[i][0] = (short)lo[i][0]; r[i][1] = (short)lo[i][1]; r[i][2] = (short)lo[i][2]; r[i][3] = (short)lo[i][3]; r[i][4] = (short)hi[i][0]; r[i][5] = (short)hi[i][1]; r[i][6] = (short)hi[i][2]; r[i][7] = (short)hi[i][3]; }
}

namespace pg8 {
constexpr int BM = 256, BK = 64, HALF = 128, HTB = HALF * BK * 2, STAGE_BYTES = 8 * HTB, NXCD = 8, WGM = 8;
__device__ __forceinline__ int lds_byte(int r, int c) { const int st = (r >> 4) * 2 + (c >> 5), rr = r & 15, cc = c & 31, ob = rr * 64 + cc * 2; return st * 1024 + (ob ^ (((ob >> 9) & 1) << 5)); }
__device__ __forceinline__ void stage_rc(int b, int& R, int& C) { const int st = b / 1024, sb = b % 1024, swz = sb ^ (((sb >> 9) & 1) << 5); R = (st >> 1) * 16 + swz / 64; C = (st & 1) * 32 + (swz % 64) / 2; }
__device__ __forceinline__ int perm32(int rho) { const int n = rho >> 4, i = rho & 15; return 8 * (i >> 2) + 4 * n + (i & 3); }
constexpr int RS_UNITS = 18;
struct Unit { int pm, pn; };
struct Gemm { const bf16_t* A; const bf16_t* Bt; int M, N, K, lda, apn; };
struct StaticOrder {
    int nM, nN, nwg, G, c;
    __device__ void init(int M, int N, int G_, int c_) { nM = M / BM; nN = N / BM; nwg = nM * nN; G = G_; c = c_; }
    __device__ bool next(int i, Unit& u) const {
        const long L = (long)i * G + c; if (L >= nwg) return false;
        int wgid = (int)L; { const int q = nwg / NXCD, r = nwg % NXCD, xcd = wgid % NXCD, off = wgid / NXCD; wgid = (xcd < r ? xcd * (q + 1) : r * (q + 1) + (xcd - r) * q) + off; }
        const int nig = WGM * nN, gid = wgid / nig, fm = gid * WGM, gsz = (nM - fm) < WGM ? (nM - fm) : WGM;
        u.pm = fm + ((wgid % nig) % gsz); u.pn = (wgid % nig) / gsz; return true;
    }
};

__device__ __forceinline__ float gelu_tanh(float x) {
    const float y = 0.7978845608f * (x + 0.044715f * x * x * x);
    const float e = __builtin_amdgcn_exp2f(-2.885390082f * y);
    return x * __builtin_amdgcn_rcpf(1.0f + e);
}
struct EpiAct {
    static constexpr bool PERM = true;
    bf16_t* O; int ldc; const float* ss_in; float* ssv; int ACT; const LAS float* rstab;
    __device__ __forceinline__ void operator()(const f32x4 (&acc)[2][2][4][2], const Unit& u, int ui, int wr, int wc, int fr, int fq) const {
        const int row0 = u.pm * BM + wr * 64 + fr, col0 = u.pn * BM + wc * 32 + 8 * fq;
        float rsv[2][4];
#pragma unroll
        for (int ai = 0; ai < 2; ++ai)
#pragma unroll
            for (int m = 0; m < 4; ++m) {
                rsv[ai][m] = (ui < RS_UNITS) ? rstab[ui * 256 + ai * HALF + wr * 64 + m * 16 + fr]
                                             : rsqrtf(sum16(ss_in + (size_t)(row0 + ai * HALF + m * 16) * 16) * (1.0f / 1024.0f) + 1e-6f);
            }
#pragma unroll
        for (int ai = 0; ai < 2; ++ai)
#pragma unroll
            for (int m = 0; m < 4; ++m) {
                const int row = row0 + ai * HALF + m * 16;
                const float rs = rsv[ai][m];
                bf16_t* rowp = O + (size_t)row * ldc + col0; float sq = 0.f;
#pragma unroll
                for (int bj = 0; bj < 2; ++bj) {
                    f32x4 v0 = acc[ai][bj][m][0] * rs, v1 = acc[ai][bj][m][1] * rs;
                    if (ACT == 1) {
#pragma unroll
                        for (int j = 0; j < 4; ++j) { v0[j] = gelu_tanh(v0[j]); v1[j] = gelu_tanh(v1[j]); sq += v0[j] * v0[j] + v1[j] * v1[j]; }
                    }
                    if (ACT == 2) {
#pragma unroll
                        for (int j = 0; j < 4; ++j) { const float a = fmaxf(v0[j], 0.f), b = fmaxf(v1[j], 0.f); v0[j] = a * a; v1[j] = b * b; }
                    }
                    u32x4 w; w.x = cvt_pk_bf16(v0[0], v0[1]); w.y = cvt_pk_bf16(v0[2], v0[3]); w.z = cvt_pk_bf16(v1[0], v1[1]); w.w = cvt_pk_bf16(v1[2], v1[3]);
                    *(u32x4*)(rowp + bj * HALF) = w;
                }
                if (ACT == 1) {
                    sq = xrow16_sum(sq);
                    if (u.pn >= 4 && fq == 0) ssv[(size_t)row * 16 + (u.pn - 4) * 4 + wc] = sq;
                }
            }
    }
};
struct EpiResid {
    static constexpr bool PERM = true;
    bf16_t* xb; float* ss_out;
    __device__ __forceinline__ void operator()(const f32x4 (&acc)[2][2][4][2], const Unit& u, int ui, int wr, int wc, int fr, int fq) const {
        const int row0 = u.pm * BM + wr * 64 + fr, col0 = u.pn * BM + wc * 32 + 8 * fq;
#pragma unroll
        for (int ai = 0; ai < 2; ++ai) {
            u32x4 xo[4][2];
#pragma unroll
            for (int m = 0; m < 4; ++m)
#pragma unroll
                for (int bj = 0; bj < 2; ++bj) xo[m][bj] = *(const u32x4*)(xb + (size_t)(row0 + ai * HALF + m * 16) * DM + col0 + bj * HALF);
#pragma unroll
            for (int m = 0; m < 4; ++m) {
                const int row = row0 + ai * HALF + m * 16; const size_t off = (size_t)row * DM + col0; float sq = 0.f;
#pragma unroll
                for (int bj = 0; bj < 2; ++bj) {
                    const u32x4 xw = xo[m][bj]; const f32x4 a0 = acc[ai][bj][m][0], a1 = acc[ai][bj][m][1];
                    const float v0 = bflo(xw.x) + a0[0], v1 = bfhi(xw.x) + a0[1], v2 = bflo(xw.y) + a0[2], v3 = bfhi(xw.y) + a0[3];
                    const float v4 = bflo(xw.z) + a1[0], v5 = bfhi(xw.z) + a1[1], v6 = bflo(xw.w) + a1[2], v7 = bfhi(xw.w) + a1[3];
                    u32x4 w; w.x = cvt_pk_bf16(v0, v1); w.y = cvt_pk_bf16(v2, v3); w.z = cvt_pk_bf16(v4, v5); w.w = cvt_pk_bf16(v6, v7);
                    *(u32x4*)(xb + off + bj * HALF) = w;
                    sq += ((v0 * v0 + v1 * v1) + (v2 * v2 + v3 * v3)) + ((v4 * v4 + v5 * v5) + (v6 * v6 + v7 * v7));
                }
                sq = xrow16_sum(sq);
                if (fq == 0) ss_out[(size_t)row * 16 + u.pn * 4 + wc] = sq;
            }
            asm volatile("" ::: "memory");
        }
    }
};

__device__ __forceinline__ void act_rs_table(LAS float* tab, const StaticOrder& S, const float* ss_in, int tid) {
    Unit u;
    for (int i = 0; i < RS_UNITS && S.next(i, u); ++i) {
        if (tid < 256) tab[i * 256 + tid] = rsqrtf(sum16(ss_in + (size_t)(u.pm * BM + tid) * 16) * (1.0f / 1024.0f) + 1e-6f);
    }
    __syncthreads();
}
template <class Epi>
__device__ __forceinline__ void gemm_phase(LAS unsigned char* lds, const Gemm g, const StaticOrder& S, const Epi& E, int wv) {
    const int tid = opaque_tid(wv), wid = __builtin_amdgcn_readfirstlane(tid >> 6), lane = tid & 63, wr = wid >> 2, wc = wid & 3, fr = lane & 15, fq = lane >> 4;
    const int K = g.K, nt = K / BK, lda = g.lda;
    unsigned voffA[2], voffB[2];
#pragma unroll
    for (int i = 0; i < 2; ++i) { int R, C; stage_rc(tid * 16 + i * 8192, R, C); const int Rb = Epi::PERM ? ((R & ~31) + perm32(R & 31)) : R;
        voffA[i] = (unsigned)(R * lda + C) * 2u; voffB[i] = (unsigned)(Rb * K + C) * 2u; }
    const size_t kstep = (size_t)(BK * 2);
    const size_t hstepA = (size_t)HALF * lda * 2, hstepB = (size_t)HALF * K * 2;
    const size_t tstepA = 2 * hstepA, tstepB = 2 * hstepB;
    const unsigned ldsw = (unsigned)wid * 1024u;
    const int aoff = lds_byte(wr * 64 + fr, fq * 8), boff = lds_byte(wc * 32 + fr, fq * 8);
#define PG8_SA(b, h) (((b) * 2 + (h)) * HTB)
#define PG8_SB(b, h) ((4 + (b) * 2 + (h)) * HTB)
#define PG8_STAGE(bufoff, gbase, voff) do { _Pragma("unroll") for (int _i = 0; _i < 2; ++_i) \
        __builtin_amdgcn_global_load_lds((const unsigned*)((const char*)(gbase) + (voff)[_i]), (LAS unsigned*)(lds + (bufoff) + ldsw + _i * 8192), 16, 0, 0); } while (0)
#define PG8_LDA(dst, b, h) do { _Pragma("unroll") for (int m = 0; m < 4; ++m) _Pragma("unroll") for (int k = 0; k < 2; ++k) dst[m][k] = *(const LAS bf16x8*)(lds + PG8_SA(b, h) + aoff + m * 2048 + k * 1024); } while (0)
#define PG8_LDB(dst, b, h) do { _Pragma("unroll") for (int n = 0; n < 2; ++n) _Pragma("unroll") for (int k = 0; k < 2; ++k) dst[n][k] = *(const LAS bf16x8*)(lds + PG8_SB(b, h) + boff + n * 2048 + k * 1024); } while (0)
#define PG8_MMA(ai, bj, At, Bt) do { __builtin_amdgcn_s_setprio(1); _Pragma("unroll") for (int m = 0; m < 4; ++m) _Pragma("unroll") for (int n = 0; n < 2; ++n) _Pragma("unroll") for (int k = 0; k < 2; ++k) \
        acc[ai][bj][m][n] = __builtin_amdgcn_mfma_f32_16x16x32_bf16(Bt[n][k], At[m][k], acc[ai][bj][m][n], 0, 0, 0); __builtin_amdgcn_s_setprio(0); } while (0)
#define PG8_WAIT_V(n) asm volatile("s_waitcnt vmcnt(" #n ")" ::: "memory")
#define PG8_WAIT_L(n) asm volatile("s_waitcnt lgkmcnt(" #n ")" ::: "memory")
#define PG8_BAR __builtin_amdgcn_s_barrier()
#define PG8_SCHED __builtin_amdgcn_sched_barrier(0)
    Unit cur, nxt; int ui = 0;
    if (!S.next(0, cur)) return;
    f32x4 acc[2][2][4][2];
#pragma unroll
    for (int a = 0; a < 2; ++a)
#pragma unroll
        for (int b = 0; b < 2; ++b)
#pragma unroll
            for (int m = 0; m < 4; ++m)
#pragma unroll
                for (int n = 0; n < 2; ++n) acc[a][b][m][n] = (f32x4){0.f, 0.f, 0.f, 0.f};
    bf16x8 At[4][2], B0[2][2], B1[2][2];
    const char* cA = (const char*)g.A + (size_t)cur.pm * tstepA + (size_t)cur.pn * g.apn; const char* cB = (const char*)g.Bt + (size_t)cur.pn * tstepB;
    PG8_STAGE(PG8_SB(0, 0), cB, voffB); PG8_STAGE(PG8_SA(0, 0), cA, voffA); PG8_STAGE(PG8_SB(0, 1), cB + hstepB, voffB); PG8_STAGE(PG8_SA(0, 1), cA + hstepA, voffA);
    if (wr == 1) PG8_BAR;
    PG8_WAIT_V(4); PG8_BAR;
    PG8_STAGE(PG8_SB(1, 0), cB + kstep, voffB); PG8_STAGE(PG8_SA(1, 0), cA + kstep, voffA); PG8_STAGE(PG8_SB(1, 1), cB + hstepB + kstep, voffB);
    PG8_WAIT_V(6); PG8_BAR;
    for (;;) {
        const bool has_next = S.next(ui + 1, nxt);
        const char* nA = has_next ? (const char*)g.A + (size_t)nxt.pm * tstepA + (size_t)nxt.pn * g.apn : cA; const char* nB = has_next ? (const char*)g.Bt + (size_t)nxt.pn * tstepB : cB;
        for (int t = 0; t < nt; t += 2) {
            const bool last = (t == nt - 2);
            const char* a1 = cA + (size_t)(t + 1) * kstep;
            const char* a2 = last ? nA : cA + (size_t)(t + 2) * kstep; const char* b2 = last ? nB : cB + (size_t)(t + 2) * kstep;
            const char* a3 = a2 + kstep; const char* b3 = b2 + kstep;
            PG8_LDB(B0, 0, 0); PG8_SCHED; PG8_LDA(At, 0, 0); PG8_STAGE(PG8_SA(1, 1), a1 + hstepA, voffA);
            PG8_WAIT_L(8); PG8_BAR; PG8_WAIT_L(0); PG8_MMA(0, 0, At, B0); PG8_BAR; PG8_SCHED;
            PG8_LDB(B1, 0, 1); PG8_STAGE(PG8_SB(0, 0), b2, voffB);
            PG8_BAR; PG8_WAIT_L(0); PG8_MMA(0, 1, At, B1); PG8_BAR;
            PG8_LDA(At, 0, 1); PG8_STAGE(PG8_SA(0, 0), a2, voffA);
            PG8_BAR; PG8_WAIT_L(0); PG8_MMA(1, 0, At, B0); PG8_BAR; PG8_SCHED;
            PG8_STAGE(PG8_SB(0, 1), b2 + hstepB, voffB);
            PG8_WAIT_V(6); PG8_BAR; PG8_MMA(1, 1, At, B1); PG8_BAR;
            PG8_LDB(B0, 1, 0); PG8_SCHED; PG8_LDA(At, 1, 0); PG8_STAGE(PG8_SA(0, 1), a2 + hstepA, voffA);
            PG8_WAIT_L(8); PG8_BAR; PG8_WAIT_L(0); PG8_MMA(0, 0, At, B0); PG8_BAR; PG8_SCHED;
            PG8_LDB(B1, 1, 1); PG8_STAGE(PG8_SB(1, 0), b3, voffB);
            PG8_BAR; PG8_WAIT_L(0); PG8_MMA(0, 1, At, B1); PG8_BAR;
            PG8_LDA(At, 1, 1); PG8_STAGE(PG8_SA(1, 0), a3, voffA);
            PG8_BAR; PG8_WAIT_L(0); PG8_MMA(1, 0, At, B0); PG8_BAR; PG8_SCHED;
            PG8_STAGE(PG8_SB(1, 1), b3 + hstepB, voffB);
            PG8_WAIT_V(6); PG8_BAR; PG8_MMA(1, 1, At, B1); PG8_BAR;
        }
        E(acc, cur, ui, wr, wc, fr, fq);
        if (!has_next) break;
#pragma unroll
        for (int a = 0; a < 2; ++a)
#pragma unroll
            for (int b = 0; b < 2; ++b)
#pragma unroll
                for (int m = 0; m < 4; ++m)
#pragma unroll
                    for (int n = 0; n < 2; ++n) acc[a][b][m][n] = (f32x4){0.f, 0.f, 0.f, 0.f};
        cur = nxt; cA = nA; cB = nB; ++ui;
    }
    PG8_WAIT_V(0);
    if (wr == 0) PG8_BAR;
    PG8_BAR;
#undef PG8_SA
#undef PG8_SB
#undef PG8_STAGE
#undef PG8_LDA
#undef PG8_LDB
#undef PG8_MMA
#undef PG8_WAIT_V
#undef PG8_WAIT_L
#undef PG8_BAR
#undef PG8_SCHED
}
}

__device__ void transpose_convert(int gw, int nw, int lane, const float* W, int K, int N, int Npad, bf16_t* Wt, int ldt, const float* rowgain, const float* colgain) {
    const int kb_n = K / 16, units = kb_n * (Npad / 256);
    for (int u = gw; u < units; u += nw) {
        const int k0 = (u % kb_n) * 16, n = (u / kb_n) * 256 + 4 * lane;
        f32x4 v[16];
        if (n < N) {
#pragma unroll
            for (int i = 0; i < 16; ++i) v[i] = *(const f32x4*)(W + (size_t)(k0 + i) * N + n);
            if (rowgain) {
#pragma unroll
                for (int i = 0; i < 16; ++i) v[i] *= rowgain[k0 + i];
            }
            if (colgain) { const f32x4 cgv = *(const f32x4*)(colgain + n);
#pragma unroll
                for (int i = 0; i < 16; ++i) v[i] *= cgv; }
        } else {
#pragma unroll
            for (int i = 0; i < 16; ++i) v[i] = (f32x4){0.f, 0.f, 0.f, 0.f};
        }
#pragma unroll
        for (int j = 0; j < 4; ++j) {
            u32x4 w0, w1; w0.x = cvt_pk_bf16(v[0][j], v[1][j]); w0.y = cvt_pk_bf16(v[2][j], v[3][j]); w0.z = cvt_pk_bf16(v[4][j], v[5][j]); w0.w = cvt_pk_bf16(v[6][j], v[7][j]);
            w1.x = cvt_pk_bf16(v[8][j], v[9][j]); w1.y = cvt_pk_bf16(v[10][j], v[11][j]); w1.z = cvt_pk_bf16(v[12][j], v[13][j]); w1.w = cvt_pk_bf16(v[14][j], v[15][j]);
            u32x4* dst = (u32x4*)(Wt + (size_t)(n + j) * ldt + k0); dst[0] = w0; dst[1] = w1;
        }
    }
}

__device__ void phase_prologue(const Params& p, LAS unsigned char* lds, int wv) {
    unsigned char* ws = p.ws;
    const int tid = opaque_tid(wv), lane = tid & 63, wave = tid >> 6;
    const int gw = blockIdx.x * 8 + wave, nw = gridDim.x * 8;
    const size_t gtid = (size_t)blockIdx.x * 512 + tid, gsz = (size_t)gridDim.x * 512;
    float* ss = (float*)(ws + WS_SS);
    bf16_t* xb = (bf16_t*)(ws + WS_XB);
    for (int row2 = (blockIdx.x * 8 + wave) * 2; row2 < MTOK; row2 += gridDim.x * 16) {
        f32x4 xv[2][4];
#pragma unroll
        for (int k = 0; k < 2; ++k)
#pragma unroll
            for (int i = 0; i < 4; ++i) xv[k][i] = ((const f32x4*)(p.x + (size_t)(row2 + k) * DM))[lane + 64 * i];
#pragma unroll
        for (int k = 0; k < 2; ++k) { const int row = row2 + k; float sq = 0.f;
#pragma unroll
            for (int i = 0; i < 4; ++i) { const f32x4 v = xv[k][i]; sq += (v[0] * v[0] + v[1] * v[1]) + (v[2] * v[2] + v[3] * v[3]);
                u32x2 w; w.x = cvt_pk_bf16(v[0], v[1]); w.y = cvt_pk_bf16(v[2], v[3]); *(u32x2*)(xb + (size_t)row * DM + (lane + 64 * i) * 4) = w; }
            sq = wave_sum(sq);
            if (lane < 16) ss[(size_t)row * 16 + lane] = lane == 0 ? sq : 0.f; }
    }
    transpose_convert(gw, nw, lane, p.a_w_in, 1024, 2048, 2048, (bf16_t*)(ws + W_A_IN), 1024, p.norm_mix_g + 0 * DM, nullptr);
    transpose_convert(gw, nw, lane, p.a_w_out, 1024, 1024, 1024, (bf16_t*)(ws + W_A_OUT), 1024, nullptr, nullptr);
    transpose_convert(gw, nw, lane, p.b_w_in, 1024, 3072, 3072, (bf16_t*)(ws + W_B_IN), 1024, p.norm_mix_g + 1 * DM, nullptr);
    transpose_convert(gw, nw, lane, p.b_w_out, 1024, 1024, 1024, (bf16_t*)(ws + W_B_OUT), 1024, nullptr, nullptr);
    transpose_convert(gw, nw, lane, p.c_w_in, 1024, 1024, 1024, (bf16_t*)(ws + W_C_IN), 1024, p.norm_mix_g + 2 * DM, nullptr);
    for (int g = 0; g < 4; ++g)
        transpose_convert(gw, nw, lane, p.c_w_grp + (size_t)g * 65536, 256, 256, 256, (bf16_t*)(ws + W_C_GRP) + (size_t)g * 65536, 256, nullptr, p.c_scale + g * 256);
    transpose_convert(gw, nw, lane, p.d_w_in, 1024, 2760, DSA_LD, (bf16_t*)(ws + W_D_IN), 1024, p.norm_mix_g + 3 * DM, nullptr);
    for (int l = 0; l < 4; ++l) {
        transpose_convert(gw, nw, lane, p.mlp_w1 + (size_t)l * 4194304, 1024, 4096, 4096, (bf16_t*)(ws + W_1) + (size_t)l * 4194304, 1024, p.norm_mlp_g + l * DM, nullptr);
        transpose_convert(gw, nw, lane, p.mlp_w2 + (size_t)l * 4194304, 4096, 1024, 1024, (bf16_t*)(ws + W_2) + (size_t)l * 4194304, 4096, nullptr, nullptr);
    }
    { bf16_t* wsm = (bf16_t*)(ws + W_A_S);
      for (size_t i = gtid; i < (size_t)8 * 128 * 128; i += gsz) { const int s = (int)(i & 127), t = (int)((i >> 7) & 127); const float v = (s <= t) ? p.a_w_s[i] : 0.f; wsm[i] = (bf16_t)(cvt_pk_bf16(v, 0.f) & 0xffffu); } }
    { bf16_t* wc = (bf16_t*)(ws + W_D_COMB);
      for (int u = gw; u < 256 * 4; u += nw) {
          const int k0 = (u >> 2) * 8, n = (u & 3) * 256 + 4 * lane, h = k0 >> 7;
          const float* uv = p.d_w_uv + (size_t)k0 * 64; const float* wo = p.d_w_out + (size_t)h * 64 * 1024 + n;
          f32x4 a[8]; float uvr[8];
#pragma unroll
          for (int i = 0; i < 8; ++i) { a[i] = (f32x4){0.f, 0.f, 0.f, 0.f}; uvr[i] = uv[i * 64 + lane]; }
#pragma unroll 8
          for (int v = 0; v < 64; ++v) { const f32x4 w4 = *(const f32x4*)(wo + (size_t)v * 1024);
#pragma unroll
              for (int i = 0; i < 8; ++i) a[i] += w4 * __uint_as_float(__builtin_amdgcn_readlane(__float_as_uint(uvr[i]), v)); }
#pragma unroll
          for (int j = 0; j < 4; ++j) {
              u32x4 w; w.x = cvt_pk_bf16(a[0][j], a[1][j]); w.y = cvt_pk_bf16(a[2][j], a[3][j]); w.z = cvt_pk_bf16(a[4][j], a[5][j]); w.w = cvt_pk_bf16(a[6][j], a[7][j]);
              *(u32x4*)(wc + (size_t)(n + j) * 2048 + k0) = w; } } }
}

__device__ void phase_sgu(const Params& p, LAS unsigned char* lds, int wv) {
    unsigned char* ws = p.ws;
    const int tid = opaque_tid(wv), lane = tid & 63, wave = __builtin_amdgcn_readfirstlane(tid >> 6), g4 = lane >> 4, l15 = lane & 15, q = l15 >> 2, pp = lane & 3;
    const bf16_t* z = (const bf16_t*)(ws + WS_BIG); bf16_t* us = (bf16_t*)(ws + WS_BIG + 256 * MiB);
    const float* ssv = (const float*)(ws + WS_SS) + (size_t)9 * MTOK * 16; const bf16_t* wsm = (const bf16_t*)(ws + W_A_S);
    const unsigned ldsbase = (unsigned)(size_t)(unsigned char*)lds;
    u32x4 raw[4]; float ssum[4];
    if ((int)blockIdx.x < 4096) { const int g = blockIdx.x & 7; const size_t row0 = (size_t)(blockIdx.x >> 3) * 128;
#pragma unroll
        for (int i = 0; i < 4; ++i) { const int e = tid + 512 * i, r = e >> 4, ch = e & 15;
            raw[i] = *(const u32x4*)(z + (row0 + r) * 2048 + 1024 + g * 128 + ch * 8); ssum[i] = sum16(ssv + (row0 + r) * 16); } }
    for (int unit = blockIdx.x; unit < 4096; unit += gridDim.x) {
        const int g = unit & 7, chunk = unit >> 3; const size_t row0 = (size_t)chunk * 128;
#pragma unroll
        for (int i = 0; i < 4; ++i) {
            const int e = tid + 512 * i, r = e >> 4, ch = e & 15;
            const float rs = rsqrtf(ssum[i] * (1.0f / 1024.0f) + 1e-6f);
            const f32x4 g0 = *(const f32x4*)(p.a_v_g + g * 128 + ch * 8), g1 = *(const f32x4*)(p.a_v_g + g * 128 + ch * 8 + 4);
            u32x4 o;
            o.x = cvt_pk_bf16(bflo(raw[i].x) * rs * g0[0], bfhi(raw[i].x) * rs * g0[1]); o.y = cvt_pk_bf16(bflo(raw[i].y) * rs * g0[2], bfhi(raw[i].y) * rs * g0[3]);
            o.z = cvt_pk_bf16(bflo(raw[i].z) * rs * g1[0], bfhi(raw[i].z) * rs * g1[1]); o.w = cvt_pk_bf16(bflo(raw[i].w) * rs * g1[2], bfhi(raw[i].w) * rs * g1[3]);
            *(LAS u32x4*)(lds + (r >> 5) * 8192 + off_b(r & 31, ch)) = o;
        }
        __syncthreads();
        const int t = 16 * wave + l15, nks = (wave >> 1) + 1;
        const float bias = p.a_b_s[g * 128 + t]; const size_t rowg = row0 + t;
        u32x2 uu8[8]; bf16x8 Bw4[4];
#pragma unroll
        for (int ks = 0; ks < 4; ++ks) Bw4[ks] = *(const bf16x8*)(wsm + ((size_t)g * 128 + t) * 128 + 32 * (ks < nks ? ks : 0) + 8 * g4);
#pragma unroll
        for (int ct = 0; ct < 8; ++ct) uu8[ct] = *(const u32x2*)(z + rowg * 2048 + g * 128 + 16 * ct + 4 * g4);
        { const int nu = unit + (int)gridDim.x;
          if (nu < 4096) { const int g2 = nu & 7; const size_t r2 = (size_t)(nu >> 3) * 128;
#pragma unroll
              for (int i = 0; i < 4; ++i) { const int e = tid + 512 * i, r = e >> 4, ch = e & 15;
                  raw[i] = *(const u32x4*)(z + (r2 + r) * 2048 + 1024 + g2 * 128 + ch * 8); ssum[i] = sum16(ssv + (r2 + r) * 16); } } }
        f32x4 acc[8];
#pragma unroll
        for (int ct = 0; ct < 8; ++ct) acc[ct] = (f32x4){0.f, 0.f, 0.f, 0.f};
#pragma unroll
        for (int ks = 0; ks < 4; ++ks) {
            if (ks < nks) {
                const bf16x8 Bw = Bw4[ks];
#pragma unroll
                for (int cb = 0; cb < 2; ++cb) {
                    unsigned ad[8]; bf16x8 Av[4];
#pragma unroll
                    for (int i = 0; i < 4; ++i) { const int ct = 4 * cb + i;
                        ad[2 * i] = ldsbase + ks * 8192 + off_b(8 * g4 + q, 2 * ct + (pp >> 1)) + 8 * (pp & 1); ad[2 * i + 1] = ldsbase + ks * 8192 + off_b(8 * g4 + 4 + q, 2 * ct + (pp >> 1)) + 8 * (pp & 1); }
                    tr_read8(ad, Av);
#pragma unroll
                    for (int i = 0; i < 4; ++i) acc[4 * cb + i] = __builtin_amdgcn_mfma_f32_16x16x32_bf16(Av[i], Bw, acc[4 * cb + i], 0, 0, 0);
                }
            }
        }
#pragma unroll
        for (int ct = 0; ct < 8; ++ct) {
            const u32x2 uu = uu8[ct];
            u32x2 o; o.x = cvt_pk_bf16(bflo(uu.x) * (acc[ct][0] + bias), bfhi(uu.x) * (acc[ct][1] + bias)); o.y = cvt_pk_bf16(bflo(uu.y) * (acc[ct][2] + bias), bfhi(uu.y) * (acc[ct][3] + bias));
            *(u32x2*)(us + rowg * 1024 + g * 128 + 16 * ct + 4 * g4) = o;
        }
        __syncthreads();
    }
}

__device__ void phase_conv(const Params& p, int wv) {
    unsigned char* ws = p.ws; const bf16_t* bch = (const bf16_t*)(ws + WS_BIG); bf16_t* gated = (bf16_t*)(ws + WS_BIG + 384 * MiB);
    const size_t gtid = (size_t)blockIdx.x * 512 + opaque_tid(wv), gsz = (size_t)gridDim.x * 512;
    for (size_t it = gtid; it < (size_t)4096 * 128; it += gsz) {
        const int ch = (int)(it & 127) * 8, rb = (int)(it >> 7); const int r0 = rb * 16;
        float w0[8], w1[8], w2[8], zm2[8], zm1[8];
#pragma unroll
        for (int j = 0; j < 8; ++j) { w0[j] = p.b_conv_w[ch + j]; w1[j] = p.b_conv_w[1024 + ch + j]; w2[j] = p.b_conv_w[2048 + ch + j]; zm2[j] = 0.f; zm1[j] = 0.f; }
        const int tpos0 = r0 & (SEQ - 1);
        for (int d = 2; d >= 1; --d) {
            if (tpos0 - d >= 0) {
                const bf16_t* rp = bch + (size_t)(r0 - d) * 3072; const u32x4 c = *(const u32x4*)(rp + 1024 + ch), h = *(const u32x4*)(rp + 2048 + ch);
                float zz[8] = {bflo(c.x) * bflo(h.x), bfhi(c.x) * bfhi(h.x), bflo(c.y) * bflo(h.y), bfhi(c.y) * bfhi(h.y), bflo(c.z) * bflo(h.z), bfhi(c.z) * bfhi(h.z), bflo(c.w) * bflo(h.w), bfhi(c.w) * bfhi(h.w)};
#pragma unroll
                for (int j = 0; j < 8; ++j) { if (d == 2) zm2[j] = zz[j]; else zm1[j] = zz[j]; }
            }
        }
        for (int r4 = r0; r4 < r0 + 16; r4 += 4) {
            u32x4 bq[4], cq[4], hq[4];
#pragma unroll
            for (int k = 0; k < 4; ++k) { const bf16_t* rp = bch + (size_t)(r4 + k) * 3072; bq[k] = *(const u32x4*)(rp + ch); cq[k] = *(const u32x4*)(rp + 1024 + ch); hq[k] = *(const u32x4*)(rp + 2048 + ch); }
#pragma unroll
            for (int k = 0; k < 4; ++k) {
                const u32x4 b = bq[k], c = cq[k], h = hq[k];
                float zz[8] = {bflo(c.x) * bflo(h.x), bfhi(c.x) * bfhi(h.x), bflo(c.y) * bflo(h.y), bfhi(c.y) * bfhi(h.y), bflo(c.z) * bflo(h.z), bfhi(c.z) * bfhi(h.z), bflo(c.w) * bflo(h.w), bfhi(c.w) * bfhi(h.w)};
                float bb[8] = {bflo(b.x), bfhi(b.x), bflo(b.y), bfhi(b.y), bflo(b.z), bfhi(b.z), bflo(b.w), bfhi(b.w)};
                float o[8];
#pragma unroll
                for (int j = 0; j < 8; ++j) { o[j] = bb[j] * (w0[j] * zm2[j] + w1[j] * zm1[j] + w2[j] * zz[j]); zm2[j] = zm1[j]; zm1[j] = zz[j]; }
                u32x4 w; w.x = cvt_pk_bf16(o[0], o[1]); w.y = cvt_pk_bf16(o[2], o[3]); w.z = cvt_pk_bf16(o[4], o[5]); w.w = cvt_pk_bf16(o[6], o[7]);
                *(u32x4*)(gated + (size_t)(r4 + k) * 1024 + ch) = w;
            }
        }
    }
}

__device__ __forceinline__ void ld8(const bf16_t* ptr, float (&f)[8]) {
    const u32x4 v = *(const u32x4*)ptr; f[0] = bflo(v.x); f[1] = bfhi(v.x); f[2] = bflo(v.y); f[3] = bfhi(v.y); f[4] = bflo(v.z); f[5] = bfhi(v.z); f[6] = bflo(v.w); f[7] = bfhi(v.w);
}
__device__ void phase_pool(const Params& p, int wv) {
    unsigned char* ws = p.ws; const bf16_t* z = (const bf16_t*)(ws + WS_BIG); bf16_t* pooled = (bf16_t*)(ws + WS_BIG + 128 * MiB);
    const size_t gtid = (size_t)blockIdx.x * 512 + opaque_tid(wv), gsz = (size_t)gridDim.x * 512;
    for (size_t it = gtid; it < (size_t)2048 * 128; it += gsz) {
        const int lane = (int)(it & 63), wv = (int)(it >> 6), chunk = (wv & 3) * 32 + (lane & 31), rb = (wv >> 2) * 2 + (lane >> 5);
        const int ch = chunk * 8, w = 2 << (ch >> 8), r0 = rb * 32;
        float S[8];
#pragma unroll
        for (int j = 0; j < 8; ++j) S[j] = 0.f;
        const int tpos0 = r0 & (SEQ - 1);
        for (int d = 1; d <= w; ++d) {
            if (tpos0 - d >= 0) { float f[8]; ld8(z + (size_t)(r0 - d) * 1024 + ch, f);
#pragma unroll
                for (int j = 0; j < 8; ++j) S[j] += f[j]; }
        }
        for (int r4 = r0; r4 < r0 + 32; r4 += 4) {
            u32x4 fa[4], oa[4];
#pragma unroll
            for (int k = 0; k < 4; ++k) { const int r = r4 + k; fa[k] = *(const u32x4*)(z + (size_t)r * 1024 + ch);
                const int rr = ((r & (SEQ - 1)) - w >= 0) ? r - w : r; oa[k] = *(const u32x4*)(z + (size_t)rr * 1024 + ch); }
#pragma unroll
            for (int k = 0; k < 4; ++k) {
                const int r = r4 + k, tpos = r & (SEQ - 1);
                float f[8] = {bflo(fa[k].x), bfhi(fa[k].x), bflo(fa[k].y), bfhi(fa[k].y), bflo(fa[k].z), bfhi(fa[k].z), bflo(fa[k].w), bfhi(fa[k].w)};
#pragma unroll
                for (int j = 0; j < 8; ++j) S[j] += f[j];
                if (tpos - w >= 0) { float o[8] = {bflo(oa[k].x), bfhi(oa[k].x), bflo(oa[k].y), bfhi(oa[k].y), bflo(oa[k].z), bfhi(oa[k].z), bflo(oa[k].w), bfhi(oa[k].w)};
#pragma unroll
                    for (int j = 0; j < 8; ++j) S[j] -= o[j]; }
                const int cnt = (tpos + 1 < w) ? tpos + 1 : w; const float inv = 1.0f / (float)cnt;
                u32x4 o; o.x = cvt_pk_bf16(S[0] * inv - f[0], S[1] * inv - f[1]); o.y = cvt_pk_bf16(S[2] * inv - f[2], S[3] * inv - f[3]);
                o.z = cvt_pk_bf16(S[4] * inv - f[4], S[5] * inv - f[5]); o.w = cvt_pk_bf16(S[6] * inv - f[6], S[7] * inv - f[7]);
                *(u32x4*)(pooled + (size_t)r * 1024 + ch) = o;
            }
        }
    }
}

__device__ __forceinline__ int cnt_ge8(const unsigned* v, unsigned cand) {
    unsigned long long m0, m1, m2, m3, m4, m5, m6, m7;
    asm("v_cmp_le_u32_e64 %0, %8, %9\n\tv_cmp_le_u32_e64 %1, %8, %10\n\tv_cmp_le_u32_e64 %2, %8, %11\n\tv_cmp_le_u32_e64 %3, %8, %12\n\t"
        "v_cmp_le_u32_e64 %4, %8, %13\n\tv_cmp_le_u32_e64 %5, %8, %14\n\tv_cmp_le_u32_e64 %6, %8, %15\n\tv_cmp_le_u32_e64 %7, %8, %16"
        : "=&s"(m0), "=&s"(m1), "=&s"(m2), "=&s"(m3), "=&s"(m4), "=&s"(m5), "=&s"(m6), "=&s"(m7)
        : "s"(cand), "v"(v[0]), "v"(v[1]), "v"(v[2]), "v"(v[3]), "v"(v[4]), "v"(v[5]), "v"(v[6]), "v"(v[7]));
    return (__builtin_popcountll(m0) + __builtin_popcountll(m1)) + (__builtin_popcountll(m2) + __builtin_popcountll(m3)) +
           (__builtin_popcountll(m4) + __builtin_popcountll(m5)) + (__builtin_popcountll(m6) + __builtin_popcountll(m7));
}
__device__ __forceinline__ void hist_find(LAS unsigned* hist, int lane, int target, int& bin, int& above) {
    const u32x4 h = *(LAS u32x4*)(hist + 4 * lane);
    const int tot = (int)(h.x + h.y + h.z + h.w);
    int suf = tot;
    suf += __builtin_amdgcn_update_dpp(0, suf, 0x101, 0xf, 0xf, true);
    suf += __builtin_amdgcn_update_dpp(0, suf, 0x102, 0xf, 0xf, true);
    suf += __builtin_amdgcn_update_dpp(0, suf, 0x104, 0xf, 0xf, true);
    suf += __builtin_amdgcn_update_dpp(0, suf, 0x108, 0xf, 0xf, true);
    { const int r1 = __builtin_amdgcn_readlane(suf, 16), r2 = __builtin_amdgcn_readlane(suf, 32), r3 = __builtin_amdgcn_readlane(suf, 48); const int g = lane >> 4;
      suf += (g == 0) ? (r1 + r2 + r3) : (g == 1) ? (r2 + r3) : (g == 2) ? r3 : 0; }
    const int excl = suf - tot;
    const bool mine = (excl < target) && (suf >= target);
    int b, ab, c = excl;
    if (c + (int)h.w >= target) { b = 3; ab = c; } else { c += (int)h.w;
        if (c + (int)h.z >= target) { b = 2; ab = c; } else { c += (int)h.z;
            if (c + (int)h.y >= target) { b = 1; ab = c; } else { c += (int)h.y; b = 0; ab = c; } } }
    const unsigned long long m = __ballot(mine);
    const int src = m ? (int)__ffsll((long long)m) - 1 : 0;
    bin = __builtin_amdgcn_readlane(4 * lane + b, src); above = __builtin_amdgcn_readlane(ab, src);
}
__device__ void phase_topk(const Params& p, LAS unsigned char* lds, int wv) {
    unsigned char* ws = p.ws;
    const int tid = opaque_tid(wv), lane = tid & 63, wave = __builtin_amdgcn_readfirstlane(tid >> 6), g4 = lane >> 4, l15 = lane & 15;
    const bf16_t* din = (const bf16_t*)(ws + WS_BIG); bf16_t* cn = (bf16_t*)(ws + WS_CN); unsigned short* idx = (unsigned short*)(ws + WS_IDX);
    LAS unsigned short* S16 = (LAS unsigned short*)lds;
    constexpr int SROW = 4112;
    { const float kg0 = p.d_kv_g[2 * lane], kg1 = p.d_kv_g[2 * lane + 1];
      for (int row4 = (blockIdx.x * 8 + wave) * 4; row4 < MTOK; row4 += gridDim.x * 32) {
        unsigned raw[4];
#pragma unroll
        for (int j = 0; j < 4; ++j) raw[j] = *(const unsigned*)(din + (size_t)(row4 + j) * DSA_LD + 2048 + 2 * lane);
#pragma unroll
        for (int j = 0; j < 4; ++j) { const float a = bflo(raw[j]), b = bfhi(raw[j]);
            const float sq = wave_sum(a * a + b * b); const float rs = rsqrtf(sq * (1.0f / 128.0f) + 1e-6f);
            *(unsigned*)(cn + (size_t)(row4 + j) * 128 + 2 * lane) = cvt_pk_bf16(a * rs * kg0, b * rs * kg1); }
      } }
    for (int unit = blockIdx.x; unit < 4096; unit += gridDim.x) {
        const bool tiled = (4096 % (2 * (int)gridDim.x)) == 0;
        const int pi = tiled ? (unit / (2 * (int)gridDim.x)) * (int)gridDim.x + (unit % (int)gridDim.x) : (unit >> 1), hi = tiled ? (unit / (int)gridDim.x) & 1 : (unit & 1);
        const int b = pi >> 7, cc = pi & 127, qt = hi ? 255 - cc : cc, qpos0 = qt * 16; const size_t rowq0 = (size_t)b * SEQ + qpos0;
        bf16x8 Aq[8][2]; float wv[8][4];
#pragma unroll
        for (int pr = 0; pr < 8; ++pr) {
            const int qg = pr >> 1, hh = pr & 1;
            const bf16_t* base = din + (rowq0 + 4 * qg + (l15 >> 2)) * DSA_LD + 2176 + (4 * hh + (l15 & 3)) * 64;
            Aq[pr][0] = *(const bf16x8*)(base + 8 * g4); Aq[pr][1] = *(const bf16x8*)(base + 32 + 8 * g4);
            const u32x2 wr = *(const u32x2*)(din + (rowq0 + 4 * qg + g4) * DSA_LD + 2752 + 4 * hh);
            wv[pr][0] = bflo(wr.x) * 0.04419417382f; wv[pr][1] = bfhi(wr.x) * 0.04419417382f; wv[pr][2] = bflo(wr.y) * 0.04419417382f; wv[pr][3] = bfhi(wr.y) * 0.04419417382f;
        }
        const int nkt = (qpos0 + 15) / 16 + 1;
        {
        bf16x8 B0[4], B1[4], N0[4], N1[4];
        LAS unsigned char* kst = lds + LDS_STG + wave * 2304;
#pragma unroll
        for (int j = 0; j < 4; ++j) { const int kt = (wave + 8 * j < nkt) ? wave + 8 * j : 0;
            const bf16_t* kb = din + ((size_t)b * SEQ + 16 * kt + (lane >> 3)) * DSA_LD + 2688 + 8 * (lane & 7);
            B0[j] = *(const bf16x8*)(kb); B1[j] = *(const bf16x8*)(kb + (size_t)8 * DSA_LD); }
        for (int kt0 = wave; kt0 < nkt; kt0 += 32) {
#pragma unroll
            for (int j = 0; j < 4; ++j) { const int kt = (kt0 + 32 + 8 * j < nkt) ? kt0 + 32 + 8 * j : 0;
                const bf16_t* kb = din + ((size_t)b * SEQ + 16 * kt + (lane >> 3)) * DSA_LD + 2688 + 8 * (lane & 7);
                N0[j] = *(const bf16x8*)(kb); N1[j] = *(const bf16x8*)(kb + (size_t)8 * DSA_LD); }
#pragma unroll
            for (int j = 0; j < 4; ++j) {
                const int kt = kt0 + 8 * j;
                if (kt < nkt) {
                    *(LAS bf16x8*)(kst + (lane >> 3) * 144 + (lane & 7) * 16) = B0[j]; *(LAS bf16x8*)(kst + (8 + (lane >> 3)) * 144 + (lane & 7) * 16) = B1[j];
                    const bf16x8 F0 = *(const LAS bf16x8*)(kst + l15 * 144 + g4 * 16), F1 = *(const LAS bf16x8*)(kst + l15 * 144 + 64 + g4 * 16);
#pragma unroll
                    for (int qg = 0; qg < 4; ++qg) {
                        float part = 0.f;
#pragma unroll
                        for (int hh = 0; hh < 2; ++hh) {
                            const int pr = 2 * qg + hh;
                            f32x4 c = (f32x4){0.f, 0.f, 0.f, 0.f};
                            c = __builtin_amdgcn_mfma_f32_16x16x32_bf16(Aq[pr][0], F0, c, 0, 0, 0);
                            c = __builtin_amdgcn_mfma_f32_16x16x32_bf16(Aq[pr][1], F1, c, 0, 0, 0);
                            part += (fmaxf(c[0], 0.f) * wv[pr][0] + fmaxf(c[1], 0.f) * wv[pr][1]) + (fmaxf(c[2], 0.f) * wv[pr][2] + fmaxf(c[3], 0.f) * wv[pr][3]);
                        }
                        const _Float16 hsc = (_Float16)(part + 0.0f);
                        S16[(4 * qg + g4) * SROW + 16 * kt + l15] = __builtin_bit_cast(unsigned short, hsc);
                    }
                }
            }
#pragma unroll
            for (int j = 0; j < 4; ++j) { B0[j] = N0[j]; B1[j] = N1[j]; }
        }
        }
        __syncthreads();
        for (int qi2 = 0; qi2 < 2; ++qi2) {
            const int ql = wave + 8 * qi2;
            const int qpos = qpos0 + ql, n = qpos + 1; unsigned short* out = idx + (rowq0 + ql) * 256;
            int lk = lane; asm volatile("" : "+v"(lk));
            if (n <= 256) {
#pragma unroll
                for (int i = 0; i < 4; ++i) { const int j = lane + 64 * i; out[j] = (unsigned short)(j < n ? j : 0xFFFF); }
            } else {
                const int ni4 = (((n + 63) >> 6) + 3) & ~3;
                const LAS unsigned short* srow = S16 + ql * SROW;
                LAS unsigned* hist = (LAS unsigned*)(lds + 131600 + wave * 1024);
                LAS unsigned short* orow = (LAS unsigned short*)(lds + 139792 + wave * 512);
#define TOPK_KEY(i_) ({ const int key_ = lk + 64 * (i_); unsigned b_ = srow[key_]; b_ ^= (b_ & 0x8000u) ? 0xFFFFu : 0x8000u; (key_ < n) ? b_ : 0u; })
                int b1, above1, b2, above2;
                *(LAS u32x4*)(hist + 4 * lane) = (u32x4){0u, 0u, 0u, 0u};
                for (int i0 = 0; i0 < ni4; i0 += 4) {
#pragma unroll
                    for (int j = 0; j < 4; ++j) { const unsigned uk = TOPK_KEY(i0 + j); (void)__hip_atomic_fetch_add(hist + (uk >> 8), 1u, __ATOMIC_RELAXED, __HIP_MEMORY_SCOPE_WORKGROUP); }
                }
                hist_find(hist, lane, 256, b1, above1);
                *(LAS u32x4*)(hist + 4 * lane) = (u32x4){0u, 0u, 0u, 0u};
                for (int i0 = 0; i0 < ni4; i0 += 4) {
#pragma unroll
                    for (int j = 0; j < 4; ++j) { const unsigned uk = TOPK_KEY(i0 + j); if ((int)(uk >> 8) == b1) (void)__hip_atomic_fetch_add(hist + (uk & 255u), 1u, __ATOMIC_RELAXED, __HIP_MEMORY_SCOPE_WORKGROUP); }
                }
                hist_find(hist, lane, 256 - above1, b2, above2);
                const unsigned T = ((unsigned)b1 << 8) | (unsigned)b2;
                const int G = above1 + above2;
                const int need = 256 - G; int base = 0, tie_seen = 0;
                const unsigned long long ltmask = (1ull << lane) - 1ull;
                for (int i0 = 0; i0 < ni4; i0 += 4) {
#pragma unroll
                    for (int j = 0; j < 4; ++j) {
                        const unsigned uk = TOPK_KEY(i0 + j);
                        const bool gt = uk > T, eq = uk == T;
                        const unsigned long long meq = __ballot(eq);
                        const bool sel = gt || (eq && (tie_seen + __popcll(meq & ltmask)) < need);
                        const unsigned long long msel = __ballot(sel);
                        if (sel) orow[base + __popcll(msel & ltmask)] = (unsigned short)(lk + 64 * (i0 + j));
                        base += __popcll(msel); tie_seen += __popcll(meq);
                    }
                }
#undef TOPK_KEY
                *(u32x2*)(out + 4 * lane) = *(LAS u32x2*)(orow + 4 * lane);
            }
        }
        __syncthreads();
    }
}

__device__ void phase_attn(const Params& p, LAS unsigned char* lds, bool dry, int wv) {
    unsigned char* ws = p.ws;
    const int tid = opaque_tid(wv), lane = tid & 63, wave = __builtin_amdgcn_readfirstlane(tid >> 6), g4 = lane >> 4, l15 = lane & 15, q = l15 >> 2, pp = lane & 3;
    bf16_t* din = (bf16_t*)(ws + WS_BIG); const bf16_t* cn = (const bf16_t*)(ws + WS_CN); const unsigned short* idx = (const unsigned short*)(ws + WS_IDX);
    LAS unsigned char* wl = lds + wave * 8192; const unsigned wbase = (unsigned)(size_t)(unsigned char*)lds + wave * 8192;
    const float scale = 0.08838834764f;
    for (int Q = blockIdx.x * 8 + wave; Q < MTOK; Q += gridDim.x * 8) {
        const int b = Q >> 12, qpos = Q & (SEQ - 1); const int nvalid = qpos + 1 < 256 ? qpos + 1 : 256;
        bf16_t* qrow = din + (size_t)Q * DSA_LD;
        bf16x8 Bq[4];
#pragma unroll
        for (int s = 0; s < 4; ++s) Bq[s] = *(const bf16x8*)(qrow + l15 * 128 + 32 * s + 8 * g4);
        f32x4 O[8];
#pragma unroll
        for (int mt = 0; mt < 8; ++mt) O[mt] = (f32x4){0.f, 0.f, 0.f, 0.f};
        float mrun = -1e30f, lrun = 0.f;
        unsigned kid[16];
#pragma unroll
        for (int i = 0; i < 16; ++i) { const int slot = i * 16 + (lane >> 2); const unsigned v = idx[(size_t)Q * 256 + slot]; kid[i] = slot < nvalid ? v : 0u; }
        bf16x8 A[2][4], An[2][4];
#pragma unroll
        for (int tl = 0; tl < 2; ++tl) { const bf16_t* crow = cn + ((size_t)b * SEQ + kid[tl]) * 128;
#pragma unroll
            for (int s = 0; s < 4; ++s) A[tl][s] = *(const bf16x8*)(crow + 32 * s + 8 * (lane & 3)); }
#pragma unroll
        for (int ck = 0; ck < 8; ++ck) {
            if (ck * 32 < nvalid) {
                if (ck < 7) {
#pragma unroll
                    for (int tl = 0; tl < 2; ++tl) { const bf16_t* crow = cn + ((size_t)b * SEQ + kid[(ck < 7 ? ck + 1 : ck) * 2 + tl]) * 128;
#pragma unroll
                        for (int s = 0; s < 4; ++s) An[tl][s] = *(const bf16x8*)(crow + 32 * s + 8 * (lane & 3)); }
                }
#pragma unroll
                for (int tl = 0; tl < 2; ++tl)
#pragma unroll
                    for (int s = 0; s < 4; ++s) *(LAS bf16x8*)(wl + off_b(16 * tl + (lane >> 2), 4 * s + (lane & 3))) = A[tl][s];
                bf16x8 Af[2][4];
#pragma unroll
                for (int tl = 0; tl < 2; ++tl)
#pragma unroll
                    for (int s = 0; s < 4; ++s) Af[tl][s] = *(const LAS bf16x8*)(wl + off_b(16 * tl + l15, 4 * s + g4));
                f32x4 S0 = (f32x4){0.f, 0.f, 0.f, 0.f}, S1 = (f32x4){0.f, 0.f, 0.f, 0.f};
#pragma unroll
                for (int s = 0; s < 4; ++s) { S0 = __builtin_amdgcn_mfma_f32_16x16x32_bf16(Af[0][s], Bq[s], S0, 0, 0, 0); S1 = __builtin_amdgcn_mfma_f32_16x16x32_bf16(Af[1][s], Bq[s], S1, 0, 0, 0); }
                float sv[8];
#pragma unroll
                for (int j = 0; j < 4; ++j) { const int s0 = ck * 32 + 4 * g4 + j; sv[j] = s0 < nvalid ? S0[j] * scale : -1e30f; sv[4 + j] = (s0 + 16) < nvalid ? S1[j] * scale : -1e30f; }
                float cm = fmaxf(fmaxf(fmaxf(sv[0], sv[1]), fmaxf(sv[2], sv[3])), fmaxf(fmaxf(sv[4], sv[5]), fmaxf(sv[6], sv[7])));
                cm = xrow16_max(cm);
                const float mn = fmaxf(mrun, cm), alpha = __expf(mrun - mn);
                float pv[8], ps = 0.f;
#pragma unroll
                for (int j = 0; j < 8; ++j) { pv[j] = __expf(sv[j] - mn); ps += pv[j]; }
                lrun = lrun * alpha + ps; mrun = mn;
#pragma unroll
                for (int mt = 0; mt < 8; ++mt) O[mt] *= alpha;
                union { u32x4 u; bf16x8 h; } Pb;
                Pb.u.x = cvt_pk_bf16(pv[0], pv[1]); Pb.u.y = cvt_pk_bf16(pv[2], pv[3]); Pb.u.z = cvt_pk_bf16(pv[4], pv[5]); Pb.u.w = cvt_pk_bf16(pv[6], pv[7]);
                asm volatile("s_waitcnt lgkmcnt(0)" ::: "memory");
#pragma unroll
                for (int mb = 0; mb < 2; ++mb) {
                    unsigned ad[8]; bf16x8 Av[4];
#pragma unroll
                    for (int i = 0; i < 4; ++i) { const int mt = 4 * mb + i;
                        ad[2 * i] = wbase + off_b(4 * g4 + q, 2 * mt + (pp >> 1)) + 8 * (pp & 1); ad[2 * i + 1] = wbase + off_b(16 + 4 * g4 + q, 2 * mt + (pp >> 1)) + 8 * (pp & 1); }
                    tr_read8(ad, Av);
#pragma unroll
                    for (int i = 0; i < 4; ++i) O[4 * mb + i] = __builtin_amdgcn_mfma_f32_16x16x32_bf16(Av[i], Pb.h, O[4 * mb + i], 0, 0, 0);
                }
                if (ck < 7) {
#pragma unroll
                    for (int tl = 0; tl < 2; ++tl)
#pragma unroll
                        for (int s = 0; s < 4; ++s) A[tl][s] = An[tl][s];
                }
            }
        }
        lrun = xrow16_sum(lrun);
        const float inv = 1.0f / lrun;
#pragma unroll
        for (int mt = 0; mt < 8; ++mt) {
            u32x2 o; o.x = cvt_pk_bf16(O[mt][0] * inv, O[mt][1] * inv); o.y = cvt_pk_bf16(O[mt][2] * inv, O[mt][3] * inv);
            if (!dry) *(u32x2*)(qrow + l15 * 128 + 16 * mt + 4 * g4) = o;
        }
    }
}

__device__ void phase_final(const Params& p, int wv) {
    const int tid = opaque_tid(wv); const int lane = tid & 63, wave = tid >> 6;
    const float* ss = (const float*)(p.ws + WS_SS) + (size_t)8 * MTOK * 16; const bf16_t* xb = (const bf16_t*)(p.ws + WS_XB);
    for (int row = blockIdx.x * 8 + wave; row < MTOK; row += gridDim.x * 8) {
        const float rs = rsqrtf(sum16(ss + (size_t)row * 16) * (1.0f / 1024.0f) + 1e-6f);
        f32x4* orow = (f32x4*)(p.out + (size_t)row * DM);
#pragma unroll
        for (int i = 0; i < 4; ++i) { const f32x4 g = *(const f32x4*)(p.final_g + (lane + 64 * i) * 4); const u32x2 xw = *(const u32x2*)(xb + (size_t)row * DM + (lane + 64 * i) * 4);
            f32x4 v = (f32x4){bflo(xw.x), bfhi(xw.x), bflo(xw.y), bfhi(xw.y)}; v = v * rs * g; orow[lane + 64 * i] = v; }
    }
}

#define XB_TMO      128
#define XB_XCNT(j)  (256  + 64 * (j))
#define XB_XSUB(j)  (1280 + 64 * (j))
#define XB_XGEN(j)  (2304 + 64 * (j))
#define XB_TOP      3328
#define XB_TOPGEN   3392
#define XCD_BAR_WORDS 3456
#define XB_SPIN_CAP (1u << 20)
__device__ __forceinline__ unsigned xb_ld(unsigned* p)              { return __hip_atomic_load(p, __ATOMIC_RELAXED, __HIP_MEMORY_SCOPE_AGENT); }
__device__ __forceinline__ unsigned xb_add(unsigned* p, unsigned v) { return __hip_atomic_fetch_add(p, v, __ATOMIC_RELAXED, __HIP_MEMORY_SCOPE_AGENT); }
__device__ __forceinline__ unsigned xb_xcc_id() { return (unsigned)__builtin_amdgcn_s_getreg((3 << 11) | 20) & 0xFu; }
#define XB_SPIN(cond, bar) do { unsigned _sp = 0; while (cond) { __builtin_amdgcn_s_sleep(1); \
    if ((++_sp & 255u) == 0u) { if (xb_ld(&(bar)[XB_TMO])) break; if (_sp > XB_SPIN_CAP) { atomicAdd(&(bar)[XB_TMO], 1u); break; } } } } while (0)
struct XcdBarrier { unsigned* bar; unsigned x; volatile LAS unsigned* st; };
__device__ __forceinline__ XcdBarrier xcd_barrier_post(unsigned* bar, volatile LAS unsigned* st, bool is_t0) {
    XcdBarrier b; b.bar = bar; b.x = xb_xcc_id(); b.st = st;
    if (is_t0) (void)xb_add(&bar[XB_XCNT(b.x)], 1u);
    return b;
}
__device__ __forceinline__ void xcd_barrier_complete(unsigned* bar, unsigned x, unsigned& nloc, unsigned& nx) {
    const unsigned G = gridDim.x * gridDim.y * gridDim.z;
    unsigned sum, cnt, mine, sp = 0u;
    for (;;) {
        sum = 0u; cnt = 0u; mine = 0u;
#pragma unroll
        for (unsigned j = 0; j < 16; ++j) { const unsigned c = xb_ld(&bar[XB_XCNT(j)]); sum += c; cnt += (c > 0u) ? 1u : 0u; mine = (j == x) ? c : mine; }
        if (sum == G) break;
        __builtin_amdgcn_s_sleep(1);
        if ((++sp & 255u) == 0u) { if (xb_ld(&bar[XB_TMO])) break; if (sp > XB_SPIN_CAP) { atomicAdd(&bar[XB_TMO], 1u); break; } }
    }
    nloc = mine > 0u ? mine : 1u; nx = cnt > 0u ? cnt : 1u;
}
__device__ __forceinline__ void xcd_barrier(const XcdBarrier& b, bool is_t0) {
    asm volatile("s_waitcnt vmcnt(0)" ::: "memory");
    __syncthreads();
    if (is_t0) {
        unsigned* bar = b.bar;
        __builtin_amdgcn_s_waitcnt(0);
        unsigned nloc = b.st[0], nx = b.st[1];
        if (nloc == 0u) { xcd_barrier_complete(bar, b.x, nloc, nx); b.st[0] = nloc; b.st[1] = nx; }
        const unsigned old = xb_add(&bar[XB_XSUB(b.x)], 1u);
        const unsigned gen = old / nloc;
        if (old + 1u == (gen + 1u) * nloc) {
            __builtin_amdgcn_fence(__ATOMIC_RELEASE, "agent");
            asm volatile("s_waitcnt vmcnt(0)" ::: "memory");
            const unsigned og = xb_add(&bar[XB_TOP], 1u);
            const unsigned tg = og / nx;
            if (og + 1u == (tg + 1u) * nx) xb_add(&bar[XB_TOPGEN], 1u);
            else XB_SPIN(xb_ld(&bar[XB_TOPGEN]) == tg, bar);
            __builtin_amdgcn_fence(__ATOMIC_ACQUIRE, "agent");
            xb_add(&bar[XB_XGEN(b.x)], 1u);
            asm volatile("s_waitcnt vmcnt(0)" ::: "memory");
        } else {
            XB_SPIN(xb_ld(&bar[XB_XGEN(b.x)]) == gen, bar);
            __builtin_amdgcn_fence(__ATOMIC_ACQUIRE, "agent");
            asm volatile("s_waitcnt vmcnt(0)" ::: "memory");
        }
    }
    __syncthreads();
}

enum { K_PRO = 0, K_GACT, K_GRES, K_SGU, K_CONV, K_POOL, K_TOPK, K_ATTN, K_FINAL };
struct PhaseDesc { int kind, act, lda, apn, N, K, ldc, ss_idx, m0, M; size_t a_off, w_off; };
__device__ __forceinline__ PhaseDesc mk_act(int act, size_t w_off, int N, int ss_idx) { PhaseDesc d{}; d.kind = K_GACT; d.act = act; d.lda = 1024; d.apn = 0; d.N = N; d.K = 1024; d.ldc = N; d.ss_idx = ss_idx; d.m0 = 0; d.M = MTOK; d.a_off = WS_XB; d.w_off = w_off; return d; }
__device__ __forceinline__ PhaseDesc mk_res(size_t a_off, int lda, int apn, size_t w_off, int K, int ss_idx) { PhaseDesc d{}; d.kind = K_GRES; d.lda = lda; d.apn = apn; d.N = 1024; d.K = K; d.ss_idx = ss_idx; d.m0 = 0; d.M = MTOK; d.a_off = a_off; d.w_off = w_off; return d; }
__device__ __forceinline__ PhaseDesc mk_kind(int kind) { PhaseDesc d{}; d.kind = kind; return d; }
constexpr int MLP_Q = 4, MQ = MTOK / MLP_Q;
__device__ __forceinline__ PhaseDesc mk_mlp(int l, int j) {
    const int q = j >> 1;
    if ((j & 1) == 0) { PhaseDesc d = mk_act(2, W_1 + (size_t)l * 8 * MiB, 4096, 2 * l + 1); d.m0 = q * MQ; d.M = MQ; d.a_off = WS_XB + (size_t)q * MQ * 1024 * 2; return d; }
    PhaseDesc d = mk_res(WS_BIG, 4096, 0, W_2 + (size_t)l * 8 * MiB, 4096, 2 * l + 2); d.m0 = q * MQ; d.M = MQ; return d;
}
__device__ __forceinline__ PhaseDesc phase_desc(int ph) {
    if (ph >= 4 && ph < 12) return mk_mlp(0, ph - 4);
    if (ph >= 15 && ph < 23) return mk_mlp(1, ph - 15);
    if (ph >= 26 && ph < 34) return mk_mlp(2, ph - 26);
    if (ph >= 38 && ph < 46) return mk_mlp(3, ph - 38);
    switch (ph) {
    case 0: return mk_kind(K_PRO);
    case 1: return mk_act(1, W_A_IN, 2048, 0);
    case 2: return mk_kind(K_SGU);
    case 3: return mk_res(WS_BIG + 256 * MiB, 1024, 0, W_A_OUT, 1024, 1);
    case 12: return mk_act(0, W_B_IN, 3072, 2);
    case 13: return mk_kind(K_CONV);
    case 14: return mk_res(WS_BIG + 384 * MiB, 1024, 0, W_B_OUT, 1024, 3);
    case 23: return mk_act(0, W_C_IN, 1024, 4);
    case 24: return mk_kind(K_POOL);
    case 25: return mk_res(WS_BIG + 128 * MiB, 1024, 512, W_C_GRP, 256, 5);
    case 34: return mk_act(0, W_D_IN, DSA_LD, 6);
    case 35: return mk_kind(K_TOPK);
    case 36: return mk_kind(K_ATTN);
    case 37: return mk_res(WS_BIG, DSA_LD, 0, W_D_COMB, 2048, 7);
    default: return mk_kind(K_FINAL);
    }
}

__device__ __forceinline__ void run_phase(int ph, const Params& p, LAS unsigned char* lds, bool dry, int wv) {
    const PhaseDesc d = phase_desc(ph);
    unsigned char* ws = p.ws; float* ss = (float*)(ws + WS_SS);
    if (d.kind == K_GACT || d.kind == K_GRES) {
        pg8::Gemm g; g.A = (const bf16_t*)(ws + d.a_off); g.Bt = (const bf16_t*)(ws + d.w_off); g.M = d.M; g.N = d.N; g.K = d.K; g.lda = d.lda; g.apn = d.apn;
        pg8::StaticOrder S; S.init(d.M, d.N, gridDim.x, blockIdx.x);
        if (d.kind == K_GACT) { pg8::EpiAct E; E.O = (bf16_t*)(ws + WS_BIG); E.ldc = d.ldc; E.ss_in = ss + ((size_t)d.ss_idx * MTOK + d.m0) * 16; E.ssv = ss + (size_t)9 * MTOK * 16; E.ACT = d.act; E.rstab = (const LAS float*)(lds + LDS_STG);
            pg8::act_rs_table((LAS float*)(lds + LDS_STG), S, E.ss_in, opaque_tid(wv)); pg8::gemm_phase(lds, g, S, E, wv); }
        else { pg8::EpiResid E; E.xb = (bf16_t*)(ws + WS_XB) + (size_t)d.m0 * DM; E.ss_out = ss + ((size_t)d.ss_idx * MTOK + d.m0) * 16; pg8::gemm_phase(lds, g, S, E, wv); }
    }
    else if (d.kind == K_PRO) phase_prologue(p, lds, wv);
    else if (d.kind == K_SGU) phase_sgu(p, lds, wv);
    else if (d.kind == K_CONV) phase_conv(p, wv);
    else if (d.kind == K_POOL) phase_pool(p, wv);
    else if (d.kind == K_TOPK) phase_topk(p, lds, wv);
    else if (d.kind == K_ATTN) phase_attn(p, lds, dry, wv);
    else phase_final(p, wv);
}

__global__ void __launch_bounds__(512, 2) fwd_megakernel(Params p) {
    extern __shared__ __attribute__((aligned(16))) unsigned char lds_raw[];
    LAS unsigned char* lds = (LAS unsigned char*)lds_raw;
    const int wv = __builtin_amdgcn_readfirstlane((int)threadIdx.x >> 6);
    volatile LAS unsigned* bst = (volatile LAS unsigned*)(lds + 131584);
    XcdBarrier xbar; xbar.bar = (unsigned*)(p.ws + WS_BAR); xbar.x = 0; xbar.st = bst;
    if (p.ph_hi - p.ph_lo > 1) {
        if (threadIdx.x == 0) { bst[0] = 0u; bst[1] = 0u; }
        if (blockIdx.x == 0) { unsigned* bw = (unsigned*)(p.ws + WS_BAR); for (int i = threadIdx.x; i < XCD_BAR_WORDS; i += 512) bw[i] = 0u; }
        __syncthreads();
    }
    for (int ph = p.ph_lo; ph < p.ph_hi; ++ph) {
#if PROBE_DUP
        const int reps = ((PROBE_DUP >> ph) & 1) ? 2 : 1;
        for (int r = 0; r < reps; ++r) { run_phase(ph, p, lds, r + 1 < reps, wv); if (r + 1 < reps) cg::this_grid().sync(); }
#else
        run_phase(ph, p, lds, false, wv);
#endif
        if (ph + 1 < p.ph_hi) {
            if (ph == p.ph_lo) { cg::this_grid().sync(); xbar = xcd_barrier_post((unsigned*)(p.ws + WS_BAR), bst, opaque_tid(wv) == 0); }
            else xcd_barrier(xbar, opaque_tid(wv) == 0);
        }
    }
}

#ifndef MK_MULTI
#define MK_MULTI 0
#endif

extern "C" void kernel_launch(void* const* d_in, const int* in_sizes, int n_in, void* d_out, int out_size, void* d_ws, size_t ws_size, hipStream_t stream) {
    static int grid = 0;
    if (grid == 0) {
        int dev = 0, cus = 0, per_cu = 0;
        hipGetDevice(&dev);
        hipDeviceGetAttribute(&cus, hipDeviceAttributeMultiprocessorCount, dev);
        if (hipFuncSetAttribute((const void*)fwd_megakernel, hipFuncAttributeMaxDynamicSharedMemorySize, LDS_BYTES) != hipSuccess) { fprintf(stderr, "hipFuncSetAttribute failed\n"); grid = -1; return; }
        if (hipOccupancyMaxActiveBlocksPerMultiprocessor(&per_cu, (const void*)fwd_megakernel, 512, LDS_BYTES) != hipSuccess || per_cu < 1) { fprintf(stderr, "occupancy query: %d\n", per_cu); per_cu = 1; }
        (void)hipGetLastError();
        grid = cus * (per_cu > 1 ? 1 : per_cu);
        if (ws_size < 840 * MiB) { fprintf(stderr, "workspace too small\n"); grid = -1; return; }
    }
    if (grid < 0) return;
    Params p{};
    const float** pp = (const float**)&p;
    for (int i = 0; i < 21; ++i) pp[i] = (const float*)d_in[i];
    p.out = (float*)d_out; p.ws = (unsigned char*)d_ws;
#if MK_MULTI
    for (int ph = 0; ph < NPHASE; ++ph) {
        p.ph_lo = ph; p.ph_hi = ph + 1;
        hipLaunchKernelGGL(fwd_megakernel, dim3(grid), dim3(512), LDS_BYTES, stream, p);
    }
#else
    p.ph_lo = 0; p.ph_hi = NPHASE;
    void* args[] = {&p};
    hipError_t e = hipLaunchCooperativeKernel((const void*)fwd_megakernel, dim3(grid), dim3(512), args, LDS_BYTES, stream);
    if (e != hipSuccess) fprintf(stderr, "cooperative launch failed: %s (grid %d)\n", hipGetErrorString(e), grid);
#endif
}
```
